# Optimizing an MI355X kernel written in HIP

```python
import math
import jax
import jax.numpy as jnp
from jax import lax
import numpy as np

D_MODEL = 1024
BATCH = 8
SEQ = 2048
DEPTH = 2

GRID_W = 64
CTX_LEN = 256
N_EVEN = (DEPTH + 1) // 2
N_ODD = DEPTH // 2
N_MOD = 6
EPS = 1e-6
F32 = jnp.float32

A_HEADS = 8
A_KV_HEADS = 2
A_GROUP = A_HEADS // A_KV_HEADS
A_HEAD_DIM = 64
A_Q = A_HEADS * A_HEAD_DIM
A_KV = A_KV_HEADS * A_HEAD_DIM
A_IN = A_Q + 2 * A_KV
A_BLOCK = 128
ROPE_THETA = 10000.0

B_HEADS = 8
B_HEAD_DIM = 64
B_WIDTH = B_HEADS * B_HEAD_DIM
B_DECAY_LORA = 64
B_AAA_LORA = 64
B_GATE_LORA = 128
B_IN = 3 * B_WIDTH + B_DECAY_LORA + B_AAA_LORA + B_GATE_LORA
B_GN_EPS = 64e-5

EVEN_IN = A_IN + B_IN
EVEN_MIX = A_Q + B_WIDTH

C_INNER = 2 * D_MODEL
C_HEAD_DIM = 64
C_HEADS = C_INNER // C_HEAD_DIM
C_GROUPS = 4
C_STATE = 128
C_CONV = 3
C_CHUNK = 128
C_CONV_DIM = C_INNER + 2 * C_GROUPS * C_STATE
ODD_IN = C_INNER + C_CONV_DIM + 2 * C_HEADS

P_HEADS = 8
P_KEYS = 128
P_EXPERTS = P_KEYS * P_KEYS
P_KEY_DIM = 128
P_TOPK = 16
P_BLOCK = 128

kernel_name = 'hybrid_gqa_rwkv7_ssd_peer_dit'


def _rmsnorm(x, gain):
    xf = x.astype(F32)
    y = xf * lax.rsqrt(jnp.mean(xf * xf, axis=-1, keepdims=True) + EPS)
    return (y * gain.astype(F32)).astype(x.dtype)


def _axial_angles(rows):
    t = jnp.arange(rows * GRID_W)
    row = (t // GRID_W).astype(F32)
    col = (t % GRID_W).astype(F32)
    m = A_HEAD_DIM // 4
    inv = ROPE_THETA ** (-jnp.arange(m, dtype=F32) / m)
    return row[:, None] * inv, col[:, None] * inv


def _rope_half(x, ang):
    m = x.shape[-1] // 2
    x1, x2 = x[..., :m], x[..., m:]
    cos, sin = jnp.cos(ang), jnp.sin(ang)
    return jnp.concatenate([x1 * cos - x2 * sin, x2 * cos + x1 * sin], axis=-1)


def _rope_2d(x, ang_r, ang_c):
    shape = (ang_r.shape[0],) + (1,) * (x.ndim - 3) + (ang_r.shape[1],)
    xf = x.astype(F32)
    half = A_HEAD_DIM // 2
    out = jnp.concatenate([_rope_half(xf[..., :half], ang_r.reshape(shape)),
                           _rope_half(xf[..., half:], ang_c.reshape(shape))], axis=-1)
    return out.astype(x.dtype)


def _attend(q, k, v):
    s = jnp.einsum('bqhgd,bkhd->bhgqk', q, k, preferred_element_type=F32) * (A_HEAD_DIM ** -0.5)
    p = jax.nn.softmax(s, axis=-1).astype(v.dtype)
    return jnp.einsum('bhgqk,bkhd->bqhgd', p, v)


def _gqa_mixer(zc, zl, q_gain, k_gain, ang_r, ang_c, with_ctx):
    bsz, lc, _ = zc.shape
    seq = zl.shape[1]

    def qkv(z):
        n = z.shape[1]
        q = _rmsnorm(z[..., :A_Q].reshape(bsz, n, A_KV_HEADS, A_GROUP, A_HEAD_DIM), q_gain)
        k = _rmsnorm(z[..., A_Q:A_Q + A_KV].reshape(bsz, n, A_KV_HEADS, A_HEAD_DIM), k_gain)
        v = z[..., A_Q + A_KV:].reshape(bsz, n, A_KV_HEADS, A_HEAD_DIM)
        return q, k, v

    qc, kc, vc = qkv(zc)
    ql, kl, vl = qkv(zl)
    ql = _rope_2d(ql, ang_r, ang_c)
    kl = _rope_2d(kl, ang_r, ang_c)
    k_all = jnp.concatenate([kc, kl], axis=1)
    v_all = jnp.concatenate([vc, vl], axis=1)
    nb = seq // A_BLOCK
    qb = jnp.moveaxis(ql.reshape(bsz, nb, A_BLOCK, A_KV_HEADS, A_GROUP, A_HEAD_DIM), 1, 0)
    ol = lax.map(lambda qblk: _attend(qblk, k_all, v_all), qb)
    ol = jnp.moveaxis(ol, 0, 1).reshape(bsz, seq, A_Q)
    oc = _attend(qc, kc, vc).reshape(bsz, lc, A_Q) if with_ctx else None
    return oc, ol


def _centred_shift(z):
    zp = jnp.pad(z, ((0, 0), (1, 1), (0, 0)))
    return 0.5 * (zp[:, :-2] + zp[:, 2:])


def _seg_reverse(t, lc):
    return jnp.concatenate([jnp.flip(t[:, :lc], axis=1), jnp.flip(t[:, lc:], axis=1)], axis=1)


def _wkv7_scan(r, w, k, v, kk, a):
    def step(s, inp):
        r_t, w_t, k_t, v_t, kk_t, a_t = inp
        sa = jnp.einsum('bhvk,bhk->bhv', s, -kk_t)
        s = (s * w_t[:, :, None, :] + sa[..., None] * (kk_t * a_t)[:, :, None, :]
             + v_t[..., None] * k_t[:, :, None, :])
        return s, jnp.einsum('bhvk,bhk->bhv', s, r_t)
    s0 = jnp.zeros(r.shape[1:] + (r.shape[-1],), F32)
    _, out = lax.scan(step, s0, (r, w, k, v, kk, a))
    return out


def _head_groupnorm(y, w, b):
    mu = jnp.mean(y, axis=-1, keepdims=True)
    var = jnp.mean(jnp.square(y - mu), axis=-1, keepdims=True)
    return (y - mu) * lax.rsqrt(var + B_GN_EPS) * w + b


def _rwkv7_mixer(zc, zl, mu, w0, w2, a0, a2, g2, k_k, k_a, r_k, gn_w, gn_b):
    bsz, lc, _ = zc.shape
    z = jnp.concatenate([zc + mu * (_centred_shift(zc) - zc),
                         zl + mu * (_centred_shift(zl) - zl)], axis=1)
    ln = z.shape[1]
    o1, o2, o3 = B_WIDTH, 2 * B_WIDTH, 3 * B_WIDTH
    o4 = o3 + B_DECAY_LORA
    o5 = o4 + B_AAA_LORA
    r, k, v = z[..., :o1], z[..., o1:o2], z[..., o2:o3]
    wl, al, gl = z[..., o3:o4], z[..., o4:o5], z[..., o5:]

    def heads(t):
        return t.reshape(bsz, ln, B_HEADS, B_HEAD_DIM).astype(F32)

    rh, vh = heads(r), heads(v)
    kk = heads(k * k_k)
    kk = kk / jnp.maximum(jnp.sqrt(jnp.sum(kk * kk, axis=-1, keepdims=True)), 1e-12)
    rk = r_k.reshape(B_HEADS, B_HEAD_DIM).astype(F32)
    gw = gn_w.reshape(B_HEADS, B_HEAD_DIM).astype(F32)
    gb = gn_b.reshape(B_HEADS, B_HEAD_DIM).astype(F32)
    g = jax.nn.sigmoid(gl) @ g2
    wt = jnp.tanh(wl)
    y = jnp.zeros((bsz, ln, B_HEADS, B_HEAD_DIM), F32)
    for d in range(2):
        w = -jax.nn.softplus(-(w0[d] + wt @ w2[d])) - 0.5
        decay = heads(jnp.exp(-jnp.exp(w.astype(F32))))
        a_lin = jax.nn.sigmoid(a0[d] + al @ a2[d])
        kd = k * (1 + (a_lin - 1) * k_a)
        ah, kdh = heads(a_lin), heads(kd)
        if d == 0:
            order = lambda t: t
        else:
            order = lambda t: _seg_reverse(t, lc)
        seqs = [jnp.moveaxis(order(t), 1, 0) for t in (rh, decay, kdh, vh, kk, ah)]
        out = order(jnp.moveaxis(_wkv7_scan(*seqs), 0, 1))
        bonus = jnp.sum(rh * kdh * rk, axis=-1, keepdims=True) * vh
        y = y + _head_groupnorm(out, gw, gb) + bonus
    y = y.reshape(bsz, ln, B_WIDTH).astype(zc.dtype) * g
    return y[:, :lc], y[:, lc:]


def _even_mixer(zc, zl, q_gain, k_gain, mu, w0, w2, a0, a2, g2, k_k, k_a, r_k, gn_w, gn_b,
                ang_r, ang_c, with_ctx):
    oc, ol = _gqa_mixer(zc[..., :A_IN], zl[..., :A_IN], q_gain, k_gain, ang_r, ang_c, with_ctx)
    rc, rl = _rwkv7_mixer(zc[..., A_IN:], zl[..., A_IN:], mu, w0, w2, a0, a2, g2,
                          k_k, k_a, r_k, gn_w, gn_b)
    yl = jnp.concatenate([ol, rl], axis=-1)
    yc = jnp.concatenate([oc, rc], axis=-1) if with_ctx else None
    return yc, yl


def _dwconv_centred(z, w, b):
    k, ch = w.shape
    y = lax.conv_general_dilated(z, w[:, None, :].astype(z.dtype), window_strides=(1,),
                                 padding=[(k // 2, k // 2)],
                                 dimension_numbers=('NWC', 'WIO', 'NWC'),
                                 feature_group_count=ch)
    return y + b.astype(z.dtype)


def _ssd_chunked(x, dt, a, bm, cm):
    bsz, ln, nh, hp = x.shape
    ng, ns = bm.shape[2], bm.shape[3]
    nr = nh // ng
    q = C_CHUNK
    nc = ln // q
    xd = (x.astype(F32) * dt[..., None]).reshape(bsz, nc, q, ng, nr, hp)
    cum = jnp.cumsum((dt * a).reshape(bsz, nc, q, ng, nr), axis=2)
    bc = bm.astype(F32).reshape(bsz, nc, q, ng, ns)
    cc = cm.astype(F32).reshape(bsz, nc, q, ng, ns)
    lower = jnp.tril(jnp.ones((q, q), bool))[None, None, :, :, None, None]
    seg = cum[:, :, :, None] - cum[:, :, None, :]
    decay_ij = jnp.exp(jnp.where(lower, seg, -jnp.inf))
    cb = jnp.einsum('bcign,bcjgn->bcijg', cc, bc)
    y_diag = jnp.einsum('bcijgr,bcjgrp->bcigrp', cb[..., None] * decay_ij, xd)
    decay_end = jnp.exp(cum[:, :, -1:] - cum)
    states = jnp.einsum('bcjgn,bcjgr,bcjgrp->bcgrpn', bc, decay_end, xd)
    chunk_decay = jnp.exp(cum[:, :, -1])

    def step(s, inp):
        st, dec = inp
        return s * dec[..., None, None] + st, s

    s0 = jnp.zeros((bsz, ng, nr, hp, ns), F32)
    _, s_prev = lax.scan(step, s0, (jnp.moveaxis(states, 1, 0), jnp.moveaxis(chunk_decay, 1, 0)))
    s_prev = jnp.moveaxis(s_prev, 0, 1)
    y_off = jnp.einsum('bcign,bcgrpn,bcigr->bcigrp', cc, s_prev, jnp.exp(cum))
    return (y_diag + y_off).reshape(bsz, ln, nh, hp)


def _mamba2_mixer(zc, zl, conv_w, conv_b, dt_bias, a_log, d_skip, norm_w, with_ctx):
    bsz, lc, _ = zc.shape
    o1 = C_INNER
    o2 = C_INNER + C_CONV_DIM
    gn = C_GROUPS * C_STATE
    z_gate = jnp.concatenate([zc[..., :o1], zl[..., :o1]], axis=1)
    xbc = jnp.concatenate([jax.nn.silu(_dwconv_centred(zc[..., o1:o2], conv_w, conv_b)),
                           jax.nn.silu(_dwconv_centred(zl[..., o1:o2], conv_w, conv_b))], axis=1)
    dt_raw = jnp.concatenate([zc[..., o2:], zl[..., o2:]], axis=1).astype(F32)
    ln = xbc.shape[1]
    xs = xbc[..., :C_INNER].reshape(bsz, ln, C_HEADS, C_HEAD_DIM)
    bm = xbc[..., C_INNER:C_INNER + gn].reshape(bsz, ln, C_GROUPS, C_STATE)
    cm = xbc[..., C_INNER + gn:].reshape(bsz, ln, C_GROUPS, C_STATE)
    y = d_skip.astype(F32)[:, None] * xs.astype(F32)
    for d in range(2):
        dt = jax.nn.softplus(dt_raw[..., d * C_HEADS:(d + 1) * C_HEADS] + dt_bias[d].astype(F32))
        a = -jnp.exp(a_log[d].astype(F32))
        if d == 0:
            order = lambda t: t
        else:
            order = lambda t: _seg_reverse(t, lc)
        y = y + order(_ssd_chunked(order(xs), order(dt), a, order(bm), order(cm)))
    y = y.reshape(bsz, ln, C_INNER).astype(zc.dtype)
    if not with_ctx:
        y, z_gate = y[:, lc:], z_gate[:, lc:]
    n = y.shape[1]
    yg = (y * jax.nn.silu(z_gate)).reshape(bsz, n, C_GROUPS, C_INNER // C_GROUPS)
    yn = _rmsnorm(yg, norm_w.reshape(C_GROUPS, C_INNER // C_GROUPS)).reshape(bsz, n, C_INNER)
    if with_ctx:
        return yn[:, :lc], yn[:, lc:]
    return None, yn


def _peer(h, w_q, sub_keys, u_tab, v_tab):
    t_all, dm = h.shape

    def block(hb):
        n = hb.shape[0]
        q = (hb @ w_q).reshape(n, P_HEADS, 2, P_KEY_DIM)
        s = jnp.einsum('thpd,hpnd->thpn', q, sub_keys).astype(F32)
        sv, si = lax.top_k(s, P_TOPK)
        cand_s = (sv[:, :, 0, :, None] + sv[:, :, 1, None, :]).reshape(n, P_HEADS, P_TOPK * P_TOPK)
        cand_i = (si[:, :, 0, :, None] * P_KEYS + si[:, :, 1, None, :]).reshape(n, P_HEADS, P_TOPK * P_TOPK)
        best_s, pos = lax.top_k(cand_s, P_TOPK)
        idx = jnp.take_along_axis(cand_i, pos, axis=-1)
        gate = jax.nn.softmax(best_s, axis=-1)
        act = jax.nn.gelu(jnp.einsum('td,thkd->thk', hb, u_tab[idx]).astype(F32), approximate=False)
        coef = (gate * act).astype(hb.dtype)
        return jnp.einsum('thk,thkd->td', coef, v_tab[idx])

    out = lax.map(block, h.reshape(t_all // P_BLOCK, P_BLOCK, dm))
    return out.reshape(t_all, dm)


def setup_inputs(seed: int = 0) -> dict:
    key = jax.random.key(seed)
    ks = list(jax.random.split(key, 40))

    def nrm(shape, scale):
        return jax.random.normal(ks.pop(), shape, F32) * scale

    def unif(shape, lo, hi):
        return jax.random.uniform(ks.pop(), shape, F32, lo, hi)

    def gain(shape):
        return 1.0 + nrm(shape, 0.02)

    dt0 = jnp.exp(unif((N_ODD, 2, C_HEADS), math.log(1e-3), math.log(1e-1)))
    return {
        'x': nrm((BATCH, SEQ, D_MODEL), 1.0),
        'c': nrm((BATCH, D_MODEL), 1.0),
        'ctx': nrm((BATCH, CTX_LEN, D_MODEL), 1.0),
        'c_ctx': nrm((D_MODEL,), 1.0),
        'mod_w': nrm((DEPTH, D_MODEL, N_MOD * D_MODEL), 0.3 * D_MODEL ** -0.5),
        'mod_b': nrm((DEPTH, N_MOD * D_MODEL), 0.02),
        'norm1_g': gain((DEPTH, D_MODEL)),
        'norm2_g': gain((DEPTH, D_MODEL)),
        'ev_w_in': nrm((N_EVEN, D_MODEL, EVEN_IN), D_MODEL ** -0.5),
        'ev_w_out': nrm((N_EVEN, EVEN_MIX, D_MODEL), EVEN_MIX ** -0.5),
        'attn_q_gain': gain((N_EVEN, A_HEAD_DIM)),
        'attn_k_gain': gain((N_EVEN, A_HEAD_DIM)),
        'rw_mu': unif((N_EVEN, B_IN), 0.0, 1.0),
        'rw_w0': unif((N_EVEN, 2, B_WIDTH), -6.5, -1.0),
        'rw_w2': nrm((N_EVEN, 2, B_DECAY_LORA, B_WIDTH), 0.1),
        'rw_a0': nrm((N_EVEN, 2, B_WIDTH), 0.1),
        'rw_a2': nrm((N_EVEN, 2, B_AAA_LORA, B_WIDTH), 0.5 * B_AAA_LORA ** -0.5),
        'rw_g2': nrm((N_EVEN, B_GATE_LORA, B_WIDTH), B_GATE_LORA ** -0.5),
        'rw_k_k': 0.85 + nrm((N_EVEN, B_WIDTH), 0.02),
        'rw_k_a': gain((N_EVEN, B_WIDTH)),
        'rw_r_k': nrm((N_EVEN, B_WIDTH), 0.1),
        'rw_gn_w': gain((N_EVEN, B_WIDTH)),
        'rw_gn_b': nrm((N_EVEN, B_WIDTH), 0.02),
        'ssd_w_in': nrm((N_ODD, D_MODEL, ODD_IN), D_MODEL ** -0.5),
        'ssd_conv_w': nrm((N_ODD, C_CONV, C_CONV_DIM), C_CONV ** -0.5),
        'ssd_conv_b': nrm((N_ODD, C_CONV_DIM), 0.02),
        'ssd_dt_bias': dt0 + jnp.log(-jnp.expm1(-dt0)),
        'ssd_a_log': jnp.log(unif((N_ODD, 2, C_HEADS), 1.0, 16.0)),
        'ssd_d': gain((N_ODD, C_HEADS)),
        'ssd_norm_w': gain((N_ODD, C_INNER)),
        'ssd_w_out': nrm((N_ODD, C_INNER, D_MODEL), C_INNER ** -0.5),
        'peer_w_q': nrm((DEPTH, D_MODEL, P_HEADS * 2 * P_KEY_DIM), D_MODEL ** -0.5),
        'peer_keys': nrm((DEPTH, P_HEADS, 2, P_KEYS, P_KEY_DIM), P_KEY_DIM ** -0.5),
        'peer_u': nrm((DEPTH, P_EXPERTS, D_MODEL), D_MODEL ** -0.5),
        'peer_v': nrm((DEPTH, P_EXPERTS, D_MODEL), P_HEADS ** -0.5),
    }


def reference(x, c, ctx, c_ctx, mod_w, mod_b, norm1_g, norm2_g, ev_w_in, ev_w_out,
              attn_q_gain, attn_k_gain, rw_mu, rw_w0, rw_w2, rw_a0, rw_a2, rw_g2, rw_k_k,
              rw_k_a, rw_r_k, rw_gn_w, rw_gn_b, ssd_w_in, ssd_conv_w, ssd_conv_b, ssd_dt_bias,
              ssd_a_log, ssd_d, ssd_norm_w, ssd_w_out, peer_w_q, peer_keys, peer_u, peer_v):
    bsz, seq, dm = x.shape
    lc = ctx.shape[1]
    rows = seq // GRID_W
    ang_r, ang_c = _axial_angles(rows)
    xl, xc = x, ctx
    for i in range(DEPTH):
        last = i == DEPTH - 1
        j = i // 2
        ml = (jax.nn.silu(c) @ mod_w[i] + mod_b[i]).reshape(bsz, 1, N_MOD, dm)
        mc = (jax.nn.silu(c_ctx) @ mod_w[i] + mod_b[i]).reshape(1, 1, N_MOD, dm)
        hl = _rmsnorm(xl, norm1_g[i]) * (1 + ml[:, :, 1]) + ml[:, :, 0]
        hc = _rmsnorm(xc, norm1_g[i]) * (1 + mc[:, :, 1]) + mc[:, :, 0]
        if i % 2 == 0:
            yc, yl = _even_mixer(hc @ ev_w_in[j], hl @ ev_w_in[j], attn_q_gain[j], attn_k_gain[j],
                                 rw_mu[j], rw_w0[j], rw_w2[j], rw_a0[j], rw_a2[j], rw_g2[j],
                                 rw_k_k[j], rw_k_a[j], rw_r_k[j], rw_gn_w[j], rw_gn_b[j],
                                 ang_r, ang_c, not last)
            w_out = ev_w_out[j]
        else:
            yc, yl = _mamba2_mixer(hc @ ssd_w_in[j], hl @ ssd_w_in[j], ssd_conv_w[j], ssd_conv_b[j],
                                   ssd_dt_bias[j], ssd_a_log[j], ssd_d[j], ssd_norm_w[j], not last)
            w_out = ssd_w_out[j]
        xl = xl + ml[:, :, 2] * (yl @ w_out)
        hl2 = _rmsnorm(xl, norm2_g[i]) * (1 + ml[:, :, 4]) + ml[:, :, 3]
        if last:
            f = _peer(hl2.reshape(-1, dm), peer_w_q[i], peer_keys[i], peer_u[i], peer_v[i])
            xl = xl + ml[:, :, 5] * f.reshape(bsz, seq, dm)
        else:
            xc = xc + mc[:, :, 2] * (yc @ w_out)
            hc2 = _rmsnorm(xc, norm2_g[i]) * (1 + mc[:, :, 4]) + mc[:, :, 3]
            f = _peer(jnp.concatenate([hc2.reshape(-1, dm), hl2.reshape(-1, dm)], axis=0),
                      peer_w_q[i], peer_keys[i], peer_u[i], peer_v[i])
            n_ctx_tok = bsz * lc
            xc = xc + mc[:, :, 5] * f[:n_ctx_tok].reshape(bsz, lc, dm)
            xl = xl + ml[:, :, 5] * f[n_ctx_tok:].reshape(bsz, seq, dm)
    return xl
```

```cpp
#include <hip/hip_runtime.h>
#include <hip/hip_cooperative_groups.h>
#include <stdint.h>
#include <string.h>
#include <stdio.h>
namespace cg = cooperative_groups;

#define DI __device__ __forceinline__
typedef unsigned short bf16_t;
typedef short bf16x8 __attribute__((ext_vector_type(8)));
typedef float f32x16 __attribute__((ext_vector_type(16)));

constexpr int NB = 8, SEQ = 2048, LC = 256, LT = 2304, NTOK = 18432, DM = 1024;
constexpr int NTHR = 512;

constexpr size_t OFF_UB = 0;
constexpr size_t OFF_VB = OFF_UB + 33554432;
constexpr size_t OFF_WIN0 = OFF_VB + 33554432;
constexpr size_t OFF_WOUT0 = OFF_WIN0 + 5242880;
constexpr size_t OFF_WIN1 = OFF_WOUT0 + 3145728;
constexpr size_t OFF_WOUT1 = OFF_WIN1 + 10747904;
constexpr size_t OFF_WQ = OFF_WOUT1 + 4194304;
constexpr size_t OFF_KEYS = OFF_WQ + 8388608;
constexpr size_t OFF_W2C = OFF_KEYS + 1048576;
constexpr size_t OFF_A2C = OFF_W2C + 131072;
constexpr size_t OFF_G2T = OFF_A2C + 131072;
constexpr size_t OFF_MOD = OFF_G2T + 131072;
constexpr size_t OFF_X = OFF_MOD + 442368;
constexpr size_t OFF_H = OFF_X + 75497472;
constexpr size_t OFF_BIG = OFF_H + 37748736;
constexpr size_t B_Z0 = 0;
constexpr size_t B_DEC = 0;
constexpr size_t B_G = 75497472;
constexpr size_t B_QN = 94371840;
constexpr size_t B_KN = B_QN + 18874368;
constexpr size_t B_VT = B_KN + 4718592;
constexpr size_t B_R = B_VT + 4718592;
constexpr size_t B_KB = B_R + 18874368;
constexpr size_t B_KK = B_KB + 18874368;
constexpr size_t B_V = B_KK + 18874368;
constexpr size_t B_AL = B_V + 18874368;
constexpr size_t B_AW = B_AL + 37748736;
constexpr size_t B_AA = B_AW + 2359296;
constexpr size_t B_AG = B_AA + 2359296;
constexpr size_t B_YMIX = B_AG + 4718592;
constexpr size_t B_L0END = B_YMIX + 56623104;
constexpr size_t B_QP = 0;
constexpr size_t B_S = 75497472;
constexpr size_t B_EI = B_S + 150994944;
constexpr size_t B_EG = B_EI + 9437184;
constexpr size_t B_PEND = B_EG + 9437184;
constexpr size_t B_ZG = 0;
constexpr size_t B_ZX = 75497472;
constexpr size_t B_Y = B_ZX;
constexpr size_t B_DT = B_ZX + 113246208;
constexpr size_t B_XBC = B_DT + 4718592;
constexpr size_t B_YN = B_XBC;
constexpr size_t B_L1END = B_XBC + 113246208;
constexpr size_t BIG_SZ = B_L1END > B_L0END ? (B_L1END > B_PEND ? B_L1END : B_PEND) : (B_L0END > B_PEND ? B_L0END : B_PEND);
constexpr size_t WS_NEED = OFF_BIG + BIG_SZ;
static_assert(WS_NEED <= 536870912, "workspace too large");

constexpr int SMEM_BYTES = 157696;

struct P {
  const float *x, *c, *ctx, *c_ctx, *mod_w, *mod_b, *n1g, *n2g, *ev_w_in, *ev_w_out, *qg, *kg, *mu, *w0, *w2, *a0, *a2, *g2,
      *k_k, *k_a, *r_k, *gn_w, *gn_b, *ssd_w_in, *conv_w, *conv_b, *dt_bias, *a_log, *ssd_d, *ssd_nw, *ssd_w_out, *pwq, *pkeys,
      *pu, *pv;
  float* out;
  char* ws;
};

DI bf16_t f2bf(float f) {
  unsigned u = __float_as_uint(f);
  u += 0x7fffu + ((u >> 16) & 1u);
  return (bf16_t)(u >> 16);
}
DI float bf2f(bf16_t b) { return __uint_as_float(((unsigned)b) << 16); }
DI unsigned pack2(float a, float b) { return (unsigned)f2bf(a) | ((unsigned)f2bf(b) << 16); }
DI float lo2f(unsigned u) { return __uint_as_float(u << 16); }
DI float hi2f(unsigned u) { return __uint_as_float(u & 0xffff0000u); }
DI void unpack8(const uint4& r, float* v) {
  v[0] = lo2f(r.x); v[1] = hi2f(r.x); v[2] = lo2f(r.y); v[3] = hi2f(r.y);
  v[4] = lo2f(r.z); v[5] = hi2f(r.z); v[6] = lo2f(r.w); v[7] = hi2f(r.w);
}
DI uint4 pack8(const float* v) {
  uint4 r; r.x = pack2(v[0], v[1]); r.y = pack2(v[2], v[3]); r.z = pack2(v[4], v[5]); r.w = pack2(v[6], v[7]);
  return r;
}
DI float shx_(float v, int off, int lane) {
  return __builtin_bit_cast(float, __builtin_amdgcn_ds_bpermute((lane ^ off) << 2, __builtin_bit_cast(int, v)));
}
DI float shup_(float v, int off, int lane) {
  return __builtin_bit_cast(float, __builtin_amdgcn_ds_bpermute((lane - off) << 2, __builtin_bit_cast(int, v)));
}
#define SHX(v, o) shx_((v), (o), lane)
DI float wave_sum_(float v, int lane) {
#pragma unroll
  for (int o = 32; o > 0; o >>= 1) v += shx_(v, o, lane);
  return v;
}
#define wave_sum(v) wave_sum_((v), lane)
DI float dpp_f(float v, const int ctrl_sel) {
  int x = __builtin_bit_cast(int, v);
  int y;
  if (ctrl_sel == 0) y = __builtin_amdgcn_mov_dpp(x, 0xB1, 0xF, 0xF, true);
  else if (ctrl_sel == 1) y = __builtin_amdgcn_mov_dpp(x, 0x4E, 0xF, 0xF, true);
  else y = __builtin_amdgcn_mov_dpp(x, 0x141, 0xF, 0xF, true);
  return __builtin_bit_cast(float, y);
}
DI float reduce8(float v) {
  v += dpp_f(v, 0);
  v += dpp_f(v, 1);
  v += dpp_f(v, 2);
  return v;
}
DI float sigmoidf_(float x) { return 1.f / (1.f + __expf(-x)); }
DI float siluf_(float x) { return x / (1.f + __expf(-x)); }
DI float softplusf_(float y) { return fmaxf(y, 0.f) + log1pf(__expf(-fabsf(y))); }
DI int scanpos(int d, int pp) { return d ? (pp < LC ? LC - 1 - pp : LT + LC - 1 - pp) : pp; }
DI int rowmod(int n) { int b = n / LT; int pos = n - b * LT; return pos < LC ? 8 : b; }
DI const float* xin_row(const P& p, int n) {
  int b = n / LT, pos = n - b * LT;
  return pos < LC ? p.ctx + ((size_t)(b * LC + pos)) * DM : p.x + ((size_t)(b * SEQ + pos - LC)) * DM;
}

template <class Epi>
DI void gemm_tile(const int TIDX, const bf16_t* __restrict__ A, int lda, const bf16_t* __restrict__ Bt, int ldb, int K, int m0, int n0,
                  Epi epi, char* smem) {
  bf16_t* As = (bf16_t*)smem;
  bf16_t* Bs = As + 2 * 256 * 72;
  const int tid = TIDX, lane = tid & 63, wave = tid >> 6;
  const int wm = wave >> 1, wn = wave & 1;
  const int r = lane & 31, h8 = lane >> 5;
  f32x16 acc[2][2];
#pragma unroll
  for (int i = 0; i < 2; i++)
#pragma unroll
    for (int j = 0; j < 2; j++)
#pragma unroll
      for (int q = 0; q < 16; q++) acc[i][j][q] = 0.f;
  const int lrow = tid >> 3, lch = tid & 7;
  const bf16_t* Ap = A + (size_t)(m0 + lrow) * lda + lch * 8;
  const bf16_t* Bp = Bt + (size_t)(n0 + lrow) * ldb + lch * 8;
  const size_t sa = (size_t)64 * lda, sb_ = (size_t)64 * ldb;
  uint4 ra0 = *(const uint4*)(Ap), ra1 = *(const uint4*)(Ap + sa), ra2 = *(const uint4*)(Ap + 2 * sa), ra3 = *(const uint4*)(Ap + 3 * sa);
  uint4 rb0 = *(const uint4*)(Bp), rb1 = *(const uint4*)(Bp + sb_);
  __syncthreads();
  {
    bf16_t* Aw = As + lrow * 72 + lch * 8;
    bf16_t* Bw = Bs + lrow * 72 + lch * 8;
    *(uint4*)(Aw) = ra0; *(uint4*)(Aw + 64 * 72) = ra1; *(uint4*)(Aw + 128 * 72) = ra2; *(uint4*)(Aw + 192 * 72) = ra3;
    *(uint4*)(Bw) = rb0; *(uint4*)(Bw + 64 * 72) = rb1;
  }
  __syncthreads();
  const int nk = K >> 6;
  for (int kt = 0; kt < nk; kt++) {
    const int cur = kt & 1;
    const bool more = kt + 1 < nk;
    if (more) {
      const bf16_t* Aq = Ap + (kt + 1) * 64;
      const bf16_t* Bq = Bp + (kt + 1) * 64;
      ra0 = *(const uint4*)(Aq); ra1 = *(const uint4*)(Aq + sa); ra2 = *(const uint4*)(Aq + 2 * sa); ra3 = *(const uint4*)(Aq + 3 * sa);
      rb0 = *(const uint4*)(Bq); rb1 = *(const uint4*)(Bq + sb_);
    }
    const bf16_t* Ac = As + cur * 256 * 72 + (wm * 64 + r) * 72 + h8 * 8;
    const bf16_t* Bc = Bs + cur * 128 * 72 + (wn * 64 + r) * 72 + h8 * 8;
#pragma unroll
    for (int ks = 0; ks < 4; ks++) {
      bf16x8 a0 = *(const bf16x8*)(Ac + ks * 16);
      bf16x8 a1 = *(const bf16x8*)(Ac + 32 * 72 + ks * 16);
      bf16x8 b0 = *(const bf16x8*)(Bc + ks * 16);
      bf16x8 b1 = *(const bf16x8*)(Bc + 32 * 72 + ks * 16);
      acc[0][0] = __builtin_amdgcn_mfma_f32_32x32x16_bf16(a0, b0, acc[0][0], 0, 0, 0);
      acc[0][1] = __builtin_amdgcn_mfma_f32_32x32x16_bf16(a0, b1, acc[0][1], 0, 0, 0);
      acc[1][0] = __builtin_amdgcn_mfma_f32_32x32x16_bf16(a1, b0, acc[1][0], 0, 0, 0);
      acc[1][1] = __builtin_amdgcn_mfma_f32_32x32x16_bf16(a1, b1, acc[1][1], 0, 0, 0);
    }
    if (more) {
      const int nx = cur ^ 1;
      bf16_t* Aw = As + nx * 256 * 72 + lrow * 72 + lch * 8;
      bf16_t* Bw = Bs + nx * 128 * 72 + lrow * 72 + lch * 8;
      *(uint4*)(Aw) = ra0; *(uint4*)(Aw + 64 * 72) = ra1; *(uint4*)(Aw + 128 * 72) = ra2; *(uint4*)(Aw + 192 * 72) = ra3;
      *(uint4*)(Bw) = rb0; *(uint4*)(Bw + 64 * 72) = rb1;
    }
    __syncthreads();
  }
#pragma unroll
  for (int mt = 0; mt < 2; mt++)
#pragma unroll
    for (int nt = 0; nt < 2; nt++)
#pragma unroll
      for (int q = 0; q < 16; q++) {
        int m = m0 + wm * 64 + mt * 32 + (q & 3) + 8 * (q >> 2) + 4 * h8;
        int n = n0 + wn * 64 + nt * 32 + r;
        epi(m, n, acc[mt][nt][q]);
      }
}

DI void tconv(const int TIDX, const float* __restrict__ src, int lds_, int K, int N, bf16_t* __restrict__ dst, int ldd, int koff, int bid,
              int nb, char* smem) {
  float* t = (float*)smem;
  const int tn = N >> 6, tk = K >> 6;
  for (int tile = bid; tile < tk * tn; tile += nb) {
    const int k0 = (tile / tn) * 64, n0 = (tile % tn) * 64;
    __syncthreads();
    for (int e = TIDX; e < 4096; e += NTHR) {
      int kk = e >> 6, nn = e & 63;
      t[kk * 65 + nn] = src[(size_t)(k0 + kk) * lds_ + n0 + nn];
    }
    __syncthreads();
    for (int e = TIDX; e < 4096; e += NTHR) {
      int nn = e >> 6, kk = e & 63;
      dst[(size_t)(n0 + nn) * ldd + koff + k0 + kk] = f2bf(t[kk * 65 + nn]);
    }
  }
}
DI void conv_flat(const int TIDX, const float* __restrict__ src, bf16_t* __restrict__ dst, size_t count, int bid, int nb) {
  const size_t n4 = count >> 2;
  for (size_t i = (size_t)bid * NTHR + TIDX; i < n4; i += (size_t)nb * NTHR) {
    float4 v = ((const float4*)src)[i];
    uint2 o; o.x = pack2(v.x, v.y); o.y = pack2(v.z, v.w);
    ((uint2*)dst)[i] = o;
  }
}
DI void mod_gemv(const int TIDX, const P& p, int bid, int nb, char* smem) {
  float* sc = (float*)smem;
  float* red = sc + 9 * 1024;
  float* modo = (float*)(p.ws + OFF_MOD);
  for (int task = bid; task < 192; task += nb) {
    const int l = task / 96, j0 = (task % 96) * 64;
    __syncthreads();
    for (int e = TIDX; e < 9 * 1024; e += NTHR) {
      int rr = e >> 10, k = e & 1023;
      float v = rr < 8 ? p.c[rr * 1024 + k] : p.c_ctx[k];
      sc[e] = v / (1.f + expf(-v));
    }
    __syncthreads();
    const int kg = TIDX >> 6, col = TIDX & 63;
    float acc[9];
#pragma unroll
    for (int q = 0; q < 9; q++) acc[q] = 0.f;
    const float* W = p.mod_w + (size_t)l * 1024 * 6144 + j0 + col;
#pragma unroll 4
    for (int k = kg * 128; k < kg * 128 + 128; ++k) {
      float w = W[(size_t)k * 6144];
#pragma unroll
      for (int q = 0; q < 9; q++) acc[q] += sc[q * 1024 + k] * w;
    }
#pragma unroll
    for (int q = 0; q < 9; q++) red[(kg * 9 + q) * 64 + col] = acc[q];
    __syncthreads();
    for (int e = TIDX; e < 9 * 64; e += NTHR) {
      int rr = e >> 6, cc = e & 63;
      float s = p.mod_b[l * 6144 + j0 + cc];
#pragma unroll
      for (int g = 0; g < 8; g++) s += red[(g * 9 + rr) * 64 + cc];
      modo[(size_t)(l * 9 + rr) * 6144 + j0 + cc] = s;
    }
  }
}

DI void norm_rows(const int TIDX, const P& p, int layer, int which, bool from_input, bool latent_only, int bid, int nb) {
  const int lane = TIDX & 63, wave = TIDX >> 6;
  const float* mod = (const float*)(p.ws + OFF_MOD);
  const float* X = (const float*)(p.ws + OFF_X);
  bf16_t* H = (bf16_t*)(p.ws + OFF_H);
  const float* g = (which ? p.n2g : p.n1g) + layer * 1024;
  for (int n = bid * 8 + wave; n < NTOK; n += nb * 8) {
    int b = n / LT, pos = n - b * LT;
    if (latent_only && pos < LC) continue;
    const float* src = from_input ? xin_row(p, n) : X + (size_t)n * DM;
    float4 v[4];
    float ss = 0.f;
#pragma unroll
    for (int i = 0; i < 4; i++) {
      v[i] = *(const float4*)(src + i * 256 + lane * 4);
      ss += v[i].x * v[i].x + v[i].y * v[i].y + v[i].z * v[i].z + v[i].w * v[i].w;
    }
    ss = wave_sum(ss);
    const float rs = rsqrtf(ss * (1.f / 1024.f) + 1e-6f);
    const int rr = pos < LC ? 8 : b;
    const float* msc = mod + (size_t)(layer * 9 + rr) * 6144 + (which ? 4 : 1) * 1024;
    const float* msh = mod + (size_t)(layer * 9 + rr) * 6144 + (which ? 3 : 0) * 1024;
#pragma unroll
    for (int i = 0; i < 4; i++) {
      int idx = i * 256 + lane * 4;
      float4 gg = *(const float4*)(g + idx), sc = *(const float4*)(msc + idx), sh = *(const float4*)(msh + idx);
      float y0 = v[i].x * rs * gg.x * (1.f + sc.x) + sh.x;
      float y1 = v[i].y * rs * gg.y * (1.f + sc.y) + sh.y;
      float y2 = v[i].z * rs * gg.z * (1.f + sc.z) + sh.z;
      float y3 = v[i].w * rs * gg.w * (1.f + sc.w) + sh.w;
      uint2 o; o.x = pack2(y0, y1); o.y = pack2(y2, y3);
      *(uint2*)(H + (size_t)n * DM + idx) = o;
    }
  }
}

DI void rope8(float* v, int e, int t, int lane) {
  const int half = e >> 2, isx2 = (e >> 1) & 1, ibase = (e & 1) * 8;
  const float posf = half ? (float)(t & 63) : (float)(t >> 6);
#pragma unroll
  for (int j = 0; j < 8; j++) {
    float pv = SHX(v[j], 2);
    float inv = exp2f(-(float)(ibase + j) * 0.83048202f);
    float ang = posf * inv;
    float rev = ang * 0.15915494309f;
    rev -= floorf(rev);
    float sn = __builtin_amdgcn_sinf(rev), cs = __builtin_amdgcn_cosf(rev);
    v[j] = isx2 ? (v[j] * cs + pv * sn) : (v[j] * cs - pv * sn);
  }
}
DI void prep0(const int TIDX, const P& p, int bid, int nb) {
  char* big = p.ws + OFF_BIG;
  const bf16_t* Z = (const bf16_t*)(big + B_Z0);
  bf16_t* QN = (bf16_t*)(big + B_QN); bf16_t* KN = (bf16_t*)(big + B_KN); bf16_t* VT = (bf16_t*)(big + B_VT);
  bf16_t* R = (bf16_t*)(big + B_R); bf16_t* KB = (bf16_t*)(big + B_KB); bf16_t* KK = (bf16_t*)(big + B_KK);
  bf16_t* V = (bf16_t*)(big + B_V); bf16_t* AW = (bf16_t*)(big + B_AW); bf16_t* AA = (bf16_t*)(big + B_AA);
  bf16_t* AG = (bf16_t*)(big + B_AG);
  const int lane = TIDX & 63, wave = TIDX >> 6;
  for (int n = bid * 8 + wave; n < NTOK; n += nb * 8) {
    const int b = n / LT, pos = n - b * LT;
    const bool lat = pos >= LC;
    const int t = pos - LC;
    const bf16_t* zr = Z + (size_t)n * 2560;
    {
      const int head = lane >> 3, e = lane & 7;
      uint4 raw = *(const uint4*)(zr + head * 64 + e * 8);
      float v[8]; unpack8(raw, v);
      float ss = 0.f;
#pragma unroll
      for (int j = 0; j < 8; j++) ss += v[j] * v[j];
      ss += SHX(ss, 1); ss += SHX(ss, 2); ss += SHX(ss, 4);
      const float rs = rsqrtf(ss * (1.f / 64.f) + 1e-6f);
#pragma unroll
      for (int j = 0; j < 8; j++) v[j] = v[j] * rs * p.qg[e * 8 + j];
      if (lat) rope8(v, e, t, lane);
#pragma unroll
      for (int j = 0; j < 8; j++) v[j] *= 0.18033688011f;
      *(uint4*)(QN + ((size_t)(b * 8 + head) * LT + pos) * 64 + e * 8) = pack8(v);
    }
    {
      const int hh = (lane >> 3) & 3, e = lane & 7;
      uint4 raw = make_uint4(0, 0, 0, 0);
      if (lane < 32) raw = *(const uint4*)(zr + 512 + hh * 64 + e * 8);
      float v[8]; unpack8(raw, v);
      float kv[8];
      float ss = 0.f;
#pragma unroll
      for (int j = 0; j < 8; j++) ss += v[j] * v[j];
      ss += SHX(ss, 1); ss += SHX(ss, 2); ss += SHX(ss, 4);
      const float rs = rsqrtf(ss * (1.f / 64.f) + 1e-6f);
#pragma unroll
      for (int j = 0; j < 8; j++) kv[j] = v[j] * rs * p.kg[e * 8 + j];
      if (lat) rope8(kv, e, t, lane);
      if (lane < 16) {
        *(uint4*)(KN + ((size_t)(b * 2 + hh) * LT + pos) * 64 + e * 8) = pack8(kv);
      } else if (lane < 32) {
        const int kvh = hh - 2;
#pragma unroll
        for (int j = 0; j < 8; j++) VT[((size_t)(b * 2 + kvh) * 64 + e * 8 + j) * LT + pos] = f2bf(v[j]);
      }
    }
    const bool hasp = (pos != 0 && pos != LC), hasn = (pos != LC - 1 && pos != LT - 1);
    const bf16_t* zc = zr + 768;
#pragma unroll
    for (int i = 0; i < 7; i++) {
      const int j = i * 256 + lane * 4;
      uint2 cu = *(const uint2*)(zc + j);
      uint2 pu = make_uint2(0, 0), nu = make_uint2(0, 0);
      if (hasp) pu = *(const uint2*)(zc - 2560 + j);
      if (hasn) nu = *(const uint2*)(zc + 2560 + j);
      float4 m4 = *(const float4*)(p.mu + j);
      float cv[4] = {lo2f(cu.x), hi2f(cu.x), lo2f(cu.y), hi2f(cu.y)};
      float pv[4] = {lo2f(pu.x), hi2f(pu.x), lo2f(pu.y), hi2f(pu.y)};
      float nv[4] = {lo2f(nu.x), hi2f(nu.x), lo2f(nu.y), hi2f(nu.y)};
      float mm[4] = {m4.x, m4.y, m4.z, m4.w};
      float zm[4];
#pragma unroll
      for (int q = 0; q < 4; q++) zm[q] = cv[q] + mm[q] * (0.5f * (pv[q] + nv[q]) - cv[q]);
      if (i < 6) {
        const int cc = (i & 1) * 256 + lane * 4;
        const int head = cc >> 6, within = cc & 63;
        const size_t oidx = ((size_t)(b * 8 + head) * LT + pos) * 64 + within;
        uint2 o; o.x = pack2(zm[0], zm[1]); o.y = pack2(zm[2], zm[3]);
        if (i < 2) {
          *(uint2*)(R + oidx) = o;
        } else if (i < 4) {
          *(uint2*)(KB + oidx) = o;
          float4 kk4 = *(const float4*)(p.k_k + cc);
          float k0 = zm[0] * kk4.x, k1 = zm[1] * kk4.y, k2 = zm[2] * kk4.z, k3 = zm[3] * kk4.w;
          float ss = k0 * k0 + k1 * k1 + k2 * k2 + k3 * k3;
          ss += SHX(ss, 1); ss += SHX(ss, 2); ss += SHX(ss, 4); ss += SHX(ss, 8);
          const float inv = 1.f / fmaxf(sqrtf(ss), 1e-12f);
          uint2 o2; o2.x = pack2(k0 * inv, k1 * inv); o2.y = pack2(k2 * inv, k3 * inv);
          *(uint2*)(KK + oidx) = o2;
        } else {
          *(uint2*)(V + oidx) = o;
        }
      } else {
        if (lane < 16) {
          uint2 o; o.x = pack2(tanhf(zm[0]), tanhf(zm[1])); o.y = pack2(tanhf(zm[2]), tanhf(zm[3]));
          *(uint2*)(AW + (size_t)n * 64 + lane * 4) = o;
        } else if (lane < 32) {
          uint2 o; o.x = pack2(zm[0], zm[1]); o.y = pack2(zm[2], zm[3]);
          *(uint2*)(AA + (size_t)n * 64 + (lane - 16) * 4) = o;
        } else {
          uint2 o; o.x = pack2(sigmoidf_(zm[0]), sigmoidf_(zm[1])); o.y = pack2(sigmoidf_(zm[2]), sigmoidf_(zm[3]));
          *(uint2*)(AG + (size_t)n * 128 + (lane - 32) * 4) = o;
        }
      }
    }
  }
}

DI void wkv_task(const int TIDX, const P& p, int task, char* smem) {
  char* big = p.ws + OFF_BIG;
  const int d = task & 1, h = (task >> 1) & 7, b = task >> 4;
  const bf16_t* R = (const bf16_t*)(big + B_R); const bf16_t* KB = (const bf16_t*)(big + B_KB);
  const bf16_t* KK = (const bf16_t*)(big + B_KK); const bf16_t* V = (const bf16_t*)(big + B_V);
  const bf16_t* AL = (const bf16_t*)(big + B_AL) + (size_t)d * NB * 8 * LT * 64;
  const float* DEC = (const float*)(big + B_DEC) + (size_t)d * NB * 8 * LT * 64;
  const bf16_t* G = (const bf16_t*)(big + B_G);
  bf16_t* YM = (bf16_t*)(big + B_YMIX);
  float* bufs = (float*)smem;
  float* outb = bufs + 2 * 6 * 1024;
  const int tid = TIDX, lane = tid & 63;
  const int row = tid >> 3, ks = tid & 7;
  const int ls = tid >> 5, li = (tid & 31) * 2;
  const size_t hb = (size_t)(b * 8 + h) * LT;
  const float ka0 = p.k_a[h * 64 + li], ka1 = p.k_a[h * 64 + li + 1];
  float S[8];
#pragma unroll
  for (int j = 0; j < 8; j++) S[j] = 0.f;
  float pr[12];
  auto gload = [&](int chunk) {
    const int pos = scanpos(d, chunk * 16 + ls);
    const size_t e0 = (hb + pos) * 64 + li;
    unsigned r2 = *(const unsigned*)(R + e0), k2 = *(const unsigned*)(KB + e0), kk2 = *(const unsigned*)(KK + e0);
    unsigned v2 = *(const unsigned*)(V + e0), a2 = *(const unsigned*)(AL + e0);
    float2 dc = *(const float2*)(DEC + e0);
    float a_0 = lo2f(a2), a_1 = hi2f(a2);
    pr[0] = lo2f(r2); pr[1] = hi2f(r2);
    pr[2] = dc.x; pr[3] = dc.y;
    pr[4] = lo2f(k2) * (1.f + (a_0 - 1.f) * ka0); pr[5] = hi2f(k2) * (1.f + (a_1 - 1.f) * ka1);
    pr[6] = lo2f(v2); pr[7] = hi2f(v2);
    pr[8] = -lo2f(kk2); pr[9] = -hi2f(kk2);
    pr[10] = lo2f(kk2) * a_0; pr[11] = hi2f(kk2) * a_1;
  };
  auto lstore = [&](int bufi) {
    float* bb = bufs + bufi * 6 * 1024 + ls * 64 + li;
#pragma unroll
    for (int q = 0; q < 6; q++) *(float2*)(bb + q * 1024) = make_float2(pr[2 * q], pr[2 * q + 1]);
  };
  __syncthreads();
  gload(0);
  lstore(0);
  __syncthreads();
  const int nch = LT / 16;
  for (int ch = 0; ch < nch; ch++) {
    const int cur = ch & 1;
    if (ch + 1 < nch) gload(ch + 1);
    const float* bb = bufs + cur * 6 * 1024;
#pragma unroll 4
    for (int s = 0; s < 16; s++) {
      const float* q0 = bb + s * 64 + ks * 8;
      float4 kn0 = *(const float4*)(q0 + 4 * 1024), kn1 = *(const float4*)(q0 + 4 * 1024 + 4);
      float sa = S[0] * kn0.x + S[1] * kn0.y + S[2] * kn0.z + S[3] * kn0.w + S[4] * kn1.x + S[5] * kn1.y + S[6] * kn1.z +
                 S[7] * kn1.w;
      sa = reduce8(sa);
      const float vv = bb[3 * 1024 + s * 64 + row];
      float4 dc0 = *(const float4*)(q0 + 1 * 1024), dc1 = *(const float4*)(q0 + 1 * 1024 + 4);
      float4 bb0 = *(const float4*)(q0 + 5 * 1024), bb1 = *(const float4*)(q0 + 5 * 1024 + 4);
      float4 kd0 = *(const float4*)(q0 + 2 * 1024), kd1 = *(const float4*)(q0 + 2 * 1024 + 4);
      S[0] = S[0] * dc0.x + sa * bb0.x + vv * kd0.x;
      S[1] = S[1] * dc0.y + sa * bb0.y + vv * kd0.y;
      S[2] = S[2] * dc0.z + sa * bb0.z + vv * kd0.z;
      S[3] = S[3] * dc0.w + sa * bb0.w + vv * kd0.w;
      S[4] = S[4] * dc1.x + sa * bb1.x + vv * kd1.x;
      S[5] = S[5] * dc1.y + sa * bb1.y + vv * kd1.y;
      S[6] = S[6] * dc1.z + sa * bb1.z + vv * kd1.z;
      S[7] = S[7] * dc1.w + sa * bb1.w + vv * kd1.w;
      float4 r0 = *(const float4*)(q0), r1 = *(const float4*)(q0 + 4);
      float o = S[0] * r0.x + S[1] * r0.y + S[2] * r0.z + S[3] * r0.w + S[4] * r1.x + S[5] * r1.y + S[6] * r1.z + S[7] * r1.w;
      o = reduce8(o);
      if (ks == 0) outb[s * 64 + row] = o;
    }
    __syncthreads();
    {
      const int pos = scanpos(d, ch * 16 + ls);
      const int n = b * LT + pos;
      const float o0 = outb[ls * 64 + li], o1 = outb[ls * 64 + li + 1];
      float sm = o0 + o1;
#pragma unroll
      for (int off = 1; off < 32; off <<= 1) sm += SHX(sm, off);
      const float mean = sm * (1.f / 64.f);
      const float d0 = o0 - mean, d1 = o1 - mean;
      float vs = d0 * d0 + d1 * d1;
#pragma unroll
      for (int off = 1; off < 32; off <<= 1) vs += SHX(vs, off);
      const float rstd = rsqrtf(vs * (1.f / 64.f) + 64e-5f);
      const int c0 = h * 64 + li;
      float bs = bb[0 * 1024 + ls * 64 + li] * bb[2 * 1024 + ls * 64 + li] * p.r_k[c0] +
                 bb[0 * 1024 + ls * 64 + li + 1] * bb[2 * 1024 + ls * 64 + li + 1] * p.r_k[c0 + 1];
#pragma unroll
      for (int off = 1; off < 32; off <<= 1) bs += SHX(bs, off);
      const float v0 = bb[3 * 1024 + ls * 64 + li], v1 = bb[3 * 1024 + ls * 64 + li + 1];
      const unsigned g2 = *(const unsigned*)(G + (size_t)n * 512 + c0);
      const float y0 = (d0 * rstd * p.gn_w[c0] + p.gn_b[c0] + bs * v0) * lo2f(g2);
      const float y1 = (d1 * rstd * p.gn_w[c0 + 1] + p.gn_b[c0 + 1] + bs * v1) * hi2f(g2);
      *(unsigned*)(YM + (size_t)n * 1536 + 512 + d * 512 + c0) = pack2(y0, y1);
    }
    if (ch + 1 < nch) lstore(cur ^ 1);
    __syncthreads();
  }
}

DI void attn_task(const int TIDX, const P& p, int task, char* smem) {
  char* big = p.ws + OFF_BIG;
  int b, head, qt;
  if (task < 512) { qt = 1 + (task & 7); head = (task >> 3) & 7; b = task >> 6; }
  else { int t2 = task - 512; qt = 0; head = t2 & 7; b = t2 >> 3; }
  const int kvh = head >> 2;
  const int nkt = (qt == 0 ? 256 : LT) / 64;
  bf16_t* Ks = (bf16_t*)smem;
  bf16_t* Vs = Ks + 2 * 64 * 72;
  const bf16_t* Kg = (const bf16_t*)(big + B_KN) + (size_t)(b * 2 + kvh) * LT * 64;
  const bf16_t* Vg = (const bf16_t*)(big + B_VT) + (size_t)(b * 2 + kvh) * 64 * LT;
  const bf16_t* QN = (const bf16_t*)(big + B_QN);
  bf16_t* YM = (bf16_t*)(big + B_YMIX);
  const int tid = TIDX, lane = tid & 63, wave = tid >> 6;
  const int r = lane & 31, h8 = lane >> 5;
  const int q0 = qt * 256 + wave * 32;
  bf16x8 qf[4];
#pragma unroll
  for (int kk = 0; kk < 4; kk++)
    qf[kk] = *(const bf16x8*)(QN + ((size_t)(b * 8 + head) * LT + q0 + r) * 64 + kk * 16 + h8 * 8);
  f32x16 o0, o1;
#pragma unroll
  for (int q = 0; q < 16; q++) { o0[q] = 0.f; o1[q] = 0.f; }
  float m = -1e30f, l = 0.f;
  const int lr = tid >> 3, lc = tid & 7;
  uint4 kreg = *(const uint4*)(Kg + (size_t)lr * 64 + lc * 8);
  uint4 vreg = *(const uint4*)(Vg + (size_t)lr * LT + lc * 8);
  __syncthreads();
  *(uint4*)(Ks + lr * 72 + lc * 8) = kreg;
  *(uint4*)(Vs + lr * 72 + lc * 8) = vreg;
  __syncthreads();
  for (int kt = 0; kt < nkt; kt++) {
    const int cur = kt & 1;
    if (kt + 1 < nkt) {
      kreg = *(const uint4*)(Kg + (size_t)((kt + 1) * 64 + lr) * 64 + lc * 8);
      vreg = *(const uint4*)(Vg + (size_t)lr * LT + (kt + 1) * 64 + lc * 8);
    }
    const bf16_t* Kc = Ks + cur * 64 * 72;
    const bf16_t* Vc = Vs + cur * 64 * 72;
    f32x16 s0, s1;
#pragma unroll
    for (int q = 0; q < 16; q++) { s0[q] = 0.f; s1[q] = 0.f; }
#pragma unroll
    for (int kk = 0; kk < 4; kk++) {
      bf16x8 a0 = *(const bf16x8*)(Kc + r * 72 + kk * 16 + h8 * 8);
      bf16x8 a1 = *(const bf16x8*)(Kc + (32 + r) * 72 + kk * 16 + h8 * 8);
      s0 = __builtin_amdgcn_mfma_f32_32x32x16_bf16(a0, qf[kk], s0, 0, 0, 0);
      s1 = __builtin_amdgcn_mfma_f32_32x32x16_bf16(a1, qf[kk], s1, 0, 0, 0);
    }
    float mx = s0[0];
#pragma unroll
    for (int q = 1; q < 16; q++) mx = fmaxf(mx, s0[q]);
#pragma unroll
    for (int q = 0; q < 16; q++) mx = fmaxf(mx, s1[q]);
    mx = fmaxf(mx, SHX(mx, 32));
    const float mnew = fmaxf(m, mx);
    const float alpha = exp2f(m - mnew);
    float sum = 0.f;
#pragma unroll
    for (int q = 0; q < 16; q++) { s0[q] = exp2f(s0[q] - mnew); sum += s0[q]; }
#pragma unroll
    for (int q = 0; q < 16; q++) { s1[q] = exp2f(s1[q] - mnew); sum += s1[q]; }
    l = l * alpha + sum;
    m = mnew;
#pragma unroll
    for (int q = 0; q < 16; q++) { o0[q] *= alpha; o1[q] *= alpha; }
#pragma unroll
    for (int t = 0; t < 2; t++) {
#pragma unroll
      for (int s = 0; s < 2; s++) {
        union { bf16x8 v; unsigned u[4]; } pf;
#pragma unroll
        for (int q = 0; q < 4; q++) {
          float x0 = t ? s1[8 * s + 2 * q] : s0[8 * s + 2 * q];
          float x1 = t ? s1[8 * s + 2 * q + 1] : s0[8 * s + 2 * q + 1];
          pf.u[q] = pack2(x0, x1);
        }
        const int kb = 32 * t + 16 * s + 4 * h8;
        union { bf16x8 v; uint2 u[2]; } v0, v1;
        v0.u[0] = *(const uint2*)(Vc + r * 72 + kb);
        v0.u[1] = *(const uint2*)(Vc + r * 72 + kb + 8);
        v1.u[0] = *(const uint2*)(Vc + (32 + r) * 72 + kb);
        v1.u[1] = *(const uint2*)(Vc + (32 + r) * 72 + kb + 8);
        o0 = __builtin_amdgcn_mfma_f32_32x32x16_bf16(v0.v, pf.v, o0, 0, 0, 0);
        o1 = __builtin_amdgcn_mfma_f32_32x32x16_bf16(v1.v, pf.v, o1, 0, 0, 0);
      }
    }
    if (kt + 1 < nkt) {
      *(uint4*)(Ks + (cur ^ 1) * 64 * 72 + lr * 72 + lc * 8) = kreg;
      *(uint4*)(Vs + (cur ^ 1) * 64 * 72 + lr * 72 + lc * 8) = vreg;
    }
    __syncthreads();
  }
  l += SHX(l, 32);
  const float inv = 1.f / l;
  bf16_t* orow = YM + (size_t)(b * LT + q0 + r) * 1536 + head * 64;
#pragma unroll
  for (int g4 = 0; g4 < 4; g4++) {
    uint2 w0, w1;
    w0.x = pack2(o0[4 * g4] * inv, o0[4 * g4 + 1] * inv); w0.y = pack2(o0[4 * g4 + 2] * inv, o0[4 * g4 + 3] * inv);
    w1.x = pack2(o1[4 * g4] * inv, o1[4 * g4 + 1] * inv); w1.y = pack2(o1[4 * g4 + 2] * inv, o1[4 * g4 + 3] * inv);
    *(uint2*)(orow + 8 * g4 + 4 * h8) = w0;
    *(uint2*)(orow + 32 + 8 * g4 + 4 * h8) = w1;
  }
}

DI void route_task(const int TIDX, const P& p, int n0, char* smem) {
  char* big = p.ws + OFF_BIG;
  const float* S = (const float*)(big + B_S);
  int* EI = (int*)(big + B_EI);
  float* EG = (float*)(big + B_EG);
  float* sc = (float*)smem;
  float* sv = sc + 256 * 129;
  unsigned char* si = (unsigned char*)(sv + 256 * 16);
  const int tid = TIDX;
  __syncthreads();
  for (int e = tid; e < 256 * 128; e += NTHR) {
    int row = e >> 7, j = e & 127;
    sc[row * 129 + j] = S[(size_t)n0 * 2048 + e];
  }
  __syncthreads();
  if (tid < 256) {
    const float* rowp = sc + tid * 129;
    float pv = __builtin_inff();
    int pi = -1;
    for (int k = 0; k < 16; k++) {
      float bv = -__builtin_inff();
      int bi = 0;
      for (int j = 0; j < 128; j++) {
        float x = rowp[j];
        bool elig = (x < pv) || (x == pv && j > pi);
        if (elig && x > bv) { bv = x; bi = j; }
      }
      sv[tid * 16 + k] = bv;
      si[tid * 16 + k] = (unsigned char)bi;
      pv = bv; pi = bi;
    }
  }
  __syncthreads();
  if (tid < 128) {
    const int tl = tid >> 3, head = tid & 7;
    const int r0 = tl * 16 + head * 2, r1 = r0 + 1;
    const float* a = sv + r0 * 16;
    const float* bq = sv + r1 * 16;
    float* eg = sc + tid * 17;
    const int n = n0 + tl;
    float pv = __builtin_inff();
    int pc = -1;
    float mx = 0.f, sum = 0.f;
    for (int k = 0; k < 16; k++) {
      float bv = -__builtin_inff();
      int bc = 0;
      for (int i = 0; i < 16; i++) {
        const int jn = 16 / (i + 1);
        const float ai = a[i];
        for (int j = 0; j < jn; j++) {
          float x = ai + bq[j];
          int c = i * 16 + j;
          bool elig = (x < pv) || (x == pv && c > pc);
          if (elig && x > bv) { bv = x; bc = c; }
        }
      }
      if (k == 0) mx = bv;
      float ev = __expf(bv - mx);
      sum += ev;
      eg[k] = ev;
      EI[(size_t)n * 128 + head * 16 + k] = (int)si[r0 * 16 + (bc >> 4)] * 128 + (int)si[r1 * 16 + (bc & 15)];
      pv = bv; pc = bc;
    }
    const float inv = 1.f / sum;
    for (int k = 0; k < 16; k++) EG[(size_t)n * 128 + head * 16 + k] = eg[k] * inv;
  }
}

DI void peer_gather(const int TIDX, const P& p, int layer, bool last, int bid, int nb) {
  char* big = p.ws + OFF_BIG;
  const int* EI = (const int*)(big + B_EI);
  const float* EG = (const float*)(big + B_EG);
  const bf16_t* UB = (const bf16_t*)(p.ws + OFF_UB);
  const bf16_t* VB = (const bf16_t*)(p.ws + OFF_VB);
  bf16_t* H = (bf16_t*)(p.ws + OFF_H);
  float* X = (float*)(p.ws + OFF_X);
  const float* mod = (const float*)(p.ws + OFF_MOD);
  const int lane = TIDX & 63, wave = TIDX >> 6;
  for (int n = bid * 8 + wave; n < NTOK; n += nb * 8) {
    const int b = n / LT, pos = n - b * LT;
    if (last && pos < LC) continue;
    float hv[16];
    {
      uint4 h0 = *(const uint4*)(H + (size_t)n * DM + lane * 8);
      uint4 h1 = *(const uint4*)(H + (size_t)n * DM + 512 + lane * 8);
      unpack8(h0, hv); unpack8(h1, hv + 8);
    }
    const int id_lo = EI[(size_t)n * 128 + lane], id_hi = EI[(size_t)n * 128 + 64 + lane];
    const float g_lo = EG[(size_t)n * 128 + lane], g_hi = EG[(size_t)n * 128 + 64 + lane];
    float act_lo = 0.f, act_hi = 0.f;
#pragma unroll 1
    for (int half = 0; half < 2; half++) {
      const int idv = half ? id_hi : id_lo;
      float actv = 0.f;
#pragma unroll 4
      for (int e = 0; e < 64; e++) {
        const int id = __builtin_amdgcn_readlane(idv, e);
        const bf16_t* ur = UB + (size_t)id * DM + lane * 8;
        uint4 u0 = *(const uint4*)(ur);
        uint4 u1 = *(const uint4*)(ur + 512);
        float uv[16];
        unpack8(u0, uv); unpack8(u1, uv + 8);
        float dsum = 0.f;
#pragma unroll
        for (int j = 0; j < 16; j++) dsum += hv[j] * uv[j];
        dsum = wave_sum(dsum);
        if (lane == e) actv = dsum;
      }
      if (half) act_hi = actv; else act_lo = actv;
    }
    const float cf_lo = g_lo * 0.5f * act_lo * (1.f + erff(act_lo * 0.70710678f));
    const float cf_hi = g_hi * 0.5f * act_hi * (1.f + erff(act_hi * 0.70710678f));
    float acc[16];
#pragma unroll
    for (int j = 0; j < 16; j++) acc[j] = 0.f;
#pragma unroll 1
    for (int half = 0; half < 2; half++) {
      const int idv = half ? id_hi : id_lo;
      const float cfv = half ? cf_hi : cf_lo;
#pragma unroll 4
      for (int e = 0; e < 64; e++) {
        const int id = __builtin_amdgcn_readlane(idv, e);
        const float cf = __builtin_bit_cast(float, __builtin_amdgcn_readlane(__builtin_bit_cast(int, cfv), e));
        const bf16_t* vr = VB + (size_t)id * DM + lane * 8;
        uint4 u0 = *(const uint4*)(vr);
        uint4 u1 = *(const uint4*)(vr + 512);
        float uv[16];
        unpack8(u0, uv); unpack8(u1, uv + 8);
#pragma unroll
        for (int j = 0; j < 16; j++) acc[j] += cf * uv[j];
      }
    }
    const int rr = pos < LC ? 8 : b;
    const float* gate = mod + (size_t)(layer * 9 + rr) * 6144 + 5 * 1024;
    float xo[16];
#pragma unroll
    for (int hf = 0; hf < 2; hf++) {
      const int base = hf * 512 + lane * 8;
      float4 x0 = *(const float4*)(X + (size_t)n * DM + base), x1 = *(const float4*)(X + (size_t)n * DM + base + 4);
      float4 g0 = *(const float4*)(gate + base), g1 = *(const float4*)(gate + base + 4);
      xo[hf * 8 + 0] = x0.x + g0.x * acc[hf * 8 + 0]; xo[hf * 8 + 1] = x0.y + g0.y * acc[hf * 8 + 1];
      xo[hf * 8 + 2] = x0.z + g0.z * acc[hf * 8 + 2]; xo[hf * 8 + 3] = x0.w + g0.w * acc[hf * 8 + 3];
      xo[hf * 8 + 4] = x1.x + g1.x * acc[hf * 8 + 4]; xo[hf * 8 + 5] = x1.y + g1.y * acc[hf * 8 + 5];
      xo[hf * 8 + 6] = x1.z + g1.z * acc[hf * 8 + 6]; xo[hf * 8 + 7] = x1.w + g1.w * acc[hf * 8 + 7];
    }
    if (last) {
      float* orow = p.out + ((size_t)(b * SEQ + pos - LC)) * DM;
#pragma unroll
      for (int hf = 0; hf < 2; hf++) {
        const int base = hf * 512 + lane * 8;
        *(float4*)(orow + base) = make_float4(xo[hf * 8], xo[hf * 8 + 1], xo[hf * 8 + 2], xo[hf * 8 + 3]);
        *(float4*)(orow + base + 4) = make_float4(xo[hf * 8 + 4], xo[hf * 8 + 5], xo[hf * 8 + 6], xo[hf * 8 + 7]);
      }
    } else {
      float ss = 0.f;
#pragma unroll
      for (int j = 0; j < 16; j++) ss += xo[j] * xo[j];
      ss = wave_sum(ss);
      const float rs = rsqrtf(ss * (1.f / 1024.f) + 1e-6f);
      const float* g = p.n1g + (layer + 1) * 1024;
      const float* msc = mod + (size_t)((layer + 1) * 9 + rr) * 6144 + 1 * 1024;
      const float* msh = mod + (size_t)((layer + 1) * 9 + rr) * 6144;
#pragma unroll
      for (int hf = 0; hf < 2; hf++) {
        const int base = hf * 512 + lane * 8;
        *(float4*)(X + (size_t)n * DM + base) = make_float4(xo[hf * 8], xo[hf * 8 + 1], xo[hf * 8 + 2], xo[hf * 8 + 3]);
        *(float4*)(X + (size_t)n * DM + base + 4) = make_float4(xo[hf * 8 + 4], xo[hf * 8 + 5], xo[hf * 8 + 6], xo[hf * 8 + 7]);
        float y[8];
#pragma unroll
        for (int j = 0; j < 8; j++) y[j] = xo[hf * 8 + j] * rs * g[base + j] * (1.f + msc[base + j]) + msh[base + j];
        *(uint4*)(H + (size_t)n * DM + base) = pack8(y);
      }
    }
  }
}

DI void conv_phase(const int TIDX, const P& p, int bid, int nb) {
  char* big = p.ws + OFF_BIG;
  const bf16_t* ZX = (const bf16_t*)(big + B_ZX);
  bf16_t* XBC = (bf16_t*)(big + B_XBC);
  const int total = NTOK * 384;
  for (int it = bid * NTHR + TIDX; it < total; it += nb * NTHR) {
    const int n = it / 384, c8 = (it - n * 384) * 8;
    const int b = n / LT, pos = n - b * LT;
    const bool hasp = (pos != 0 && pos != LC), hasn = (pos != LC - 1 && pos != LT - 1);
    const bf16_t* zc = ZX + (size_t)n * 3072 + c8;
    uint4 cu = *(const uint4*)zc, pu = make_uint4(0, 0, 0, 0), nu = make_uint4(0, 0, 0, 0);
    if (hasp) pu = *(const uint4*)(zc - 3072);
    if (hasn) nu = *(const uint4*)(zc + 3072);
    float cv[8], pv[8], nv[8], y[8];
    unpack8(cu, cv); unpack8(pu, pv); unpack8(nu, nv);
#pragma unroll
    for (int j = 0; j < 8; j++) {
      float a = p.conv_b[c8 + j] + p.conv_w[c8 + j] * pv[j] + p.conv_w[3072 + c8 + j] * cv[j] + p.conv_w[6144 + c8 + j] * nv[j];
      y[j] = siluf_(a);
    }
    *(uint4*)(XBC + (size_t)n * 3072 + c8) = pack8(y);
  }
}

DI void ssd_task(const int TIDX, const P& p, int task, char* smem) {
  char* big = p.ws + OFF_BIG;
  const int b = task >> 5, h = task & 31, g = h >> 3;
  bf16_t* Cs = (bf16_t*)smem;
  bf16_t* Bs = Cs + 128 * 136;
  bf16_t* BT = Bs + 128 * 136;
  bf16_t* xT = BT + 128 * 136;
  bf16_t* sb = xT + 64 * 136;
  float* cum = (float*)(sb + 64 * 136);
  float* dtv = cum + 128;
  const bf16_t* XBC = (const bf16_t*)(big + B_XBC);
  const float* DT = (const float*)(big + B_DT);
  bf16_t* Y = (bf16_t*)(big + B_Y);
  const int tid = TIDX, lane = tid & 63, wave = tid >> 6;
  const int r = lane & 31, h8 = lane >> 5;
  const float dskip = p.ssd_d[h];
  for (int d = 0; d < 2; d++) {
    const float a = -expf(p.a_log[d * 32 + h]);
    const float bias = p.dt_bias[d * 32 + h];
    f32x16 sacc;
#pragma unroll
    for (int q = 0; q < 16; q++) sacc[q] = 0.f;
    __syncthreads();
    for (int e = tid; e < 64 * 136; e += NTHR) sb[e] = 0;
    for (int c = 0; c < 18; c++) {
      __syncthreads();
      if (wave == 0) {
        const int i0 = lane * 2, i1 = i0 + 1;
        const int p0 = scanpos(d, c * 128 + i0), p1 = scanpos(d, c * 128 + i1);
        const float dt0 = softplusf_(DT[(size_t)(b * LT + p0) * 64 + d * 32 + h] + bias);
        const float dt1 = softplusf_(DT[(size_t)(b * LT + p1) * 64 + d * 32 + h] + bias);
        const float a0 = a * dt0, a1 = a0 + a * dt1;
        float tot = a1;
#pragma unroll
        for (int off = 1; off < 64; off <<= 1) {
          float t = shup_(tot, off, lane);
          if (lane >= off) tot += t;
        }
        const float excl = tot - a1;
        cum[i0] = excl + a0; cum[i1] = excl + a1;
        dtv[i0] = dt0; dtv[i1] = dt1;
      }
      __syncthreads();
      const float cl = cum[127];
      {
        const int j = tid >> 2, part = tid & 3;
        const int pos = scanpos(d, c * 128 + j);
        const bf16_t* rowp = XBC + (size_t)(b * LT + pos) * 3072;
        const float wj = __expf(cl - cum[j]) * dtv[j];
#pragma unroll
        for (int q = 0; q < 4; q++) {
          const int col = part * 32 + q * 8;
          uint4 cvv = *(const uint4*)(rowp + 2560 + g * 128 + col);
          *(uint4*)(Cs + j * 136 + col) = cvv;
          uint4 bvv = *(const uint4*)(rowp + 2048 + g * 128 + col);
          *(uint4*)(Bs + j * 136 + col) = bvv;
          float bf[8]; unpack8(bvv, bf);
#pragma unroll
          for (int e = 0; e < 8; e++) BT[(col + e) * 136 + j] = f2bf(bf[e] * wj);
        }
#pragma unroll
        for (int q = 0; q < 2; q++) {
          const int col = part * 16 + q * 8;
          uint4 xv = *(const uint4*)(rowp + h * 64 + col);
          const bf16_t* xe = (const bf16_t*)&xv;
#pragma unroll
          for (int e = 0; e < 8; e++) xT[(col + e) * 136 + j] = xe[e];
        }
      }
      __syncthreads();
      const int it = wave >> 1;
      f32x16 G0, G1;
#pragma unroll
      for (int q = 0; q < 16; q++) { G0[q] = 0.f; G1[q] = 0.f; }
      {
        const int jt0 = (wave & 1) * 2, jt1 = jt0 + 1;
        if (jt0 <= it) {
#pragma unroll
          for (int ks = 0; ks < 8; ks++) {
            bf16x8 av = *(const bf16x8*)(Cs + (it * 32 + r) * 136 + ks * 16 + h8 * 8);
            bf16x8 b0 = *(const bf16x8*)(Bs + (jt0 * 32 + r) * 136 + ks * 16 + h8 * 8);
            G0 = __builtin_amdgcn_mfma_f32_32x32x16_bf16(av, b0, G0, 0, 0, 0);
            if (jt1 <= it) {
              bf16x8 b1 = *(const bf16x8*)(Bs + (jt1 * 32 + r) * 136 + ks * 16 + h8 * 8);
              G1 = __builtin_amdgcn_mfma_f32_32x32x16_bf16(av, b1, G1, 0, 0, 0);
            }
          }
        }
      }
      __syncthreads();
      {
        bf16_t* Ms = Bs;
        const int jt0 = (wave & 1) * 2;
        const int j0 = jt0 * 32 + r, j1 = j0 + 32;
        const float cj0 = cum[j0], cj1 = cum[j1], dj0 = dtv[j0], dj1 = dtv[j1];
#pragma unroll
        for (int q = 0; q < 16; q++) {
          const int i = it * 32 + (q & 3) + 8 * (q >> 2) + 4 * h8;
          const float ci = cum[i];
          float m0 = (j0 <= i) ? G0[q] * __expf(ci - cj0) * dj0 : 0.f;
          float m1 = (j1 <= i) ? G1[q] * __expf(ci - cj1) * dj1 : 0.f;
          Ms[i * 136 + j0] = f2bf(m0);
          Ms[i * 136 + j1] = f2bf(m1);
        }
      }
      __syncthreads();
      {
        const bf16_t* Ms = Bs;
        const int pt = wave & 1;
        f32x16 yd, yo;
#pragma unroll
        for (int q = 0; q < 16; q++) { yd[q] = 0.f; yo[q] = 0.f; }
#pragma unroll
        for (int ks = 0; ks < 8; ks++) {
          if (ks < (it + 1) * 2) {
            bf16x8 av = *(const bf16x8*)(Ms + (it * 32 + r) * 136 + ks * 16 + h8 * 8);
            bf16x8 bv = *(const bf16x8*)(xT + (pt * 32 + r) * 136 + ks * 16 + h8 * 8);
            yd = __builtin_amdgcn_mfma_f32_32x32x16_bf16(av, bv, yd, 0, 0, 0);
          }
          bf16x8 cv = *(const bf16x8*)(Cs + (it * 32 + r) * 136 + ks * 16 + h8 * 8);
          bf16x8 sv = *(const bf16x8*)(sb + (pt * 32 + r) * 136 + ks * 16 + h8 * 8);
          yo = __builtin_amdgcn_mfma_f32_32x32x16_bf16(cv, sv, yo, 0, 0, 0);
        }
        if (c >= 2) {
          const int pp = pt * 32 + r;
#pragma unroll
          for (int q = 0; q < 16; q++) {
            const int i = it * 32 + (q & 3) + 8 * (q >> 2) + 4 * h8;
            float y = yd[q] + __expf(cum[i]) * yo[q];
            const int pos = scanpos(d, c * 128 + i);
            const size_t idx = (size_t)(b * LT + pos) * 2048 + h * 64 + pp;
            if (d == 0) y += dskip * bf2f(xT[pp * 136 + i]);
            else y += bf2f(Y[idx]);
            Y[idx] = f2bf(y);
          }
        }
      }
      __syncthreads();
      {
        const int pt = wave & 1, nt = wave >> 1;
        const float ecl = __expf(cl);
#pragma unroll
        for (int q = 0; q < 16; q++) sacc[q] *= ecl;
#pragma unroll
        for (int ks = 0; ks < 8; ks++) {
          bf16x8 av = *(const bf16x8*)(xT + (pt * 32 + r) * 136 + ks * 16 + h8 * 8);
          bf16x8 bv = *(const bf16x8*)(BT + (nt * 32 + r) * 136 + ks * 16 + h8 * 8);
          sacc = __builtin_amdgcn_mfma_f32_32x32x16_bf16(av, bv, sacc, 0, 0, 0);
        }
#pragma unroll
        for (int q = 0; q < 16; q++) {
          const int pp = pt * 32 + (q & 3) + 8 * (q >> 2) + 4 * h8;
          sb[pp * 136 + nt * 32 + r] = f2bf(sacc[q]);
        }
      }
    }
  }
}

DI void gate_norm(const int TIDX, const P& p, int bid, int nb) {
  char* big = p.ws + OFF_BIG;
  const bf16_t* Y = (const bf16_t*)(big + B_Y);
  const bf16_t* ZG = (const bf16_t*)(big + B_ZG);
  bf16_t* YN = (bf16_t*)(big + B_YN);
  const int lane = TIDX & 63, wave = TIDX >> 6;
  for (int n = bid * 8 + wave; n < NTOK; n += nb * 8) {
    const int b = n / LT, pos = n - b * LT;
    if (pos < LC) continue;
#pragma unroll
    for (int gq = 0; gq < 4; gq++) {
      const int base = gq * 512 + lane * 8;
      uint4 yv = *(const uint4*)(Y + (size_t)n * 2048 + base);
      uint4 zv = *(const uint4*)(ZG + (size_t)n * 2048 + base);
      float y[8], z[8];
      unpack8(yv, y); unpack8(zv, z);
      float ss = 0.f;
#pragma unroll
      for (int j = 0; j < 8; j++) { y[j] = y[j] * siluf_(z[j]); ss += y[j] * y[j]; }
      ss = wave_sum(ss);
      const float rs = rsqrtf(ss * (1.f / 512.f) + 1e-6f);
#pragma unroll
      for (int j = 0; j < 8; j++) y[j] = y[j] * rs * p.ssd_nw[base + j];
      *(uint4*)(YN + (size_t)n * 2048 + base) = pack8(y);
    }
  }
}

DI void run_phase(const int TIDX, const P& p, int ph, int bid, int nb, char* smem) {
  char* ws = p.ws;
  char* big = ws + OFF_BIG;
  float* X = (float*)(ws + OFF_X);
  const float* mod = (const float*)(ws + OFF_MOD);
  bf16_t* H = (bf16_t*)(ws + OFF_H);
  switch (ph) {
    case 0: {
      mod_gemv(TIDX, p, bid, nb, smem);
      tconv(TIDX, p.ev_w_in, 2560, 1024, 2560, (bf16_t*)(ws + OFF_WIN0), 1024, 0, bid, nb, smem);
      tconv(TIDX, p.ev_w_out, 1024, 1024, 1024, (bf16_t*)(ws + OFF_WOUT0), 1536, 0, bid, nb, smem);
      tconv(TIDX, p.ev_w_out + 512 * 1024, 1024, 512, 1024, (bf16_t*)(ws + OFF_WOUT0), 1536, 1024, bid, nb, smem);
      tconv(TIDX, p.ssd_w_in, 5184, 1024, 5184, (bf16_t*)(ws + OFF_WIN1), 1024, 0, bid, nb, smem);
      tconv(TIDX, p.ssd_w_out, 1024, 2048, 1024, (bf16_t*)(ws + OFF_WOUT1), 2048, 0, bid, nb, smem);
      tconv(TIDX, p.pwq, 2048, 1024, 2048, (bf16_t*)(ws + OFF_WQ), 1024, 0, bid, nb, smem);
      tconv(TIDX, p.pwq + 1024 * 2048, 2048, 1024, 2048, (bf16_t*)(ws + OFF_WQ) + 2048 * 1024, 1024, 0, bid, nb, smem);
      tconv(TIDX, p.w2, 512, 64, 512, (bf16_t*)(ws + OFF_W2C), 64, 0, bid, nb, smem);
      tconv(TIDX, p.w2 + 64 * 512, 512, 64, 512, (bf16_t*)(ws + OFF_W2C) + 512 * 64, 64, 0, bid, nb, smem);
      tconv(TIDX, p.a2, 512, 64, 512, (bf16_t*)(ws + OFF_A2C), 64, 0, bid, nb, smem);
      tconv(TIDX, p.a2 + 64 * 512, 512, 64, 512, (bf16_t*)(ws + OFF_A2C) + 512 * 64, 64, 0, bid, nb, smem);
      tconv(TIDX, p.g2, 512, 128, 512, (bf16_t*)(ws + OFF_G2T), 128, 0, bid, nb, smem);
      conv_flat(TIDX, p.pkeys, (bf16_t*)(ws + OFF_KEYS), (size_t)2 * 16 * 128 * 128, bid, nb);
      conv_flat(TIDX, p.pu, (bf16_t*)(ws + OFF_UB), (size_t)16384 * 1024, bid, nb);
      conv_flat(TIDX, p.pv, (bf16_t*)(ws + OFF_VB), (size_t)16384 * 1024, bid, nb);
    } break;
    case 1: norm_rows(TIDX, p, 0, 0, true, false, bid, nb); break;
    case 2: {
      bf16_t* Z = (bf16_t*)(big + B_Z0);
      auto epi = [=](int m, int n, float v) { Z[(size_t)m * 2560 + n] = f2bf(v); };
      for (int t = bid; t < 72 * 20; t += nb) {
        int mt = t / 20, nt = t % 20;
        gemm_tile(TIDX, H, 1024, (const bf16_t*)(ws + OFF_WIN0), 1024, 1024, mt * 256, nt * 128, epi, smem);
      }
    } break;
    case 3: prep0(TIDX, p, bid, nb); break;
    case 4: {
      float* DEC = (float*)(big + B_DEC);
      bf16_t* AL = (bf16_t*)(big + B_AL);
      bf16_t* G = (bf16_t*)(big + B_G);
      const float* w0 = p.w0; const float* a0 = p.a0;
      auto epi1 = [=](int m, int n, float v) {
        int d = n >> 9, c = n & 511, hh = c >> 6, i = c & 63;
        int b = m / LT, pos = m - b * LT;
        float x = w0[n] + v;
        float w = -softplusf_(-x) - 0.5f;
        DEC[(size_t)d * (NB * 8 * LT * 64) + ((size_t)(b * 8 + hh) * LT + pos) * 64 + i] = expf(-expf(w));
      };
      auto epi2 = [=](int m, int n, float v) {
        int d = n >> 9, c = n & 511, hh = c >> 6, i = c & 63;
        int b = m / LT, pos = m - b * LT;
        AL[(size_t)d * (NB * 8 * LT * 64) + ((size_t)(b * 8 + hh) * LT + pos) * 64 + i] = f2bf(sigmoidf_(a0[n] + v));
      };
      auto epi3 = [=](int m, int n, float v) { G[(size_t)m * 512 + n] = f2bf(v); };
      for (int t = bid; t < 1440; t += nb) {
        if (t < 576) {
          gemm_tile(TIDX, (const bf16_t*)(big + B_AW), 64, (const bf16_t*)(ws + OFF_W2C), 64, 64, (t >> 3) * 256, (t & 7) * 128, epi1, smem);
        } else if (t < 1152) {
          int t2 = t - 576;
          gemm_tile(TIDX, (const bf16_t*)(big + B_AA), 64, (const bf16_t*)(ws + OFF_A2C), 64, 64, (t2 >> 3) * 256, (t2 & 7) * 128, epi2, smem);
        } else {
          int t2 = t - 1152;
          gemm_tile(TIDX, (const bf16_t*)(big + B_AG), 128, (const bf16_t*)(ws + OFF_G2T), 128, 128, (t2 >> 2) * 256, (t2 & 3) * 128, epi3, smem);
        }
      }
    } break;
    case 5: {
      if (nb >= 256) {
        if (bid < 128) wkv_task(TIDX, p, bid, smem);
        else for (int t = bid - 128; t < 576; t += nb - 128) attn_task(TIDX, p, t, smem);
      } else {
        for (int t = bid; t < 128; t += nb) wkv_task(TIDX, p, t, smem);
        for (int t = bid; t < 576; t += nb) attn_task(TIDX, p, t, smem);
      }
    } break;
    case 6: {
      const float* gate = mod;
      const float* xc_ = p.ctx; const float* xl_ = p.x;
      auto epi = [=](int m, int n, float v) {
        int b = m / LT, pos = m - b * LT;
        int rr = pos < LC ? 8 : b;
        const float* xr = pos < LC ? xc_ + ((size_t)(b * LC + pos)) * DM : xl_ + ((size_t)(b * SEQ + pos - LC)) * DM;
        X[(size_t)m * DM + n] = xr[n] + gate[(size_t)rr * 6144 + 2 * 1024 + n] * v;
      };
      for (int t = bid; t < 72 * 8; t += nb)
        gemm_tile(TIDX, (const bf16_t*)(big + B_YMIX), 1536, (const bf16_t*)(ws + OFF_WOUT0), 1536, 1536, (t >> 3) * 256, (t & 7) * 128, epi, smem);
    } break;
    case 7: norm_rows(TIDX, p, 0, 1, false, false, bid, nb); break;
    case 8: {
      bf16_t* QP = (bf16_t*)(big + B_QP);
      auto epi = [=](int m, int n, float v) { QP[(size_t)m * 2048 + n] = f2bf(v); };
      for (int t = bid; t < 72 * 16; t += nb)
        gemm_tile(TIDX, H, 1024, (const bf16_t*)(ws + OFF_WQ), 1024, 1024, (t >> 4) * 256, (t & 15) * 128, epi, smem);
    } break;
    case 9: {
      float* S = (float*)(big + B_S);
      for (int t = bid; t < 72 * 16; t += nb) {
        int hp = t & 15;
        auto epi = [=](int m, int n, float v) { S[(size_t)m * 2048 + hp * 128 + n] = v; };
        gemm_tile(TIDX, (const bf16_t*)(big + B_QP) + hp * 128, 2048, (const bf16_t*)(ws + OFF_KEYS) + hp * 128 * 128, 128, 128, (t >> 4) * 256, 0, epi, smem);
      }
    } break;
    case 10:
      for (int t = bid; t < NTOK / 16; t += nb) route_task(TIDX, p, t * 16, smem);
      break;
    case 11: peer_gather(TIDX, p, 0, false, bid, nb); break;
    case 12: {
      bf16_t* ZG = (bf16_t*)(big + B_ZG);
      bf16_t* ZX = (bf16_t*)(big + B_ZX);
      float* DT = (float*)(big + B_DT);
      auto epi = [=](int m, int n, float v) {
        if (n < 2048) ZG[(size_t)m * 2048 + n] = f2bf(v);
        else if (n < 5120) ZX[(size_t)m * 3072 + n - 2048] = f2bf(v);
        else if (n < 5184) DT[(size_t)m * 64 + n - 5120] = v;
      };
      for (int t = bid; t < 72 * 41; t += nb) {
        int mt = t / 41, nt = t % 41;
        gemm_tile(TIDX, H, 1024, (const bf16_t*)(ws + OFF_WIN1), 1024, 1024, mt * 256, nt * 128, epi, smem);
      }
    } break;
    case 13: {
      conv_phase(TIDX, p, bid, nb);
      conv_flat(TIDX, p.pu + (size_t)16384 * 1024, (bf16_t*)(ws + OFF_UB), (size_t)16384 * 1024, bid, nb);
      conv_flat(TIDX, p.pv + (size_t)16384 * 1024, (bf16_t*)(ws + OFF_VB), (size_t)16384 * 1024, bid, nb);
    } break;
    case 14:
      for (int t = bid; t < 256; t += nb) ssd_task(TIDX, p, t, smem);
      break;
    case 15: gate_norm(TIDX, p, bid, nb); break;
    case 16: {
      const float* gate = mod + (size_t)9 * 6144;
      auto epi = [=](int m, int n, float v) {
        int b = m / LT;
        X[(size_t)m * DM + n] += gate[(size_t)b * 6144 + 2 * 1024 + n] * v;
      };
      for (int t = bid; t < 64 * 8; t += nb) {
        int mtl = t >> 3, b = mtl >> 3, mt = b * 9 + 1 + (mtl & 7);
        gemm_tile(TIDX, (const bf16_t*)(big + B_YN), 2048, (const bf16_t*)(ws + OFF_WOUT1), 2048, 2048, mt * 256, (t & 7) * 128, epi, smem);
      }
    } break;
    case 17: norm_rows(TIDX, p, 1, 1, false, true, bid, nb); break;
    case 18: {
      bf16_t* QP = (bf16_t*)(big + B_QP);
      auto epi = [=](int m, int n, float v) { QP[(size_t)m * 2048 + n] = f2bf(v); };
      for (int t = bid; t < 64 * 16; t += nb) {
        int mtl = t >> 4, b = mtl >> 3, mt = b * 9 + 1 + (mtl & 7);
        gemm_tile(TIDX, H, 1024, (const bf16_t*)(ws + OFF_WQ) + 2048 * 1024, 1024, 1024, mt * 256, (t & 15) * 128, epi, smem);
      }
    } break;
    case 19: {
      float* S = (float*)(big + B_S);
      for (int t = bid; t < 64 * 16; t += nb) {
        int hp = t & 15;
        int mtl = t >> 4, b = mtl >> 3, mt = b * 9 + 1 + (mtl & 7);
        auto epi = [=](int m, int n, float v) { S[(size_t)m * 2048 + hp * 128 + n] = v; };
        gemm_tile(TIDX, (const bf16_t*)(big + B_QP) + hp * 128, 2048, (const bf16_t*)(ws + OFF_KEYS) + (16 + hp) * 128 * 128, 128, 128, mt * 256, 0, epi, smem);
      }
    } break;
    case 20:
      for (int t = bid; t < NB * (SEQ / 16); t += nb) {
        int b = t / (SEQ / 16), tt = t % (SEQ / 16);
        route_task(TIDX, p, b * LT + LC + tt * 16, smem);
      }
      break;
    case 21: peer_gather(TIDX, p, 1, true, bid, nb); break;
  }
}
constexpr int NPHASE = 22;

__global__ void __launch_bounds__(NTHR) mega(P p) {
  __shared__ __attribute__((aligned(16))) char smem[SMEM_BYTES];
  cg::grid_group grid = cg::this_grid();
#define PHC(i, last)                                             \
  {                                                              \
    P q = p;                                                     \
    int bid = blockIdx.x, nb = gridDim.x;                        \
    char* sm = smem;                                             \
    int TIDX = __builtin_amdgcn_workitem_id_x();                 \
    asm volatile("" : "+s"(q.ws), "+s"(bid), "+s"(nb), "+v"(TIDX)); \
    run_phase(TIDX, q, i, bid, nb, sm);                          \
    if (!last) grid.sync();                                      \
  }
  PHC(0, 0) PHC(1, 0) PHC(2, 0) PHC(3, 0) PHC(4, 0) PHC(5, 0) PHC(6, 0) PHC(7, 0) PHC(8, 0) PHC(9, 0) PHC(10, 0)
  PHC(11, 0) PHC(12, 0) PHC(13, 0) PHC(14, 0) PHC(15, 0) PHC(16, 0) PHC(17, 0) PHC(18, 0) PHC(19, 0) PHC(20, 0) PHC(21, 1)
}

extern "C" void kernel_launch(void* const* d_in, const int* in_sizes, int n_in, void* d_out, int out_size, void* d_ws,
                              size_t ws_size, hipStream_t stream) {
  static int grid_blocks = 0;
  if (!grid_blocks) {
    int dev = 0, cus = 0, per_cu = 0;
    hipGetDevice(&dev);
    hipDeviceGetAttribute(&cus, hipDeviceAttributeMultiprocessorCount, dev);
    hipOccupancyMaxActiveBlocksPerMultiprocessor(&per_cu, mega, NTHR, 0);
    if (per_cu < 1) per_cu = 1;
    grid_blocks = cus * per_cu;
  }
  P p;
  memset(&p, 0, sizeof(p));
  const float** fp = (const float**)&p;
  for (int i = 0; i < 35; i++) fp[i] = (const float*)d_in[i];
  p.out = (float*)d_out;
  p.ws = (char*)d_ws;
  if (ws_size < WS_NEED) fprintf(stderr, "workspace too small: %zu < %zu\n", ws_size, (size_t)WS_NEED);
  void* args[] = {&p};
  hipError_t e = hipLaunchCooperativeKernel((void*)mega, dim3(grid_blocks), dim3(NTHR), args, 0, stream);
  if (e != hipSuccess) fprintf(stderr, "cooperative launch failed: %s (grid %d)\n", hipGetErrorString(e), grid_blocks);
}
```

```cpp
#include <hip/hip_runtime.h>
#include <hip/hip_cooperative_groups.h>
#include <stdint.h>
#include <string.h>
#include <stdio.h>
namespace cg = cooperative_groups;

#define DI __device__ __forceinline__
typedef unsigned short bf16_t;
typedef short bf16x8 __attribute__((ext_vector_type(8)));
typedef float f32x16 __attribute__((ext_vector_type(16)));

constexpr int NB = 8, SEQ = 2048, LC = 256, LT = 2304, NTOK = 18432, DM = 1024;
constexpr int NTHR = 512;

constexpr size_t OFF_UB = 0;
constexpr size_t OFF_VB = OFF_UB + 33554432;
constexpr size_t OFF_WIN0 = OFF_VB + 33554432;
constexpr size_t OFF_WOUT0 = OFF_WIN0 + 5242880;
constexpr size_t OFF_WIN1 = OFF_WOUT0 + 3145728;
constexpr size_t OFF_WOUT1 = OFF_WIN1 + 10747904;
constexpr size_t OFF_WQ = OFF_WOUT1 + 4194304;
constexpr size_t OFF_KEYS = OFF_WQ + 8388608;
constexpr size_t OFF_W2C = OFF_KEYS + 1048576;
constexpr size_t OFF_A2C = OFF_W2C + 131072;
constexpr size_t OFF_G2T = OFF_A2C + 131072;
constexpr size_t OFF_MOD = OFF_G2T + 131072;
constexpr size_t OFF_X = OFF_MOD + 442368;
constexpr size_t OFF_H = OFF_X + 75497472;
constexpr size_t OFF_BIG = OFF_H + 37748736;
constexpr size_t B_Z0 = 0;
constexpr size_t B_DEC = 0;
constexpr size_t B_G = 75497472;
constexpr size_t B_QN = 94371840;
constexpr size_t B_KN = B_QN + 18874368;
constexpr size_t B_VT = B_KN + 4718592;
constexpr size_t B_R = B_VT + 4718592;
constexpr size_t B_KB = B_R + 18874368;
constexpr size_t B_KK = B_KB + 18874368;
constexpr size_t B_V = B_KK + 18874368;
constexpr size_t B_AL = B_V + 18874368;
constexpr size_t B_AW = B_AL + 37748736;
constexpr size_t B_AA = B_AW + 2359296;
constexpr size_t B_AG = B_AA + 2359296;
constexpr size_t B_YMIX = B_AG + 4718592;
constexpr size_t B_L0END = B_YMIX + 56623104;
constexpr size_t B_QP = 0;
constexpr size_t B_S = 75497472;
constexpr size_t B_EI = B_S + 150994944;
constexpr size_t B_EG = B_EI + 9437184;
constexpr size_t B_PEND = B_EG + 9437184;
constexpr size_t B_ZG = 0;
constexpr size_t B_ZX = 75497472;
constexpr size_t B_Y = B_ZX;
constexpr size_t B_DT = B_ZX + 113246208;
constexpr size_t B_XBC = B_DT + 4718592;
constexpr size_t B_YN = B_XBC;
constexpr size_t B_L1END = B_XBC + 113246208;
constexpr size_t BIG_SZ = B_L1END > B_L0END ? (B_L1END > B_PEND ? B_L1END : B_PEND) : (B_L0END > B_PEND ? B_L0END : B_PEND);
constexpr size_t WS_NEED = OFF_BIG + BIG_SZ;
static_assert(WS_NEED <= 536870912, "workspace too large");

constexpr int SMEM_BYTES = 157696;

struct P {
  const float *x, *c, *ctx, *c_ctx, *mod_w, *mod_b, *n1g, *n2g, *ev_w_in, *ev_w_out, *qg, *kg, *mu, *w0, *w2, *a0, *a2, *g2,
      *k_k, *k_a, *r_k, *gn_w, *gn_b, *ssd_w_in, *conv_w, *conv_b, *dt_bias, *a_log, *ssd_d, *ssd_nw, *ssd_w_out, *pwq, *pkeys,
      *pu, *pv;
  float* out;
  char* ws;
};

DI bf16_t f2bf(float f) {
  unsigned u = __float_as_uint(f);
  u += 0x7fffu + ((u >> 16) & 1u);
  return (bf16_t)(u >> 16);
}
DI float bf2f(bf16_t b) { return __uint_as_float(((unsigned)b) << 16); }
DI unsigned pack2(float a, float b) { return (unsigned)f2bf(a) | ((unsigned)f2bf(b) << 16); }
DI float lo2f(unsigned u) { return __uint_as_float(u << 16); }
DI float hi2f(unsigned u) { return __uint_as_float(u & 0xffff0000u); }
DI void unpack8(const uint4& r, float* v) {
  v[0] = lo2f(r.x); v[1] = hi2f(r.x); v[2] = lo2f(r.y); v[3] = hi2f(r.y);
  v[4] = lo2f(r.z); v[5] = hi2f(r.z); v[6] = lo2f(r.w); v[7] = hi2f(r.w);
}
DI uint4 pack8(const float* v) {
  uint4 r; r.x = pack2(v[0], v[1]); r.y = pack2(v[2], v[3]); r.z = pack2(v[4], v[5]); r.w = pack2(v[6], v[7]);
  return r;
}
DI float shx_(float v, int off, int lane) {
  return __builtin_bit_cast(float, __builtin_amdgcn_ds_bpermute((lane ^ off) << 2, __builtin_bit_cast(int, v)));
}
DI float shup_(float v, int off, int lane) {
  return __builtin_bit_cast(float, __builtin_amdgcn_ds_bpermute((lane - off) << 2, __builtin_bit_cast(int, v)));
}
#define SHX(v, o) shx_((v), (o), lane)
DI float wave_sum_(float v, int lane) {
#pragma unroll
  for (int o = 32; o > 0; o >>= 1) v += shx_(v, o, lane);
  return v;
}
#define wave_sum(v) wave_sum_((v), lane)
DI float dpp_f(float v, const int ctrl_sel) {
  int x = __builtin_bit_cast(int, v);
  int y;
  if (ctrl_sel == 0) y = __builtin_amdgcn_mov_dpp(x, 0xB1, 0xF, 0xF, true);
  else if (ctrl_sel == 1) y = __builtin_amdgcn_mov_dpp(x, 0x4E, 0xF, 0xF, true);
  else y = __builtin_amdgcn_mov_dpp(x, 0x141, 0xF, 0xF, true);
  return __builtin_bit_cast(float, y);
}
DI float reduce8(float v) {
  v += dpp_f(v, 0);
  v += dpp_f(v, 1);
  v += dpp_f(v, 2);
  return v;
}
DI float sigmoidf_(float x) { return 1.f / (1.f + __expf(-x)); }
DI float siluf_(float x) { return x / (1.f + __expf(-x)); }
DI float softplusf_(float y) { return fmaxf(y, 0.f) + log1pf(__expf(-fabsf(y))); }
DI int scanpos(int d, int pp) { return d ? (pp < LC ? LC - 1 - pp : LT + LC - 1 - pp) : pp; }
DI int rowmod(int n) { int b = n / LT; int pos = n - b * LT; return pos < LC ? 8 : b; }
DI const float* xin_row(const P& p, int n) {
  int b = n / LT, pos = n - b * LT;
  return pos < LC ? p.ctx + ((size_t)(b * LC + pos)) * DM : p.x + ((size_t)(b * SEQ + pos - LC)) * DM;
}

template <class Epi>
DI void gemm_tile(const int TIDX, const bf16_t* __restrict__ A, int lda, const bf16_t* __restrict__ Bt, int ldb, int K, int m0, int n0,
                  Epi epi, char* smem) {
  bf16_t* As = (bf16_t*)smem;
  bf16_t* Bs = As + 2 * 256 * 72;
  const int tid = TIDX, lane = tid & 63, wave = tid >> 6;
  const int wm = wave >> 1, wn = wave & 1;
  const int r = lane & 31, h8 = lane >> 5;
  f32x16 acc[2][2];
#pragma unroll
  for (int i = 0; i < 2; i++)
#pragma unroll
    for (int j = 0; j < 2; j++)
#pragma unroll
      for (int q = 0; q < 16; q++) acc[i][j][q] = 0.f;
  const int lrow = tid >> 3, lch = tid & 7;
  const bf16_t* Ap = A + (size_t)(m0 + lrow) * lda + lch * 8;
  const bf16_t* Bp = Bt + (size_t)(n0 + lrow) * ldb + lch * 8;
  const size_t sa = (size_t)64 * lda, sb_ = (size_t)64 * ldb;
  uint4 ra0 = *(const uint4*)(Ap), ra1 = *(const uint4*)(Ap + sa), ra2 = *(const uint4*)(Ap + 2 * sa), ra3 = *(const uint4*)(Ap + 3 * sa);
  uint4 rb0 = *(const uint4*)(Bp), rb1 = *(const uint4*)(Bp + sb_);
  __syncthreads();
  {
    bf16_t* Aw = As + lrow * 72 + lch * 8;
    bf16_t* Bw = Bs + lrow * 72 + lch * 8;
    *(uint4*)(Aw) = ra0; *(uint4*)(Aw + 64 * 72) = ra1; *(uint4*)(Aw + 128 * 72) = ra2; *(uint4*)(Aw + 192 * 72) = ra3;
    *(uint4*)(Bw) = rb0; *(uint4*)(Bw + 64 * 72) = rb1;
  }
  __syncthreads();
  const int nk = K >> 6;
  for (int kt = 0; kt < nk; kt++) {
    const int cur = kt & 1;
    const bool more = kt + 1 < nk;
    if (more) {
      const bf16_t* Aq = Ap + (kt + 1) * 64;
      const bf16_t* Bq = Bp + (kt + 1) * 64;
      ra0 = *(const uint4*)(Aq); ra1 = *(const uint4*)(Aq + sa); ra2 = *(const uint4*)(Aq + 2 * sa); ra3 = *(const uint4*)(Aq + 3 * sa);
      rb0 = *(const uint4*)(Bq); rb1 = *(const uint4*)(Bq + sb_);
    }
    const bf16_t* Ac = As + cur * 256 * 72 + (wm * 64 + r) * 72 + h8 * 8;
    const bf16_t* Bc = Bs + cur * 128 * 72 + (wn * 64 + r) * 72 + h8 * 8;
#pragma unroll
    for (int ks = 0; ks < 4; ks++) {
      bf16x8 a0 = *(const bf16x8*)(Ac + ks * 16);
      bf16x8 a1 = *(const bf16x8*)(Ac + 32 * 72 + ks * 16);
      bf16x8 b0 = *(const bf16x8*)(Bc + ks * 16);
      bf16x8 b1 = *(const bf16x8*)(Bc + 32 * 72 + ks * 16);
      acc[0][0] = __builtin_amdgcn_mfma_f32_32x32x16_bf16(a0, b0, acc[0][0], 0, 0, 0);
      acc[0][1] = __builtin_amdgcn_mfma_f32_32x32x16_bf16(a0, b1, acc[0][1], 0, 0, 0);
      acc[1][0] = __builtin_amdgcn_mfma_f32_32x32x16_bf16(a1, b0, acc[1][0], 0, 0, 0);
      acc[1][1] = __builtin_amdgcn_mfma_f32_32x32x16_bf16(a1, b1, acc[1][1], 0, 0, 0);
    }
    if (more) {
      const int nx = cur ^ 1;
      bf16_t* Aw = As + nx * 256 * 72 + lrow * 72 + lch * 8;
      bf16_t* Bw = Bs + nx * 128 * 72 + lrow * 72 + lch * 8;
      *(uint4*)(Aw) = ra0; *(uint4*)(Aw + 64 * 72) = ra1; *(uint4*)(Aw + 128 * 72) = ra2; *(uint4*)(Aw + 192 * 72) = ra3;
      *(uint4*)(Bw) = rb0; *(uint4*)(Bw + 64 * 72) = rb1;
    }
    __syncthreads();
  }
#pragma unroll
  for (int mt = 0; mt < 2; mt++)
#pragma unroll
    for (int nt = 0; nt < 2; nt++)
#pragma unroll
      for (int q = 0; q < 16; q++) {
        int m = m0 + wm * 64 + mt * 32 + (q & 3) + 8 * (q >> 2) + 4 * h8;
        int n = n0 + wn * 64 + nt * 32 + r;
        epi(m, n, acc[mt][nt][q]);
      }
}

DI void tconv(const int TIDX, const float* __restrict__ src, int lds_, int K, int N, bf16_t* __restrict__ dst, int ldd, int koff, int bid,
              int nb, char* smem) {
  float* t = (float*)smem;
  const int tn = N >> 6, tk = K >> 6;
  for (int tile = bid; tile < tk * tn; tile += nb) {
    const int k0 = (tile / tn) * 64, n0 = (tile % tn) * 64;
    __syncthreads();
    for (int e = TIDX; e < 4096; e += NTHR) {
      int kk = e >> 6, nn = e & 63;
      t[kk * 65 + nn] = src[(size_t)(k0 + kk) * lds_ + n0 + nn];
    }
    __syncthreads();
    for (int e = TIDX; e < 4096; e += NTHR) {
      int nn = e >> 6, kk = e & 63;
      dst[(size_t)(n0 + nn) * ldd + koff + k0 + kk] = f2bf(t[kk * 65 + nn]);
    }
  }
}
DI void conv_flat(const int TIDX, const float* __restrict__ src, bf16_t* __restrict__ dst, size_t count, int bid, int nb) {
  const size_t n4 = count >> 2;
  for (size_t i = (size_t)bid * NTHR + TIDX; i < n4; i += (size_t)nb * NTHR) {
    float4 v = ((const float4*)src)[i];
    uint2 o; o.x = pack2(v.x, v.y); o.y = pack2(v.z, v.w);
    ((uint2*)dst)[i] = o;
  }
}
DI void mod_gemv(const int TIDX, const P& p, int bid, int nb, char* smem) {
  float* sc = (float*)smem;
  float* red = sc + 9 * 1024;
  float* modo = (float*)(p.ws + OFF_MOD);
  for (int task = bid; task < 192; task += nb) {
    const int l = task / 96, j0 = (task % 96) * 64;
    __syncthreads();
    for (int e = TIDX; e < 9 * 1024; e += NTHR) {
      int rr = e >> 10, k = e & 1023;
      float v = rr < 8 ? p.c[rr * 1024 + k] : p.c_ctx[k];
      sc[e] = v / (1.f + expf(-v));
    }
    __syncthreads();
    const int kg = TIDX >> 6, col = TIDX & 63;
    float acc[9];
#pragma unroll
    for (int q = 0; q < 9; q++) acc[q] = 0.f;
    const float* W = p.mod_w + (size_t)l * 1024 * 6144 + j0 + col;
#pragma unroll 4
    for (int k = kg * 128; k < kg * 128 + 128; ++k) {
      float w = W[(size_t)k * 6144];
#pragma unroll
      for (int q = 0; q < 9; q++) acc[q] += sc[q * 1024 + k] * w;
    }
#pragma unroll
    for (int q = 0; q < 9; q++) red[(kg * 9 + q) * 64 + col] = acc[q];
    __syncthreads();
    for (int e = TIDX; e < 9 * 64; e += NTHR) {
      int rr = e >> 6, cc = e & 63;
      float s = p.mod_b[l * 6144 + j0 + cc];
#pragma unroll
      for (int g = 0; g < 8; g++) s += red[(g * 9 + rr) * 64 + cc];
      modo[(size_t)(l * 9 + rr) * 6144 + j0 + cc] = s;
    }
  }
}

DI void norm_rows(const int TIDX, const P& p, int layer, int which, bool from_input, bool latent_only, int bid, int nb) {
  const int lane = TIDX & 63, wave = TIDX >> 6;
  const float* mod = (const float*)(p.ws + OFF_MOD);
  const float* X = (const float*)(p.ws + OFF_X);
  bf16_t* H = (bf16_t*)(p.ws + OFF_H);
  const float* g = (which ? p.n2g : p.n1g) + layer * 1024;
  for (int n = bid * 8 + wave; n < NTOK; n += nb * 8) {
    int b = n / LT, pos = n - b * LT;
    if (latent_only && pos < LC) continue;
    const float* src = from_input ? xin_row(p, n) : X + (size_t)n * DM;
    float4 v[4];
    float ss = 0.f;
#pragma unroll
    for (int i = 0; i < 4; i++) {
      v[i] = *(const float4*)(src + i * 256 + lane * 4);
      ss += v[i].x * v[i].x + v[i].y * v[i].y + v[i].z * v[i].z + v[i].w * v[i].w;
    }
    ss = wave_sum(ss);
    const float rs = rsqrtf(ss * (1.f / 1024.f) + 1e-6f);
    const int rr = pos < LC ? 8 : b;
    const float* msc = mod + (size_t)(layer * 9 + rr) * 6144 + (which ? 4 : 1) * 1024;
    const float* msh = mod + (size_t)(layer * 9 + rr) * 6144 + (which ? 3 : 0) * 1024;
#pragma unroll
    for (int i = 0; i < 4; i++) {
      int idx = i * 256 + lane * 4;
      float4 gg = *(const float4*)(g + idx), sc = *(const float4*)(msc + idx), sh = *(const float4*)(msh + idx);
      float y0 = v[i].x * rs * gg.x * (1.f + sc.x) + sh.x;
      float y1 = v[i].y * rs * gg.y * (1.f + sc.y) + sh.y;
      float y2 = v[i].z * rs * gg.z * (1.f + sc.z) + sh.z;
      float y3 = v[i].w * rs * gg.w * (1.f + sc.w) + sh.w;
      uint2 o; o.x = pack2(y0, y1); o.y = pack2(y2, y3);
      *(uint2*)(H + (size_t)n * DM + idx) = o;
    }
  }
}

DI void rope8(float* v, int e, int t, int lane) {
  const int half = e >> 2, isx2 = (e >> 1) & 1, ibase = (e & 1) * 8;
  const float posf = half ? (float)(t & 63) : (float)(t >> 6);
#pragma unroll
  for (int j = 0; j < 8; j++) {
    float pv = SHX(v[j], 2);
    float inv = exp2f(-(float)(ibase + j) * 0.83048202f);
    float ang = posf * inv;
    float rev = ang * 0.15915494309f;
    rev -= floorf(rev);
    float sn = __builtin_amdgcn_sinf(rev), cs = __builtin_amdgcn_cosf(rev);
    v[j] = isx2 ? (v[j] * cs + pv * sn) : (v[j] * cs - pv * sn);
  }
}
DI void prep0(const int TIDX, const P& p, int bid, int nb) {
  char* big = p.ws + OFF_BIG;
  const bf16_t* Z = (const bf16_t*)(big + B_Z0);
  bf16_t* QN = (bf16_t*)(big + B_QN); bf16_t* KN = (bf16_t*)(big + B_KN); bf16_t* VT = (bf16_t*)(big + B_VT);
  bf16_t* R = (bf16_t*)(big + B_R); bf16_t* KB = (bf16_t*)(big + B_KB); bf16_t* KK = (bf16_t*)(big + B_KK);
  bf16_t* V = (bf16_t*)(big + B_V); bf16_t* AW = (bf16_t*)(big + B_AW); bf16_t* AA = (bf16_t*)(big + B_AA);
  bf16_t* AG = (bf16_t*)(big + B_AG);
  const int lane = TIDX & 63, wave = TIDX >> 6;
  for (int n = bid * 8 + wave; n < NTOK; n += nb * 8) {
    const int b = n / LT, pos = n - b * LT;
    const bool lat = pos >= LC;
    const int t = pos - LC;
    const bf16_t* zr = Z + (size_t)n * 2560;
    {
      const int head = lane >> 3, e = lane & 7;
      uint4 raw = *(const uint4*)(zr + head * 64 + e * 8);
      float v[8]; unpack8(raw, v);
      float ss = 0.f;
#pragma unroll
      for (int j = 0; j < 8; j++) ss += v[j] * v[j];
      ss += SHX(ss, 1); ss += SHX(ss, 2); ss += SHX(ss, 4);
      const float rs = rsqrtf(ss * (1.f / 64.f) + 1e-6f);
#pragma unroll
      for (int j = 0; j < 8; j++) v[j] = v[j] * rs * p.qg[e * 8 + j];
      if (lat) rope8(v, e, t, lane);
#pragma unroll
      for (int j = 0; j < 8; j++) v[j] *= 0.18033688011f;
      *(uint4*)(QN + ((size_t)(b * 8 + head) * LT + pos) * 64 + e * 8) = pack8(v);
    }
    {
      const int hh = (lane >> 3) & 3, e = lane & 7;
      uint4 raw = make_uint4(0, 0, 0, 0);
      if (lane < 32) raw = *(const uint4*)(zr + 512 + hh * 64 + e * 8);
      float v[8]; unpack8(raw, v);
      float kv[8];
      float ss = 0.f;
#pragma unroll
      for (int j = 0; j < 8; j++) ss += v[j] * v[j];
      ss += SHX(ss, 1); ss += SHX(ss, 2); ss += SHX(ss, 4);
      const float rs = rsqrtf(ss * (1.f / 64.f) + 1e-6f);
#pragma unroll
      for (int j = 0; j < 8; j++) kv[j] = v[j] * rs * p.kg[e * 8 + j];
      if (lat) rope8(kv, e, t, lane);
      if (lane < 16) {
        *(uint4*)(KN + ((size_t)(b * 2 + hh) * LT + pos) * 64 + e * 8) = pack8(kv);
      } else if (lane < 32) {
        const int kvh = hh - 2;
#pragma unroll
        for (int j = 0; j < 8; j++) VT[((size_t)(b * 2 + kvh) * 64 + e * 8 + j) * LT + pos] = f2bf(v[j]);
      }
    }
    const bool hasp = (pos != 0 && pos != LC), hasn = (pos != LC - 1 && pos != LT - 1);
    const bf16_t* zc = zr + 768;
#pragma unroll
    for (int i = 0; i < 7; i++) {
      const int j = i * 256 + lane * 4;
      uint2 cu = *(const uint2*)(zc + j);
      uint2 pu = make_uint2(0, 0), nu = make_uint2(0, 0);
      if (hasp) pu = *(const uint2*)(zc - 2560 + j);
      if (hasn) nu = *(const uint2*)(zc + 2560 + j);
      float4 m4 = *(const float4*)(p.mu + j);
      float cv[4] = {lo2f(cu.x), hi2f(cu.x), lo2f(cu.y), hi2f(cu.y)};
      float pv[4] = {lo2f(pu.x), hi2f(pu.x), lo2f(pu.y), hi2f(pu.y)};
      float nv[4] = {lo2f(nu.x), hi2f(nu.x), lo2f(nu.y), hi2f(nu.y)};
      float mm[4] = {m4.x, m4.y, m4.z, m4.w};
      float zm[4];
#pragma unroll
      for (int q = 0; q < 4; q++) zm[q] = cv[q] + mm[q] * (0.5f * (pv[q] + nv[q]) - cv[q]);
      if (i < 6) {
        const int cc = (i & 1) * 256 + lane * 4;
        const int head = cc >> 6, within = cc & 63;
        const size_t oidx = ((size_t)(b * 8 + head) * LT + pos) * 64 + within;
        uint2 o; o.x = pack2(zm[0], zm[1]); o.y = pack2(zm[2], zm[3]);
        if (i < 2) {
          *(uint2*)(R + oidx) = o;
        } else if (i < 4) {
          *(uint2*)(KB + oidx) = o;
          float4 kk4 = *(const float4*)(p.k_k + cc);
          float k0 = zm[0] * kk4.x, k1 = zm[1] * kk4.y, k2 = zm[2] * kk4.z, k3 = zm[3] * kk4.w;
          float ss = k0 * k0 + k1 * k1 + k2 * k2 + k3 * k3;
          ss += SHX(ss, 1); ss += SHX(ss, 2); ss += SHX(ss, 4); ss += SHX(ss, 8);
          const float inv = 1.f / fmaxf(sqrtf(ss), 1e-12f);
          uint2 o2; o2.x = pack2(k0 * inv, k1 * inv); o2.y = pack2(k2 * inv, k3 * inv);
          *(uint2*)(KK + oidx) = o2;
        } else {
          *(uint2*)(V + oidx) = o;
        }
      } else {
        if (lane < 16) {
          uint2 o; o.x = pack2(tanhf(zm[0]), tanhf(zm[1])); o.y = pack2(tanhf(zm[2]), tanhf(zm[3]));
          *(uint2*)(AW + (size_t)n * 64 + lane * 4) = o;
        } else if (lane < 32) {
          uint2 o; o.x = pack2(zm[0], zm[1]); o.y = pack2(zm[2], zm[3]);
          *(uint2*)(AA + (size_t)n * 64 + (lane - 16) * 4) = o;
        } else {
          uint2 o; o.x = pack2(sigmoidf_(zm[0]), sigmoidf_(zm[1])); o.y = pack2(sigmoidf_(zm[2]), sigmoidf_(zm[3]));
          *(uint2*)(AG + (size_t)n * 128 + (lane - 32) * 4) = o;
        }
      }
    }
  }
}

DI void wkv_task(const int TIDX, const P& p, int task, char* smem) {
  char* big = p.ws + OFF_BIG;
  const int d = task & 1, h = (task >> 1) & 7, b = task >> 4;
  const bf16_t* R = (const bf16_t*)(big + B_R); const bf16_t* KB = (const bf16_t*)(big + B_KB);
  const bf16_t* KK = (const bf16_t*)(big + B_KK); const bf16_t* V = (const bf16_t*)(big + B_V);
  const bf16_t* AL = (const bf16_t*)(big + B_AL) + (size_t)d * NB * 8 * LT * 64;
  const float* DEC = (const float*)(big + B_DEC) + (size_t)d * NB * 8 * LT * 64;
  const bf16_t* G = (const bf16_t*)(big + B_G);
  bf16_t* YM = (bf16_t*)(big + B_YMIX);
  float* bufs = (float*)smem;
  float* outb = bufs + 2 * 6 * 1024;
  const int tid = TIDX, lane = tid & 63;
  const int row = tid >> 3, ks = tid & 7;
  const int ls = tid >> 5, li = (tid & 31) * 2;
  const size_t hb = (size_t)(b * 8 + h) * LT;
  const float ka0 = p.k_a[h * 64 + li], ka1 = p.k_a[h * 64 + li + 1];
  float S[8];
#pragma unroll
  for (int j = 0; j < 8; j++) S[j] = 0.f;
  float pr[12];
  auto gload = [&](int chunk) {
    const int pos = scanpos(d, chunk * 16 + ls);
    const size_t e0 = (hb + pos) * 64 + li;
    unsigned r2 = *(const unsigned*)(R + e0), k2 = *(const unsigned*)(KB + e0), kk2 = *(const unsigned*)(KK + e0);
    unsigned v2 = *(const unsigned*)(V + e0), a2 = *(const unsigned*)(AL + e0);
    float2 dc = *(const float2*)(DEC + e0);
    float a_0 = lo2f(a2), a_1 = hi2f(a2);
    pr[0] = lo2f(r2); pr[1] = hi2f(r2);
    pr[2] = dc.x; pr[3] = dc.y;
    pr[4] = lo2f(k2) * (1.f + (a_0 - 1.f) * ka0); pr[5] = hi2f(k2) * (1.f + (a_1 - 1.f) * ka1);
    pr[6] = lo2f(v2); pr[7] = hi2f(v2);
    pr[8] = -lo2f(kk2); pr[9] = -hi2f(kk2);
    pr[10] = lo2f(kk2) * a_0; pr[11] = hi2f(kk2) * a_1;
  };
  auto lstore = [&](int bufi) {
    float* bb = bufs + bufi * 6 * 1024 + ls * 64 + li;
#pragma unroll
    for (int q = 0; q < 6; q++) *(float2*)(bb + q * 1024) = make_float2(pr[2 * q], pr[2 * q + 1]);
  };
  __syncthreads();
  gload(0);
  lstore(0);
  __syncthreads();
  const int nch = LT / 16;
  for (int ch = 0; ch < nch; ch++) {
    const int cur = ch & 1;
    if (ch + 1 < nch) gload(ch + 1);
    const float* bb = bufs + cur * 6 * 1024;
#pragma unroll 4
    for (int s = 0; s < 16; s++) {
      const float* q0 = bb + s * 64 + ks * 8;
      float4 kn0 = *(const float4*)(q0 + 4 * 1024), kn1 = *(const float4*)(q0 + 4 * 1024 + 4);
      float sa = S[0] * kn0.x + S[1] * kn0.y + S[2] * kn0.z + S[3] * kn0.w + S[4] * kn1.x + S[5] * kn1.y + S[6] * kn1.z +
                 S[7] * kn1.w;
      sa = reduce8(sa);
      const float vv = bb[3 * 1024 + s * 64 + row];
      float4 dc0 = *(const float4*)(q0 + 1 * 1024), dc1 = *(const float4*)(q0 + 1 * 1024 + 4);
      float4 bb0 = *(const float4*)(q0 + 5 * 1024), bb1 = *(const float4*)(q0 + 5 * 1024 + 4);
      float4 kd0 = *(const float4*)(q0 + 2 * 1024), kd1 = *(const float4*)(q0 + 2 * 1024 + 4);
      S[0] = S[0] * dc0.x + sa * bb0.x + vv * kd0.x;
      S[1] = S[1] * dc0.y + sa * bb0.y + vv * kd0.y;
      S[2] = S[2] * dc0.z + sa * bb0.z + vv * kd0.z;
      S[3] = S[3] * dc0.w + sa * bb0.w + vv * kd0.w;
      S[4] = S[4] * dc1.x + sa * bb1.x + vv * kd1.x;
      S[5] = S[5] * dc1.y + sa * bb1.y + vv * kd1.y;
      S[6] = S[6] * dc1.z + sa * bb1.z + vv * kd1.z;
      S[7] = S[7] * dc1.w + sa * bb1.w + vv * kd1.w;
      float4 r0 = *(const float4*)(q0), r1 = *(const float4*)(q0 + 4);
      float o = S[0] * r0.x + S[1] * r0.y + S[2] * r0.z + S[3] * r0.w + S[4] * r1.x + S[5] * r1.y + S[6] * r1.z + S[7] * r1.w;
      o = reduce8(o);
      if (ks == 0) outb[s * 64 + row] = o;
    }
    __syncthreads();
    {
      const int pos = scanpos(d, ch * 16 + ls);
      const int n = b * LT + pos;
      const float o0 = outb[ls * 64 + li], o1 = outb[ls * 64 + li + 1];
      float sm = o0 + o1;
#pragma unroll
      for (int off = 1; off < 32; off <<= 1) sm += SHX(sm, off);
      const float mean = sm * (1.f / 64.f);
      const float d0 = o0 - mean, d1 = o1 - mean;
      float vs = d0 * d0 + d1 * d1;
#pragma unroll
      for (int off = 1; off < 32; off <<= 1) vs += SHX(vs, off);
      const float rstd = rsqrtf(vs * (1.f / 64.f) + 64e-5f);
      const int c0 = h * 64 + li;
      float bs = bb[0 * 1024 + ls * 64 + li] * bb[2 * 1024 + ls * 64 + li] * p.r_k[c0] +
                 bb[0 * 1024 + ls * 64 + li + 1] * bb[2 * 1024 + ls * 64 + li + 1] * p.r_k[c0 + 1];
#pragma unroll
      for (int off = 1; off < 32; off <<= 1) bs += SHX(bs, off);
      const float v0 = bb[3 * 1024 + ls * 64 + li], v1 = bb[3 * 1024 + ls * 64 + li + 1];
      const unsigned g2 = *(const unsigned*)(G + (size_t)n * 512 + c0);
      const float y0 = (d0 * rstd * p.gn_w[c0] + p.gn_b[c0] + bs * v0) * lo2f(g2);
      const float y1 = (d1 * rstd * p.gn_w[c0 + 1] + p.gn_b[c0 + 1] + bs * v1) * hi2f(g2);
      *(unsigned*)(YM + (size_t)n * 1536 + 512 + d * 512 + c0) = pack2(y0, y1);
    }
    if (ch + 1 < nch) lstore(cur ^ 1);
    __syncthreads();
  }
}

DI void attn_task(const int TIDX, const P& p, int task, char* smem) {
  char* big = p.ws + OFF_BIG;
  int b, head, qt;
  if (task < 512) { qt = 1 + (task & 7); head = (task >> 3) & 7; b = task >> 6; }
  else { int t2 = task - 512; qt = 0; head = t2 & 7; b = t2 >> 3; }
  const int kvh = head >> 2;
  const int nkt = (qt == 0 ? 256 : LT) / 64;
  bf16_t* Ks = (bf16_t*)smem;
  bf16_t* Vs = Ks + 2 * 64 * 72;
  const bf16_t* Kg = (const bf16_t*)(big + B_KN) + (size_t)(b * 2 + kvh) * LT * 64;
  const bf16_t* Vg = (const bf16_t*)(big + B_VT) + (size_t)(b * 2 + kvh) * 64 * LT;
  const bf16_t* QN = (const bf16_t*)(big + B_QN);
  bf16_t* YM = (bf16_t*)(big + B_YMIX);
  const int tid = TIDX, lane = tid & 63, wave = tid >> 6;
  const int r = lane & 31, h8 = lane >> 5;
  const int q0 = qt * 256 + wave * 32;
  bf16x8 qf[4];
#pragma unroll
  for (int kk = 0; kk < 4; kk++)
    qf[kk] = *(const bf16x8*)(QN + ((size_t)(b * 8 + head) * LT + q0 + r) * 64 + kk * 16 + h8 * 8);
  f32x16 o0, o1;
#pragma unroll
  for (int q = 0; q < 16; q++) { o0[q] = 0.f; o1[q] = 0.f; }
  float m = -1e30f, l = 0.f;
  const int lr = tid >> 3, lc = tid & 7;
  uint4 kreg = *(const uint4*)(Kg + (size_t)lr * 64 + lc * 8);
  uint4 vreg = *(const uint4*)(Vg + (size_t)lr * LT + lc * 8);
  __syncthreads();
  *(uint4*)(Ks + lr * 72 + lc * 8) = kreg;
  *(uint4*)(Vs + lr * 72 + lc * 8) = vreg;
  __syncthreads();
  for (int kt = 0; kt < nkt; kt++) {
    const int cur = kt & 1;
    if (kt + 1 < nkt) {
      kreg = *(const uint4*)(Kg + (size_t)((kt + 1) * 64 + lr) * 64 + lc * 8);
      vreg = *(const uint4*)(Vg + (size_t)lr * LT + (kt + 1) * 64 + lc * 8);
    }
    const bf16_t* Kc = Ks + cur * 64 * 72;
    const bf16_t* Vc = Vs + cur * 64 * 72;
    f32x16 s0, s1;
#pragma unroll
    for (int q = 0; q < 16; q++) { s0[q] = 0.f; s1[q] = 0.f; }
#pragma unroll
    for (int kk = 0; kk < 4; kk++) {
      bf16x8 a0 = *(const bf16x8*)(Kc + r * 72 + kk * 16 + h8 * 8);
      bf16x8 a1 = *(const bf16x8*)(Kc + (32 + r) * 72 + kk * 16 + h8 * 8);
      s0 = __builtin_amdgcn_mfma_f32_32x32x16_bf16(a0, qf[kk], s0, 0, 0, 0);
      s1 = __builtin_amdgcn_mfma_f32_32x32x16_bf16(a1, qf[kk], s1, 0, 0, 0);
    }
    float mx = s0[0];
#pragma unroll
    for (int q = 1; q < 16; q++) mx = fmaxf(mx, s0[q]);
#pragma unroll
    for (int q = 0; q < 16; q++) mx = fmaxf(mx, s1[q]);
    mx = fmaxf(mx, SHX(mx, 32));
    const float mnew = fmaxf(m, mx);
    const float alpha = exp2f(m - mnew);
    float sum = 0.f;
#pragma unroll
    for (int q = 0; q < 16; q++) { s0[q] = exp2f(s0[q] - mnew); sum += s0[q]; }
#pragma unroll
    for (int q = 0; q < 16; q++) { s1[q] = exp2f(s1[q] - mnew); sum += s1[q]; }
    l = l * alpha + sum;
    m = mnew;
#pragma unroll
    for (int q = 0; q < 16; q++) { o0[q] *= alpha; o1[q] *= alpha; }
#pragma unroll
    for (int t = 0; t < 2; t++) {
#pragma unroll
      for (int s = 0; s < 2; s++) {
        union { bf16x8 v; unsigned u[4]; } pf;
#pragma unroll
        for (int q = 0; q < 4; q++) {
          float x0 = t ? s1[8 * s + 2 * q] : s0[8 * s + 2 * q];
          float x1 = t ? s1[8 * s + 2 * q + 1] : s0[8 * s + 2 * q + 1];
          pf.u[q] = pack2(x0, x1);
        }
        const int kb = 32 * t + 16 * s + 4 * h8;
        union { bf16x8 v; uint2 u[2]; } v0, v1;
        v0.u[0] = *(const uint2*)(Vc + r * 72 + kb);
        v0.u[1] = *(const uint2*)(Vc + r * 72 + kb + 8);
        v1.u[0] = *(const uint2*)(Vc + (32 + r) * 72 + kb);
        v1.u[1] = *(const uint2*)(Vc + (32 + r) * 72 + kb + 8);
        o0 = __builtin_amdgcn_mfma_f32_32x32x16_bf16(v0.v, pf.v, o0, 0, 0, 0);
        o1 = __builtin_amdgcn_mfma_f32_32x32x16_bf16(v1.v, pf.v, o1, 0, 0, 0);
      }
    }
    if (kt + 1 < nkt) {
      *(uint4*)(Ks + (cur ^ 1) * 64 * 72 + lr * 72 + lc * 8) = kreg;
      *(uint4*)(Vs + (cur ^ 1) * 64 * 72 + lr * 72 + lc * 8) = vreg;
    }
    __syncthreads();
  }
  l += SHX(l, 32);
  const float inv = 1.f / l;
  bf16_t* orow = YM + (size_t)(b * LT + q0 + r) * 1536 + head * 64;
#pragma unroll
  for (int g4 = 0; g4 < 4; g4++) {
    uint2 w0, w1;
    w0.x = pack2(o0[4 * g4] * inv, o0[4 * g4 + 1] * inv); w0.y = pack2(o0[4 * g4 + 2] * inv, o0[4 * g4 + 3] * inv);
    w1.x = pack2(o1[4 * g4] * inv, o1[4 * g4 + 1] * inv); w1.y = pack2(o1[4 * g4 + 2] * inv, o1[4 * g4 + 3] * inv);
    *(uint2*)(orow + 8 * g4 + 4 * h8) = w0;
    *(uint2*)(orow + 32 + 8 * g4 + 4 * h8) = w1;
  }
}

DI void route_task(const int TIDX, const P& p, int n0, char* smem) {
  char* big = p.ws + OFF_BIG;
  const float* S = (const float*)(big + B_S);
  int* EI = (int*)(big + B_EI);
  float* EG = (float*)(big + B_EG);
  float* sc = (float*)smem;
  float* sv = sc + 256 * 129;
  unsigned char* si = (unsigned char*)(sv + 256 * 16);
  const int tid = TIDX;
  __syncthreads();
  for (int e = tid; e < 256 * 128; e += NTHR) {
    int row = e >> 7, j = e & 127;
    sc[row * 129 + j] = S[(size_t)n0 * 2048 + e];
  }
  __syncthreads();
  if (tid < 256) {
    const float* rowp = sc + tid * 129;
    float pv = __builtin_inff();
    int pi = -1;
    for (int k = 0; k < 16; k++) {
      float bv = -__builtin_inff();
      int bi = 0;
      for (int j = 0; j < 128; j++) {
        float x = rowp[j];
        bool elig = (x < pv) || (x == pv && j > pi);
        if (elig && x > bv) { bv = x; bi = j; }
      }
      sv[tid * 16 + k] = bv;
      si[tid * 16 + k] = (unsigned char)bi;
      pv = bv; pi = bi;
    }
  }
  __syncthreads();
  if (tid < 128) {
    const int tl = tid >> 3, head = tid & 7;
    const int r0 = tl * 16 + head * 2, r1 = r0 + 1;
    const float* a = sv + r0 * 16;
    const float* bq = sv + r1 * 16;
    float* eg = sc + tid * 17;
    const int n = n0 + tl;
    float pv = __builtin_inff();
    int pc = -1;
    float mx = 0.f, sum = 0.f;
    for (int k = 0; k < 16; k++) {
      float bv = -__builtin_inff();
      int bc = 0;
      for (int i = 0; i < 16; i++) {
        const int jn = 16 / (i + 1);
        const float ai = a[i];
        for (int j = 0; j < jn; j++) {
          float x = ai + bq[j];
          int c = i * 16 + j;
          bool elig = (x < pv) || (x == pv && c > pc);
          if (elig && x > bv) { bv = x; bc = c; }
        }
      }
      if (k == 0) mx = bv;
      float ev = __expf(bv - mx);
      sum += ev;
      eg[k] = ev;
      EI[(size_t)n * 128 + head * 16 + k] = (int)si[r0 * 16 + (bc >> 4)] * 128 + (int)si[r1 * 16 + (bc & 15)];
      pv = bv; pc = bc;
    }
    const float inv = 1.f / sum;
    for (int k = 0; k < 16; k++) EG[(size_t)n * 128 + head * 16 + k] = eg[k] * inv;
  }
}


DI int f2ord(float f) { int s = __float_as_int(f); return s ^ ((s >> 31) & 0x7fffffff); }
DI float ord2f(int s) { return __int_as_float(s ^ ((s >> 31) & 0x7fffffff)); }
DI void ce_desc(int& a, int& b) { int hi = max(a, b), lo = min(a, b); a = hi; b = lo; }
template <int N>
DI void bsort_desc(int* v) {
#pragma unroll
  for (int k = 2; k <= N; k <<= 1)
#pragma unroll
    for (int j = k >> 1; j > 0; j >>= 1)
#pragma unroll
      for (int i = 0; i < N; i++) {
        const int l = i ^ j;
        if (l > i) {
          if ((i & k) == 0) ce_desc(v[i], v[l]); else ce_desc(v[l], v[i]);
        }
      }
}
DI void merge16(int* a, const int* b) {
#pragma unroll
  for (int i = 0; i < 16; i++) a[i] = max(a[i], b[15 - i]);
#pragma unroll
  for (int j = 8; j > 0; j >>= 1)
#pragma unroll
    for (int i = 0; i < 16; i++) {
      const int l = i ^ j;
      if (l > i) ce_desc(a[i], a[l]);
    }
}
DI void top16_of_64(int* v) {
  bsort_desc<16>(v); bsort_desc<16>(v + 16); bsort_desc<16>(v + 32); bsort_desc<16>(v + 48);
  merge16(v, v + 16); merge16(v + 32, v + 48); merge16(v, v + 32);
}
DI void route2_task(const int TIDX, const P& p, int layer, int m0, int head, char* smem) {
  char* big = p.ws + OFF_BIG;
  const bf16_t* QP = (const bf16_t*)(big + B_QP);
  int* EI = (int*)(big + B_EI);
  float* EG = (float*)(big + B_EG);
  bf16_t* Ks = (bf16_t*)smem;
  unsigned char* sidx = (unsigned char*)(Ks + 256 * 136);
  const bf16_t* keys = (const bf16_t*)(p.ws + OFF_KEYS) + (size_t)(layer * 16 + head * 2) * 128 * 128;
  const int tid = TIDX, lane = tid & 63, wave = tid >> 6;
  const int r = lane & 31, h8 = lane >> 5;
  __syncthreads();
  {
    const int row = tid >> 1, half = tid & 1;
#pragma unroll
    for (int q = 0; q < 8; q++)
      *(uint4*)(Ks + row * 136 + half * 64 + q * 8) = *(const uint4*)(keys + (size_t)row * 128 + half * 64 + q * 8);
  }
  __syncthreads();
  const int tok = m0 + wave * 32 + r;
  int la[16], lb[16];
#pragma unroll
  for (int pp = 0; pp < 2; pp++) {
    bf16x8 qf[8];
#pragma unroll
    for (int ks = 0; ks < 8; ks++)
      qf[ks] = *(const bf16x8*)(QP + (size_t)tok * 2048 + head * 256 + pp * 128 + ks * 16 + h8 * 8);
    int v[64];
#pragma unroll
    for (int kt = 0; kt < 4; kt++) {
      f32x16 acc;
#pragma unroll
      for (int q = 0; q < 16; q++) acc[q] = 0.f;
#pragma unroll
      for (int ks = 0; ks < 8; ks++) {
        bf16x8 a = *(const bf16x8*)(Ks + (pp * 128 + kt * 32 + r) * 136 + ks * 16 + h8 * 8);
        acc = __builtin_amdgcn_mfma_f32_32x32x16_bf16(a, qf[ks], acc, 0, 0, 0);
      }
#pragma unroll
      for (int q = 0; q < 16; q++) v[kt * 16 + q] = (f2ord(acc[q]) & ~127) | (kt * 32 + (q & 3) + 8 * (q >> 2) + 4 * h8);
    }
    top16_of_64(v);
    int pr[16];
#pragma unroll
    for (int i = 0; i < 16; i++) pr[i] = __builtin_amdgcn_ds_bpermute((lane ^ 32) << 2, v[i]);
    merge16(v, pr);
#pragma unroll
    for (int i = 0; i < 16; i++) { if (pp == 0) la[i] = v[i]; else lb[i] = v[i]; }
  }
  {
    unsigned* sw = (unsigned*)(sidx + tid * 32);
#pragma unroll
    for (int i = 0; i < 4; i++) {
      sw[i] = (la[4 * i] & 127) | ((la[4 * i + 1] & 127) << 8) | ((la[4 * i + 2] & 127) << 16) | ((la[4 * i + 3] & 127) << 24);
      sw[4 + i] = (lb[4 * i] & 127) | ((lb[4 * i + 1] & 127) << 8) | ((lb[4 * i + 2] & 127) << 16) | ((lb[4 * i + 3] & 127) << 24);
    }
  }
  float fa[16], fb[16];
#pragma unroll
  for (int i = 0; i < 16; i++) { fa[i] = ord2f(la[i]); fb[i] = ord2f(lb[i]); }
  int c[64];
  {
    int cnt = 0;
#pragma unroll
    for (int i = 0; i < 16; i++)
#pragma unroll
      for (int j = 0; j < 16; j++)
        if ((i + 1) * (j + 1) <= 16) { c[cnt] = (f2ord(fa[i] + fb[j]) & ~255) | (i * 16 + j); cnt++; }
#pragma unroll
    for (int q = 50; q < 64; q++) c[q] = (int)0x80000000;
  }
  top16_of_64(c);
  const float mx = ord2f(c[0]);
  float ev[16], sum = 0.f;
#pragma unroll
  for (int k = 0; k < 16; k++) { ev[k] = __expf(ord2f(c[k]) - mx); sum += ev[k]; }
  const float inv = 1.f / sum;
  const size_t ob = (size_t)tok * 128 + head * 16;
#pragma unroll
  for (int k = 0; k < 16; k++) {
    const int code = c[k] & 255;
    const int ia = sidx[tid * 32 + (code >> 4)], ib = sidx[tid * 32 + 16 + (code & 15)];
    if (h8 == 0) EI[ob + k] = ia * 128 + ib; else EG[ob + k] = ev[k] * inv;
  }
}

DI void peer_gather(const int TIDX, const P& p, int layer, bool last, int bid, int nb, const bool dry) {
  char* big = p.ws + OFF_BIG;
  const int* EI = (const int*)(big + B_EI);
  const float* EG = (const float*)(big + B_EG);
  const bf16_t* UB = (const bf16_t*)(p.ws + OFF_UB);
  const bf16_t* VB = (const bf16_t*)(p.ws + OFF_VB);
  const bf16_t* H = (const bf16_t*)(p.ws + OFF_H);
  const float* X = (const float*)(p.ws + OFF_X);
  bf16_t* Hw = dry ? (bf16_t*)(big + B_QP) : (bf16_t*)(p.ws + OFF_H);
  float* Xw = dry ? (float*)(big + B_S) : (float*)(p.ws + OFF_X);
  const float* mod = (const float*)(p.ws + OFF_MOD);
  const int lane = TIDX & 63, wave = TIDX >> 6;
  for (int n = bid * 8 + wave; n < NTOK; n += nb * 8) {
    const int b = n / LT, pos = n - b * LT;
    if (last && pos < LC) continue;
    float hv[16];
    {
      uint4 h0 = *(const uint4*)(H + (size_t)n * DM + lane * 8);
      uint4 h1 = *(const uint4*)(H + (size_t)n * DM + 512 + lane * 8);
      unpack8(h0, hv); unpack8(h1, hv + 8);
    }
    const int id_lo = EI[(size_t)n * 128 + lane], id_hi = EI[(size_t)n * 128 + 64 + lane];
    const float g_lo = EG[(size_t)n * 128 + lane], g_hi = EG[(size_t)n * 128 + 64 + lane];
    float act_lo = 0.f, act_hi = 0.f;
#pragma unroll 1
    for (int half = 0; half < 2; half++) {
      const int idv = half ? id_hi : id_lo;
      float actv = 0.f;
#pragma unroll 4
      for (int e = 0; e < 64; e++) {
        const int id = __builtin_amdgcn_readlane(idv, e);
        const bf16_t* ur = UB + (size_t)id * DM + lane * 8;
        uint4 u0 = *(const uint4*)(ur);
        uint4 u1 = *(const uint4*)(ur + 512);
        float uv[16];
        unpack8(u0, uv); unpack8(u1, uv + 8);
        float dsum = 0.f;
#pragma unroll
        for (int j = 0; j < 16; j++) dsum += hv[j] * uv[j];
        dsum = wave_sum(dsum);
        if (lane == e) actv = dsum;
      }
      if (half) act_hi = actv; else act_lo = actv;
    }
    const float cf_lo = g_lo * 0.5f * act_lo * (1.f + erff(act_lo * 0.70710678f));
    const float cf_hi = g_hi * 0.5f * act_hi * (1.f + erff(act_hi * 0.70710678f));
    float acc[16];
#pragma unroll
    for (int j = 0; j < 16; j++) acc[j] = 0.f;
#pragma unroll 1
    for (int half = 0; half < 2; half++) {
      const int idv = half ? id_hi : id_lo;
      const float cfv = half ? cf_hi : cf_lo;
#pragma unroll 4
      for (int e = 0; e < 64; e++) {
        const int id = __builtin_amdgcn_readlane(idv, e);
        const float cf = __builtin_bit_cast(float, __builtin_amdgcn_readlane(__builtin_bit_cast(int, cfv), e));
        const bf16_t* vr = VB + (size_t)id * DM + lane * 8;
        uint4 u0 = *(const uint4*)(vr);
        uint4 u1 = *(const uint4*)(vr + 512);
        float uv[16];
        unpack8(u0, uv); unpack8(u1, uv + 8);
#pragma unroll
        for (int j = 0; j < 16; j++) acc[j] += cf * uv[j];
      }
    }
    const int rr = pos < LC ? 8 : b;
    const float* gate = mod + (size_t)(layer * 9 + rr) * 6144 + 5 * 1024;
    float xo[16];
#pragma unroll
    for (int hf = 0; hf < 2; hf++) {
      const int base = hf * 512 + lane * 8;
      float4 x0 = *(const float4*)(X + (size_t)n * DM + base), x1 = *(const float4*)(X + (size_t)n * DM + base + 4);
      float4 g0 = *(const float4*)(gate + base), g1 = *(const float4*)(gate + base + 4);
      xo[hf * 8 + 0] = x0.x + g0.x * acc[hf * 8 + 0]; xo[hf * 8 + 1] = x0.y + g0.y * acc[hf * 8 + 1];
      xo[hf * 8 + 2] = x0.z + g0.z * acc[hf * 8 + 2]; xo[hf * 8 + 3] = x0.w + g0.w * acc[hf * 8 + 3];
      xo[hf * 8 + 4] = x1.x + g1.x * acc[hf * 8 + 4]; xo[hf * 8 + 5] = x1.y + g1.y * acc[hf * 8 + 5];
      xo[hf * 8 + 6] = x1.z + g1.z * acc[hf * 8 + 6]; xo[hf * 8 + 7] = x1.w + g1.w * acc[hf * 8 + 7];
    }
    if (last) {
      float* orow = p.out + ((size_t)(b * SEQ + pos - LC)) * DM;
#pragma unroll
      for (int hf = 0; hf < 2; hf++) {
        const int base = hf * 512 + lane * 8;
        *(float4*)(orow + base) = make_float4(xo[hf * 8], xo[hf * 8 + 1], xo[hf * 8 + 2], xo[hf * 8 + 3]);
        *(float4*)(orow + base + 4) = make_float4(xo[hf * 8 + 4], xo[hf * 8 + 5], xo[hf * 8 + 6], xo[hf * 8 + 7]);
      }
    } else {
      float ss = 0.f;
#pragma unroll
      for (int j = 0; j < 16; j++) ss += xo[j] * xo[j];
      ss = wave_sum(ss);
      const float rs = rsqrtf(ss * (1.f / 1024.f) + 1e-6f);
      const float* g = p.n1g + (layer + 1) * 1024;
      const float* msc = mod + (size_t)((layer + 1) * 9 + rr) * 6144 + 1 * 1024;
      const float* msh = mod + (size_t)((layer + 1) * 9 + rr) * 6144;
#pragma unroll
      for (int hf = 0; hf < 2; hf++) {
        const int base = hf * 512 + lane * 8;
        *(float4*)(Xw + (size_t)n * DM + base) = make_float4(xo[hf * 8], xo[hf * 8 + 1], xo[hf * 8 + 2], xo[hf * 8 + 3]);
        *(float4*)(Xw + (size_t)n * DM + base + 4) = make_float4(xo[hf * 8 + 4], xo[hf * 8 + 5], xo[hf * 8 + 6], xo[hf * 8 + 7]);
        float y[8];
#pragma unroll
        for (int j = 0; j < 8; j++) y[j] = xo[hf * 8 + j] * rs * g[base + j] * (1.f + msc[base + j]) + msh[base + j];
        *(uint4*)(Hw + (size_t)n * DM + base) = pack8(y);
      }
    }
  }
}

DI void conv_phase(const int TIDX, const P& p, int bid, int nb) {
  char* big = p.ws + OFF_BIG;
  const bf16_t* ZX = (const bf16_t*)(big + B_ZX);
  bf16_t* XBC = (bf16_t*)(big + B_XBC);
  const int total = NTOK * 384;
  for (int it = bid * NTHR + TIDX; it < total; it += nb * NTHR) {
    const int n = it / 384, c8 = (it - n * 384) * 8;
    const int b = n / LT, pos = n - b * LT;
    const bool hasp = (pos != 0 && pos != LC), hasn = (pos != LC - 1 && pos != LT - 1);
    const bf16_t* zc = ZX + (size_t)n * 3072 + c8;
    uint4 cu = *(const uint4*)zc, pu = make_uint4(0, 0, 0, 0), nu = make_uint4(0, 0, 0, 0);
    if (hasp) pu = *(const uint4*)(zc - 3072);
    if (hasn) nu = *(const uint4*)(zc + 3072);
    float cv[8], pv[8], nv[8], y[8];
    unpack8(cu, cv); unpack8(pu, pv); unpack8(nu, nv);
#pragma unroll
    for (int j = 0; j < 8; j++) {
      float a = p.conv_b[c8 + j] + p.conv_w[c8 + j] * pv[j] + p.conv_w[3072 + c8 + j] * cv[j] + p.conv_w[6144 + c8 + j] * nv[j];
      y[j] = siluf_(a);
    }
    *(uint4*)(XBC + (size_t)n * 3072 + c8) = pack8(y);
  }
}

DI void ssd_task(const int TIDX, const P& p, int task, char* smem) {
  char* big = p.ws + OFF_BIG;
  const int b = task >> 5, h = task & 31, g = h >> 3;
  bf16_t* Cs = (bf16_t*)smem;
  bf16_t* Bs = Cs + 128 * 136;
  bf16_t* BT = Bs + 128 * 136;
  bf16_t* xT = BT + 128 * 136;
  bf16_t* sb = xT + 64 * 136;
  float* cum = (float*)(sb + 64 * 136);
  float* dtv = cum + 128;
  const bf16_t* XBC = (const bf16_t*)(big + B_XBC);
  const float* DT = (const float*)(big + B_DT);
  bf16_t* Y = (bf16_t*)(big + B_Y);
  const int tid = TIDX, lane = tid & 63, wave = tid >> 6;
  const int r = lane & 31, h8 = lane >> 5;
  const float dskip = p.ssd_d[h];
  for (int d = 0; d < 2; d++) {
    const float a = -expf(p.a_log[d * 32 + h]);
    const float bias = p.dt_bias[d * 32 + h];
    f32x16 sacc;
#pragma unroll
    for (int q = 0; q < 16; q++) sacc[q] = 0.f;
    __syncthreads();
    for (int e = tid; e < 64 * 136; e += NTHR) sb[e] = 0;
    for (int c = 0; c < 18; c++) {
      __syncthreads();
      if (wave == 0) {
        const int i0 = lane * 2, i1 = i0 + 1;
        const int p0 = scanpos(d, c * 128 + i0), p1 = scanpos(d, c * 128 + i1);
        const float dt0 = softplusf_(DT[(size_t)(b * LT + p0) * 64 + d * 32 + h] + bias);
        const float dt1 = softplusf_(DT[(size_t)(b * LT + p1) * 64 + d * 32 + h] + bias);
        const float a0 = a * dt0, a1 = a0 + a * dt1;
        float tot = a1;
#pragma unroll
        for (int off = 1; off < 64; off <<= 1) {
          float t = shup_(tot, off, lane);
          if (lane >= off) tot += t;
        }
        const float excl = tot - a1;
        cum[i0] = excl + a0; cum[i1] = excl + a1;
        dtv[i0] = dt0; dtv[i1] = dt1;
      }
      __syncthreads();
      const float cl = cum[127];
      {
        const int j = tid >> 2, part = tid & 3;
        const int pos = scanpos(d, c * 128 + j);
        const bf16_t* rowp = XBC + (size_t)(b * LT + pos) * 3072;
        const float wj = __expf(cl - cum[j]) * dtv[j];
#pragma unroll
        for (int q = 0; q < 4; q++) {
          const int col = part * 32 + q * 8;
          uint4 cvv = *(const uint4*)(rowp + 2560 + g * 128 + col);
          *(uint4*)(Cs + j * 136 + col) = cvv;
          uint4 bvv = *(const uint4*)(rowp + 2048 + g * 128 + col);
          *(uint4*)(Bs + j * 136 + col) = bvv;
          float bf[8]; unpack8(bvv, bf);
#pragma unroll
          for (int e = 0; e < 8; e++) BT[(col + e) * 136 + j] = f2bf(bf[e] * wj);
        }
#pragma unroll
        for (int q = 0; q < 2; q++) {
          const int col = part * 16 + q * 8;
          uint4 xv = *(const uint4*)(rowp + h * 64 + col);
          const bf16_t* xe = (const bf16_t*)&xv;
#pragma unroll
          for (int e = 0; e < 8; e++) xT[(col + e) * 136 + j] = xe[e];
        }
      }
      __syncthreads();
      const int it = wave >> 1;
      f32x16 G0, G1;
#pragma unroll
      for (int q = 0; q < 16; q++) { G0[q] = 0.f; G1[q] = 0.f; }
      {
        const int jt0 = (wave & 1) * 2, jt1 = jt0 + 1;
        if (jt0 <= it) {
#pragma unroll
          for (int ks = 0; ks < 8; ks++) {
            bf16x8 av = *(const bf16x8*)(Cs + (it * 32 + r) * 136 + ks * 16 + h8 * 8);
            bf16x8 b0 = *(const bf16x8*)(Bs + (jt0 * 32 + r) * 136 + ks * 16 + h8 * 8);
            G0 = __builtin_amdgcn_mfma_f32_32x32x16_bf16(av, b0, G0, 0, 0, 0);
            if (jt1 <= it) {
              bf16x8 b1 = *(const bf16x8*)(Bs + (jt1 * 32 + r) * 136 + ks * 16 + h8 * 8);
              G1 = __builtin_amdgcn_mfma_f32_32x32x16_bf16(av, b1, G1, 0, 0, 0);
            }
          }
        }
      }
      __syncthreads();
      {
        bf16_t* Ms = Bs;
        const int jt0 = (wave & 1) * 2;
        const int j0 = jt0 * 32 + r, j1 = j0 + 32;
        const float cj0 = cum[j0], cj1 = cum[j1], dj0 = dtv[j0], dj1 = dtv[j1];
#pragma unroll
        for (int q = 0; q < 16; q++) {
          const int i = it * 32 + (q & 3) + 8 * (q >> 2) + 4 * h8;
          const float ci = cum[i];
          float m0 = (j0 <= i) ? G0[q] * __expf(ci - cj0) * dj0 : 0.f;
          float m1 = (j1 <= i) ? G1[q] * __expf(ci - cj1) * dj1 : 0.f;
          Ms[i * 136 + j0] = f2bf(m0);
          Ms[i * 136 + j1] = f2bf(m1);
        }
      }
      __syncthreads();
      {
        const bf16_t* Ms = Bs;
        const int pt = wave & 1;
        f32x16 yd, yo;
#pragma unroll
        for (int q = 0; q < 16; q++) { yd[q] = 0.f; yo[q] = 0.f; }
#pragma unroll
        for (int ks = 0; ks < 8; ks++) {
          if (ks < (it + 1) * 2) {
            bf16x8 av = *(const bf16x8*)(Ms + (it * 32 + r) * 136 + ks * 16 + h8 * 8);
            bf16x8 bv = *(const bf16x8*)(xT + (pt * 32 + r) * 136 + ks * 16 + h8 * 8);
            yd = __builtin_amdgcn_mfma_f32_32x32x16_bf16(av, bv, yd, 0, 0, 0);
          }
          bf16x8 cv = *(const bf16x8*)(Cs + (it * 32 + r) * 136 + ks * 16 + h8 * 8);
          bf16x8 sv = *(const bf16x8*)(sb + (pt * 32 + r) * 136 + ks * 16 + h8 * 8);
          yo = __builtin_amdgcn_mfma_f32_32x32x16_bf16(cv, sv, yo, 0, 0, 0);
        }
        if (c >= 2) {
          const int pp = pt * 32 + r;
#pragma unroll
          for (int q = 0; q < 16; q++) {
            const int i = it * 32 + (q & 3) + 8 * (q >> 2) + 4 * h8;
            float y = yd[q] + __expf(cum[i]) * yo[q];
            const int pos = scanpos(d, c * 128 + i);
            const size_t idx = (size_t)(b * LT + pos) * 2048 + h * 64 + pp;
            if (d == 0) y += dskip * bf2f(xT[pp * 136 + i]);
            else y += bf2f(Y[idx]);
            Y[idx] = f2bf(y);
          }
        }
      }
      __syncthreads();
      {
        const int pt = wave & 1, nt = wave >> 1;
        const float ecl = __expf(cl);
#pragma unroll
        for (int q = 0; q < 16; q++) sacc[q] *= ecl;
#pragma unroll
        for (int ks = 0; ks < 8; ks++) {
          bf16x8 av = *(const bf16x8*)(xT + (pt * 32 + r) * 136 + ks * 16 + h8 * 8);
          bf16x8 bv = *(const bf16x8*)(BT + (nt * 32 + r) * 136 + ks * 16 + h8 * 8);
          sacc = __builtin_amdgcn_mfma_f32_32x32x16_bf16(av, bv, sacc, 0, 0, 0);
        }
#pragma unroll
        for (int q = 0; q < 16; q++) {
          const int pp = pt * 32 + (q & 3) + 8 * (q >> 2) + 4 * h8;
          sb[pp * 136 + nt * 32 + r] = f2bf(sacc[q]);
        }
      }
    }
  }
}

DI void gate_norm(const int TIDX, const P& p, int bid, int nb) {
  char* big = p.ws + OFF_BIG;
  const bf16_t* Y = (const bf16_t*)(big + B_Y);
  const bf16_t* ZG = (const bf16_t*)(big + B_ZG);
  bf16_t* YN = (bf16_t*)(big + B_YN);
  const int lane = TIDX & 63, wave = TIDX >> 6;
  for (int n = bid * 8 + wave; n < NTOK; n += nb * 8) {
    const int b = n / LT, pos = n - b * LT;
    if (pos < LC) continue;
#pragma unroll
    for (int gq = 0; gq < 4; gq++) {
      const int base = gq * 512 + lane * 8;
      uint4 yv = *(const uint4*)(Y + (size_t)n * 2048 + base);
      uint4 zv = *(const uint4*)(ZG + (size_t)n * 2048 + base);
      float y[8], z[8];
      unpack8(yv, y); unpack8(zv, z);
      float ss = 0.f;
#pragma unroll
      for (int j = 0; j < 8; j++) { y[j] = y[j] * siluf_(z[j]); ss += y[j] * y[j]; }
      ss = wave_sum(ss);
      const float rs = rsqrtf(ss * (1.f / 512.f) + 1e-6f);
#pragma unroll
      for (int j = 0; j < 8; j++) y[j] = y[j] * rs * p.ssd_nw[base + j];
      *(uint4*)(YN + (size_t)n * 2048 + base) = pack8(y);
    }
  }
}

DI void run_phase(const int TIDX, const P& p, int ph, int bid, int nb, char* smem, const bool dry = false) {
  char* ws = p.ws;
  char* big = ws + OFF_BIG;
  float* X = (float*)(ws + OFF_X);
  const float* mod = (const float*)(ws + OFF_MOD);
  bf16_t* H = (bf16_t*)(ws + OFF_H);
  switch (ph) {
    case 0: {
      mod_gemv(TIDX, p, bid, nb, smem);
      tconv(TIDX, p.ev_w_in, 2560, 1024, 2560, (bf16_t*)(ws + OFF_WIN0), 1024, 0, bid, nb, smem);
      tconv(TIDX, p.ev_w_out, 1024, 1024, 1024, (bf16_t*)(ws + OFF_WOUT0), 1536, 0, bid, nb, smem);
      tconv(TIDX, p.ev_w_out + 512 * 1024, 1024, 512, 1024, (bf16_t*)(ws + OFF_WOUT0), 1536, 1024, bid, nb, smem);
      tconv(TIDX, p.ssd_w_in, 5184, 1024, 5184, (bf16_t*)(ws + OFF_WIN1), 1024, 0, bid, nb, smem);
      tconv(TIDX, p.ssd_w_out, 1024, 2048, 1024, (bf16_t*)(ws + OFF_WOUT1), 2048, 0, bid, nb, smem);
      tconv(TIDX, p.pwq, 2048, 1024, 2048, (bf16_t*)(ws + OFF_WQ), 1024, 0, bid, nb, smem);
      tconv(TIDX, p.pwq + 1024 * 2048, 2048, 1024, 2048, (bf16_t*)(ws + OFF_WQ) + 2048 * 1024, 1024, 0, bid, nb, smem);
      tconv(TIDX, p.w2, 512, 64, 512, (bf16_t*)(ws + OFF_W2C), 64, 0, bid, nb, smem);
      tconv(TIDX, p.w2 + 64 * 512, 512, 64, 512, (bf16_t*)(ws + OFF_W2C) + 512 * 64, 64, 0, bid, nb, smem);
      tconv(TIDX, p.a2, 512, 64, 512, (bf16_t*)(ws + OFF_A2C), 64, 0, bid, nb, smem);
      tconv(TIDX, p.a2 + 64 * 512, 512, 64, 512, (bf16_t*)(ws + OFF_A2C) + 512 * 64, 64, 0, bid, nb, smem);
      tconv(TIDX, p.g2, 512, 128, 512, (bf16_t*)(ws + OFF_G2T), 128, 0, bid, nb, smem);
      conv_flat(TIDX, p.pkeys, (bf16_t*)(ws + OFF_KEYS), (size_t)2 * 16 * 128 * 128, bid, nb);
      conv_flat(TIDX, p.pu, (bf16_t*)(ws + OFF_UB), (size_t)16384 * 1024, bid, nb);
      conv_flat(TIDX, p.pv, (bf16_t*)(ws + OFF_VB), (size_t)16384 * 1024, bid, nb);
    } break;
    case 1: norm_rows(TIDX, p, 0, 0, true, false, bid, nb); break;
    case 2: {
      bf16_t* Z = (bf16_t*)(big + B_Z0);
      auto epi = [=](int m, int n, float v) { Z[(size_t)m * 2560 + n] = f2bf(v); };
      for (int t = bid; t < 72 * 20; t += nb) {
        int mt = t / 20, nt = t % 20;
        gemm_tile(TIDX, H, 1024, (const bf16_t*)(ws + OFF_WIN0), 1024, 1024, mt * 256, nt * 128, epi, smem);
      }
    } break;
    case 3: prep0(TIDX, p, bid, nb); break;
    case 4: {
      float* DEC = (float*)(big + B_DEC);
      bf16_t* AL = (bf16_t*)(big + B_AL);
      bf16_t* G = (bf16_t*)(big + B_G);
      const float* w0 = p.w0; const float* a0 = p.a0;
      auto epi1 = [=](int m, int n, float v) {
        int d = n >> 9, c = n & 511, hh = c >> 6, i = c & 63;
        int b = m / LT, pos = m - b * LT;
        float x = w0[n] + v;
        float w = -softplusf_(-x) - 0.5f;
        DEC[(size_t)d * (NB * 8 * LT * 64) + ((size_t)(b * 8 + hh) * LT + pos) * 64 + i] = expf(-expf(w));
      };
      auto epi2 = [=](int m, int n, float v) {
        int d = n >> 9, c = n & 511, hh = c >> 6, i = c & 63;
        int b = m / LT, pos = m - b * LT;
        AL[(size_t)d * (NB * 8 * LT * 64) + ((size_t)(b * 8 + hh) * LT + pos) * 64 + i] = f2bf(sigmoidf_(a0[n] + v));
      };
      auto epi3 = [=](int m, int n, float v) { G[(size_t)m * 512 + n] = f2bf(v); };
      for (int t = bid; t < 1440; t += nb) {
        if (t < 576) {
          gemm_tile(TIDX, (const bf16_t*)(big + B_AW), 64, (const bf16_t*)(ws + OFF_W2C), 64, 64, (t >> 3) * 256, (t & 7) * 128, epi1, smem);
        } else if (t < 1152) {
          int t2 = t - 576;
          gemm_tile(TIDX, (const bf16_t*)(big + B_AA), 64, (const bf16_t*)(ws + OFF_A2C), 64, 64, (t2 >> 3) * 256, (t2 & 7) * 128, epi2, smem);
        } else {
          int t2 = t - 1152;
          gemm_tile(TIDX, (const bf16_t*)(big + B_AG), 128, (const bf16_t*)(ws + OFF_G2T), 128, 128, (t2 >> 2) * 256, (t2 & 3) * 128, epi3, smem);
        }
      }
    } break;
    case 5: {
      if (nb >= 256) {
        if (bid < 128) wkv_task(TIDX, p, bid, smem);
        else for (int t = bid - 128; t < 576; t += nb - 128) attn_task(TIDX, p, t, smem);
      } else {
        for (int t = bid; t < 128; t += nb) wkv_task(TIDX, p, t, smem);
        for (int t = bid; t < 576; t += nb) attn_task(TIDX, p, t, smem);
      }
    } break;
    case 6: {
      const float* gate = mod;
      const float* xc_ = p.ctx; const float* xl_ = p.x;
      auto epi = [=](int m, int n, float v) {
        int b = m / LT, pos = m - b * LT;
        int rr = pos < LC ? 8 : b;
        const float* xr = pos < LC ? xc_ + ((size_t)(b * LC + pos)) * DM : xl_ + ((size_t)(b * SEQ + pos - LC)) * DM;
        X[(size_t)m * DM + n] = xr[n] + gate[(size_t)rr * 6144 + 2 * 1024 + n] * v;
      };
      for (int t = bid; t < 72 * 8; t += nb)
        gemm_tile(TIDX, (const bf16_t*)(big + B_YMIX), 1536, (const bf16_t*)(ws + OFF_WOUT0), 1536, 1536, (t >> 3) * 256, (t & 7) * 128, epi, smem);
    } break;
    case 7: norm_rows(TIDX, p, 0, 1, false, false, bid, nb); break;
    case 8: {
      bf16_t* QP = (bf16_t*)(big + B_QP);
      auto epi = [=](int m, int n, float v) { QP[(size_t)m * 2048 + n] = f2bf(v); };
      for (int t = bid; t < 72 * 16; t += nb)
        gemm_tile(TIDX, H, 1024, (const bf16_t*)(ws + OFF_WQ), 1024, 1024, (t >> 4) * 256, (t & 15) * 128, epi, smem);
    } break;
    case 9: break;
    case 10:
      for (int t = bid; t < 72 * 8; t += nb) route2_task(TIDX, p, 0, (t >> 3) * 256, t & 7, smem);
      break;
    case 11: peer_gather(TIDX, p, 0, false, bid, nb, dry); break;
    case 12: {
      bf16_t* ZG = (bf16_t*)(big + B_ZG);
      bf16_t* ZX = (bf16_t*)(big + B_ZX);
      float* DT = (float*)(big + B_DT);
      auto epi = [=](int m, int n, float v) {
        if (n < 2048) ZG[(size_t)m * 2048 + n] = f2bf(v);
        else if (n < 5120) ZX[(size_t)m * 3072 + n - 2048] = f2bf(v);
        else if (n < 5184) DT[(size_t)m * 64 + n - 5120] = v;
      };
      for (int t = bid; t < 72 * 41; t += nb) {
        int mt = t / 41, nt = t % 41;
        gemm_tile(TIDX, H, 1024, (const bf16_t*)(ws + OFF_WIN1), 1024, 1024, mt * 256, nt * 128, epi, smem);
      }
    } break;
    case 13: {
      conv_phase(TIDX, p, bid, nb);
      conv_flat(TIDX, p.pu + (size_t)16384 * 1024, (bf16_t*)(ws + OFF_UB), (size_t)16384 * 1024, bid, nb);
      conv_flat(TIDX, p.pv + (size_t)16384 * 1024, (bf16_t*)(ws + OFF_VB), (size_t)16384 * 1024, bid, nb);
    } break;
    case 14:
      for (int t = bid; t < 256; t += nb) ssd_task(TIDX, p, t, smem);
      break;
    case 15: gate_norm(TIDX, p, bid, nb); break;
    case 16: {
      const float* gate = mod + (size_t)9 * 6144;
      auto epi = [=](int m, int n, float v) {
        int b = m / LT;
        X[(size_t)m * DM + n] += gate[(size_t)b * 6144 + 2 * 1024 + n] * v;
      };
      for (int t = bid; t < 64 * 8; t += nb) {
        int mtl = t >> 3, b = mtl >> 3, mt = b * 9 + 1 + (mtl & 7);
        gemm_tile(TIDX, (const bf16_t*)(big + B_YN), 2048, (const bf16_t*)(ws + OFF_WOUT1), 2048, 2048, mt * 256, (t & 7) * 128, epi, smem);
      }
    } break;
    case 17: norm_rows(TIDX, p, 1, 1, false, true, bid, nb); break;
    case 18: {
      bf16_t* QP = (bf16_t*)(big + B_QP);
      auto epi = [=](int m, int n, float v) { QP[(size_t)m * 2048 + n] = f2bf(v); };
      for (int t = bid; t < 64 * 16; t += nb) {
        int mtl = t >> 4, b = mtl >> 3, mt = b * 9 + 1 + (mtl & 7);
        gemm_tile(TIDX, H, 1024, (const bf16_t*)(ws + OFF_WQ) + 2048 * 1024, 1024, 1024, mt * 256, (t & 15) * 128, epi, smem);
      }
    } break;
    case 19: break;
    case 20:
      for (int t = bid; t < 64 * 8; t += nb) {
        int mtl = t >> 3, b = mtl >> 3, mt = b * 9 + 1 + (mtl & 7);
        route2_task(TIDX, p, 1, mt * 256, t & 7, smem);
      }
      break;
    case 21: peer_gather(TIDX, p, 1, true, bid, nb, false); break;
  }
}
constexpr int NPHASE = 22;
#ifndef DUP_MASK
#define DUP_MASK 0u
#endif

__global__ void __launch_bounds__(NTHR) mega(P p) {
  __shared__ __attribute__((aligned(16))) char smem[SMEM_BYTES];
  cg::grid_group grid = cg::this_grid();
#define PHC(i, last)                                             \
  {                                                              \
    P q = p;                                                     \
    int bid = blockIdx.x, nb = gridDim.x;                        \
    char* sm = smem;                                             \
    int TIDX = __builtin_amdgcn_workitem_id_x();                 \
    asm volatile("" : "+s"(q.ws), "+s"(bid), "+s"(nb), "+v"(TIDX)); \
    if ((DUP_MASK >> i) & 1) { run_phase(TIDX, q, i, bid, nb, sm, true); grid.sync(); } \
    run_phase(TIDX, q, i, bid, nb, sm);                          \
    if (!last) grid.sync();                                      \
  }
  PHC(0, 0) PHC(1, 0) PHC(2, 0) PHC(3, 0) PHC(4, 0) PHC(5, 0) PHC(6, 0) PHC(7, 0) PHC(8, 0) PHC(10, 0)
  PHC(11, 0) PHC(12, 0) PHC(13, 0) PHC(14, 0) PHC(15, 0) PHC(16, 0) PHC(17, 0) PHC(18, 0) PHC(20, 0) PHC(21, 1)
}

extern "C" void kernel_launch(void* const* d_in, const int* in_sizes, int n_in, void* d_out, int out_size, void* d_ws,
                              size_t ws_size, hipStream_t stream) {
  static int grid_blocks = 0;
  if (!grid_blocks) {
    int dev = 0, cus = 0, per_cu = 0;
    hipGetDevice(&dev);
    hipDeviceGetAttribute(&cus, hipDeviceAttributeMultiprocessorCount, dev);
    hipOccupancyMaxActiveBlocksPerMultiprocessor(&per_cu, mega, NTHR, 0);
    if (per_cu < 1) per_cu = 1;
    grid_blocks = cus * per_cu;
  }
  P p;
  memset(&p, 0, sizeof(p));
  const float** fp = (const float**)&p;
  for (int i = 0; i < 35; i++) fp[i] = (const float*)d_in[i];
  p.out = (float*)d_out;
  p.ws = (char*)d_ws;
  if (ws_size < WS_NEED) fprintf(stderr, "workspace too small: %zu < %zu\n", ws_size, (size_t)WS_NEED);
  void* args[] = {&p};
  hipError_t e = hipLaunchCooperativeKernel((void*)mega, dim3(grid_blocks), dim3(NTHR), args, 0, stream);
  if (e != hipSuccess) fprintf(stderr, "cooperative launch failed: %s (grid %d)\n", hipGetErrorString(e), grid_blocks);
}
```

```cpp
#include <hip/hip_runtime.h>
#include <hip/hip_cooperative_groups.h>
#include <stdint.h>
#include <string.h>
#include <stdio.h>
namespace cg = cooperative_groups;

#define DI __device__ __forceinline__
typedef unsigned short bf16_t;
typedef short bf16x8 __attribute__((ext_vector_type(8)));
typedef float f32x16 __attribute__((ext_vector_type(16)));

constexpr int NB = 8, SEQ = 2048, LC = 256, LT = 2304, NTOK = 18432, DM = 1024;
constexpr int NTHR = 512;

constexpr size_t OFF_UB = 0;
constexpr size_t OFF_VB = OFF_UB + 33554432;
constexpr size_t OFF_WIN0 = OFF_VB + 33554432;
constexpr size_t OFF_WOUT0 = OFF_WIN0 + 5242880;
constexpr size_t OFF_WIN1 = OFF_WOUT0 + 3145728;
constexpr size_t OFF_WOUT1 = OFF_WIN1 + 10747904;
constexpr size_t OFF_WQ = OFF_WOUT1 + 4194304;
constexpr size_t OFF_KEYS = OFF_WQ + 8388608;
constexpr size_t OFF_W2C = OFF_KEYS + 1048576;
constexpr size_t OFF_A2C = OFF_W2C + 131072;
constexpr size_t OFF_G2T = OFF_A2C + 131072;
constexpr size_t OFF_MOD = OFF_G2T + 131072;
constexpr size_t OFF_X = OFF_MOD + 442368;
constexpr size_t OFF_H = OFF_X + 75497472;
constexpr size_t OFF_BIG = OFF_H + 37748736;
constexpr size_t B_Z0 = 0;
constexpr size_t B_DEC = 0;
constexpr size_t B_G = 75497472;
constexpr size_t B_QN = 94371840;
constexpr size_t B_KN = B_QN + 18874368;
constexpr size_t B_VT = B_KN + 4718592;
constexpr size_t B_R = B_VT + 4718592;
constexpr size_t B_KB = B_R + 18874368;
constexpr size_t B_KK = B_KB + 18874368;
constexpr size_t B_V = B_KK + 18874368;
constexpr size_t B_AL = B_V + 18874368;
constexpr size_t B_AW = B_AL + 37748736;
constexpr size_t B_AA = B_AW + 2359296;
constexpr size_t B_AG = B_AA + 2359296;
constexpr size_t B_YMIX = B_AG + 4718592;
constexpr size_t B_L0END = B_YMIX + 56623104;
constexpr size_t B_QP = 0;
constexpr size_t B_S = 75497472;
constexpr size_t B_EI = B_S + 150994944;
constexpr size_t B_EG = B_EI + 9437184;
constexpr size_t B_PEND = B_EG + 9437184;
constexpr size_t B_ZG = 0;
constexpr size_t B_ZX = 75497472;
constexpr size_t B_Y = B_ZX;
constexpr size_t B_DT = B_ZX + 113246208;
constexpr size_t B_XBC = B_DT + 4718592;
constexpr size_t B_YN = B_XBC;
constexpr size_t B_L1END = B_XBC + 113246208;
constexpr size_t BIG_SZ = B_L1END > B_L0END ? (B_L1END > B_PEND ? B_L1END : B_PEND) : (B_L0END > B_PEND ? B_L0END : B_PEND);
constexpr size_t WS_NEED = OFF_BIG + BIG_SZ;
static_assert(WS_NEED <= 536870912, "workspace too large");

constexpr int SMEM_BYTES = 157696;

struct P {
  const float *x, *c, *ctx, *c_ctx, *mod_w, *mod_b, *n1g, *n2g, *ev_w_in, *ev_w_out, *qg, *kg, *mu, *w0, *w2, *a0, *a2, *g2,
      *k_k, *k_a, *r_k, *gn_w, *gn_b, *ssd_w_in, *conv_w, *conv_b, *dt_bias, *a_log, *ssd_d, *ssd_nw, *ssd_w_out, *pwq, *pkeys,
      *pu, *pv;
  float* out;
  char* ws;
};

DI bf16_t f2bf(float f) {
  unsigned u = __float_as_uint(f);
  u += 0x7fffu + ((u >> 16) & 1u);
  return (bf16_t)(u >> 16);
}
DI float bf2f(bf16_t b) { return __uint_as_float(((unsigned)b) << 16); }
DI unsigned pack2(float a, float b) { return (unsigned)f2bf(a) | ((unsigned)f2bf(b) << 16); }
DI float lo2f(unsigned u) { return __uint_as_float(u << 16); }
DI float hi2f(unsigned u) { return __uint_as_float(u & 0xffff0000u); }
DI void unpack8(const uint4& r, float* v) {
  v[0] = lo2f(r.x); v[1] = hi2f(r.x); v[2] = lo2f(r.y); v[3] = hi2f(r.y);
  v[4] = lo2f(r.z); v[5] = hi2f(r.z); v[6] = lo2f(r.w); v[7] = hi2f(r.w);
}
DI uint4 pack8(const float* v) {
  uint4 r; r.x = pack2(v[0], v[1]); r.y = pack2(v[2], v[3]); r.z = pack2(v[4], v[5]); r.w = pack2(v[6], v[7]);
  return r;
}
DI float shx_(float v, int off, int lane) {
  return __builtin_bit_cast(float, __builtin_amdgcn_ds_bpermute((lane ^ off) << 2, __builtin_bit_cast(int, v)));
}
DI float shup_(float v, int off, int lane) {
  return __builtin_bit_cast(float, __builtin_amdgcn_ds_bpermute((lane - off) << 2, __builtin_bit_cast(int, v)));
}
#define SHX(v, o) shx_((v), (o), lane)
DI float wave_sum_(float v, int lane) {
#pragma unroll
  for (int o = 32; o > 0; o >>= 1) v += shx_(v, o, lane);
  return v;
}
#define wave_sum(v) wave_sum_((v), lane)
DI float dpp_f(float v, const int ctrl_sel) {
  int x = __builtin_bit_cast(int, v);
  int y;
  if (ctrl_sel == 0) y = __builtin_amdgcn_mov_dpp(x, 0xB1, 0xF, 0xF, true);
  else if (ctrl_sel == 1) y = __builtin_amdgcn_mov_dpp(x, 0x4E, 0xF, 0xF, true);
  else y = __builtin_amdgcn_mov_dpp(x, 0x141, 0xF, 0xF, true);
  return __builtin_bit_cast(float, y);
}
DI float reduce8(float v) {
  v += dpp_f(v, 0);
  v += dpp_f(v, 1);
  v += dpp_f(v, 2);
  return v;
}
DI float wave_sum_dpp(float v, int lane) {
  v += dpp_f(v, 0);
  v += dpp_f(v, 1);
  v += dpp_f(v, 2);
  v += __builtin_bit_cast(float, __builtin_amdgcn_mov_dpp(__builtin_bit_cast(int, v), 0x140, 0xF, 0xF, true));
  v += shx_(v, 16, lane);
  v += shx_(v, 32, lane);
  return v;
}
typedef float f32x2 __attribute__((ext_vector_type(2)));
DI void cvt16_fp8(const uint4& w, float* f) {
  f32x2 t;
  t = __builtin_amdgcn_cvt_pk_f32_fp8((int)w.x, false); f[0] = t.x; f[1] = t.y;
  t = __builtin_amdgcn_cvt_pk_f32_fp8((int)w.x, true); f[2] = t.x; f[3] = t.y;
  t = __builtin_amdgcn_cvt_pk_f32_fp8((int)w.y, false); f[4] = t.x; f[5] = t.y;
  t = __builtin_amdgcn_cvt_pk_f32_fp8((int)w.y, true); f[6] = t.x; f[7] = t.y;
  t = __builtin_amdgcn_cvt_pk_f32_fp8((int)w.z, false); f[8] = t.x; f[9] = t.y;
  t = __builtin_amdgcn_cvt_pk_f32_fp8((int)w.z, true); f[10] = t.x; f[11] = t.y;
  t = __builtin_amdgcn_cvt_pk_f32_fp8((int)w.w, false); f[12] = t.x; f[13] = t.y;
  t = __builtin_amdgcn_cvt_pk_f32_fp8((int)w.w, true); f[14] = t.x; f[15] = t.y;
}
DI float sigmoidf_(float x) { return 1.f / (1.f + __expf(-x)); }
DI float siluf_(float x) { return x / (1.f + __expf(-x)); }
DI float softplusf_(float y) { return fmaxf(y, 0.f) + log1pf(__expf(-fabsf(y))); }
DI int scanpos(int d, int pp) { return d ? (pp < LC ? LC - 1 - pp : LT + LC - 1 - pp) : pp; }
DI int rowmod(int n) { int b = n / LT; int pos = n - b * LT; return pos < LC ? 8 : b; }
DI const float* xin_row(const P& p, int n) {
  int b = n / LT, pos = n - b * LT;
  return pos < LC ? p.ctx + ((size_t)(b * LC + pos)) * DM : p.x + ((size_t)(b * SEQ + pos - LC)) * DM;
}

template <class Epi>
DI void gemm_tile(const int TIDX, const bf16_t* __restrict__ A, int lda, const bf16_t* __restrict__ Bt, int ldb, int K, int m0, int n0,
                  Epi epi, char* smem) {
  bf16_t* As = (bf16_t*)smem;
  bf16_t* Bs = As + 2 * 256 * 72;
  const int tid = TIDX, lane = tid & 63, wave = tid >> 6;
  const int wm = wave >> 1, wn = wave & 1;
  const int r = lane & 31, h8 = lane >> 5;
  f32x16 acc[2][2];
#pragma unroll
  for (int i = 0; i < 2; i++)
#pragma unroll
    for (int j = 0; j < 2; j++)
#pragma unroll
      for (int q = 0; q < 16; q++) acc[i][j][q] = 0.f;
  const int lrow = tid >> 3, lch = tid & 7;
  const bf16_t* Ap = A + (size_t)(m0 + lrow) * lda + lch * 8;
  const bf16_t* Bp = Bt + (size_t)(n0 + lrow) * ldb + lch * 8;
  const size_t sa = (size_t)64 * lda, sb_ = (size_t)64 * ldb;
  uint4 ra0 = *(const uint4*)(Ap), ra1 = *(const uint4*)(Ap + sa), ra2 = *(const uint4*)(Ap + 2 * sa), ra3 = *(const uint4*)(Ap + 3 * sa);
  uint4 rb0 = *(const uint4*)(Bp), rb1 = *(const uint4*)(Bp + sb_);
  __syncthreads();
  {
    bf16_t* Aw = As + lrow * 72 + lch * 8;
    bf16_t* Bw = Bs + lrow * 72 + lch * 8;
    *(uint4*)(Aw) = ra0; *(uint4*)(Aw + 64 * 72) = ra1; *(uint4*)(Aw + 128 * 72) = ra2; *(uint4*)(Aw + 192 * 72) = ra3;
    *(uint4*)(Bw) = rb0; *(uint4*)(Bw + 64 * 72) = rb1;
  }
  __syncthreads();
  const int nk = K >> 6;
  for (int kt = 0; kt < nk; kt++) {
    const int cur = kt & 1;
    const bool more = kt + 1 < nk;
    if (more) {
      const bf16_t* Aq = Ap + (kt + 1) * 64;
      const bf16_t* Bq = Bp + (kt + 1) * 64;
      ra0 = *(const uint4*)(Aq); ra1 = *(const uint4*)(Aq + sa); ra2 = *(const uint4*)(Aq + 2 * sa); ra3 = *(const uint4*)(Aq + 3 * sa);
      rb0 = *(const uint4*)(Bq); rb1 = *(const uint4*)(Bq + sb_);
    }
    const bf16_t* Ac = As + cur * 256 * 72 + (wm * 64 + r) * 72 + h8 * 8;
    const bf16_t* Bc = Bs + cur * 128 * 72 + (wn * 64 + r) * 72 + h8 * 8;
#pragma unroll
    for (int ks = 0; ks < 4; ks++) {
      bf16x8 a0 = *(const bf16x8*)(Ac + ks * 16);
      bf16x8 a1 = *(const bf16x8*)(Ac + 32 * 72 + ks * 16);
      bf16x8 b0 = *(const bf16x8*)(Bc + ks * 16);
      bf16x8 b1 = *(const bf16x8*)(Bc + 32 * 72 + ks * 16);
      acc[0][0] = __builtin_amdgcn_mfma_f32_32x32x16_bf16(a0, b0, acc[0][0], 0, 0, 0);
      acc[0][1] = __builtin_amdgcn_mfma_f32_32x32x16_bf16(a0, b1, acc[0][1], 0, 0, 0);
      acc[1][0] = __builtin_amdgcn_mfma_f32_32x32x16_bf16(a1, b0, acc[1][0], 0, 0, 0);
      acc[1][1] = __builtin_amdgcn_mfma_f32_32x32x16_bf16(a1, b1, acc[1][1], 0, 0, 0);
    }
    if (more) {
      const int nx = cur ^ 1;
      bf16_t* Aw = As + nx * 256 * 72 + lrow * 72 + lch * 8;
      bf16_t* Bw = Bs + nx * 128 * 72 + lrow * 72 + lch * 8;
      *(uint4*)(Aw) = ra0; *(uint4*)(Aw + 64 * 72) = ra1; *(uint4*)(Aw + 128 * 72) = ra2; *(uint4*)(Aw + 192 * 72) = ra3;
      *(uint4*)(Bw) = rb0; *(uint4*)(Bw + 64 * 72) = rb1;
    }
    __syncthreads();
  }
#pragma unroll
  for (int mt = 0; mt < 2; mt++)
#pragma unroll
    for (int nt = 0; nt < 2; nt++)
#pragma unroll
      for (int q = 0; q < 16; q++) {
        int m = m0 + wm * 64 + mt * 32 + (q & 3) + 8 * (q >> 2) + 4 * h8;
        int n = n0 + wn * 64 + nt * 32 + r;
        epi(m, n, acc[mt][nt][q]);
      }
}

DI void tconv(const int TIDX, const float* __restrict__ src, int lds_, int K, int N, bf16_t* __restrict__ dst, int ldd, int koff, int bid,
              int nb, char* smem) {
  float* t = (float*)smem;
  const int tn = N >> 6, tk = K >> 6;
  for (int tile = bid; tile < tk * tn; tile += nb) {
    const int k0 = (tile / tn) * 64, n0 = (tile % tn) * 64;
    __syncthreads();
    for (int e = TIDX; e < 4096; e += NTHR) {
      int kk = e >> 6, nn = e & 63;
      t[kk * 65 + nn] = src[(size_t)(k0 + kk) * lds_ + n0 + nn];
    }
    __syncthreads();
    for (int e = TIDX; e < 4096; e += NTHR) {
      int nn = e >> 6, kk = e & 63;
      dst[(size_t)(n0 + nn) * ldd + koff + k0 + kk] = f2bf(t[kk * 65 + nn]);
    }
  }
}
DI void conv_flat(const int TIDX, const float* __restrict__ src, bf16_t* __restrict__ dst, size_t count, int bid, int nb) {
  const size_t n4 = count >> 2;
  for (size_t i = (size_t)bid * NTHR + TIDX; i < n4; i += (size_t)nb * NTHR) {
    float4 v = ((const float4*)src)[i];
    uint2 o; o.x = pack2(v.x, v.y); o.y = pack2(v.z, v.w);
    ((uint2*)dst)[i] = o;
  }
}
DI void conv_fp8(const int TIDX, const float* __restrict__ src, unsigned char* __restrict__ dst, float* __restrict__ scl, int bid, int nb) {
  const int lane = TIDX & 63, wave = TIDX >> 6;
  for (int row = bid * 8 + wave; row < 16384; row += nb * 8) {
    const float* sp = src + (size_t)row * 1024 + lane * 16;
    float4 v0 = *(const float4*)(sp), v1 = *(const float4*)(sp + 4), v2 = *(const float4*)(sp + 8), v3 = *(const float4*)(sp + 12);
    float am = fmaxf(fmaxf(fmaxf(fabsf(v0.x), fabsf(v0.y)), fmaxf(fabsf(v0.z), fabsf(v0.w))),
                     fmaxf(fmaxf(fabsf(v1.x), fabsf(v1.y)), fmaxf(fabsf(v1.z), fabsf(v1.w))));
    am = fmaxf(am, fmaxf(fmaxf(fmaxf(fabsf(v2.x), fabsf(v2.y)), fmaxf(fabsf(v2.z), fabsf(v2.w))),
                         fmaxf(fmaxf(fabsf(v3.x), fabsf(v3.y)), fmaxf(fabsf(v3.z), fabsf(v3.w)))));
#pragma unroll
    for (int o = 32; o > 0; o >>= 1) am = fmaxf(am, shx_(am, o, lane));
    const float sc = am > 0.f ? 224.f / am : 1.f;
    if (lane == 0) scl[row] = am > 0.f ? am * (1.f / 224.f) : 1.f;
    uint4 o;
    int t = 0;
    t = __builtin_amdgcn_cvt_pk_fp8_f32(v0.x * sc, v0.y * sc, t, false); t = __builtin_amdgcn_cvt_pk_fp8_f32(v0.z * sc, v0.w * sc, t, true); o.x = (unsigned)t;
    t = __builtin_amdgcn_cvt_pk_fp8_f32(v1.x * sc, v1.y * sc, t, false); t = __builtin_amdgcn_cvt_pk_fp8_f32(v1.z * sc, v1.w * sc, t, true); o.y = (unsigned)t;
    t = __builtin_amdgcn_cvt_pk_fp8_f32(v2.x * sc, v2.y * sc, t, false); t = __builtin_amdgcn_cvt_pk_fp8_f32(v2.z * sc, v2.w * sc, t, true); o.z = (unsigned)t;
    t = __builtin_amdgcn_cvt_pk_fp8_f32(v3.x * sc, v3.y * sc, t, false); t = __builtin_amdgcn_cvt_pk_fp8_f32(v3.z * sc, v3.w * sc, t, true); o.w = (unsigned)t;
    *(uint4*)(dst + (size_t)row * 1024 + lane * 16) = o;
  }
}
DI void mod_gemv(const int TIDX, const P& p, int bid, int nb, char* smem) {
  float* sc = (float*)smem;
  float* red = sc + 9 * 1024;
  float* modo = (float*)(p.ws + OFF_MOD);
  for (int task = bid; task < 192; task += nb) {
    const int l = task / 96, j0 = (task % 96) * 64;
    __syncthreads();
    for (int e = TIDX; e < 9 * 1024; e += NTHR) {
      int rr = e >> 10, k = e & 1023;
      float v = rr < 8 ? p.c[rr * 1024 + k] : p.c_ctx[k];
      sc[e] = v / (1.f + expf(-v));
    }
    __syncthreads();
    const int kg = TIDX >> 6, col = TIDX & 63;
    float acc[9];
#pragma unroll
    for (int q = 0; q < 9; q++) acc[q] = 0.f;
    const float* W = p.mod_w + (size_t)l * 1024 * 6144 + j0 + col;
#pragma unroll 4
    for (int k = kg * 128; k < kg * 128 + 128; ++k) {
      float w = W[(size_t)k * 6144];
#pragma unroll
      for (int q = 0; q < 9; q++) acc[q] += sc[q * 1024 + k] * w;
    }
#pragma unroll
    for (int q = 0; q < 9; q++) red[(kg * 9 + q) * 64 + col] = acc[q];
    __syncthreads();
    for (int e = TIDX; e < 9 * 64; e += NTHR) {
      int rr = e >> 6, cc = e & 63;
      float s = p.mod_b[l * 6144 + j0 + cc];
#pragma unroll
      for (int g = 0; g < 8; g++) s += red[(g * 9 + rr) * 64 + cc];
      modo[(size_t)(l * 9 + rr) * 6144 + j0 + cc] = s;
    }
  }
}

DI void norm_rows(const int TIDX, const P& p, int layer, int which, bool from_input, bool latent_only, int bid, int nb) {
  const int lane = TIDX & 63, wave = TIDX >> 6;
  const float* mod = (const float*)(p.ws + OFF_MOD);
  const float* X = (const float*)(p.ws + OFF_X);
  bf16_t* H = (bf16_t*)(p.ws + OFF_H);
  const float* g = (which ? p.n2g : p.n1g) + layer * 1024;
  for (int n = bid * 8 + wave; n < NTOK; n += nb * 8) {
    int b = n / LT, pos = n - b * LT;
    if (latent_only && pos < LC) continue;
    const float* src = from_input ? xin_row(p, n) : X + (size_t)n * DM;
    float4 v[4];
    float ss = 0.f;
#pragma unroll
    for (int i = 0; i < 4; i++) {
      v[i] = *(const float4*)(src + i * 256 + lane * 4);
      ss += v[i].x * v[i].x + v[i].y * v[i].y + v[i].z * v[i].z + v[i].w * v[i].w;
    }
    ss = wave_sum(ss);
    const float rs = rsqrtf(ss * (1.f / 1024.f) + 1e-6f);
    const int rr = pos < LC ? 8 : b;
    const float* msc = mod + (size_t)(layer * 9 + rr) * 6144 + (which ? 4 : 1) * 1024;
    const float* msh = mod + (size_t)(layer * 9 + rr) * 6144 + (which ? 3 : 0) * 1024;
#pragma unroll
    for (int i = 0; i < 4; i++) {
      int idx = i * 256 + lane * 4;
      float4 gg = *(const float4*)(g + idx), sc = *(const float4*)(msc + idx), sh = *(const float4*)(msh + idx);
      float y0 = v[i].x * rs * gg.x * (1.f + sc.x) + sh.x;
      float y1 = v[i].y * rs * gg.y * (1.f + sc.y) + sh.y;
      float y2 = v[i].z * rs * gg.z * (1.f + sc.z) + sh.z;
      float y3 = v[i].w * rs * gg.w * (1.f + sc.w) + sh.w;
      uint2 o; o.x = pack2(y0, y1); o.y = pack2(y2, y3);
      *(uint2*)(H + (size_t)n * DM + idx) = o;
    }
  }
}

DI void rope8(float* v, int e, int t, int lane) {
  const int half = e >> 2, isx2 = (e >> 1) & 1, ibase = (e & 1) * 8;
  const float posf = half ? (float)(t & 63) : (float)(t >> 6);
#pragma unroll
  for (int j = 0; j < 8; j++) {
    float pv = SHX(v[j], 2);
    float inv = exp2f(-(float)(ibase + j) * 0.83048202f);
    float ang = posf * inv;
    float rev = ang * 0.15915494309f;
    rev -= floorf(rev);
    float sn = __builtin_amdgcn_sinf(rev), cs = __builtin_amdgcn_cosf(rev);
    v[j] = isx2 ? (v[j] * cs + pv * sn) : (v[j] * cs - pv * sn);
  }
}
DI void prep0(const int TIDX, const P& p, int bid, int nb) {
  char* big = p.ws + OFF_BIG;
  const bf16_t* Z = (const bf16_t*)(big + B_Z0);
  bf16_t* QN = (bf16_t*)(big + B_QN); bf16_t* KN = (bf16_t*)(big + B_KN); bf16_t* VT = (bf16_t*)(big + B_VT);
  bf16_t* R = (bf16_t*)(big + B_R); bf16_t* KB = (bf16_t*)(big + B_KB); bf16_t* KK = (bf16_t*)(big + B_KK);
  bf16_t* V = (bf16_t*)(big + B_V); bf16_t* AW = (bf16_t*)(big + B_AW); bf16_t* AA = (bf16_t*)(big + B_AA);
  bf16_t* AG = (bf16_t*)(big + B_AG);
  const int lane = TIDX & 63, wave = TIDX >> 6;
  for (int n = bid * 8 + wave; n < NTOK; n += nb * 8) {
    const int b = n / LT, pos = n - b * LT;
    const bool lat = pos >= LC;
    const int t = pos - LC;
    const bf16_t* zr = Z + (size_t)n * 2560;
    {
      const int head = lane >> 3, e = lane & 7;
      uint4 raw = *(const uint4*)(zr + head * 64 + e * 8);
      float v[8]; unpack8(raw, v);
      float ss = 0.f;
#pragma unroll
      for (int j = 0; j < 8; j++) ss += v[j] * v[j];
      ss += SHX(ss, 1); ss += SHX(ss, 2); ss += SHX(ss, 4);
      const float rs = rsqrtf(ss * (1.f / 64.f) + 1e-6f);
#pragma unroll
      for (int j = 0; j < 8; j++) v[j] = v[j] * rs * p.qg[e * 8 + j];
      if (lat) rope8(v, e, t, lane);
#pragma unroll
      for (int j = 0; j < 8; j++) v[j] *= 0.18033688011f;
      *(uint4*)(QN + ((size_t)(b * 8 + head) * LT + pos) * 64 + e * 8) = pack8(v);
    }
    {
      const int hh = (lane >> 3) & 3, e = lane & 7;
      uint4 raw = make_uint4(0, 0, 0, 0);
      if (lane < 32) raw = *(const uint4*)(zr + 512 + hh * 64 + e * 8);
      float v[8]; unpack8(raw, v);
      float kv[8];
      float ss = 0.f;
#pragma unroll
      for (int j = 0; j < 8; j++) ss += v[j] * v[j];
      ss += SHX(ss, 1); ss += SHX(ss, 2); ss += SHX(ss, 4);
      const float rs = rsqrtf(ss * (1.f / 64.f) + 1e-6f);
#pragma unroll
      for (int j = 0; j < 8; j++) kv[j] = v[j] * rs * p.kg[e * 8 + j];
      if (lat) rope8(kv, e, t, lane);
      if (lane < 16) {
        *(uint4*)(KN + ((size_t)(b * 2 + hh) * LT + pos) * 64 + e * 8) = pack8(kv);
      } else if (lane < 32) {
        const int kvh = hh - 2;
#pragma unroll
        for (int j = 0; j < 8; j++) VT[((size_t)(b * 2 + kvh) * 64 + e * 8 + j) * LT + pos] = f2bf(v[j]);
      }
    }
    const bool hasp = (pos != 0 && pos != LC), hasn = (pos != LC - 1 && pos != LT - 1);
    const bf16_t* zc = zr + 768;
#pragma unroll
    for (int i = 0; i < 7; i++) {
      const int j = i * 256 + lane * 4;
      uint2 cu = *(const uint2*)(zc + j);
      uint2 pu = make_uint2(0, 0), nu = make_uint2(0, 0);
      if (hasp) pu = *(const uint2*)(zc - 2560 + j);
      if (hasn) nu = *(const uint2*)(zc + 2560 + j);
      float4 m4 = *(const float4*)(p.mu + j);
      float cv[4] = {lo2f(cu.x), hi2f(cu.x), lo2f(cu.y), hi2f(cu.y)};
      float pv[4] = {lo2f(pu.x), hi2f(pu.x), lo2f(pu.y), hi2f(pu.y)};
      float nv[4] = {lo2f(nu.x), hi2f(nu.x), lo2f(nu.y), hi2f(nu.y)};
      float mm[4] = {m4.x, m4.y, m4.z, m4.w};
      float zm[4];
#pragma unroll
      for (int q = 0; q < 4; q++) zm[q] = cv[q] + mm[q] * (0.5f * (pv[q] + nv[q]) - cv[q]);
      if (i < 6) {
        const int cc = (i & 1) * 256 + lane * 4;
        const int head = cc >> 6, within = cc & 63;
        const size_t oidx = ((size_t)(b * 8 + head) * LT + pos) * 64 + within;
        uint2 o; o.x = pack2(zm[0], zm[1]); o.y = pack2(zm[2], zm[3]);
        if (i < 2) {
          *(uint2*)(R + oidx) = o;
        } else if (i < 4) {
          *(uint2*)(KB + oidx) = o;
          float4 kk4 = *(const float4*)(p.k_k + cc);
          float k0 = zm[0] * kk4.x, k1 = zm[1] * kk4.y, k2 = zm[2] * kk4.z, k3 = zm[3] * kk4.w;
          float ss = k0 * k0 + k1 * k1 + k2 * k2 + k3 * k3;
          ss += SHX(ss, 1); ss += SHX(ss, 2); ss += SHX(ss, 4); ss += SHX(ss, 8);
          const float inv = 1.f / fmaxf(sqrtf(ss), 1e-12f);
          uint2 o2; o2.x = pack2(k0 * inv, k1 * inv); o2.y = pack2(k2 * inv, k3 * inv);
          *(uint2*)(KK + oidx) = o2;
        } else {
          *(uint2*)(V + oidx) = o;
        }
      } else {
        if (lane < 16) {
          uint2 o; o.x = pack2(tanhf(zm[0]), tanhf(zm[1])); o.y = pack2(tanhf(zm[2]), tanhf(zm[3]));
          *(uint2*)(AW + (size_t)n * 64 + lane * 4) = o;
        } else if (lane < 32) {
          uint2 o; o.x = pack2(zm[0], zm[1]); o.y = pack2(zm[2], zm[3]);
          *(uint2*)(AA + (size_t)n * 64 + (lane - 16) * 4) = o;
        } else {
          uint2 o; o.x = pack2(sigmoidf_(zm[0]), sigmoidf_(zm[1])); o.y = pack2(sigmoidf_(zm[2]), sigmoidf_(zm[3]));
          *(uint2*)(AG + (size_t)n * 128 + (lane - 32) * 4) = o;
        }
      }
    }
  }
}

DI void wkv_task(const int TIDX, const P& p, int task, char* smem) {
  char* big = p.ws + OFF_BIG;
  const int d = task & 1, h = (task >> 1) & 7, b = task >> 4;
  const bf16_t* R = (const bf16_t*)(big + B_R); const bf16_t* KB = (const bf16_t*)(big + B_KB);
  const bf16_t* KK = (const bf16_t*)(big + B_KK); const bf16_t* V = (const bf16_t*)(big + B_V);
  const bf16_t* AL = (const bf16_t*)(big + B_AL) + (size_t)d * NB * 8 * LT * 64;
  const float* DEC = (const float*)(big + B_DEC) + (size_t)d * NB * 8 * LT * 64;
  const bf16_t* G = (const bf16_t*)(big + B_G);
  bf16_t* YM = (bf16_t*)(big + B_YMIX);
  float* bufs = (float*)smem;
  float* outb = bufs + 2 * 6 * 1024;
  const int tid = TIDX, lane = tid & 63;
  const int row = tid >> 3, ks = tid & 7;
  const int ls = tid >> 5, li = (tid & 31) * 2;
  const size_t hb = (size_t)(b * 8 + h) * LT;
  const float ka0 = p.k_a[h * 64 + li], ka1 = p.k_a[h * 64 + li + 1];
  float S[8];
#pragma unroll
  for (int j = 0; j < 8; j++) S[j] = 0.f;
  float pr[12];
  auto gload = [&](int chunk) {
    const int pos = scanpos(d, chunk * 16 + ls);
    const size_t e0 = (hb + pos) * 64 + li;
    unsigned r2 = *(const unsigned*)(R + e0), k2 = *(const unsigned*)(KB + e0), kk2 = *(const unsigned*)(KK + e0);
    unsigned v2 = *(const unsigned*)(V + e0), a2 = *(const unsigned*)(AL + e0);
    float2 dc = *(const float2*)(DEC + e0);
    float a_0 = lo2f(a2), a_1 = hi2f(a2);
    pr[0] = lo2f(r2); pr[1] = hi2f(r2);
    pr[2] = dc.x; pr[3] = dc.y;
    pr[4] = lo2f(k2) * (1.f + (a_0 - 1.f) * ka0); pr[5] = hi2f(k2) * (1.f + (a_1 - 1.f) * ka1);
    pr[6] = lo2f(v2); pr[7] = hi2f(v2);
    pr[8] = -lo2f(kk2); pr[9] = -hi2f(kk2);
    pr[10] = lo2f(kk2) * a_0; pr[11] = hi2f(kk2) * a_1;
  };
  auto lstore = [&](int bufi) {
    float* bb = bufs + bufi * 6 * 1024 + ls * 64 + li;
#pragma unroll
    for (int q = 0; q < 6; q++) *(float2*)(bb + q * 1024) = make_float2(pr[2 * q], pr[2 * q + 1]);
  };
  __syncthreads();
  gload(0);
  lstore(0);
  __syncthreads();
  const int nch = LT / 16;
  for (int ch = 0; ch < nch; ch++) {
    const int cur = ch & 1;
    if (ch + 1 < nch) gload(ch + 1);
    const float* bb = bufs + cur * 6 * 1024;
#pragma unroll 4
    for (int s = 0; s < 16; s++) {
      const float* q0 = bb + s * 64 + ks * 8;
      float4 kn0 = *(const float4*)(q0 + 4 * 1024), kn1 = *(const float4*)(q0 + 4 * 1024 + 4);
      float sa = S[0] * kn0.x + S[1] * kn0.y + S[2] * kn0.z + S[3] * kn0.w + S[4] * kn1.x + S[5] * kn1.y + S[6] * kn1.z +
                 S[7] * kn1.w;
      sa = reduce8(sa);
      const float vv = bb[3 * 1024 + s * 64 + row];
      float4 dc0 = *(const float4*)(q0 + 1 * 1024), dc1 = *(const float4*)(q0 + 1 * 1024 + 4);
      float4 bb0 = *(const float4*)(q0 + 5 * 1024), bb1 = *(const float4*)(q0 + 5 * 1024 + 4);
      float4 kd0 = *(const float4*)(q0 + 2 * 1024), kd1 = *(const float4*)(q0 + 2 * 1024 + 4);
      S[0] = S[0] * dc0.x + sa * bb0.x + vv * kd0.x;
      S[1] = S[1] * dc0.y + sa * bb0.y + vv * kd0.y;
      S[2] = S[2] * dc0.z + sa * bb0.z + vv * kd0.z;
      S[3] = S[3] * dc0.w + sa * bb0.w + vv * kd0.w;
      S[4] = S[4] * dc1.x + sa * bb1.x + vv * kd1.x;
      S[5] = S[5] * dc1.y + sa * bb1.y + vv * kd1.y;
      S[6] = S[6] * dc1.z + sa * bb1.z + vv * kd1.z;
      S[7] = S[7] * dc1.w + sa * bb1.w + vv * kd1.w;
      float4 r0 = *(const float4*)(q0), r1 = *(const float4*)(q0 + 4);
      float o = S[0] * r0.x + S[1] * r0.y + S[2] * r0.z + S[3] * r0.w + S[4] * r1.x + S[5] * r1.y + S[6] * r1.z + S[7] * r1.w;
      o = reduce8(o);
      if (ks == 0) outb[s * 64 + row] = o;
    }
    __syncthreads();
    {
      const int pos = scanpos(d, ch * 16 + ls);
      const int n = b * LT + pos;
      const float o0 = outb[ls * 64 + li], o1 = outb[ls * 64 + li + 1];
      float sm = o0 + o1;
#pragma unroll
      for (int off = 1; off < 32; off <<= 1) sm += SHX(sm, off);
      const float mean = sm * (1.f / 64.f);
      const float d0 = o0 - mean, d1 = o1 - mean;
      float vs = d0 * d0 + d1 * d1;
#pragma unroll
      for (int off = 1; off < 32; off <<= 1) vs += SHX(vs, off);
      const float rstd = rsqrtf(vs * (1.f / 64.f) + 64e-5f);
      const int c0 = h * 64 + li;
      float bs = bb[0 * 1024 + ls * 64 + li] * bb[2 * 1024 + ls * 64 + li] * p.r_k[c0] +
                 bb[0 * 1024 + ls * 64 + li + 1] * bb[2 * 1024 + ls * 64 + li + 1] * p.r_k[c0 + 1];
#pragma unroll
      for (int off = 1; off < 32; off <<= 1) bs += SHX(bs, off);
      const float v0 = bb[3 * 1024 + ls * 64 + li], v1 = bb[3 * 1024 + ls * 64 + li + 1];
      const unsigned g2 = *(const unsigned*)(G + (size_t)n * 512 + c0);
      const float y0 = (d0 * rstd * p.gn_w[c0] + p.gn_b[c0] + bs * v0) * lo2f(g2);
      const float y1 = (d1 * rstd * p.gn_w[c0 + 1] + p.gn_b[c0 + 1] + bs * v1) * hi2f(g2);
      *(unsigned*)(YM + (size_t)n * 1536 + 512 + d * 512 + c0) = pack2(y0, y1);
    }
    if (ch + 1 < nch) lstore(cur ^ 1);
    __syncthreads();
  }
}

DI void attn_task(const int TIDX, const P& p, int task, char* smem) {
  char* big = p.ws + OFF_BIG;
  int b, head, qt;
  if (task < 512) { qt = 1 + (task & 7); head = (task >> 3) & 7; b = task >> 6; }
  else { int t2 = task - 512; qt = 0; head = t2 & 7; b = t2 >> 3; }
  const int kvh = head >> 2;
  const int nkt = (qt == 0 ? 256 : LT) / 64;
  bf16_t* Ks = (bf16_t*)smem;
  bf16_t* Vs = Ks + 2 * 64 * 72;
  const bf16_t* Kg = (const bf16_t*)(big + B_KN) + (size_t)(b * 2 + kvh) * LT * 64;
  const bf16_t* Vg = (const bf16_t*)(big + B_VT) + (size_t)(b * 2 + kvh) * 64 * LT;
  const bf16_t* QN = (const bf16_t*)(big + B_QN);
  bf16_t* YM = (bf16_t*)(big + B_YMIX);
  const int tid = TIDX, lane = tid & 63, wave = tid >> 6;
  const int r = lane & 31, h8 = lane >> 5;
  const int q0 = qt * 256 + wave * 32;
  bf16x8 qf[4];
#pragma unroll
  for (int kk = 0; kk < 4; kk++)
    qf[kk] = *(const bf16x8*)(QN + ((size_t)(b * 8 + head) * LT + q0 + r) * 64 + kk * 16 + h8 * 8);
  f32x16 o0, o1;
#pragma unroll
  for (int q = 0; q < 16; q++) { o0[q] = 0.f; o1[q] = 0.f; }
  float m = -1e30f, l = 0.f;
  const int lr = tid >> 3, lc = tid & 7;
  uint4 kreg = *(const uint4*)(Kg + (size_t)lr * 64 + lc * 8);
  uint4 vreg = *(const uint4*)(Vg + (size_t)lr * LT + lc * 8);
  __syncthreads();
  *(uint4*)(Ks + lr * 72 + lc * 8) = kreg;
  *(uint4*)(Vs + lr * 72 + lc * 8) = vreg;
  __syncthreads();
  for (int kt = 0; kt < nkt; kt++) {
    const int cur = kt & 1;
    if (kt + 1 < nkt) {
      kreg = *(const uint4*)(Kg + (size_t)((kt + 1) * 64 + lr) * 64 + lc * 8);
      vreg = *(const uint4*)(Vg + (size_t)lr * LT + (kt + 1) * 64 + lc * 8);
    }
    const bf16_t* Kc = Ks + cur * 64 * 72;
    const bf16_t* Vc = Vs + cur * 64 * 72;
    f32x16 s0, s1;
#pragma unroll
    for (int q = 0; q < 16; q++) { s0[q] = 0.f; s1[q] = 0.f; }
#pragma unroll
    for (int kk = 0; kk < 4; kk++) {
      bf16x8 a0 = *(const bf16x8*)(Kc + r * 72 + kk * 16 + h8 * 8);
      bf16x8 a1 = *(const bf16x8*)(Kc + (32 + r) * 72 + kk * 16 + h8 * 8);
      s0 = __builtin_amdgcn_mfma_f32_32x32x16_bf16(a0, qf[kk], s0, 0, 0, 0);
      s1 = __builtin_amdgcn_mfma_f32_32x32x16_bf16(a1, qf[kk], s1, 0, 0, 0);
    }
    float mx = s0[0];
#pragma unroll
    for (int q = 1; q < 16; q++) mx = fmaxf(mx, s0[q]);
#pragma unroll
    for (int q = 0; q < 16; q++) mx = fmaxf(mx, s1[q]);
    mx = fmaxf(mx, SHX(mx, 32));
    const float mnew = fmaxf(m, mx);
    const float alpha = exp2f(m - mnew);
    float sum = 0.f;
#pragma unroll
    for (int q = 0; q < 16; q++) { s0[q] = exp2f(s0[q] - mnew); sum += s0[q]; }
#pragma unroll
    for (int q = 0; q < 16; q++) { s1[q] = exp2f(s1[q] - mnew); sum += s1[q]; }
    l = l * alpha + sum;
    m = mnew;
#pragma unroll
    for (int q = 0; q < 16; q++) { o0[q] *= alpha; o1[q] *= alpha; }
#pragma unroll
    for (int t = 0; t < 2; t++) {
#pragma unroll
      for (int s = 0; s < 2; s++) {
        union { bf16x8 v; unsigned u[4]; } pf;
#pragma unroll
        for (int q = 0; q < 4; q++) {
          float x0 = t ? s1[8 * s + 2 * q] : s0[8 * s + 2 * q];
          float x1 = t ? s1[8 * s + 2 * q + 1] : s0[8 * s + 2 * q + 1];
          pf.u[q] = pack2(x0, x1);
        }
        const int kb = 32 * t + 16 * s + 4 * h8;
        union { bf16x8 v; uint2 u[2]; } v0, v1;
        v0.u[0] = *(const uint2*)(Vc + r * 72 + kb);
        v0.u[1] = *(const uint2*)(Vc + r * 72 + kb + 8);
        v1.u[0] = *(const uint2*)(Vc + (32 + r) * 72 + kb);
        v1.u[1] = *(const uint2*)(Vc + (32 + r) * 72 + kb + 8);
        o0 = __builtin_amdgcn_mfma_f32_32x32x16_bf16(v0.v, pf.v, o0, 0, 0, 0);
        o1 = __builtin_amdgcn_mfma_f32_32x32x16_bf16(v1.v, pf.v, o1, 0, 0, 0);
      }
    }
    if (kt + 1 < nkt) {
      *(uint4*)(Ks + (cur ^ 1) * 64 * 72 + lr * 72 + lc * 8) = kreg;
      *(uint4*)(Vs + (cur ^ 1) * 64 * 72 + lr * 72 + lc * 8) = vreg;
    }
    __syncthreads();
  }
  l += SHX(l, 32);
  const float inv = 1.f / l;
  bf16_t* orow = YM + (size_t)(b * LT + q0 + r) * 1536 + head * 64;
#pragma unroll
  for (int g4 = 0; g4 < 4; g4++) {
    uint2 w0, w1;
    w0.x = pack2(o0[4 * g4] * inv, o0[4 * g4 + 1] * inv); w0.y = pack2(o0[4 * g4 + 2] * inv, o0[4 * g4 + 3] * inv);
    w1.x = pack2(o1[4 * g4] * inv, o1[4 * g4 + 1] * inv); w1.y = pack2(o1[4 * g4 + 2] * inv, o1[4 * g4 + 3] * inv);
    *(uint2*)(orow + 8 * g4 + 4 * h8) = w0;
    *(uint2*)(orow + 32 + 8 * g4 + 4 * h8) = w1;
  }
}

DI void route_task(const int TIDX, const P& p, int n0, char* smem) {
  char* big = p.ws + OFF_BIG;
  const float* S = (const float*)(big + B_S);
  int* EI = (int*)(big + B_EI);
  float* EG = (float*)(big + B_EG);
  float* sc = (float*)smem;
  float* sv = sc + 256 * 129;
  unsigned char* si = (unsigned char*)(sv + 256 * 16);
  const int tid = TIDX;
  __syncthreads();
  for (int e = tid; e < 256 * 128; e += NTHR) {
    int row = e >> 7, j = e & 127;
    sc[row * 129 + j] = S[(size_t)n0 * 2048 + e];
  }
  __syncthreads();
  if (tid < 256) {
    const float* rowp = sc + tid * 129;
    float pv = __builtin_inff();
    int pi = -1;
    for (int k = 0; k < 16; k++) {
      float bv = -__builtin_inff();
      int bi = 0;
      for (int j = 0; j < 128; j++) {
        float x = rowp[j];
        bool elig = (x < pv) || (x == pv && j > pi);
        if (elig && x > bv) { bv = x; bi = j; }
      }
      sv[tid * 16 + k] = bv;
      si[tid * 16 + k] = (unsigned char)bi;
      pv = bv; pi = bi;
    }
  }
  __syncthreads();
  if (tid < 128) {
    const int tl = tid >> 3, head = tid & 7;
    const int r0 = tl * 16 + head * 2, r1 = r0 + 1;
    const float* a = sv + r0 * 16;
    const float* bq = sv + r1 * 16;
    float* eg = sc + tid * 17;
    const int n = n0 + tl;
    float pv = __builtin_inff();
    int pc = -1;
    float mx = 0.f, sum = 0.f;
    for (int k = 0; k < 16; k++) {
      float bv = -__builtin_inff();
      int bc = 0;
      for (int i = 0; i < 16; i++) {
        const int jn = 16 / (i + 1);
        const float ai = a[i];
        for (int j = 0; j < jn; j++) {
          float x = ai + bq[j];
          int c = i * 16 + j;
          bool elig = (x < pv) || (x == pv && c > pc);
          if (elig && x > bv) { bv = x; bc = c; }
        }
      }
      if (k == 0) mx = bv;
      float ev = __expf(bv - mx);
      sum += ev;
      eg[k] = ev;
      EI[(size_t)n * 128 + head * 16 + k] = (int)si[r0 * 16 + (bc >> 4)] * 128 + (int)si[r1 * 16 + (bc & 15)];
      pv = bv; pc = bc;
    }
    const float inv = 1.f / sum;
    for (int k = 0; k < 16; k++) EG[(size_t)n * 128 + head * 16 + k] = eg[k] * inv;
  }
}


DI int f2ord(float f) { int s = __float_as_int(f); return s ^ ((s >> 31) & 0x7fffffff); }
DI float ord2f(int s) { return __int_as_float(s ^ ((s >> 31) & 0x7fffffff)); }
DI void ce_desc(int& a, int& b) { int hi = max(a, b), lo = min(a, b); a = hi; b = lo; }
template <int N>
DI void bsort_desc(int* v) {
#pragma unroll
  for (int k = 2; k <= N; k <<= 1)
#pragma unroll
    for (int j = k >> 1; j > 0; j >>= 1)
#pragma unroll
      for (int i = 0; i < N; i++) {
        const int l = i ^ j;
        if (l > i) {
          if ((i & k) == 0) ce_desc(v[i], v[l]); else ce_desc(v[l], v[i]);
        }
      }
}
DI void merge16(int* a, const int* b) {
#pragma unroll
  for (int i = 0; i < 16; i++) a[i] = max(a[i], b[15 - i]);
#pragma unroll
  for (int j = 8; j > 0; j >>= 1)
#pragma unroll
    for (int i = 0; i < 16; i++) {
      const int l = i ^ j;
      if (l > i) ce_desc(a[i], a[l]);
    }
}
DI void top16_of_64(int* v) {
  bsort_desc<16>(v); bsort_desc<16>(v + 16); bsort_desc<16>(v + 32); bsort_desc<16>(v + 48);
  merge16(v, v + 16); merge16(v + 32, v + 48); merge16(v, v + 32);
}
DI void route2_task(const int TIDX, const P& p, int layer, int m0, int head, char* smem) {
  char* big = p.ws + OFF_BIG;
  const bf16_t* QP = (const bf16_t*)(big + B_QP);
  int* EI = (int*)(big + B_EI);
  float* EG = (float*)(big + B_EG);
  bf16_t* Ks = (bf16_t*)smem;
  unsigned char* sidx = (unsigned char*)(Ks + 256 * 136);
  const bf16_t* keys = (const bf16_t*)(p.ws + OFF_KEYS) + (size_t)(layer * 16 + head * 2) * 128 * 128;
  const int tid = TIDX, lane = tid & 63, wave = tid >> 6;
  const int r = lane & 31, h8 = lane >> 5;
  __syncthreads();
  {
    const int row = tid >> 1, half = tid & 1;
#pragma unroll
    for (int q = 0; q < 8; q++)
      *(uint4*)(Ks + row * 136 + half * 64 + q * 8) = *(const uint4*)(keys + (size_t)row * 128 + half * 64 + q * 8);
  }
  __syncthreads();
  const int tok = m0 + wave * 32 + r;
  int la[16], lb[16];
#pragma unroll
  for (int pp = 0; pp < 2; pp++) {
    bf16x8 qf[8];
#pragma unroll
    for (int ks = 0; ks < 8; ks++)
      qf[ks] = *(const bf16x8*)(QP + (size_t)tok * 2048 + head * 256 + pp * 128 + ks * 16 + h8 * 8);
    int v[64];
#pragma unroll
    for (int kt = 0; kt < 4; kt++) {
      f32x16 acc;
#pragma unroll
      for (int q = 0; q < 16; q++) acc[q] = 0.f;
#pragma unroll
      for (int ks = 0; ks < 8; ks++) {
        bf16x8 a = *(const bf16x8*)(Ks + (pp * 128 + kt * 32 + r) * 136 + ks * 16 + h8 * 8);
        acc = __builtin_amdgcn_mfma_f32_32x32x16_bf16(a, qf[ks], acc, 0, 0, 0);
      }
#pragma unroll
      for (int q = 0; q < 16; q++) v[kt * 16 + q] = (f2ord(acc[q]) & ~127) | (kt * 32 + (q & 3) + 8 * (q >> 2) + 4 * h8);
    }
    top16_of_64(v);
    int pr[16];
#pragma unroll
    for (int i = 0; i < 16; i++) pr[i] = __builtin_amdgcn_ds_bpermute((lane ^ 32) << 2, v[i]);
    merge16(v, pr);
#pragma unroll
    for (int i = 0; i < 16; i++) { if (pp == 0) la[i] = v[i]; else lb[i] = v[i]; }
  }
  {
    unsigned* sw = (unsigned*)(sidx + tid * 32);
#pragma unroll
    for (int i = 0; i < 4; i++) {
      sw[i] = (la[4 * i] & 127) | ((la[4 * i + 1] & 127) << 8) | ((la[4 * i + 2] & 127) << 16) | ((la[4 * i + 3] & 127) << 24);
      sw[4 + i] = (lb[4 * i] & 127) | ((lb[4 * i + 1] & 127) << 8) | ((lb[4 * i + 2] & 127) << 16) | ((lb[4 * i + 3] & 127) << 24);
    }
  }
  float fa[16], fb[16];
#pragma unroll
  for (int i = 0; i < 16; i++) { fa[i] = ord2f(la[i]); fb[i] = ord2f(lb[i]); }
  int c[64];
  {
    int cnt = 0;
#pragma unroll
    for (int i = 0; i < 16; i++)
#pragma unroll
      for (int j = 0; j < 16; j++)
        if ((i + 1) * (j + 1) <= 16) { c[cnt] = (f2ord(fa[i] + fb[j]) & ~255) | (i * 16 + j); cnt++; }
#pragma unroll
    for (int q = 50; q < 64; q++) c[q] = (int)0x80000000;
  }
  top16_of_64(c);
  const float mx = ord2f(c[0]);
  float ev[16], sum = 0.f;
#pragma unroll
  for (int k = 0; k < 16; k++) { ev[k] = __expf(ord2f(c[k]) - mx); sum += ev[k]; }
  const float inv = 1.f / sum;
  const size_t ob = (size_t)tok * 128 + head * 16;
#pragma unroll
  for (int k = 0; k < 16; k++) {
    const int code = c[k] & 255;
    const int ia = sidx[tid * 32 + (code >> 4)], ib = sidx[tid * 32 + 16 + (code & 15)];
    if (h8 == 0) EI[ob + k] = ia * 128 + ib; else EG[ob + k] = ev[k] * inv;
  }
}

DI void peer_gather(const int TIDX, const P& p, int layer, bool last, int bid, int nb, const bool dry) {
  char* big = p.ws + OFF_BIG;
  const int* EI = (const int*)(big + B_EI);
  const float* EG = (const float*)(big + B_EG);
  const unsigned char* UB = (const unsigned char*)(p.ws + OFF_UB);
  const unsigned char* VB = (const unsigned char*)(p.ws + OFF_VB);
  const float* US = (const float*)(p.ws + OFF_UB + 16777216);
  const float* VS = (const float*)(p.ws + OFF_VB + 16777216);
  const bf16_t* H = (const bf16_t*)(p.ws + OFF_H);
  const float* X = (const float*)(p.ws + OFF_X);
  bf16_t* Hw = dry ? (bf16_t*)(big + B_QP) : (bf16_t*)(p.ws + OFF_H);
  float* Xw = dry ? (float*)(big + B_S) : (float*)(p.ws + OFF_X);
  const float* mod = (const float*)(p.ws + OFF_MOD);
  const int lane = TIDX & 63, wave = TIDX >> 6;
  for (int n = bid * 8 + wave; n < NTOK; n += nb * 8) {
    const int b = n / LT, pos = n - b * LT;
    if (last && pos < LC) continue;
    float hv[16];
    {
      uint4 h0 = *(const uint4*)(H + (size_t)n * DM + lane * 16);
      uint4 h1 = *(const uint4*)(H + (size_t)n * DM + lane * 16 + 8);
      unpack8(h0, hv); unpack8(h1, hv + 8);
    }
    const int id_lo = EI[(size_t)n * 128 + lane], id_hi = EI[(size_t)n * 128 + 64 + lane];
    const float g_lo = EG[(size_t)n * 128 + lane], g_hi = EG[(size_t)n * 128 + 64 + lane];
    const float us_lo = US[id_lo], us_hi = US[id_hi], vs_lo = VS[id_lo], vs_hi = VS[id_hi];
    float act_lo = 0.f, act_hi = 0.f;
#pragma unroll 1
    for (int half = 0; half < 2; half++) {
      const int idv = half ? id_hi : id_lo;
      float actv = 0.f;
#pragma unroll 8
      for (int e = 0; e < 64; e++) {
        const int id = __builtin_amdgcn_readlane(idv, e);
        const uint4 w = *(const uint4*)(UB + (size_t)id * 1024 + lane * 16);
        float uv[16];
        cvt16_fp8(w, uv);
        float d0 = 0.f, d1 = 0.f;
#pragma unroll
        for (int j = 0; j < 8; j++) { d0 += hv[j] * uv[j]; d1 += hv[8 + j] * uv[8 + j]; }
        const float dsum = wave_sum_dpp(d0 + d1, lane);
        if (lane == e) actv = dsum;
      }
      if (half) act_hi = actv; else act_lo = actv;
    }
    act_lo *= us_lo; act_hi *= us_hi;
    const float cf_lo = g_lo * 0.5f * act_lo * (1.f + erff(act_lo * 0.70710678f)) * vs_lo;
    const float cf_hi = g_hi * 0.5f * act_hi * (1.f + erff(act_hi * 0.70710678f)) * vs_hi;
    float acc[16];
#pragma unroll
    for (int j = 0; j < 16; j++) acc[j] = 0.f;
#pragma unroll 1
    for (int half = 0; half < 2; half++) {
      const int idv = half ? id_hi : id_lo;
      const float cfv = half ? cf_hi : cf_lo;
#pragma unroll 8
      for (int e = 0; e < 64; e++) {
        const int id = __builtin_amdgcn_readlane(idv, e);
        const float cf = __builtin_bit_cast(float, __builtin_amdgcn_readlane(__builtin_bit_cast(int, cfv), e));
        const uint4 w = *(const uint4*)(VB + (size_t)id * 1024 + lane * 16);
        float uv[16];
        cvt16_fp8(w, uv);
#pragma unroll
        for (int j = 0; j < 16; j++) acc[j] += cf * uv[j];
      }
    }
    const int rr = pos < LC ? 8 : b;
    const float* gate = mod + (size_t)(layer * 9 + rr) * 6144 + 5 * 1024 + lane * 16;
    const float* xr = X + (size_t)n * DM + lane * 16;
    float xo[16];
#pragma unroll
    for (int q = 0; q < 4; q++) {
      float4 x0 = *(const float4*)(xr + q * 4), g0 = *(const float4*)(gate + q * 4);
      xo[q * 4 + 0] = x0.x + g0.x * acc[q * 4 + 0]; xo[q * 4 + 1] = x0.y + g0.y * acc[q * 4 + 1];
      xo[q * 4 + 2] = x0.z + g0.z * acc[q * 4 + 2]; xo[q * 4 + 3] = x0.w + g0.w * acc[q * 4 + 3];
    }
    if (last) {
      float* orow = p.out + ((size_t)(b * SEQ + pos - LC)) * DM + lane * 16;
#pragma unroll
      for (int q = 0; q < 4; q++) *(float4*)(orow + q * 4) = make_float4(xo[q * 4], xo[q * 4 + 1], xo[q * 4 + 2], xo[q * 4 + 3]);
    } else {
      float ss = 0.f;
#pragma unroll
      for (int j = 0; j < 16; j++) ss += xo[j] * xo[j];
      ss = wave_sum(ss);
      const float rs = rsqrtf(ss * (1.f / 1024.f) + 1e-6f);
      const float* g = p.n1g + (layer + 1) * 1024 + lane * 16;
      const float* msc = mod + (size_t)((layer + 1) * 9 + rr) * 6144 + 1 * 1024 + lane * 16;
      const float* msh = mod + (size_t)((layer + 1) * 9 + rr) * 6144 + lane * 16;
      float* xw = Xw + (size_t)n * DM + lane * 16;
#pragma unroll
      for (int q = 0; q < 4; q++) *(float4*)(xw + q * 4) = make_float4(xo[q * 4], xo[q * 4 + 1], xo[q * 4 + 2], xo[q * 4 + 3]);
      float y[16];
#pragma unroll
      for (int j = 0; j < 16; j++) y[j] = xo[j] * rs * g[j] * (1.f + msc[j]) + msh[j];
      *(uint4*)(Hw + (size_t)n * DM + lane * 16) = pack8(y);
      *(uint4*)(Hw + (size_t)n * DM + lane * 16 + 8) = pack8(y + 8);
    }
  }
}

DI void conv_phase(const int TIDX, const P& p, int bid, int nb) {
  char* big = p.ws + OFF_BIG;
  const bf16_t* ZX = (const bf16_t*)(big + B_ZX);
  bf16_t* XBC = (bf16_t*)(big + B_XBC);
  const int total = NTOK * 384;
  for (int it = bid * NTHR + TIDX; it < total; it += nb * NTHR) {
    const int n = it / 384, c8 = (it - n * 384) * 8;
    const int b = n / LT, pos = n - b * LT;
    const bool hasp = (pos != 0 && pos != LC), hasn = (pos != LC - 1 && pos != LT - 1);
    const bf16_t* zc = ZX + (size_t)n * 3072 + c8;
    uint4 cu = *(const uint4*)zc, pu = make_uint4(0, 0, 0, 0), nu = make_uint4(0, 0, 0, 0);
    if (hasp) pu = *(const uint4*)(zc - 3072);
    if (hasn) nu = *(const uint4*)(zc + 3072);
    float cv[8], pv[8], nv[8], y[8];
    unpack8(cu, cv); unpack8(pu, pv); unpack8(nu, nv);
#pragma unroll
    for (int j = 0; j < 8; j++) {
      float a = p.conv_b[c8 + j] + p.conv_w[c8 + j] * pv[j] + p.conv_w[3072 + c8 + j] * cv[j] + p.conv_w[6144 + c8 + j] * nv[j];
      y[j] = siluf_(a);
    }
    *(uint4*)(XBC + (size_t)n * 3072 + c8) = pack8(y);
  }
}

DI void ssd_task(const int TIDX, const P& p, int task, char* smem) {
  char* big = p.ws + OFF_BIG;
  const int b = task >> 5, h = task & 31, g = h >> 3;
  bf16_t* Cs = (bf16_t*)smem;
  bf16_t* Bs = Cs + 128 * 136;
  bf16_t* BT = Bs + 128 * 136;
  bf16_t* xT = BT + 128 * 136;
  bf16_t* sb = xT + 64 * 136;
  float* cum = (float*)(sb + 64 * 136);
  float* dtv = cum + 128;
  const bf16_t* XBC = (const bf16_t*)(big + B_XBC);
  const float* DT = (const float*)(big + B_DT);
  bf16_t* Y = (bf16_t*)(big + B_Y);
  const int tid = TIDX, lane = tid & 63, wave = tid >> 6;
  const int r = lane & 31, h8 = lane >> 5;
  const float dskip = p.ssd_d[h];
  for (int d = 0; d < 2; d++) {
    const float a = -expf(p.a_log[d * 32 + h]);
    const float bias = p.dt_bias[d * 32 + h];
    f32x16 sacc;
#pragma unroll
    for (int q = 0; q < 16; q++) sacc[q] = 0.f;
    __syncthreads();
    for (int e = tid; e < 64 * 136; e += NTHR) sb[e] = 0;
    for (int c = 0; c < 18; c++) {
      __syncthreads();
      if (wave == 0) {
        const int i0 = lane * 2, i1 = i0 + 1;
        const int p0 = scanpos(d, c * 128 + i0), p1 = scanpos(d, c * 128 + i1);
        const float dt0 = softplusf_(DT[(size_t)(b * LT + p0) * 64 + d * 32 + h] + bias);
        const float dt1 = softplusf_(DT[(size_t)(b * LT + p1) * 64 + d * 32 + h] + bias);
        const float a0 = a * dt0, a1 = a0 + a * dt1;
        float tot = a1;
#pragma unroll
        for (int off = 1; off < 64; off <<= 1) {
          float t = shup_(tot, off, lane);
          if (lane >= off) tot += t;
        }
        const float excl = tot - a1;
        cum[i0] = excl + a0; cum[i1] = excl + a1;
        dtv[i0] = dt0; dtv[i1] = dt1;
      }
      __syncthreads();
      const float cl = cum[127];
      {
        const int j = tid >> 2, part = tid & 3;
        const int pos = scanpos(d, c * 128 + j);
        const bf16_t* rowp = XBC + (size_t)(b * LT + pos) * 3072;
        const float wj = __expf(cl - cum[j]) * dtv[j];
#pragma unroll
        for (int q = 0; q < 4; q++) {
          const int col = part * 32 + q * 8;
          uint4 cvv = *(const uint4*)(rowp + 2560 + g * 128 + col);
          *(uint4*)(Cs + j * 136 + col) = cvv;
          uint4 bvv = *(const uint4*)(rowp + 2048 + g * 128 + col);
          *(uint4*)(Bs + j * 136 + col) = bvv;
          float bf[8]; unpack8(bvv, bf);
#pragma unroll
          for (int e = 0; e < 8; e++) BT[(col + e) * 136 + j] = f2bf(bf[e] * wj);
        }
#pragma unroll
        for (int q = 0; q < 2; q++) {
          const int col = part * 16 + q * 8;
          uint4 xv = *(const uint4*)(rowp + h * 64 + col);
          const bf16_t* xe = (const bf16_t*)&xv;
#pragma unroll
          for (int e = 0; e < 8; e++) xT[(col + e) * 136 + j] = xe[e];
        }
      }
      __syncthreads();
      const int it = wave >> 1;
      f32x16 G0, G1;
#pragma unroll
      for (int q = 0; q < 16; q++) { G0[q] = 0.f; G1[q] = 0.f; }
      {
        const int jt0 = (wave & 1) * 2, jt1 = jt0 + 1;
        if (jt0 <= it) {
#pragma unroll
          for (int ks = 0; ks < 8; ks++) {
            bf16x8 av = *(const bf16x8*)(Cs + (it * 32 + r) * 136 + ks * 16 + h8 * 8);
            bf16x8 b0 = *(const bf16x8*)(Bs + (jt0 * 32 + r) * 136 + ks * 16 + h8 * 8);
            G0 = __builtin_amdgcn_mfma_f32_32x32x16_bf16(av, b0, G0, 0, 0, 0);
            if (jt1 <= it) {
              bf16x8 b1 = *(const bf16x8*)(Bs + (jt1 * 32 + r) * 136 + ks * 16 + h8 * 8);
              G1 = __builtin_amdgcn_mfma_f32_32x32x16_bf16(av, b1, G1, 0, 0, 0);
            }
          }
        }
      }
      __syncthreads();
      {
        bf16_t* Ms = Bs;
        const int jt0 = (wave & 1) * 2;
        const int j0 = jt0 * 32 + r, j1 = j0 + 32;
        const float cj0 = cum[j0], cj1 = cum[j1], dj0 = dtv[j0], dj1 = dtv[j1];
#pragma unroll
        for (int q = 0; q < 16; q++) {
          const int i = it * 32 + (q & 3) + 8 * (q >> 2) + 4 * h8;
          const float ci = cum[i];
          float m0 = (j0 <= i) ? G0[q] * __expf(ci - cj0) * dj0 : 0.f;
          float m1 = (j1 <= i) ? G1[q] * __expf(ci - cj1) * dj1 : 0.f;
          Ms[i * 136 + j0] = f2bf(m0);
          Ms[i * 136 + j1] = f2bf(m1);
        }
      }
      __syncthreads();
      {
        const bf16_t* Ms = Bs;
        const int pt = wave & 1;
        f32x16 yd, yo;
#pragma unroll
        for (int q = 0; q < 16; q++) { yd[q] = 0.f; yo[q] = 0.f; }
#pragma unroll
        for (int ks = 0; ks < 8; ks++) {
          if (ks < (it + 1) * 2) {
            bf16x8 av = *(const bf16x8*)(Ms + (it * 32 + r) * 136 + ks * 16 + h8 * 8);
            bf16x8 bv = *(const bf16x8*)(xT + (pt * 32 + r) * 136 + ks * 16 + h8 * 8);
            yd = __builtin_amdgcn_mfma_f32_32x32x16_bf16(av, bv, yd, 0, 0, 0);
          }
          bf16x8 cv = *(const bf16x8*)(Cs + (it * 32 + r) * 136 + ks * 16 + h8 * 8);
          bf16x8 sv = *(const bf16x8*)(sb + (pt * 32 + r) * 136 + ks * 16 + h8 * 8);
          yo = __builtin_amdgcn_mfma_f32_32x32x16_bf16(cv, sv, yo, 0, 0, 0);
        }
        if (c >= 2) {
          const int pp = pt * 32 + r;
#pragma unroll
          for (int q = 0; q < 16; q++) {
            const int i = it * 32 + (q & 3) + 8 * (q >> 2) + 4 * h8;
            float y = yd[q] + __expf(cum[i]) * yo[q];
            const int pos = scanpos(d, c * 128 + i);
            const size_t idx = (size_t)(b * LT + pos) * 2048 + h * 64 + pp;
            if (d == 0) y += dskip * bf2f(xT[pp * 136 + i]);
            else y += bf2f(Y[idx]);
            Y[idx] = f2bf(y);
          }
        }
      }
      __syncthreads();
      {
        const int pt = wave & 1, nt = wave >> 1;
        const float ecl = __expf(cl);
#pragma unroll
        for (int q = 0; q < 16; q++) sacc[q] *= ecl;
#pragma unroll
        for (int ks = 0; ks < 8; ks++) {
          bf16x8 av = *(const bf16x8*)(xT + (pt * 32 + r) * 136 + ks * 16 + h8 * 8);
          bf16x8 bv = *(const bf16x8*)(BT + (nt * 32 + r) * 136 + ks * 16 + h8 * 8);
          sacc = __builtin_amdgcn_mfma_f32_32x32x16_bf16(av, bv, sacc, 0, 0, 0);
        }
#pragma unroll
        for (int q = 0; q < 16; q++) {
          const int pp = pt * 32 + (q & 3) + 8 * (q >> 2) + 4 * h8;
          sb[pp * 136 + nt * 32 + r] = f2bf(sacc[q]);
        }
      }
    }
  }
}

DI void gate_norm(const int TIDX, const P& p, int bid, int nb) {
  char* big = p.ws + OFF_BIG;
  const bf16_t* Y = (const bf16_t*)(big + B_Y);
  const bf16_t* ZG = (const bf16_t*)(big + B_ZG);
  bf16_t* YN = (bf16_t*)(big + B_YN);
  const int lane = TIDX & 63, wave = TIDX >> 6;
  for (int n = bid * 8 + wave; n < NTOK; n += nb * 8) {
    const int b = n / LT, pos = n - b * LT;
    if (pos < LC) continue;
#pragma unroll
    for (int gq = 0; gq < 4; gq++) {
      const int base = gq * 512 + lane * 8;
      uint4 yv = *(const uint4*)(Y + (size_t)n * 2048 + base);
      uint4 zv = *(const uint4*)(ZG + (size_t)n * 2048 + base);
      float y[8], z[8];
      unpack8(yv, y); unpack8(zv, z);
      float ss = 0.f;
#pragma unroll
      for (int j = 0; j < 8; j++) { y[j] = y[j] * siluf_(z[j]); ss += y[j] * y[j]; }
      ss = wave_sum(ss);
      const float rs = rsqrtf(ss * (1.f / 512.f) + 1e-6f);
#pragma unroll
      for (int j = 0; j < 8; j++) y[j] = y[j] * rs * p.ssd_nw[base + j];
      *(uint4*)(YN + (size_t)n * 2048 + base) = pack8(y);
    }
  }
}

DI void run_phase(const int TIDX, const P& p, int ph, int bid, int nb, char* smem, const bool dry = false) {
  char* ws = p.ws;
  char* big = ws + OFF_BIG;
  float* X = (float*)(ws + OFF_X);
  const float* mod = (const float*)(ws + OFF_MOD);
  bf16_t* H = (bf16_t*)(ws + OFF_H);
  switch (ph) {
    case 0: {
      mod_gemv(TIDX, p, bid, nb, smem);
      tconv(TIDX, p.ev_w_in, 2560, 1024, 2560, (bf16_t*)(ws + OFF_WIN0), 1024, 0, bid, nb, smem);
      tconv(TIDX, p.ev_w_out, 1024, 1024, 1024, (bf16_t*)(ws + OFF_WOUT0), 1536, 0, bid, nb, smem);
      tconv(TIDX, p.ev_w_out + 512 * 1024, 1024, 512, 1024, (bf16_t*)(ws + OFF_WOUT0), 1536, 1024, bid, nb, smem);
      tconv(TIDX, p.ssd_w_in, 5184, 1024, 5184, (bf16_t*)(ws + OFF_WIN1), 1024, 0, bid, nb, smem);
      tconv(TIDX, p.ssd_w_out, 1024, 2048, 1024, (bf16_t*)(ws + OFF_WOUT1), 2048, 0, bid, nb, smem);
      tconv(TIDX, p.pwq, 2048, 1024, 2048, (bf16_t*)(ws + OFF_WQ), 1024, 0, bid, nb, smem);
      tconv(TIDX, p.pwq + 1024 * 2048, 2048, 1024, 2048, (bf16_t*)(ws + OFF_WQ) + 2048 * 1024, 1024, 0, bid, nb, smem);
      tconv(TIDX, p.w2, 512, 64, 512, (bf16_t*)(ws + OFF_W2C), 64, 0, bid, nb, smem);
      tconv(TIDX, p.w2 + 64 * 512, 512, 64, 512, (bf16_t*)(ws + OFF_W2C) + 512 * 64, 64, 0, bid, nb, smem);
      tconv(TIDX, p.a2, 512, 64, 512, (bf16_t*)(ws + OFF_A2C), 64, 0, bid, nb, smem);
      tconv(TIDX, p.a2 + 64 * 512, 512, 64, 512, (bf16_t*)(ws + OFF_A2C) + 512 * 64, 64, 0, bid, nb, smem);
      tconv(TIDX, p.g2, 512, 128, 512, (bf16_t*)(ws + OFF_G2T), 128, 0, bid, nb, smem);
      conv_flat(TIDX, p.pkeys, (bf16_t*)(ws + OFF_KEYS), (size_t)2 * 16 * 128 * 128, bid, nb);
      conv_fp8(TIDX, p.pu, (unsigned char*)(ws + OFF_UB), (float*)(ws + OFF_UB + 16777216), bid, nb);
      conv_fp8(TIDX, p.pv, (unsigned char*)(ws + OFF_VB), (float*)(ws + OFF_VB + 16777216), bid, nb);
    } break;
    case 1: norm_rows(TIDX, p, 0, 0, true, false, bid, nb); break;
    case 2: {
      bf16_t* Z = (bf16_t*)(big + B_Z0);
      auto epi = [=](int m, int n, float v) { Z[(size_t)m * 2560 + n] = f2bf(v); };
      for (int t = bid; t < 72 * 20; t += nb) {
        int mt = t / 20, nt = t % 20;
        gemm_tile(TIDX, H, 1024, (const bf16_t*)(ws + OFF_WIN0), 1024, 1024, mt * 256, nt * 128, epi, smem);
      }
    } break;
    case 3: prep0(TIDX, p, bid, nb); break;
    case 4: {
      float* DEC = (float*)(big + B_DEC);
      bf16_t* AL = (bf16_t*)(big + B_AL);
      bf16_t* G = (bf16_t*)(big + B_G);
      const float* w0 = p.w0; const float* a0 = p.a0;
      auto epi1 = [=](int m, int n, float v) {
        int d = n >> 9, c = n & 511, hh = c >> 6, i = c & 63;
        int b = m / LT, pos = m - b * LT;
        float x = w0[n] + v;
        float w = -softplusf_(-x) - 0.5f;
        DEC[(size_t)d * (NB * 8 * LT * 64) + ((size_t)(b * 8 + hh) * LT + pos) * 64 + i] = expf(-expf(w));
      };
      auto epi2 = [=](int m, int n, float v) {
        int d = n >> 9, c = n & 511, hh = c >> 6, i = c & 63;
        int b = m / LT, pos = m - b * LT;
        AL[(size_t)d * (NB * 8 * LT * 64) + ((size_t)(b * 8 + hh) * LT + pos) * 64 + i] = f2bf(sigmoidf_(a0[n] + v));
      };
      auto epi3 = [=](int m, int n, float v) { G[(size_t)m * 512 + n] = f2bf(v); };
      for (int t = bid; t < 1440; t += nb) {
        if (t < 576) {
          gemm_tile(TIDX, (const bf16_t*)(big + B_AW), 64, (const bf16_t*)(ws + OFF_W2C), 64, 64, (t >> 3) * 256, (t & 7) * 128, epi1, smem);
        } else if (t < 1152) {
          int t2 = t - 576;
          gemm_tile(TIDX, (const bf16_t*)(big + B_AA), 64, (const bf16_t*)(ws + OFF_A2C), 64, 64, (t2 >> 3) * 256, (t2 & 7) * 128, epi2, smem);
        } else {
          int t2 = t - 1152;
          gemm_tile(TIDX, (const bf16_t*)(big + B_AG), 128, (const bf16_t*)(ws + OFF_G2T), 128, 128, (t2 >> 2) * 256, (t2 & 3) * 128, epi3, smem);
        }
      }
    } break;
    case 5: {
      if (nb >= 256) {
        if (bid < 128) wkv_task(TIDX, p, bid, smem);
        else for (int t = bid - 128; t < 576; t += nb - 128) attn_task(TIDX, p, t, smem);
      } else {
        for (int t = bid; t < 128; t += nb) wkv_task(TIDX, p, t, smem);
        for (int t = bid; t < 576; t += nb) attn_task(TIDX, p, t, smem);
      }
    } break;
    case 6: {
      const float* gate = mod;
      const float* xc_ = p.ctx; const float* xl_ = p.x;
      auto epi = [=](int m, int n, float v) {
        int b = m / LT, pos = m - b * LT;
        int rr = pos < LC ? 8 : b;
        const float* xr = pos < LC ? xc_ + ((size_t)(b * LC + pos)) * DM : xl_ + ((size_t)(b * SEQ + pos - LC)) * DM;
        X[(size_t)m * DM + n] = xr[n] + gate[(size_t)rr * 6144 + 2 * 1024 + n] * v;
      };
      for (int t = bid; t < 72 * 8; t += nb)
        gemm_tile(TIDX, (const bf16_t*)(big + B_YMIX), 1536, (const bf16_t*)(ws + OFF_WOUT0), 1536, 1536, (t >> 3) * 256, (t & 7) * 128, epi, smem);
    } break;
    case 7: norm_rows(TIDX, p, 0, 1, false, false, bid, nb); break;
    case 8: {
      bf16_t* QP = (bf16_t*)(big + B_QP);
      auto epi = [=](int m, int n, float v) { QP[(size_t)m * 2048 + n] = f2bf(v); };
      for (int t = bid; t < 72 * 16; t += nb)
        gemm_tile(TIDX, H, 1024, (const bf16_t*)(ws + OFF_WQ), 1024, 1024, (t >> 4) * 256, (t & 15) * 128, epi, smem);
    } break;
    case 9: break;
    case 10:
      for (int t = bid; t < 72 * 8; t += nb) route2_task(TIDX, p, 0, (t >> 3) * 256, t & 7, smem);
      break;
    case 11: peer_gather(TIDX, p, 0, false, bid, nb, dry); break;
    case 12: {
      bf16_t* ZG = (bf16_t*)(big + B_ZG);
      bf16_t* ZX = (bf16_t*)(big + B_ZX);
      float* DT = (float*)(big + B_DT);
      auto epi = [=](int m, int n, float v) {
        if (n < 2048) ZG[(size_t)m * 2048 + n] = f2bf(v);
        else if (n < 5120) ZX[(size_t)m * 3072 + n - 2048] = f2bf(v);
        else if (n < 5184) DT[(size_t)m * 64 + n - 5120] = v;
      };
      for (int t = bid; t < 72 * 41; t += nb) {
        int mt = t / 41, nt = t % 41;
        gemm_tile(TIDX, H, 1024, (const bf16_t*)(ws + OFF_WIN1), 1024, 1024, mt * 256, nt * 128, epi, smem);
      }
    } break;
    case 13: {
      conv_phase(TIDX, p, bid, nb);
      conv_fp8(TIDX, p.pu + (size_t)16384 * 1024, (unsigned char*)(ws + OFF_UB), (float*)(ws + OFF_UB + 16777216), bid, nb);
      conv_fp8(TIDX, p.pv + (size_t)16384 * 1024, (unsigned char*)(ws + OFF_VB), (float*)(ws + OFF_VB + 16777216), bid, nb);
    } break;
    case 14:
      for (int t = bid; t < 256; t += nb) ssd_task(TIDX, p, t, smem);
      break;
    case 15: gate_norm(TIDX, p, bid, nb); break;
    case 16: {
      const float* gate = mod + (size_t)9 * 6144;
      auto epi = [=](int m, int n, float v) {
        int b = m / LT;
        X[(size_t)m * DM + n] += gate[(size_t)b * 6144 + 2 * 1024 + n] * v;
      };
      for (int t = bid; t < 64 * 8; t += nb) {
        int mtl = t >> 3, b = mtl >> 3, mt = b * 9 + 1 + (mtl & 7);
        gemm_tile(TIDX, (const bf16_t*)(big + B_YN), 2048, (const bf16_t*)(ws + OFF_WOUT1), 2048, 2048, mt * 256, (t & 7) * 128, epi, smem);
      }
    } break;
    case 17: norm_rows(TIDX, p, 1, 1, false, true, bid, nb); break;
    case 18: {
      bf16_t* QP = (bf16_t*)(big + B_QP);
      auto epi = [=](int m, int n, float v) { QP[(size_t)m * 2048 + n] = f2bf(v); };
      for (int t = bid; t < 64 * 16; t += nb) {
        int mtl = t >> 4, b = mtl >> 3, mt = b * 9 + 1 + (mtl & 7);
        gemm_tile(TIDX, H, 1024, (const bf16_t*)(ws + OFF_WQ) + 2048 * 1024, 1024, 1024, mt * 256, (t & 15) * 128, epi, smem);
      }
    } break;
    case 19: break;
    case 20:
      for (int t = bid; t < 64 * 8; t += nb) {
        int mtl = t >> 3, b = mtl >> 3, mt = b * 9 + 1 + (mtl & 7);
        route2_task(TIDX, p, 1, mt * 256, t & 7, smem);
      }
      break;
    case 21: peer_gather(TIDX, p, 1, true, bid, nb, false); break;
  }
}
constexpr int NPHASE = 22;
#ifndef DUP_MASK
#define DUP_MASK 0u
#endif

__global__ void __launch_bounds__(NTHR) mega(P p) {
  __shared__ __attribute__((aligned(16))) char smem[SMEM_BYTES];
  cg::grid_group grid = cg::this_grid();
#define PHC(i, last)                                             \
  {                                                              \
    P q = p;                                                     \
    int bid = blockIdx.x, nb = gridDim.x;                        \
    char* sm = smem;                                             \
    int TIDX = __builtin_amdgcn_workitem_id_x();                 \
    asm volatile("" : "+s"(q.ws), "+s"(bid), "+s"(nb), "+v"(TIDX)); \
    if ((DUP_MASK >> i) & 1) { run_phase(TIDX, q, i, bid, nb, sm, true); grid.sync(); } \
    run_phase(TIDX, q, i, bid, nb, sm);                          \
    if (!last) grid.sync();                                      \
  }
  PHC(0, 0) PHC(1, 0) PHC(2, 0) PHC(3, 0) PHC(4, 0) PHC(5, 0) PHC(6, 0) PHC(7, 0) PHC(8, 0) PHC(10, 0)
  PHC(11, 0) PHC(12, 0) PHC(13, 0) PHC(14, 0) PHC(15, 0) PHC(16, 0) PHC(17, 0) PHC(18, 0) PHC(20, 0) PHC(21, 1)
}

extern "C" void kernel_launch(void* const* d_in, const int* in_sizes, int n_in, void* d_out, int out_size, void* d_ws,
                              size_t ws_size, hipStream_t stream) {
  static int grid_blocks = 0;
  if (!grid_blocks) {
    int dev = 0, cus = 0, per_cu = 0;
    hipGetDevice(&dev);
    hipDeviceGetAttribute(&cus, hipDeviceAttributeMultiprocessorCount, dev);
    hipOccupancyMaxActiveBlocksPerMultiprocessor(&per_cu, mega, NTHR, 0);
    if (per_cu < 1) per_cu = 1;
    grid_blocks = cus * per_cu;
  }
  P p;
  memset(&p, 0, sizeof(p));
  const float** fp = (const float**)&p;
  for (int i = 0; i < 35; i++) fp[i] = (const float*)d_in[i];
  p.out = (float*)d_out;
  p.ws = (char*)d_ws;
  if (ws_size < WS_NEED) fprintf(stderr, "workspace too small: %zu < %zu\n", ws_size, (size_t)WS_NEED);
  void* args[] = {&p};
  hipError_t e = hipLaunchCooperativeKernel((void*)mega, dim3(grid_blocks), dim3(NTHR), args, 0, stream);
  if (e != hipSuccess) fprintf(stderr, "cooperative launch failed: %s (grid %d)\n", hipGetErrorString(e), grid_blocks);
}
```

```cpp
#include <hip/hip_runtime.h>
#include <hip/hip_cooperative_groups.h>
#include <stdint.h>
#include <string.h>
#include <stdio.h>
namespace cg = cooperative_groups;

#define DI __device__ __forceinline__
typedef unsigned short bf16_t;
typedef short bf16x8 __attribute__((ext_vector_type(8)));
typedef float f32x16 __attribute__((ext_vector_type(16)));

constexpr int NB = 8, SEQ = 2048, LC = 256, LT = 2304, NTOK = 18432, DM = 1024;
constexpr int NTHR = 512;

constexpr size_t OFF_UB = 0;
constexpr size_t OFF_VB = OFF_UB + 33554432;
constexpr size_t OFF_WIN0 = OFF_VB + 33554432;
constexpr size_t OFF_WOUT0 = OFF_WIN0 + 5242880;
constexpr size_t OFF_WIN1 = OFF_WOUT0 + 3145728;
constexpr size_t OFF_WOUT1 = OFF_WIN1 + 10747904;
constexpr size_t OFF_WQ = OFF_WOUT1 + 4194304;
constexpr size_t OFF_KEYS = OFF_WQ + 8388608;
constexpr size_t OFF_W2C = OFF_KEYS + 1048576;
constexpr size_t OFF_A2C = OFF_W2C + 131072;
constexpr size_t OFF_G2T = OFF_A2C + 131072;
constexpr size_t OFF_MOD = OFF_G2T + 131072;
constexpr size_t OFF_X = OFF_MOD + 442368;
constexpr size_t OFF_H = OFF_X + 75497472;
constexpr size_t OFF_BIG = OFF_H + 37748736;
constexpr size_t B_Z0 = 0;
constexpr size_t B_DEC = 0;
constexpr size_t B_G = 75497472;
constexpr size_t B_QN = 94371840;
constexpr size_t B_KN = B_QN + 18874368;
constexpr size_t B_VT = B_KN + 4718592;
constexpr size_t B_R = B_VT + 4718592;
constexpr size_t B_KB = B_R + 18874368;
constexpr size_t B_KK = B_KB + 18874368;
constexpr size_t B_V = B_KK + 18874368;
constexpr size_t B_AL = B_V + 18874368;
constexpr size_t B_AW = B_AL + 37748736;
constexpr size_t B_AA = B_AW + 2359296;
constexpr size_t B_AG = B_AA + 2359296;
constexpr size_t B_YMIX = B_AW;
constexpr size_t B_OUT = B_YMIX + 37748736;
constexpr size_t B_L0END = B_OUT + 37748736;
constexpr size_t OFF_BON = OFF_UB + 16777216 + 1048576;
constexpr size_t B_QP = 0;
constexpr size_t B_S = 75497472;
constexpr size_t B_EI = B_S + 150994944;
constexpr size_t B_EG = B_EI + 9437184;
constexpr size_t B_PEND = B_EG + 9437184;
constexpr size_t B_ZG = 0;
constexpr size_t B_ZX = 75497472;
constexpr size_t B_Y = B_ZX;
constexpr size_t B_DT = B_ZX + 113246208;
constexpr size_t B_XBC = B_DT + 4718592;
constexpr size_t B_YN = B_XBC;
constexpr size_t B_L1END = B_XBC + 113246208;
constexpr size_t BIG_SZ = B_L1END > B_L0END ? (B_L1END > B_PEND ? B_L1END : B_PEND) : (B_L0END > B_PEND ? B_L0END : B_PEND);
constexpr size_t WS_NEED = OFF_BIG + BIG_SZ;
static_assert(WS_NEED <= 536870912, "workspace too large");

constexpr int SMEM_BYTES = 157696;

struct P {
  const float *x, *c, *ctx, *c_ctx, *mod_w, *mod_b, *n1g, *n2g, *ev_w_in, *ev_w_out, *qg, *kg, *mu, *w0, *w2, *a0, *a2, *g2,
      *k_k, *k_a, *r_k, *gn_w, *gn_b, *ssd_w_in, *conv_w, *conv_b, *dt_bias, *a_log, *ssd_d, *ssd_nw, *ssd_w_out, *pwq, *pkeys,
      *pu, *pv;
  float* out;
  char* ws;
};

typedef float f32x2 __attribute__((ext_vector_type(2)));
typedef __bf16 bf16x2_t __attribute__((ext_vector_type(2)));
DI bf16_t f2bf(float f) { return __builtin_bit_cast(bf16_t, (__bf16)f); }
DI float bf2f(bf16_t b) { return __uint_as_float(((unsigned)b) << 16); }
DI unsigned pack2(float a, float b) {
  f32x2 f = {a, b};
  return __builtin_bit_cast(unsigned, __builtin_convertvector(f, bf16x2_t));
}
DI float lo2f(unsigned u) { return __uint_as_float(u << 16); }
DI float hi2f(unsigned u) { return __uint_as_float(u & 0xffff0000u); }
DI void unpack8(const uint4& r, float* v) {
  v[0] = lo2f(r.x); v[1] = hi2f(r.x); v[2] = lo2f(r.y); v[3] = hi2f(r.y);
  v[4] = lo2f(r.z); v[5] = hi2f(r.z); v[6] = lo2f(r.w); v[7] = hi2f(r.w);
}
DI uint4 pack8(const float* v) {
  uint4 r; r.x = pack2(v[0], v[1]); r.y = pack2(v[2], v[3]); r.z = pack2(v[4], v[5]); r.w = pack2(v[6], v[7]);
  return r;
}
DI float shx_(float v, int off, int lane) {
  return __builtin_bit_cast(float, __builtin_amdgcn_ds_bpermute((lane ^ off) << 2, __builtin_bit_cast(int, v)));
}
DI float shup_(float v, int off, int lane) {
  return __builtin_bit_cast(float, __builtin_amdgcn_ds_bpermute((lane - off) << 2, __builtin_bit_cast(int, v)));
}
#define SHX(v, o) shx_((v), (o), lane)
DI float wave_sum_(float v, int lane) {
#pragma unroll
  for (int o = 32; o > 0; o >>= 1) v += shx_(v, o, lane);
  return v;
}
#define wave_sum(v) wave_sum_((v), lane)
DI float dpp_f(float v, const int ctrl_sel) {
  int x = __builtin_bit_cast(int, v);
  int y;
  if (ctrl_sel == 0) y = __builtin_amdgcn_mov_dpp(x, 0xB1, 0xF, 0xF, true);
  else if (ctrl_sel == 1) y = __builtin_amdgcn_mov_dpp(x, 0x4E, 0xF, 0xF, true);
  else y = __builtin_amdgcn_mov_dpp(x, 0x141, 0xF, 0xF, true);
  return __builtin_bit_cast(float, y);
}
DI float reduce8(float v) {
  v += dpp_f(v, 0);
  v += dpp_f(v, 1);
  v += dpp_f(v, 2);
  return v;
}
DI float wave_sum_dpp(float v, int lane) {
  v += dpp_f(v, 0);
  v += dpp_f(v, 1);
  v += dpp_f(v, 2);
  v += __builtin_bit_cast(float, __builtin_amdgcn_mov_dpp(__builtin_bit_cast(int, v), 0x140, 0xF, 0xF, true));
  v += shx_(v, 16, lane);
  v += shx_(v, 32, lane);
  return v;
}
DI void cvt16_fp8(const uint4& w, float* f) {
  f32x2 t;
  t = __builtin_amdgcn_cvt_pk_f32_fp8((int)w.x, false); f[0] = t.x; f[1] = t.y;
  t = __builtin_amdgcn_cvt_pk_f32_fp8((int)w.x, true); f[2] = t.x; f[3] = t.y;
  t = __builtin_amdgcn_cvt_pk_f32_fp8((int)w.y, false); f[4] = t.x; f[5] = t.y;
  t = __builtin_amdgcn_cvt_pk_f32_fp8((int)w.y, true); f[6] = t.x; f[7] = t.y;
  t = __builtin_amdgcn_cvt_pk_f32_fp8((int)w.z, false); f[8] = t.x; f[9] = t.y;
  t = __builtin_amdgcn_cvt_pk_f32_fp8((int)w.z, true); f[10] = t.x; f[11] = t.y;
  t = __builtin_amdgcn_cvt_pk_f32_fp8((int)w.w, false); f[12] = t.x; f[13] = t.y;
  t = __builtin_amdgcn_cvt_pk_f32_fp8((int)w.w, true); f[14] = t.x; f[15] = t.y;
}
DI float sigmoidf_(float x) { return __builtin_amdgcn_rcpf(1.f + __expf(-x)); }
DI float siluf_(float x) { return x * __builtin_amdgcn_rcpf(1.f + __expf(-x)); }
DI float softplusf_(float y) { return fmaxf(y, 0.f) + log1pf(__expf(-fabsf(y))); }
DI int scanpos(int d, int pp) { return d ? (pp < LC ? LC - 1 - pp : LT + LC - 1 - pp) : pp; }
DI int rowmod(int n) { int b = n / LT; int pos = n - b * LT; return pos < LC ? 8 : b; }
DI const float* xin_row(const P& p, int n) {
  int b = n / LT, pos = n - b * LT;
  return pos < LC ? p.ctx + ((size_t)(b * LC + pos)) * DM : p.x + ((size_t)(b * SEQ + pos - LC)) * DM;
}

template <class Epi>
DI void gemm_tile(const int TIDX, const bf16_t* __restrict__ A, int lda, const bf16_t* __restrict__ Bt, int ldb, int K, int m0, int n0,
                  Epi epi, char* smem) {
  bf16_t* As = (bf16_t*)smem;
  bf16_t* Bs = As + 2 * 256 * 72;
  const int tid = TIDX, lane = tid & 63, wave = tid >> 6;
  const int wm = wave >> 1, wn = wave & 1;
  const int r = lane & 31, h8 = lane >> 5;
  f32x16 acc[2][2];
#pragma unroll
  for (int i = 0; i < 2; i++)
#pragma unroll
    for (int j = 0; j < 2; j++)
#pragma unroll
      for (int q = 0; q < 16; q++) acc[i][j][q] = 0.f;
  const int lrow = tid >> 3, lch = tid & 7;
  const bf16_t* Ap = A + (size_t)(m0 + lrow) * lda + lch * 8;
  const bf16_t* Bp = Bt + (size_t)(n0 + lrow) * ldb + lch * 8;
  const size_t sa = (size_t)64 * lda, sb_ = (size_t)64 * ldb;
  uint4 ra0 = *(const uint4*)(Ap), ra1 = *(const uint4*)(Ap + sa), ra2 = *(const uint4*)(Ap + 2 * sa), ra3 = *(const uint4*)(Ap + 3 * sa);
  uint4 rb0 = *(const uint4*)(Bp), rb1 = *(const uint4*)(Bp + sb_);
  __syncthreads();
  {
    bf16_t* Aw = As + lrow * 72 + lch * 8;
    bf16_t* Bw = Bs + lrow * 72 + lch * 8;
    *(uint4*)(Aw) = ra0; *(uint4*)(Aw + 64 * 72) = ra1; *(uint4*)(Aw + 128 * 72) = ra2; *(uint4*)(Aw + 192 * 72) = ra3;
    *(uint4*)(Bw) = rb0; *(uint4*)(Bw + 64 * 72) = rb1;
  }
  __syncthreads();
  const int nk = K >> 6;
  for (int kt = 0; kt < nk; kt++) {
    const int cur = kt & 1;
    const bool more = kt + 1 < nk;
    if (more) {
      const bf16_t* Aq = Ap + (kt + 1) * 64;
      const bf16_t* Bq = Bp + (kt + 1) * 64;
      ra0 = *(const uint4*)(Aq); ra1 = *(const uint4*)(Aq + sa); ra2 = *(const uint4*)(Aq + 2 * sa); ra3 = *(const uint4*)(Aq + 3 * sa);
      rb0 = *(const uint4*)(Bq); rb1 = *(const uint4*)(Bq + sb_);
    }
    const bf16_t* Ac = As + cur * 256 * 72 + (wm * 64 + r) * 72 + h8 * 8;
    const bf16_t* Bc = Bs + cur * 128 * 72 + (wn * 64 + r) * 72 + h8 * 8;
#pragma unroll
    for (int ks = 0; ks < 4; ks++) {
      bf16x8 a0 = *(const bf16x8*)(Ac + ks * 16);
      bf16x8 a1 = *(const bf16x8*)(Ac + 32 * 72 + ks * 16);
      bf16x8 b0 = *(const bf16x8*)(Bc + ks * 16);
      bf16x8 b1 = *(const bf16x8*)(Bc + 32 * 72 + ks * 16);
      acc[0][0] = __builtin_amdgcn_mfma_f32_32x32x16_bf16(a0, b0, acc[0][0], 0, 0, 0);
      acc[0][1] = __builtin_amdgcn_mfma_f32_32x32x16_bf16(a0, b1, acc[0][1], 0, 0, 0);
      acc[1][0] = __builtin_amdgcn_mfma_f32_32x32x16_bf16(a1, b0, acc[1][0], 0, 0, 0);
      acc[1][1] = __builtin_amdgcn_mfma_f32_32x32x16_bf16(a1, b1, acc[1][1], 0, 0, 0);
    }
    if (more) {
      const int nx = cur ^ 1;
      bf16_t* Aw = As + nx * 256 * 72 + lrow * 72 + lch * 8;
      bf16_t* Bw = Bs + nx * 128 * 72 + lrow * 72 + lch * 8;
      *(uint4*)(Aw) = ra0; *(uint4*)(Aw + 64 * 72) = ra1; *(uint4*)(Aw + 128 * 72) = ra2; *(uint4*)(Aw + 192 * 72) = ra3;
      *(uint4*)(Bw) = rb0; *(uint4*)(Bw + 64 * 72) = rb1;
    }
    __syncthreads();
  }
  float* Cs = (float*)smem;
#pragma unroll
  for (int mt = 0; mt < 2; mt++)
#pragma unroll
    for (int nt = 0; nt < 2; nt++)
#pragma unroll
      for (int q = 0; q < 16; q++)
        Cs[(wm * 64 + mt * 32 + (q & 3) + 8 * (q >> 2) + 4 * h8) * 132 + wn * 64 + nt * 32 + r] = acc[mt][nt][q];
  __syncthreads();
#pragma unroll
  for (int i = 0; i < 8; i++) {
    const int seg = i * NTHR + tid;
    const int row = seg >> 4, cs = (seg & 15) * 8;
    const float4 c0 = *(const float4*)(Cs + row * 132 + cs), c1 = *(const float4*)(Cs + row * 132 + cs + 4);
    float v[8] = {c0.x, c0.y, c0.z, c0.w, c1.x, c1.y, c1.z, c1.w};
    epi(m0 + row, n0 + cs, v);
  }
}

DI void tconv(const int TIDX, const float* __restrict__ src, int lds_, int K, int N, bf16_t* __restrict__ dst, int ldd, int koff, int bid,
              int nb, char* smem) {
  float* t = (float*)smem;
  const int tn = N >> 6, tk = K >> 6;
  for (int tile = bid; tile < tk * tn; tile += nb) {
    const int k0 = (tile / tn) * 64, n0 = (tile % tn) * 64;
    __syncthreads();
    for (int e = TIDX; e < 4096; e += NTHR) {
      int kk = e >> 6, nn = e & 63;
      t[kk * 65 + nn] = src[(size_t)(k0 + kk) * lds_ + n0 + nn];
    }
    __syncthreads();
    for (int e = TIDX; e < 4096; e += NTHR) {
      int nn = e >> 6, kk = e & 63;
      dst[(size_t)(n0 + nn) * ldd + koff + k0 + kk] = f2bf(t[kk * 65 + nn]);
    }
  }
}
DI void conv_flat(const int TIDX, const float* __restrict__ src, bf16_t* __restrict__ dst, size_t count, int bid, int nb) {
  const size_t n4 = count >> 2;
  for (size_t i = (size_t)bid * NTHR + TIDX; i < n4; i += (size_t)nb * NTHR) {
    float4 v = ((const float4*)src)[i];
    uint2 o; o.x = pack2(v.x, v.y); o.y = pack2(v.z, v.w);
    ((uint2*)dst)[i] = o;
  }
}
DI void conv_fp8(const int TIDX, const float* __restrict__ src, unsigned char* __restrict__ dst, float* __restrict__ scl, int bid, int nb) {
  const int lane = TIDX & 63, wave = TIDX >> 6;
  for (int row = bid * 8 + wave; row < 16384; row += nb * 8) {
    const float* sp = src + (size_t)row * 1024 + lane * 16;
    float4 v0 = *(const float4*)(sp), v1 = *(const float4*)(sp + 4), v2 = *(const float4*)(sp + 8), v3 = *(const float4*)(sp + 12);
    float am = fmaxf(fmaxf(fmaxf(fabsf(v0.x), fabsf(v0.y)), fmaxf(fabsf(v0.z), fabsf(v0.w))),
                     fmaxf(fmaxf(fabsf(v1.x), fabsf(v1.y)), fmaxf(fabsf(v1.z), fabsf(v1.w))));
    am = fmaxf(am, fmaxf(fmaxf(fmaxf(fabsf(v2.x), fabsf(v2.y)), fmaxf(fabsf(v2.z), fabsf(v2.w))),
                         fmaxf(fmaxf(fabsf(v3.x), fabsf(v3.y)), fmaxf(fabsf(v3.z), fabsf(v3.w)))));
#pragma unroll
    for (int o = 32; o > 0; o >>= 1) am = fmaxf(am, shx_(am, o, lane));
    const float sc = am > 0.f ? 224.f / am : 1.f;
    if (lane == 0) scl[row] = am > 0.f ? am * (1.f / 224.f) : 1.f;
    uint4 o;
    int t = 0;
    t = __builtin_amdgcn_cvt_pk_fp8_f32(v0.x * sc, v0.y * sc, t, false); t = __builtin_amdgcn_cvt_pk_fp8_f32(v0.z * sc, v0.w * sc, t, true); o.x = (unsigned)t;
    t = __builtin_amdgcn_cvt_pk_fp8_f32(v1.x * sc, v1.y * sc, t, false); t = __builtin_amdgcn_cvt_pk_fp8_f32(v1.z * sc, v1.w * sc, t, true); o.y = (unsigned)t;
    t = __builtin_amdgcn_cvt_pk_fp8_f32(v2.x * sc, v2.y * sc, t, false); t = __builtin_amdgcn_cvt_pk_fp8_f32(v2.z * sc, v2.w * sc, t, true); o.z = (unsigned)t;
    t = __builtin_amdgcn_cvt_pk_fp8_f32(v3.x * sc, v3.y * sc, t, false); t = __builtin_amdgcn_cvt_pk_fp8_f32(v3.z * sc, v3.w * sc, t, true); o.w = (unsigned)t;
    *(uint4*)(dst + (size_t)row * 1024 + lane * 16) = o;
  }
}
DI void mod_gemv(const int TIDX, const P& p, int bid, int nb, char* smem) {
  float* sc = (float*)smem;
  float* red = sc + 9 * 1024;
  float* modo = (float*)(p.ws + OFF_MOD);
  for (int task = bid; task < 192; task += nb) {
    const int l = task / 96, j0 = (task % 96) * 64;
    __syncthreads();
    for (int e = TIDX; e < 9 * 1024; e += NTHR) {
      int rr = e >> 10, k = e & 1023;
      float v = rr < 8 ? p.c[rr * 1024 + k] : p.c_ctx[k];
      sc[e] = v / (1.f + expf(-v));
    }
    __syncthreads();
    const int kg = TIDX >> 6, col = TIDX & 63;
    float acc[9];
#pragma unroll
    for (int q = 0; q < 9; q++) acc[q] = 0.f;
    const float* W = p.mod_w + (size_t)l * 1024 * 6144 + j0 + col;
#pragma unroll 4
    for (int k = kg * 128; k < kg * 128 + 128; ++k) {
      float w = W[(size_t)k * 6144];
#pragma unroll
      for (int q = 0; q < 9; q++) acc[q] += sc[q * 1024 + k] * w;
    }
#pragma unroll
    for (int q = 0; q < 9; q++) red[(kg * 9 + q) * 64 + col] = acc[q];
    __syncthreads();
    for (int e = TIDX; e < 9 * 64; e += NTHR) {
      int rr = e >> 6, cc = e & 63;
      float s = p.mod_b[l * 6144 + j0 + cc];
#pragma unroll
      for (int g = 0; g < 8; g++) s += red[(g * 9 + rr) * 64 + cc];
      modo[(size_t)(l * 9 + rr) * 6144 + j0 + cc] = s;
    }
  }
}

DI void norm_rows(const int TIDX, const P& p, int layer, int which, bool from_input, bool latent_only, int bid, int nb) {
  const int lane = TIDX & 63, wave = TIDX >> 6;
  const float* mod = (const float*)(p.ws + OFF_MOD);
  const float* X = (const float*)(p.ws + OFF_X);
  bf16_t* H = (bf16_t*)(p.ws + OFF_H);
  const float* g = (which ? p.n2g : p.n1g) + layer * 1024;
  for (int n = bid * 8 + wave; n < NTOK; n += nb * 8) {
    int b = n / LT, pos = n - b * LT;
    if (latent_only && pos < LC) continue;
    const float* src = from_input ? xin_row(p, n) : X + (size_t)n * DM;
    float4 v[4];
    float ss = 0.f;
#pragma unroll
    for (int i = 0; i < 4; i++) {
      v[i] = *(const float4*)(src + i * 256 + lane * 4);
      ss += v[i].x * v[i].x + v[i].y * v[i].y + v[i].z * v[i].z + v[i].w * v[i].w;
    }
    ss = wave_sum(ss);
    const float rs = rsqrtf(ss * (1.f / 1024.f) + 1e-6f);
    const int rr = pos < LC ? 8 : b;
    const float* msc = mod + (size_t)(layer * 9 + rr) * 6144 + (which ? 4 : 1) * 1024;
    const float* msh = mod + (size_t)(layer * 9 + rr) * 6144 + (which ? 3 : 0) * 1024;
#pragma unroll
    for (int i = 0; i < 4; i++) {
      int idx = i * 256 + lane * 4;
      float4 gg = *(const float4*)(g + idx), sc = *(const float4*)(msc + idx), sh = *(const float4*)(msh + idx);
      float y0 = v[i].x * rs * gg.x * (1.f + sc.x) + sh.x;
      float y1 = v[i].y * rs * gg.y * (1.f + sc.y) + sh.y;
      float y2 = v[i].z * rs * gg.z * (1.f + sc.z) + sh.z;
      float y3 = v[i].w * rs * gg.w * (1.f + sc.w) + sh.w;
      uint2 o; o.x = pack2(y0, y1); o.y = pack2(y2, y3);
      *(uint2*)(H + (size_t)n * DM + idx) = o;
    }
  }
}

DI void rope8(float* v, int e, int t, int lane) {
  const int half = e >> 2, isx2 = (e >> 1) & 1, ibase = (e & 1) * 8;
  const float posf = half ? (float)(t & 63) : (float)(t >> 6);
#pragma unroll
  for (int j = 0; j < 8; j++) {
    float pv = SHX(v[j], 2);
    float inv = exp2f(-(float)(ibase + j) * 0.83048202f);
    float ang = posf * inv;
    float rev = ang * 0.15915494309f;
    rev -= floorf(rev);
    float sn = __builtin_amdgcn_sinf(rev), cs = __builtin_amdgcn_cosf(rev);
    v[j] = isx2 ? (v[j] * cs + pv * sn) : (v[j] * cs - pv * sn);
  }
}
DI void prep0(const int TIDX, const P& p, int bid, int nb) {
  char* big = p.ws + OFF_BIG;
  const bf16_t* Z = (const bf16_t*)(big + B_Z0);
  bf16_t* QN = (bf16_t*)(big + B_QN); bf16_t* KN = (bf16_t*)(big + B_KN); bf16_t* VT = (bf16_t*)(big + B_VT);
  bf16_t* R = (bf16_t*)(big + B_R); bf16_t* KB = (bf16_t*)(big + B_KB); bf16_t* KK = (bf16_t*)(big + B_KK);
  bf16_t* V = (bf16_t*)(big + B_V); bf16_t* AW = (bf16_t*)(big + B_AW); bf16_t* AA = (bf16_t*)(big + B_AA);
  bf16_t* AG = (bf16_t*)(big + B_AG);
  const int lane = TIDX & 63, wave = TIDX >> 6;
  for (int n = bid * 8 + wave; n < NTOK; n += nb * 8) {
    const int b = n / LT, pos = n - b * LT;
    const bool lat = pos >= LC;
    const int t = pos - LC;
    const bf16_t* zr = Z + (size_t)n * 2560;
    {
      const int head = lane >> 3, e = lane & 7;
      uint4 raw = *(const uint4*)(zr + head * 64 + e * 8);
      float v[8]; unpack8(raw, v);
      float ss = 0.f;
#pragma unroll
      for (int j = 0; j < 8; j++) ss += v[j] * v[j];
      ss += SHX(ss, 1); ss += SHX(ss, 2); ss += SHX(ss, 4);
      const float rs = rsqrtf(ss * (1.f / 64.f) + 1e-6f);
#pragma unroll
      for (int j = 0; j < 8; j++) v[j] = v[j] * rs * p.qg[e * 8 + j];
      if (lat) rope8(v, e, t, lane);
#pragma unroll
      for (int j = 0; j < 8; j++) v[j] *= 0.18033688011f;
      *(uint4*)(QN + ((size_t)(b * 8 + head) * LT + pos) * 64 + e * 8) = pack8(v);
    }
    {
      const int hh = (lane >> 3) & 3, e = lane & 7;
      uint4 raw = make_uint4(0, 0, 0, 0);
      if (lane < 32) raw = *(const uint4*)(zr + 512 + hh * 64 + e * 8);
      float v[8]; unpack8(raw, v);
      float kv[8];
      float ss = 0.f;
#pragma unroll
      for (int j = 0; j < 8; j++) ss += v[j] * v[j];
      ss += SHX(ss, 1); ss += SHX(ss, 2); ss += SHX(ss, 4);
      const float rs = rsqrtf(ss * (1.f / 64.f) + 1e-6f);
#pragma unroll
      for (int j = 0; j < 8; j++) kv[j] = v[j] * rs * p.kg[e * 8 + j];
      if (lat) rope8(kv, e, t, lane);
      if (lane < 16) {
        *(uint4*)(KN + ((size_t)(b * 2 + hh) * LT + pos) * 64 + e * 8) = pack8(kv);
      } else if (lane < 32) {
        const int kvh = hh - 2;
#pragma unroll
        for (int j = 0; j < 8; j++) VT[((size_t)(b * 2 + kvh) * 64 + e * 8 + j) * LT + pos] = f2bf(v[j]);
      }
    }
    const bool hasp = (pos != 0 && pos != LC), hasn = (pos != LC - 1 && pos != LT - 1);
    const bf16_t* zc = zr + 768;
#pragma unroll
    for (int i = 0; i < 7; i++) {
      const int j = i * 256 + lane * 4;
      uint2 cu = *(const uint2*)(zc + j);
      uint2 pu = make_uint2(0, 0), nu = make_uint2(0, 0);
      if (hasp) pu = *(const uint2*)(zc - 2560 + j);
      if (hasn) nu = *(const uint2*)(zc + 2560 + j);
      float4 m4 = *(const float4*)(p.mu + j);
      float cv[4] = {lo2f(cu.x), hi2f(cu.x), lo2f(cu.y), hi2f(cu.y)};
      float pv[4] = {lo2f(pu.x), hi2f(pu.x), lo2f(pu.y), hi2f(pu.y)};
      float nv[4] = {lo2f(nu.x), hi2f(nu.x), lo2f(nu.y), hi2f(nu.y)};
      float mm[4] = {m4.x, m4.y, m4.z, m4.w};
      float zm[4];
#pragma unroll
      for (int q = 0; q < 4; q++) zm[q] = cv[q] + mm[q] * (0.5f * (pv[q] + nv[q]) - cv[q]);
      if (i < 6) {
        const int cc = (i & 1) * 256 + lane * 4;
        const int head = cc >> 6, within = cc & 63;
        const size_t oidx = ((size_t)(b * 8 + head) * LT + pos) * 64 + within;
        uint2 o; o.x = pack2(zm[0], zm[1]); o.y = pack2(zm[2], zm[3]);
        if (i < 2) {
          *(uint2*)(R + oidx) = o;
        } else if (i < 4) {
          *(uint2*)(KB + oidx) = o;
          float4 kk4 = *(const float4*)(p.k_k + cc);
          float k0 = zm[0] * kk4.x, k1 = zm[1] * kk4.y, k2 = zm[2] * kk4.z, k3 = zm[3] * kk4.w;
          float ss = k0 * k0 + k1 * k1 + k2 * k2 + k3 * k3;
          ss += SHX(ss, 1); ss += SHX(ss, 2); ss += SHX(ss, 4); ss += SHX(ss, 8);
          const float inv = 1.f / fmaxf(sqrtf(ss), 1e-12f);
          uint2 o2; o2.x = pack2(k0 * inv, k1 * inv); o2.y = pack2(k2 * inv, k3 * inv);
          *(uint2*)(KK + oidx) = o2;
        } else {
          *(uint2*)(V + oidx) = o;
        }
      } else {
        if (lane < 16) {
          uint2 o; o.x = pack2(tanhf(zm[0]), tanhf(zm[1])); o.y = pack2(tanhf(zm[2]), tanhf(zm[3]));
          *(uint2*)(AW + (size_t)n * 64 + lane * 4) = o;
        } else if (lane < 32) {
          uint2 o; o.x = pack2(zm[0], zm[1]); o.y = pack2(zm[2], zm[3]);
          *(uint2*)(AA + (size_t)n * 64 + (lane - 16) * 4) = o;
        } else {
          uint2 o; o.x = pack2(sigmoidf_(zm[0]), sigmoidf_(zm[1])); o.y = pack2(sigmoidf_(zm[2]), sigmoidf_(zm[3]));
          *(uint2*)(AG + (size_t)n * 128 + (lane - 32) * 4) = o;
        }
      }
    }
  }
}

DI float reduce16(float v) {
  v += dpp_f(v, 0);
  v += dpp_f(v, 1);
  v += dpp_f(v, 2);
  v += __builtin_bit_cast(float, __builtin_amdgcn_mov_dpp(__builtin_bit_cast(int, v), 0x140, 0xF, 0xF, true));
  return v;
}
DI void reduce16_2(float& a, float& b) {
  a += dpp_f(a, 0); b += dpp_f(b, 0);
  a += dpp_f(a, 1); b += dpp_f(b, 1);
  a += dpp_f(a, 2); b += dpp_f(b, 2);
  a += __builtin_bit_cast(float, __builtin_amdgcn_mov_dpp(__builtin_bit_cast(int, a), 0x140, 0xF, 0xF, true));
  b += __builtin_bit_cast(float, __builtin_amdgcn_mov_dpp(__builtin_bit_cast(int, b), 0x140, 0xF, 0xF, true));
}
DI void wkv2_task(const int TIDX, const P& p, int task, char* smem) {
  char* big = p.ws + OFF_BIG;
  const int rh = task & 1, d = (task >> 1) & 1, h = (task >> 2) & 7, b = task >> 5;
  const bf16_t* R = (const bf16_t*)(big + B_R); const bf16_t* KB = (const bf16_t*)(big + B_KB);
  const bf16_t* KK = (const bf16_t*)(big + B_KK); const bf16_t* V = (const bf16_t*)(big + B_V);
  const bf16_t* AL = (const bf16_t*)(big + B_AL) + (size_t)d * NB * 8 * LT * 64;
  const float* DEC = (const float*)(big + B_DEC) + (size_t)d * NB * 8 * LT * 64;
  bf16_t* OUT = (bf16_t*)(big + B_OUT) + (size_t)d * NB * 8 * LT * 64;
  float* BON = (float*)(p.ws + OFF_BON) + (size_t)d * NB * 8 * LT;
  float* bufs = (float*)smem;
  float* outb = bufs + 2 * 6 * 2048;
  const int tid = TIDX;
  const int row = tid >> 4, ks = tid & 15;
  const int ls = tid >> 4, li = (tid & 15) * 4;
  const size_t hb = (size_t)(b * 8 + h) * LT;
  const float4 ka = *(const float4*)(p.k_a + h * 64 + li);
  const float4 rk = *(const float4*)(p.r_k + h * 64 + li);
  f32x2 S01 = {0.f, 0.f}, S23 = {0.f, 0.f};
  float pr[24];
  auto gload = [&](int chunk) {
    const int pos = scanpos(d, chunk * 32 + ls);
    const size_t e0 = (hb + pos) * 64 + li;
    const uint2 r4 = *(const uint2*)(R + e0), k4 = *(const uint2*)(KB + e0), kk4 = *(const uint2*)(KK + e0);
    const uint2 v4 = *(const uint2*)(V + e0), a4 = *(const uint2*)(AL + e0);
    const float4 dc = *(const float4*)(DEC + e0);
    const float a0 = lo2f(a4.x), a1 = hi2f(a4.x), a2 = lo2f(a4.y), a3 = hi2f(a4.y);
    const float q0 = lo2f(kk4.x), q1 = hi2f(kk4.x), q2 = lo2f(kk4.y), q3 = hi2f(kk4.y);
    pr[0] = lo2f(r4.x); pr[1] = hi2f(r4.x); pr[2] = lo2f(r4.y); pr[3] = hi2f(r4.y);
    pr[4] = dc.x; pr[5] = dc.y; pr[6] = dc.z; pr[7] = dc.w;
    pr[8] = lo2f(k4.x) * (1.f + (a0 - 1.f) * ka.x); pr[9] = hi2f(k4.x) * (1.f + (a1 - 1.f) * ka.y);
    pr[10] = lo2f(k4.y) * (1.f + (a2 - 1.f) * ka.z); pr[11] = hi2f(k4.y) * (1.f + (a3 - 1.f) * ka.w);
    pr[12] = lo2f(v4.x); pr[13] = hi2f(v4.x); pr[14] = lo2f(v4.y); pr[15] = hi2f(v4.y);
    pr[16] = -q0; pr[17] = -q1; pr[18] = -q2; pr[19] = -q3;
    pr[20] = q0 * a0; pr[21] = q1 * a1; pr[22] = q2 * a2; pr[23] = q3 * a3;
    float bp = pr[0] * pr[8] * rk.x + pr[1] * pr[9] * rk.y + pr[2] * pr[10] * rk.z + pr[3] * pr[11] * rk.w;
    bp = reduce16(bp);
    if (rh == 0 && (tid & 15) == 0) BON[hb + pos] = bp;
  };
  auto lstore = [&](int bufi) {
    float* bb = bufs + bufi * 6 * 2048 + ls * 64 + li;
#pragma unroll
    for (int q = 0; q < 6; q++) *(float4*)(bb + q * 2048) = make_float4(pr[4 * q], pr[4 * q + 1], pr[4 * q + 2], pr[4 * q + 3]);
  };
  __syncthreads();
  gload(0);
  lstore(0);
  __syncthreads();
  const int nch = LT / 32;
  for (int ch = 0; ch < nch; ch++) {
    const int cur = ch & 1;
    if (ch + 1 < nch) gload(ch + 1);
    const float* bb = bufs + cur * 6 * 2048;
    const float* qb = bb + ks * 4;
    const float* vb = bb + 3 * 2048 + rh * 32 + row;
    float4 n_kn = *(const float4*)(qb + 4 * 2048), n_dc = *(const float4*)(qb + 1 * 2048), n_bv = *(const float4*)(qb + 5 * 2048);
    float4 n_kd = *(const float4*)(qb + 2 * 2048), n_rr = *(const float4*)(qb);
    float n_vv = vb[0];
    float upend = 0.f;
#pragma unroll 4
    for (int s = 0; s < 32; s++) {
      const float4 kn = n_kn, dc = n_dc, bv = n_bv, kd = n_kd, rr = n_rr;
      const float vv = n_vv;
      if (s + 1 < 32) {
        const float* q1 = qb + (s + 1) * 64;
        n_kn = *(const float4*)(q1 + 4 * 2048); n_dc = *(const float4*)(q1 + 1 * 2048); n_bv = *(const float4*)(q1 + 5 * 2048);
        n_kd = *(const float4*)(q1 + 2 * 2048); n_rr = *(const float4*)(q1);
        n_vv = vb[(s + 1) * 64];
      }
      f32x2 t = S01 * (f32x2){kn.x, kn.y};
      t = S23 * (f32x2){kn.z, kn.w} + t;
      float sa = t.x + t.y;
      reduce16_2(sa, upend);
      if (s > 0) outb[(s - 1) * 32 + row] = upend;
      const f32x2 sa2 = {sa, sa}, vv2 = {vv, vv};
      S01 = S01 * (f32x2){dc.x, dc.y} + sa2 * (f32x2){bv.x, bv.y} + vv2 * (f32x2){kd.x, kd.y};
      S23 = S23 * (f32x2){dc.z, dc.w} + sa2 * (f32x2){bv.z, bv.w} + vv2 * (f32x2){kd.z, kd.w};
      f32x2 u = S01 * (f32x2){rr.x, rr.y};
      u = S23 * (f32x2){rr.z, rr.w} + u;
      upend = u.x + u.y;
    }
    upend = reduce16(upend);
    outb[31 * 32 + row] = upend;
    __syncthreads();
    {
      const int idx = tid * 2, s = idx >> 5, r2 = idx & 31;
      const int pos = scanpos(d, ch * 32 + s);
      *(unsigned*)(OUT + (hb + pos) * 64 + rh * 32 + r2) = pack2(outb[idx], outb[idx + 1]);
    }
    if (ch + 1 < nch) lstore(cur ^ 1);
    __syncthreads();
  }
}
DI void wkv_finalize(const int TIDX, const P& p, int bid, int nb) {
  char* big = p.ws + OFF_BIG;
  const bf16_t* OUT = (const bf16_t*)(big + B_OUT);
  const float* BON = (const float*)(p.ws + OFF_BON);
  const bf16_t* V = (const bf16_t*)(big + B_V);
  const bf16_t* G = (const bf16_t*)(big + B_G);
  bf16_t* YM = (bf16_t*)(big + B_YMIX);
  const int lane = TIDX & 63, wave = TIDX >> 6;
  for (int item = bid * 8 + wave; item < NTOK * 8; item += nb * 8) {
    const int n = item >> 3, h = item & 7;
    const int b = n / LT, pos = n - b * LT;
    const size_t hb = (size_t)(b * 8 + h) * LT + pos;
    const int c = h * 64 + lane;
    const float vval = bf2f(V[hb * 64 + lane]);
    const float gw = p.gn_w[c], gb = p.gn_b[c];
    float y = 0.f;
#pragma unroll
    for (int d = 0; d < 2; d++) {
      const float o = bf2f(OUT[((size_t)d * NB * 8 * LT + hb) * 64 + lane]);
      const float mean = wave_sum_dpp(o, lane) * (1.f / 64.f);
      const float dd = o - mean;
      const float var = wave_sum_dpp(dd * dd, lane) * (1.f / 64.f);
      const float rstd = rsqrtf(var + 64e-5f);
      const float bon = BON[(size_t)d * NB * 8 * LT + hb];
      y += dd * rstd * gw + gb + bon * vval;
    }
    y *= bf2f(G[(size_t)n * 512 + c]);
    YM[(size_t)n * 1024 + 512 + c] = f2bf(y);
  }
}

DI void attn_task(const int TIDX, const P& p, int task, char* smem) {
  char* big = p.ws + OFF_BIG;
  int b, head, qt;
  if (task < 512) { qt = 1 + (task & 7); head = (task >> 3) & 7; b = task >> 6; }
  else { int t2 = task - 512; qt = 0; head = t2 & 7; b = t2 >> 3; }
  const int kvh = head >> 2;
  const int nkt = (qt == 0 ? 256 : LT) / 64;
  bf16_t* Ks = (bf16_t*)smem;
  bf16_t* Vs = Ks + 2 * 64 * 72;
  const bf16_t* Kg = (const bf16_t*)(big + B_KN) + (size_t)(b * 2 + kvh) * LT * 64;
  const bf16_t* Vg = (const bf16_t*)(big + B_VT) + (size_t)(b * 2 + kvh) * 64 * LT;
  const bf16_t* QN = (const bf16_t*)(big + B_QN);
  bf16_t* YM = (bf16_t*)(big + B_YMIX);
  const int tid = TIDX, lane = tid & 63, wave = tid >> 6;
  const int r = lane & 31, h8 = lane >> 5;
  const int q0 = qt * 256 + wave * 32;
  bf16x8 qf[4];
#pragma unroll
  for (int kk = 0; kk < 4; kk++)
    qf[kk] = *(const bf16x8*)(QN + ((size_t)(b * 8 + head) * LT + q0 + r) * 64 + kk * 16 + h8 * 8);
  f32x16 o0, o1;
#pragma unroll
  for (int q = 0; q < 16; q++) { o0[q] = 0.f; o1[q] = 0.f; }
  float m = -1e30f, l = 0.f;
  const int lr = tid >> 3, lc = tid & 7;
  uint4 kreg = *(const uint4*)(Kg + (size_t)lr * 64 + lc * 8);
  uint4 vreg = *(const uint4*)(Vg + (size_t)lr * LT + lc * 8);
  __syncthreads();
  *(uint4*)(Ks + lr * 72 + lc * 8) = kreg;
  *(uint4*)(Vs + lr * 72 + lc * 8) = vreg;
  __syncthreads();
  for (int kt = 0; kt < nkt; kt++) {
    const int cur = kt & 1;
    if (kt + 1 < nkt) {
      kreg = *(const uint4*)(Kg + (size_t)((kt + 1) * 64 + lr) * 64 + lc * 8);
      vreg = *(const uint4*)(Vg + (size_t)lr * LT + (kt + 1) * 64 + lc * 8);
    }
    const bf16_t* Kc = Ks + cur * 64 * 72;
    const bf16_t* Vc = Vs + cur * 64 * 72;
    f32x16 s0, s1;
#pragma unroll
    for (int q = 0; q < 16; q++) { s0[q] = 0.f; s1[q] = 0.f; }
#pragma unroll
    for (int kk = 0; kk < 4; kk++) {
      bf16x8 a0 = *(const bf16x8*)(Kc + r * 72 + kk * 16 + h8 * 8);
      bf16x8 a1 = *(const bf16x8*)(Kc + (32 + r) * 72 + kk * 16 + h8 * 8);
      s0 = __builtin_amdgcn_mfma_f32_32x32x16_bf16(a0, qf[kk], s0, 0, 0, 0);
      s1 = __builtin_amdgcn_mfma_f32_32x32x16_bf16(a1, qf[kk], s1, 0, 0, 0);
    }
    float mx = s0[0];
#pragma unroll
    for (int q = 1; q < 16; q++) mx = fmaxf(mx, s0[q]);
#pragma unroll
    for (int q = 0; q < 16; q++) mx = fmaxf(mx, s1[q]);
    mx = fmaxf(mx, SHX(mx, 32));
    const float mnew = fmaxf(m, mx);
    const float alpha = __builtin_amdgcn_exp2f(m - mnew);
    float sum = 0.f;
#pragma unroll
    for (int q = 0; q < 16; q++) { s0[q] = __builtin_amdgcn_exp2f(s0[q] - mnew); sum += s0[q]; }
#pragma unroll
    for (int q = 0; q < 16; q++) { s1[q] = __builtin_amdgcn_exp2f(s1[q] - mnew); sum += s1[q]; }
    l = l * alpha + sum;
    m = mnew;
#pragma unroll
    for (int q = 0; q < 16; q++) { o0[q] *= alpha; o1[q] *= alpha; }
#pragma unroll
    for (int t = 0; t < 2; t++) {
#pragma unroll
      for (int s = 0; s < 2; s++) {
        union { bf16x8 v; unsigned u[4]; } pf;
#pragma unroll
        for (int q = 0; q < 4; q++) {
          float x0 = t ? s1[8 * s + 2 * q] : s0[8 * s + 2 * q];
          float x1 = t ? s1[8 * s + 2 * q + 1] : s0[8 * s + 2 * q + 1];
          pf.u[q] = pack2(x0, x1);
        }
        const int kb = 32 * t + 16 * s + 4 * h8;
        union { bf16x8 v; uint2 u[2]; } v0, v1;
        v0.u[0] = *(const uint2*)(Vc + r * 72 + kb);
        v0.u[1] = *(const uint2*)(Vc + r * 72 + kb + 8);
        v1.u[0] = *(const uint2*)(Vc + (32 + r) * 72 + kb);
        v1.u[1] = *(const uint2*)(Vc + (32 + r) * 72 + kb + 8);
        o0 = __builtin_amdgcn_mfma_f32_32x32x16_bf16(v0.v, pf.v, o0, 0, 0, 0);
        o1 = __builtin_amdgcn_mfma_f32_32x32x16_bf16(v1.v, pf.v, o1, 0, 0, 0);
      }
    }
    if (kt + 1 < nkt) {
      *(uint4*)(Ks + (cur ^ 1) * 64 * 72 + lr * 72 + lc * 8) = kreg;
      *(uint4*)(Vs + (cur ^ 1) * 64 * 72 + lr * 72 + lc * 8) = vreg;
    }
    __syncthreads();
  }
  l += SHX(l, 32);
  const float inv = 1.f / l;
  bf16_t* orow = YM + (size_t)(b * LT + q0 + r) * 1024 + head * 64;
#pragma unroll
  for (int g4 = 0; g4 < 4; g4++) {
    uint2 w0, w1;
    w0.x = pack2(o0[4 * g4] * inv, o0[4 * g4 + 1] * inv); w0.y = pack2(o0[4 * g4 + 2] * inv, o0[4 * g4 + 3] * inv);
    w1.x = pack2(o1[4 * g4] * inv, o1[4 * g4 + 1] * inv); w1.y = pack2(o1[4 * g4 + 2] * inv, o1[4 * g4 + 3] * inv);
    *(uint2*)(orow + 8 * g4 + 4 * h8) = w0;
    *(uint2*)(orow + 32 + 8 * g4 + 4 * h8) = w1;
  }
}

DI void route_task(const int TIDX, const P& p, int n0, char* smem) {
  char* big = p.ws + OFF_BIG;
  const float* S = (const float*)(big + B_S);
  int* EI = (int*)(big + B_EI);
  float* EG = (float*)(big + B_EG);
  float* sc = (float*)smem;
  float* sv = sc + 256 * 129;
  unsigned char* si = (unsigned char*)(sv + 256 * 16);
  const int tid = TIDX;
  __syncthreads();
  for (int e = tid; e < 256 * 128; e += NTHR) {
    int row = e >> 7, j = e & 127;
    sc[row * 129 + j] = S[(size_t)n0 * 2048 + e];
  }
  __syncthreads();
  if (tid < 256) {
    const float* rowp = sc + tid * 129;
    float pv = __builtin_inff();
    int pi = -1;
    for (int k = 0; k < 16; k++) {
      float bv = -__builtin_inff();
      int bi = 0;
      for (int j = 0; j < 128; j++) {
        float x = rowp[j];
        bool elig = (x < pv) || (x == pv && j > pi);
        if (elig && x > bv) { bv = x; bi = j; }
      }
      sv[tid * 16 + k] = bv;
      si[tid * 16 + k] = (unsigned char)bi;
      pv = bv; pi = bi;
    }
  }
  __syncthreads();
  if (tid < 128) {
    const int tl = tid >> 3, head = tid & 7;
    const int r0 = tl * 16 + head * 2, r1 = r0 + 1;
    const float* a = sv + r0 * 16;
    const float* bq = sv + r1 * 16;
    float* eg = sc + tid * 17;
    const int n = n0 + tl;
    float pv = __builtin_inff();
    int pc = -1;
    float mx = 0.f, sum = 0.f;
    for (int k = 0; k < 16; k++) {
      float bv = -__builtin_inff();
      int bc = 0;
      for (int i = 0; i < 16; i++) {
        const int jn = 16 / (i + 1);
        const float ai = a[i];
        for (int j = 0; j < jn; j++) {
          float x = ai + bq[j];
          int c = i * 16 + j;
          bool elig = (x < pv) || (x == pv && c > pc);
          if (elig && x > bv) { bv = x; bc = c; }
        }
      }
      if (k == 0) mx = bv;
      float ev = __expf(bv - mx);
      sum += ev;
      eg[k] = ev;
      EI[(size_t)n * 128 + head * 16 + k] = (int)si[r0 * 16 + (bc >> 4)] * 128 + (int)si[r1 * 16 + (bc & 15)];
      pv = bv; pc = bc;
    }
    const float inv = 1.f / sum;
    for (int k = 0; k < 16; k++) EG[(size_t)n * 128 + head * 16 + k] = eg[k] * inv;
  }
}


DI int f2ord(float f) { int s = __float_as_int(f); return s ^ ((s >> 31) & 0x7fffffff); }
DI float ord2f(int s) { return __int_as_float(s ^ ((s >> 31) & 0x7fffffff)); }
DI void ce_desc(int& a, int& b) { int hi = max(a, b), lo = min(a, b); a = hi; b = lo; }
template <int N>
DI void bsort_desc(int* v) {
#pragma unroll
  for (int k = 2; k <= N; k <<= 1)
#pragma unroll
    for (int j = k >> 1; j > 0; j >>= 1)
#pragma unroll
      for (int i = 0; i < N; i++) {
        const int l = i ^ j;
        if (l > i) {
          if ((i & k) == 0) ce_desc(v[i], v[l]); else ce_desc(v[l], v[i]);
        }
      }
}
DI void merge16(int* a, const int* b) {
#pragma unroll
  for (int i = 0; i < 16; i++) a[i] = max(a[i], b[15 - i]);
#pragma unroll
  for (int j = 8; j > 0; j >>= 1)
#pragma unroll
    for (int i = 0; i < 16; i++) {
      const int l = i ^ j;
      if (l > i) ce_desc(a[i], a[l]);
    }
}
DI void top16_of_64(int* v) {
  bsort_desc<16>(v); bsort_desc<16>(v + 16); bsort_desc<16>(v + 32); bsort_desc<16>(v + 48);
  merge16(v, v + 16); merge16(v + 32, v + 48); merge16(v, v + 32);
}
DI void route2_task(const int TIDX, const P& p, int layer, int m0, int head, char* smem) {
  char* big = p.ws + OFF_BIG;
  const bf16_t* QP = (const bf16_t*)(big + B_QP);
  int* EI = (int*)(big + B_EI);
  float* EG = (float*)(big + B_EG);
  bf16_t* Ks = (bf16_t*)smem;
  unsigned char* sidx = (unsigned char*)(Ks + 256 * 136);
  const bf16_t* keys = (const bf16_t*)(p.ws + OFF_KEYS) + (size_t)(layer * 16 + head * 2) * 128 * 128;
  const int tid = TIDX, lane = tid & 63, wave = tid >> 6;
  const int r = lane & 31, h8 = lane >> 5;
  __syncthreads();
  {
    const int row = tid >> 1, half = tid & 1;
#pragma unroll
    for (int q = 0; q < 8; q++)
      *(uint4*)(Ks + row * 136 + half * 64 + q * 8) = *(const uint4*)(keys + (size_t)row * 128 + half * 64 + q * 8);
  }
  __syncthreads();
  const int tok = m0 + wave * 32 + r;
  int la[16], lb[16];
#pragma unroll
  for (int pp = 0; pp < 2; pp++) {
    bf16x8 qf[8];
#pragma unroll
    for (int ks = 0; ks < 8; ks++)
      qf[ks] = *(const bf16x8*)(QP + (size_t)tok * 2048 + head * 256 + pp * 128 + ks * 16 + h8 * 8);
    int v[64];
#pragma unroll
    for (int kt = 0; kt < 4; kt++) {
      f32x16 acc;
#pragma unroll
      for (int q = 0; q < 16; q++) acc[q] = 0.f;
#pragma unroll
      for (int ks = 0; ks < 8; ks++) {
        bf16x8 a = *(const bf16x8*)(Ks + (pp * 128 + kt * 32 + r) * 136 + ks * 16 + h8 * 8);
        acc = __builtin_amdgcn_mfma_f32_32x32x16_bf16(a, qf[ks], acc, 0, 0, 0);
      }
#pragma unroll
      for (int q = 0; q < 16; q++) v[kt * 16 + q] = (f2ord(acc[q]) & ~127) | (kt * 32 + (q & 3) + 8 * (q >> 2) + 4 * h8);
    }
    top16_of_64(v);
    int pr[16];
#pragma unroll
    for (int i = 0; i < 16; i++) pr[i] = __builtin_amdgcn_ds_bpermute((lane ^ 32) << 2, v[i]);
    merge16(v, pr);
#pragma unroll
    for (int i = 0; i < 16; i++) { if (pp == 0) la[i] = v[i]; else lb[i] = v[i]; }
  }
  {
    unsigned* sw = (unsigned*)(sidx + tid * 32);
#pragma unroll
    for (int i = 0; i < 4; i++) {
      sw[i] = (la[4 * i] & 127) | ((la[4 * i + 1] & 127) << 8) | ((la[4 * i + 2] & 127) << 16) | ((la[4 * i + 3] & 127) << 24);
      sw[4 + i] = (lb[4 * i] & 127) | ((lb[4 * i + 1] & 127) << 8) | ((lb[4 * i + 2] & 127) << 16) | ((lb[4 * i + 3] & 127) << 24);
    }
  }
  float fa[16], fb[16];
#pragma unroll
  for (int i = 0; i < 16; i++) { fa[i] = ord2f(la[i]); fb[i] = ord2f(lb[i]); }
  int c[64];
  {
    int cnt = 0;
#pragma unroll
    for (int i = 0; i < 16; i++)
#pragma unroll
      for (int j = 0; j < 16; j++)
        if ((i + 1) * (j + 1) <= 16) { c[cnt] = (f2ord(fa[i] + fb[j]) & ~255) | (i * 16 + j); cnt++; }
#pragma unroll
    for (int q = 50; q < 64; q++) c[q] = (int)0x80000000;
  }
  top16_of_64(c);
  const float mx = ord2f(c[0]);
  float ev[16], sum = 0.f;
#pragma unroll
  for (int k = 0; k < 16; k++) { ev[k] = __expf(ord2f(c[k]) - mx); sum += ev[k]; }
  const float inv = 1.f / sum;
  const size_t ob = (size_t)tok * 128 + head * 16;
#pragma unroll
  for (int k = 0; k < 16; k++) {
    const int code = c[k] & 255;
    const int ia = sidx[tid * 32 + (code >> 4)], ib = sidx[tid * 32 + 16 + (code & 15)];
    if (h8 == 0) EI[ob + k] = ia * 128 + ib; else EG[ob + k] = ev[k] * inv;
  }
}

DI void peer_gather(const int TIDX, const P& p, int layer, bool last, int bid, int nb, const bool dry) {
  char* big = p.ws + OFF_BIG;
  const int* EI = (const int*)(big + B_EI);
  const float* EG = (const float*)(big + B_EG);
  const unsigned char* UB = (const unsigned char*)(p.ws + OFF_UB);
  const unsigned char* VB = (const unsigned char*)(p.ws + OFF_VB);
  const float* US = (const float*)(p.ws + OFF_UB + 16777216);
  const float* VS = (const float*)(p.ws + OFF_VB + 16777216);
  const bf16_t* H = (const bf16_t*)(p.ws + OFF_H);
  const float* X = (const float*)(p.ws + OFF_X);
  bf16_t* Hw = dry ? (bf16_t*)(big + B_QP) : (bf16_t*)(p.ws + OFF_H);
  float* Xw = dry ? (float*)(big + B_S) : (float*)(p.ws + OFF_X);
  const float* mod = (const float*)(p.ws + OFF_MOD);
  const int lane = TIDX & 63, wave = TIDX >> 6;
  for (int n = bid * 8 + wave; n < NTOK; n += nb * 8) {
    const int b = n / LT, pos = n - b * LT;
    if (last && pos < LC) continue;
    float hv[16];
    {
      uint4 h0 = *(const uint4*)(H + (size_t)n * DM + lane * 16);
      uint4 h1 = *(const uint4*)(H + (size_t)n * DM + lane * 16 + 8);
      unpack8(h0, hv); unpack8(h1, hv + 8);
    }
    const int id_lo = EI[(size_t)n * 128 + lane], id_hi = EI[(size_t)n * 128 + 64 + lane];
    const float g_lo = EG[(size_t)n * 128 + lane], g_hi = EG[(size_t)n * 128 + 64 + lane];
    const float us_lo = US[id_lo], us_hi = US[id_hi], vs_lo = VS[id_lo], vs_hi = VS[id_hi];
    float act_lo = 0.f, act_hi = 0.f;
#pragma unroll 1
    for (int half = 0; half < 2; half++) {
      const int idv = half ? id_hi : id_lo;
      float actv = 0.f;
#pragma unroll 8
      for (int e = 0; e < 64; e++) {
        const int id = __builtin_amdgcn_readlane(idv, e);
        const uint4 w = *(const uint4*)(UB + (size_t)id * 1024 + lane * 16);
        float uv[16];
        cvt16_fp8(w, uv);
        float d0 = 0.f, d1 = 0.f;
#pragma unroll
        for (int j = 0; j < 8; j++) { d0 += hv[j] * uv[j]; d1 += hv[8 + j] * uv[8 + j]; }
        const float dsum = wave_sum_dpp(d0 + d1, lane);
        if (lane == e) actv = dsum;
      }
      if (half) act_hi = actv; else act_lo = actv;
    }
    act_lo *= us_lo; act_hi *= us_hi;
    const float cf_lo = g_lo * 0.5f * act_lo * (1.f + erff(act_lo * 0.70710678f)) * vs_lo;
    const float cf_hi = g_hi * 0.5f * act_hi * (1.f + erff(act_hi * 0.70710678f)) * vs_hi;
    float acc[16];
#pragma unroll
    for (int j = 0; j < 16; j++) acc[j] = 0.f;
#pragma unroll 1
    for (int half = 0; half < 2; half++) {
      const int idv = half ? id_hi : id_lo;
      const float cfv = half ? cf_hi : cf_lo;
#pragma unroll 8
      for (int e = 0; e < 64; e++) {
        const int id = __builtin_amdgcn_readlane(idv, e);
        const float cf = __builtin_bit_cast(float, __builtin_amdgcn_readlane(__builtin_bit_cast(int, cfv), e));
        const uint4 w = *(const uint4*)(VB + (size_t)id * 1024 + lane * 16);
        float uv[16];
        cvt16_fp8(w, uv);
#pragma unroll
        for (int j = 0; j < 16; j++) acc[j] += cf * uv[j];
      }
    }
    const int rr = pos < LC ? 8 : b;
    const float* gate = mod + (size_t)(layer * 9 + rr) * 6144 + 5 * 1024 + lane * 16;
    const float* xr = X + (size_t)n * DM + lane * 16;
    float xo[16];
#pragma unroll
    for (int q = 0; q < 4; q++) {
      float4 x0 = *(const float4*)(xr + q * 4), g0 = *(const float4*)(gate + q * 4);
      xo[q * 4 + 0] = x0.x + g0.x * acc[q * 4 + 0]; xo[q * 4 + 1] = x0.y + g0.y * acc[q * 4 + 1];
      xo[q * 4 + 2] = x0.z + g0.z * acc[q * 4 + 2]; xo[q * 4 + 3] = x0.w + g0.w * acc[q * 4 + 3];
    }
    if (last) {
      float* orow = p.out + ((size_t)(b * SEQ + pos - LC)) * DM + lane * 16;
#pragma unroll
      for (int q = 0; q < 4; q++) *(float4*)(orow + q * 4) = make_float4(xo[q * 4], xo[q * 4 + 1], xo[q * 4 + 2], xo[q * 4 + 3]);
    } else {
      float ss = 0.f;
#pragma unroll
      for (int j = 0; j < 16; j++) ss += xo[j] * xo[j];
      ss = wave_sum(ss);
      const float rs = rsqrtf(ss * (1.f / 1024.f) + 1e-6f);
      const float* g = p.n1g + (layer + 1) * 1024 + lane * 16;
      const float* msc = mod + (size_t)((layer + 1) * 9 + rr) * 6144 + 1 * 1024 + lane * 16;
      const float* msh = mod + (size_t)((layer + 1) * 9 + rr) * 6144 + lane * 16;
      float* xw = Xw + (size_t)n * DM + lane * 16;
#pragma unroll
      for (int q = 0; q < 4; q++) *(float4*)(xw + q * 4) = make_float4(xo[q * 4], xo[q * 4 + 1], xo[q * 4 + 2], xo[q * 4 + 3]);
      float y[16];
#pragma unroll
      for (int j = 0; j < 16; j++) y[j] = xo[j] * rs * g[j] * (1.f + msc[j]) + msh[j];
      *(uint4*)(Hw + (size_t)n * DM + lane * 16) = pack8(y);
      *(uint4*)(Hw + (size_t)n * DM + lane * 16 + 8) = pack8(y + 8);
    }
  }
}

DI void conv_phase(const int TIDX, const P& p, int bid, int nb) {
  char* big = p.ws + OFF_BIG;
  const bf16_t* ZX = (const bf16_t*)(big + B_ZX);
  bf16_t* XBC = (bf16_t*)(big + B_XBC);
  const int total = NTOK * 384;
  for (int it = bid * NTHR + TIDX; it < total; it += nb * NTHR) {
    const int n = it / 384, c8 = (it - n * 384) * 8;
    const int b = n / LT, pos = n - b * LT;
    const bool hasp = (pos != 0 && pos != LC), hasn = (pos != LC - 1 && pos != LT - 1);
    const bf16_t* zc = ZX + (size_t)n * 3072 + c8;
    uint4 cu = *(const uint4*)zc, pu = make_uint4(0, 0, 0, 0), nu = make_uint4(0, 0, 0, 0);
    if (hasp) pu = *(const uint4*)(zc - 3072);
    if (hasn) nu = *(const uint4*)(zc + 3072);
    float cv[8], pv[8], nv[8], y[8];
    unpack8(cu, cv); unpack8(pu, pv); unpack8(nu, nv);
#pragma unroll
    for (int j = 0; j < 8; j++) {
      float a = p.conv_b[c8 + j] + p.conv_w[c8 + j] * pv[j] + p.conv_w[3072 + c8 + j] * cv[j] + p.conv_w[6144 + c8 + j] * nv[j];
      y[j] = siluf_(a);
    }
    *(uint4*)(XBC + (size_t)n * 3072 + c8) = pack8(y);
  }
}

DI void ssd_task(const int TIDX, const P& p, int task, char* smem) {
  char* big = p.ws + OFF_BIG;
  const int b = task >> 5, h = task & 31, g = h >> 3;
  bf16_t* Cs = (bf16_t*)smem;
  bf16_t* Bs = Cs + 128 * 136;
  bf16_t* BT = Bs + 128 * 136;
  bf16_t* xT = BT + 128 * 136;
  bf16_t* sb = xT + 64 * 136;
  float* cum = (float*)(sb + 64 * 136);
  float* dtv = cum + 128;
  const bf16_t* XBC = (const bf16_t*)(big + B_XBC);
  const float* DT = (const float*)(big + B_DT);
  bf16_t* Y = (bf16_t*)(big + B_Y);
  const int tid = TIDX, lane = tid & 63, wave = tid >> 6;
  const int r = lane & 31, h8 = lane >> 5;
  const float dskip = p.ssd_d[h];
  for (int d = 0; d < 2; d++) {
    const float a = -expf(p.a_log[d * 32 + h]);
    const float bias = p.dt_bias[d * 32 + h];
    f32x16 sacc;
#pragma unroll
    for (int q = 0; q < 16; q++) sacc[q] = 0.f;
    __syncthreads();
    for (int e = tid; e < 64 * 136; e += NTHR) sb[e] = 0;
    for (int c = 0; c < 18; c++) {
      __syncthreads();
      if (wave == 0) {
        const int i0 = lane * 2, i1 = i0 + 1;
        const int p0 = scanpos(d, c * 128 + i0), p1 = scanpos(d, c * 128 + i1);
        const float dt0 = softplusf_(DT[(size_t)(b * LT + p0) * 64 + d * 32 + h] + bias);
        const float dt1 = softplusf_(DT[(size_t)(b * LT + p1) * 64 + d * 32 + h] + bias);
        const float a0 = a * dt0, a1 = a0 + a * dt1;
        float tot = a1;
#pragma unroll
        for (int off = 1; off < 64; off <<= 1) {
          float t = shup_(tot, off, lane);
          if (lane >= off) tot += t;
        }
        const float excl = tot - a1;
        cum[i0] = excl + a0; cum[i1] = excl + a1;
        dtv[i0] = dt0; dtv[i1] = dt1;
      }
      __syncthreads();
      const float cl = cum[127];
      {
        const int j = tid >> 2, part = tid & 3;
        const int pos = scanpos(d, c * 128 + j);
        const bf16_t* rowp = XBC + (size_t)(b * LT + pos) * 3072;
        const float wj = __expf(cl - cum[j]) * dtv[j];
#pragma unroll
        for (int q = 0; q < 4; q++) {
          const int col = part * 32 + q * 8;
          uint4 cvv = *(const uint4*)(rowp + 2560 + g * 128 + col);
          *(uint4*)(Cs + j * 136 + col) = cvv;
          uint4 bvv = *(const uint4*)(rowp + 2048 + g * 128 + col);
          *(uint4*)(Bs + j * 136 + col) = bvv;
          float bf[8]; unpack8(bvv, bf);
#pragma unroll
          for (int e = 0; e < 8; e++) BT[(col + e) * 136 + j] = f2bf(bf[e] * wj);
        }
#pragma unroll
        for (int q = 0; q < 2; q++) {
          const int col = part * 16 + q * 8;
          uint4 xv = *(const uint4*)(rowp + h * 64 + col);
          const bf16_t* xe = (const bf16_t*)&xv;
#pragma unroll
          for (int e = 0; e < 8; e++) xT[(col + e) * 136 + j] = xe[e];
        }
      }
      __syncthreads();
      const int it = wave >> 1;
      f32x16 G0, G1;
#pragma unroll
      for (int q = 0; q < 16; q++) { G0[q] = 0.f; G1[q] = 0.f; }
      {
        const int jt0 = (wave & 1) * 2, jt1 = jt0 + 1;
        if (jt0 <= it) {
#pragma unroll
          for (int ks = 0; ks < 8; ks++) {
            bf16x8 av = *(const bf16x8*)(Cs + (it * 32 + r) * 136 + ks * 16 + h8 * 8);
            bf16x8 b0 = *(const bf16x8*)(Bs + (jt0 * 32 + r) * 136 + ks * 16 + h8 * 8);
            G0 = __builtin_amdgcn_mfma_f32_32x32x16_bf16(av, b0, G0, 0, 0, 0);
            if (jt1 <= it) {
              bf16x8 b1 = *(const bf16x8*)(Bs + (jt1 * 32 + r) * 136 + ks * 16 + h8 * 8);
              G1 = __builtin_amdgcn_mfma_f32_32x32x16_bf16(av, b1, G1, 0, 0, 0);
            }
          }
        }
      }
      __syncthreads();
      {
        bf16_t* Ms = Bs;
        const int jt0 = (wave & 1) * 2;
        const int j0 = jt0 * 32 + r, j1 = j0 + 32;
        const float cj0 = cum[j0], cj1 = cum[j1], dj0 = dtv[j0], dj1 = dtv[j1];
#pragma unroll
        for (int q = 0; q < 16; q++) {
          const int i = it * 32 + (q & 3) + 8 * (q >> 2) + 4 * h8;
          const float ci = cum[i];
          float m0 = (j0 <= i) ? G0[q] * __expf(ci - cj0) * dj0 : 0.f;
          float m1 = (j1 <= i) ? G1[q] * __expf(ci - cj1) * dj1 : 0.f;
          Ms[i * 136 + j0] = f2bf(m0);
          Ms[i * 136 + j1] = f2bf(m1);
        }
      }
      __syncthreads();
      {
        const bf16_t* Ms = Bs;
        const int pt = wave & 1;
        f32x16 yd, yo;
#pragma unroll
        for (int q = 0; q < 16; q++) { yd[q] = 0.f; yo[q] = 0.f; }
#pragma unroll
        for (int ks = 0; ks < 8; ks++) {
          if (ks < (it + 1) * 2) {
            bf16x8 av = *(const bf16x8*)(Ms + (it * 32 + r) * 136 + ks * 16 + h8 * 8);
            bf16x8 bv = *(const bf16x8*)(xT + (pt * 32 + r) * 136 + ks * 16 + h8 * 8);
            yd = __builtin_amdgcn_mfma_f32_32x32x16_bf16(av, bv, yd, 0, 0, 0);
          }
          bf16x8 cv = *(const bf16x8*)(Cs + (it * 32 + r) * 136 + ks * 16 + h8 * 8);
          bf16x8 sv = *(const bf16x8*)(sb + (pt * 32 + r) * 136 + ks * 16 + h8 * 8);
          yo = __builtin_amdgcn_mfma_f32_32x32x16_bf16(cv, sv, yo, 0, 0, 0);
        }
        if (c >= 2) {
          const int pp = pt * 32 + r;
#pragma unroll
          for (int q = 0; q < 16; q++) {
            const int i = it * 32 + (q & 3) + 8 * (q >> 2) + 4 * h8;
            float y = yd[q] + __expf(cum[i]) * yo[q];
            const int pos = scanpos(d, c * 128 + i);
            const size_t idx = (size_t)(b * LT + pos) * 2048 + h * 64 + pp;
            if (d == 0) y += dskip * bf2f(xT[pp * 136 + i]);
            else y += bf2f(Y[idx]);
            Y[idx] = f2bf(y);
          }
        }
      }
      __syncthreads();
      {
        const int pt = wave & 1, nt = wave >> 1;
        const float ecl = __expf(cl);
#pragma unroll
        for (int q = 0; q < 16; q++) sacc[q] *= ecl;
#pragma unroll
        for (int ks = 0; ks < 8; ks++) {
          bf16x8 av = *(const bf16x8*)(xT + (pt * 32 + r) * 136 + ks * 16 + h8 * 8);
          bf16x8 bv = *(const bf16x8*)(BT + (nt * 32 + r) * 136 + ks * 16 + h8 * 8);
          sacc = __builtin_amdgcn_mfma_f32_32x32x16_bf16(av, bv, sacc, 0, 0, 0);
        }
#pragma unroll
        for (int q = 0; q < 16; q++) {
          const int pp = pt * 32 + (q & 3) + 8 * (q >> 2) + 4 * h8;
          sb[pp * 136 + nt * 32 + r] = f2bf(sacc[q]);
        }
      }
    }
  }
}

DI void gate_norm(const int TIDX, const P& p, int bid, int nb) {
  char* big = p.ws + OFF_BIG;
  const bf16_t* Y = (const bf16_t*)(big + B_Y);
  const bf16_t* ZG = (const bf16_t*)(big + B_ZG);
  bf16_t* YN = (bf16_t*)(big + B_YN);
  const int lane = TIDX & 63, wave = TIDX >> 6;
  for (int n = bid * 8 + wave; n < NTOK; n += nb * 8) {
    const int b = n / LT, pos = n - b * LT;
    if (pos < LC) continue;
#pragma unroll
    for (int gq = 0; gq < 4; gq++) {
      const int base = gq * 512 + lane * 8;
      uint4 yv = *(const uint4*)(Y + (size_t)n * 2048 + base);
      uint4 zv = *(const uint4*)(ZG + (size_t)n * 2048 + base);
      float y[8], z[8];
      unpack8(yv, y); unpack8(zv, z);
      float ss = 0.f;
#pragma unroll
      for (int j = 0; j < 8; j++) { y[j] = y[j] * siluf_(z[j]); ss += y[j] * y[j]; }
      ss = wave_sum(ss);
      const float rs = rsqrtf(ss * (1.f / 512.f) + 1e-6f);
#pragma unroll
      for (int j = 0; j < 8; j++) y[j] = y[j] * rs * p.ssd_nw[base + j];
      *(uint4*)(YN + (size_t)n * 2048 + base) = pack8(y);
    }
  }
}

DI void run_phase(const int TIDX, const P& p, int ph, int bid, int nb, char* smem, const bool dry = false) {
  char* ws = p.ws;
  char* big = ws + OFF_BIG;
  float* X = (float*)(ws + OFF_X);
  const float* mod = (const float*)(ws + OFF_MOD);
  bf16_t* H = (bf16_t*)(ws + OFF_H);
  switch (ph) {
    case 0: {
      mod_gemv(TIDX, p, bid, nb, smem);
      tconv(TIDX, p.ev_w_in, 2560, 1024, 2560, (bf16_t*)(ws + OFF_WIN0), 1024, 0, bid, nb, smem);
      tconv(TIDX, p.ev_w_out, 1024, 1024, 1024, (bf16_t*)(ws + OFF_WOUT0), 1024, 0, bid, nb, smem);
      tconv(TIDX, p.ssd_w_in, 5184, 1024, 5184, (bf16_t*)(ws + OFF_WIN1), 1024, 0, bid, nb, smem);
      tconv(TIDX, p.ssd_w_out, 1024, 2048, 1024, (bf16_t*)(ws + OFF_WOUT1), 2048, 0, bid, nb, smem);
      tconv(TIDX, p.pwq, 2048, 1024, 2048, (bf16_t*)(ws + OFF_WQ), 1024, 0, bid, nb, smem);
      tconv(TIDX, p.pwq + 1024 * 2048, 2048, 1024, 2048, (bf16_t*)(ws + OFF_WQ) + 2048 * 1024, 1024, 0, bid, nb, smem);
      tconv(TIDX, p.w2, 512, 64, 512, (bf16_t*)(ws + OFF_W2C), 64, 0, bid, nb, smem);
      tconv(TIDX, p.w2 + 64 * 512, 512, 64, 512, (bf16_t*)(ws + OFF_W2C) + 512 * 64, 64, 0, bid, nb, smem);
      tconv(TIDX, p.a2, 512, 64, 512, (bf16_t*)(ws + OFF_A2C), 64, 0, bid, nb, smem);
      tconv(TIDX, p.a2 + 64 * 512, 512, 64, 512, (bf16_t*)(ws + OFF_A2C) + 512 * 64, 64, 0, bid, nb, smem);
      tconv(TIDX, p.g2, 512, 128, 512, (bf16_t*)(ws + OFF_G2T), 128, 0, bid, nb, smem);
      conv_flat(TIDX, p.pkeys, (bf16_t*)(ws + OFF_KEYS), (size_t)2 * 16 * 128 * 128, bid, nb);
      conv_fp8(TIDX, p.pu, (unsigned char*)(ws + OFF_UB), (float*)(ws + OFF_UB + 16777216), bid, nb);
      conv_fp8(TIDX, p.pv, (unsigned char*)(ws + OFF_VB), (float*)(ws + OFF_VB + 16777216), bid, nb);
    } break;
    case 1: norm_rows(TIDX, p, 0, 0, true, false, bid, nb); break;
    case 2: {
      bf16_t* Z = (bf16_t*)(big + B_Z0);
      auto epi = [=](int m, int n, const float* v) { *(uint4*)(Z + (size_t)m * 2560 + n) = pack8(v); };
      for (int t = bid; t < 72 * 20; t += nb) {
        int mt = t / 20, nt = t % 20;
        gemm_tile(TIDX, H, 1024, (const bf16_t*)(ws + OFF_WIN0), 1024, 1024, mt * 256, nt * 128, epi, smem);
      }
    } break;
    case 3: prep0(TIDX, p, bid, nb); break;
    case 4: {
      float* DEC = (float*)(big + B_DEC);
      bf16_t* AL = (bf16_t*)(big + B_AL);
      bf16_t* G = (bf16_t*)(big + B_G);
      const float* w0 = p.w0; const float* a0 = p.a0;
      auto epi1 = [=](int m, int n, const float* v) {
        int d = n >> 9, c = n & 511, hh = c >> 6, i = c & 63;
        int b = m / LT, pos = m - b * LT;
        float o[8];
#pragma unroll
        for (int j = 0; j < 8; j++) {
          float x = w0[n + j] + v[j];
          float w = -softplusf_(-x) - 0.5f;
          o[j] = __expf(-__expf(w));
        }
        float* dp = DEC + (size_t)d * (NB * 8 * LT * 64) + ((size_t)(b * 8 + hh) * LT + pos) * 64 + i;
        *(float4*)dp = make_float4(o[0], o[1], o[2], o[3]);
        *(float4*)(dp + 4) = make_float4(o[4], o[5], o[6], o[7]);
      };
      auto epi2 = [=](int m, int n, const float* v) {
        int d = n >> 9, c = n & 511, hh = c >> 6, i = c & 63;
        int b = m / LT, pos = m - b * LT;
        float o[8];
#pragma unroll
        for (int j = 0; j < 8; j++) o[j] = sigmoidf_(a0[n + j] + v[j]);
        *(uint4*)(AL + (size_t)d * (NB * 8 * LT * 64) + ((size_t)(b * 8 + hh) * LT + pos) * 64 + i) = pack8(o);
      };
      auto epi3 = [=](int m, int n, const float* v) { *(uint4*)(G + (size_t)m * 512 + n) = pack8(v); };
      for (int t = bid; t < 1440; t += nb) {
        if (t < 576) {
          gemm_tile(TIDX, (const bf16_t*)(big + B_AW), 64, (const bf16_t*)(ws + OFF_W2C), 64, 64, (t >> 3) * 256, (t & 7) * 128, epi1, smem);
        } else if (t < 1152) {
          int t2 = t - 576;
          gemm_tile(TIDX, (const bf16_t*)(big + B_AA), 64, (const bf16_t*)(ws + OFF_A2C), 64, 64, (t2 >> 3) * 256, (t2 & 7) * 128, epi2, smem);
        } else {
          int t2 = t - 1152;
          gemm_tile(TIDX, (const bf16_t*)(big + B_AG), 128, (const bf16_t*)(ws + OFF_G2T), 128, 128, (t2 >> 2) * 256, (t2 & 3) * 128, epi3, smem);
        }
      }
    } break;
    case 5: {
      for (int t = bid; t < 256; t += nb) wkv2_task(TIDX, p, t, smem);
      for (int t = bid; t < 576; t += nb) attn_task(TIDX, p, t, smem);
    } break;
    case 22: wkv_finalize(TIDX, p, bid, nb); break;
    case 23: for (int t = bid; t < 256; t += nb) wkv2_task(TIDX, p, t, smem); break;
    case 24: for (int t = bid; t < 576; t += nb) attn_task(TIDX, p, t, smem); break;
    case 6: {
      const float* gate = mod;
      const float* xc_ = p.ctx; const float* xl_ = p.x;
      auto epi = [=](int m, int n, const float* v) {
        int b = m / LT, pos = m - b * LT;
        int rr = pos < LC ? 8 : b;
        const float* xr = (pos < LC ? xc_ + ((size_t)(b * LC + pos)) * DM : xl_ + ((size_t)(b * SEQ + pos - LC)) * DM) + n;
        const float* gp = gate + (size_t)rr * 6144 + 2 * 1024 + n;
        const float4 x0 = *(const float4*)xr, x1 = *(const float4*)(xr + 4), g0 = *(const float4*)gp, g1 = *(const float4*)(gp + 4);
        float* xo = X + (size_t)m * DM + n;
        *(float4*)xo = make_float4(x0.x + g0.x * v[0], x0.y + g0.y * v[1], x0.z + g0.z * v[2], x0.w + g0.w * v[3]);
        *(float4*)(xo + 4) = make_float4(x1.x + g1.x * v[4], x1.y + g1.y * v[5], x1.z + g1.z * v[6], x1.w + g1.w * v[7]);
      };
      for (int t = bid; t < 72 * 8; t += nb)
        gemm_tile(TIDX, (const bf16_t*)(big + B_YMIX), 1024, (const bf16_t*)(ws + OFF_WOUT0), 1024, 1024, (t >> 3) * 256, (t & 7) * 128, epi, smem);
    } break;
    case 7: norm_rows(TIDX, p, 0, 1, false, false, bid, nb); break;
    case 8: {
      bf16_t* QP = (bf16_t*)(big + B_QP);
      auto epi = [=](int m, int n, const float* v) { *(uint4*)(QP + (size_t)m * 2048 + n) = pack8(v); };
      for (int t = bid; t < 72 * 16; t += nb)
        gemm_tile(TIDX, H, 1024, (const bf16_t*)(ws + OFF_WQ), 1024, 1024, (t >> 4) * 256, (t & 15) * 128, epi, smem);
    } break;
    case 9: break;
    case 10:
      for (int t = bid; t < 72 * 8; t += nb) route2_task(TIDX, p, 0, (t >> 3) * 256, t & 7, smem);
      break;
    case 11: peer_gather(TIDX, p, 0, false, bid, nb, dry); break;
    case 12: {
      bf16_t* ZG = (bf16_t*)(big + B_ZG);
      bf16_t* ZX = (bf16_t*)(big + B_ZX);
      float* DT = (float*)(big + B_DT);
      auto epi = [=](int m, int n, const float* v) {
        if (n < 2048) *(uint4*)(ZG + (size_t)m * 2048 + n) = pack8(v);
        else if (n < 5120) *(uint4*)(ZX + (size_t)m * 3072 + n - 2048) = pack8(v);
        else if (n < 5184) {
          float* dp = DT + (size_t)m * 64 + n - 5120;
          *(float4*)dp = make_float4(v[0], v[1], v[2], v[3]);
          *(float4*)(dp + 4) = make_float4(v[4], v[5], v[6], v[7]);
        }
      };
      for (int t = bid; t < 72 * 41; t += nb) {
        int mt = t / 41, nt = t % 41;
        gemm_tile(TIDX, H, 1024, (const bf16_t*)(ws + OFF_WIN1), 1024, 1024, mt * 256, nt * 128, epi, smem);
      }
    } break;
    case 13: {
      conv_phase(TIDX, p, bid, nb);
      conv_fp8(TIDX, p.pu + (size_t)16384 * 1024, (unsigned char*)(ws + OFF_UB), (float*)(ws + OFF_UB + 16777216), bid, nb);
      conv_fp8(TIDX, p.pv + (size_t)16384 * 1024, (unsigned char*)(ws + OFF_VB), (float*)(ws + OFF_VB + 16777216), bid, nb);
    } break;
    case 14:
      for (int t = bid; t < 256; t += nb) ssd_task(TIDX, p, t, smem);
      break;
    case 15: gate_norm(TIDX, p, bid, nb); break;
    case 16: {
      const float* gate = mod + (size_t)9 * 6144;
      auto epi = [=](int m, int n, const float* v) {
        int b = m / LT;
        const float* gp = gate + (size_t)b * 6144 + 2 * 1024 + n;
        const float4 g0 = *(const float4*)gp, g1 = *(const float4*)(gp + 4);
        float* xo = X + (size_t)m * DM + n;
        const float4 x0 = *(const float4*)xo, x1 = *(const float4*)(xo + 4);
        *(float4*)xo = make_float4(x0.x + g0.x * v[0], x0.y + g0.y * v[1], x0.z + g0.z * v[2], x0.w + g0.w * v[3]);
        *(float4*)(xo + 4) = make_float4(x1.x + g1.x * v[4], x1.y + g1.y * v[5], x1.z + g1.z * v[6], x1.w + g1.w * v[7]);
      };
      for (int t = bid; t < 64 * 8; t += nb) {
        int mtl = t >> 3, b = mtl >> 3, mt = b * 9 + 1 + (mtl & 7);
        gemm_tile(TIDX, (const bf16_t*)(big + B_YN), 2048, (const bf16_t*)(ws + OFF_WOUT1), 2048, 2048, mt * 256, (t & 7) * 128, epi, smem);
      }
    } break;
    case 17: norm_rows(TIDX, p, 1, 1, false, true, bid, nb); break;
    case 18: {
      bf16_t* QP = (bf16_t*)(big + B_QP);
      auto epi = [=](int m, int n, const float* v) { *(uint4*)(QP + (size_t)m * 2048 + n) = pack8(v); };
      for (int t = bid; t < 64 * 16; t += nb) {
        int mtl = t >> 4, b = mtl >> 3, mt = b * 9 + 1 + (mtl & 7);
        gemm_tile(TIDX, H, 1024, (const bf16_t*)(ws + OFF_WQ) + 2048 * 1024, 1024, 1024, mt * 256, (t & 15) * 128, epi, smem);
      }
    } break;
    case 19: break;
    case 20:
      for (int t = bid; t < 64 * 8; t += nb) {
        int mtl = t >> 3, b = mtl >> 3, mt = b * 9 + 1 + (mtl & 7);
        route2_task(TIDX, p, 1, mt * 256, t & 7, smem);
      }
      break;
    case 21: peer_gather(TIDX, p, 1, true, bid, nb, false); break;
  }
}
constexpr int NPHASE = 22;
#ifndef EXTRA
#define EXTRA
#endif
#ifndef DUP_MASK
#define DUP_MASK 0u
#endif

__global__ void __launch_bounds__(NTHR) mega(P p) {
  __shared__ __attribute__((aligned(16))) char smem[SMEM_BYTES];
  cg::grid_group grid = cg::this_grid();
#define PHC(i, last)                                             \
  {                                                              \
    P q = p;                                                     \
    int bid = blockIdx.x, nb = gridDim.x;                        \
    char* sm = smem;                                             \
    int TIDX = __builtin_amdgcn_workitem_id_x();                 \
    asm volatile("" : "+s"(q.ws), "+s"(bid), "+s"(nb), "+v"(TIDX)); \
    if ((DUP_MASK >> i) & 1) { run_phase(TIDX, q, i, bid, nb, sm, true); grid.sync(); } \
    run_phase(TIDX, q, i, bid, nb, sm);                          \
    if (!last) grid.sync();                                      \
  }
  PHC(0, 0) PHC(1, 0) PHC(2, 0) PHC(3, 0) PHC(4, 0) PHC(5, 0) EXTRA PHC(22, 0) PHC(6, 0) PHC(7, 0) PHC(8, 0) PHC(10, 0)
  PHC(11, 0) PHC(12, 0) PHC(13, 0) PHC(14, 0) PHC(15, 0) PHC(16, 0) PHC(17, 0) PHC(18, 0) PHC(20, 0) PHC(21, 1)
}

extern "C" void kernel_launch(void* const* d_in, const int* in_sizes, int n_in, void* d_out, int out_size, void* d_ws,
                              size_t ws_size, hipStream_t stream) {
  static int grid_blocks = 0;
  if (!grid_blocks) {
    int dev = 0, cus = 0, per_cu = 0;
    hipGetDevice(&dev);
    hipDeviceGetAttribute(&cus, hipDeviceAttributeMultiprocessorCount, dev);
    hipOccupancyMaxActiveBlocksPerMultiprocessor(&per_cu, mega, NTHR, 0);
    if (per_cu < 1) per_cu = 1;
    grid_blocks = cus * per_cu;
  }
  P p;
  memset(&p, 0, sizeof(p));
  const float** fp = (const float**)&p;
  for (int i = 0; i < 35; i++) fp[i] = (const float*)d_in[i];
  p.out = (float*)d_out;
  p.ws = (char*)d_ws;
  if (ws_size < WS_NEED) fprintf(stderr, "workspace too small: %zu < %zu\n", ws_size, (size_t)WS_NEED);
  void* args[] = {&p};
  hipError_t e = hipLaunchCooperativeKernel((void*)mega, dim3(grid_blocks), dim3(NTHR), args, 0, stream);
  if (e != hipSuccess) fprintf(stderr, "cooperative launch failed: %s (grid %d)\n", hipGetErrorString(e), grid_blocks);
}
```

```cpp
#include <hip/hip_runtime.h>
#include <hip/hip_cooperative_groups.h>
#include <stdint.h>
#include <string.h>
#include <stdio.h>
namespace cg = cooperative_groups;

#define DI __device__ __forceinline__
typedef unsigned short bf16_t;
typedef short bf16x8 __attribute__((ext_vector_type(8)));
typedef float f32x16 __attribute__((ext_vector_type(16)));

constexpr int NB = 8, SEQ = 2048, LC = 256, LT = 2304, NTOK = 18432, DM = 1024;
constexpr int NTHR = 512;

constexpr size_t OFF_UB = 0;
constexpr size_t OFF_VB = OFF_UB + 33554432;
constexpr size_t OFF_WIN0 = OFF_VB + 33554432;
constexpr size_t OFF_WOUT0 = OFF_WIN0 + 5242880;
constexpr size_t OFF_WIN1 = OFF_WOUT0 + 3145728;
constexpr size_t OFF_WOUT1 = OFF_WIN1 + 10747904;
constexpr size_t OFF_WQ = OFF_WOUT1 + 4194304;
constexpr size_t OFF_KEYS = OFF_WQ + 8388608;
constexpr size_t OFF_W2C = OFF_KEYS + 1048576;
constexpr size_t OFF_A2C = OFF_W2C + 131072;
constexpr size_t OFF_G2T = OFF_A2C + 131072;
constexpr size_t OFF_MOD = OFF_G2T + 131072;
constexpr size_t OFF_X = OFF_MOD + 442368;
constexpr size_t OFF_H = OFF_X + 75497472;
constexpr size_t OFF_BIG = OFF_H + 37748736;
constexpr size_t B_Z0 = 0;
constexpr size_t B_DEC = 0;
constexpr size_t B_G = 75497472;
constexpr size_t B_QN = 94371840;
constexpr size_t B_KN = B_QN + 18874368;
constexpr size_t B_VT = B_KN + 4718592;
constexpr size_t B_R = B_VT + 4718592;
constexpr size_t B_KB = B_R + 18874368;
constexpr size_t B_KK = B_KB + 18874368;
constexpr size_t B_V = B_KK + 18874368;
constexpr size_t B_AL = B_V + 18874368;
constexpr size_t B_AW = B_AL + 37748736;
constexpr size_t B_AA = B_AW + 2359296;
constexpr size_t B_AG = B_AA + 2359296;
constexpr size_t B_YMIX = B_AW;
constexpr size_t B_OUT = B_YMIX + 37748736;
constexpr size_t B_L0END = B_OUT + 37748736;
constexpr size_t OFF_BON = OFF_UB + 16777216 + 1048576;
constexpr size_t B_QP = 0;
constexpr size_t B_S = 75497472;
constexpr size_t B_EI = B_S + 150994944;
constexpr size_t B_EG = B_EI + 9437184;
constexpr size_t B_PEND = B_EG + 9437184;
constexpr size_t B_ZG = 0;
constexpr size_t B_ZX = 75497472;
constexpr size_t B_Y = B_ZX;
constexpr size_t B_DT = B_ZX + 113246208;
constexpr size_t B_XBC = B_DT + 4718592;
constexpr size_t B_YN = B_XBC;
constexpr size_t B_L1END = B_XBC + 113246208;
constexpr size_t BIG_SZ = B_L1END > B_L0END ? (B_L1END > B_PEND ? B_L1END : B_PEND) : (B_L0END > B_PEND ? B_L0END : B_PEND);
constexpr size_t WS_NEED = OFF_BIG + BIG_SZ;
static_assert(WS_NEED <= 536870912, "workspace too large");

constexpr int SMEM_BYTES = 157696;

struct P {
  const float *x, *c, *ctx, *c_ctx, *mod_w, *mod_b, *n1g, *n2g, *ev_w_in, *ev_w_out, *qg, *kg, *mu, *w0, *w2, *a0, *a2, *g2,
      *k_k, *k_a, *r_k, *gn_w, *gn_b, *ssd_w_in, *conv_w, *conv_b, *dt_bias, *a_log, *ssd_d, *ssd_nw, *ssd_w_out, *pwq, *pkeys,
      *pu, *pv;
  float* out;
  char* ws;
};

typedef float f32x2 __attribute__((ext_vector_type(2)));
typedef __bf16 bf16x2_t __attribute__((ext_vector_type(2)));
DI bf16_t f2bf(float f) { return __builtin_bit_cast(bf16_t, (__bf16)f); }
DI float bf2f(bf16_t b) { return __uint_as_float(((unsigned)b) << 16); }
DI unsigned pack2(float a, float b) {
  f32x2 f = {a, b};
  return __builtin_bit_cast(unsigned, __builtin_convertvector(f, bf16x2_t));
}
DI float lo2f(unsigned u) { return __uint_as_float(u << 16); }
DI float hi2f(unsigned u) { return __uint_as_float(u & 0xffff0000u); }
DI void unpack8(const uint4& r, float* v) {
  v[0] = lo2f(r.x); v[1] = hi2f(r.x); v[2] = lo2f(r.y); v[3] = hi2f(r.y);
  v[4] = lo2f(r.z); v[5] = hi2f(r.z); v[6] = lo2f(r.w); v[7] = hi2f(r.w);
}
DI uint4 pack8(const float* v) {
  uint4 r; r.x = pack2(v[0], v[1]); r.y = pack2(v[2], v[3]); r.z = pack2(v[4], v[5]); r.w = pack2(v[6], v[7]);
  return r;
}
DI float shx_(float v, int off, int lane) {
  return __builtin_bit_cast(float, __builtin_amdgcn_ds_bpermute((lane ^ off) << 2, __builtin_bit_cast(int, v)));
}
DI float shup_(float v, int off, int lane) {
  return __builtin_bit_cast(float, __builtin_amdgcn_ds_bpermute((lane - off) << 2, __builtin_bit_cast(int, v)));
}
#define SHX(v, o) shx_((v), (o), lane)
DI float wave_sum_(float v, int lane) {
#pragma unroll
  for (int o = 32; o > 0; o >>= 1) v += shx_(v, o, lane);
  return v;
}
#define wave_sum(v) wave_sum_((v), lane)
DI float dpp_f(float v, const int ctrl_sel) {
  int x = __builtin_bit_cast(int, v);
  int y;
  if (ctrl_sel == 0) y = __builtin_amdgcn_mov_dpp(x, 0xB1, 0xF, 0xF, true);
  else if (ctrl_sel == 1) y = __builtin_amdgcn_mov_dpp(x, 0x4E, 0xF, 0xF, true);
  else y = __builtin_amdgcn_mov_dpp(x, 0x141, 0xF, 0xF, true);
  return __builtin_bit_cast(float, y);
}
DI float reduce8(float v) {
  v += dpp_f(v, 0);
  v += dpp_f(v, 1);
  v += dpp_f(v, 2);
  return v;
}
DI float wave_sum_dpp(float v, int lane) {
  v += dpp_f(v, 0);
  v += dpp_f(v, 1);
  v += dpp_f(v, 2);
  v += __builtin_bit_cast(float, __builtin_amdgcn_mov_dpp(__builtin_bit_cast(int, v), 0x140, 0xF, 0xF, true));
  v += shx_(v, 16, lane);
  v += shx_(v, 32, lane);
  return v;
}
DI void cvt16_fp8(const uint4& w, float* f) {
  f32x2 t;
  t = __builtin_amdgcn_cvt_pk_f32_fp8((int)w.x, false); f[0] = t.x; f[1] = t.y;
  t = __builtin_amdgcn_cvt_pk_f32_fp8((int)w.x, true); f[2] = t.x; f[3] = t.y;
  t = __builtin_amdgcn_cvt_pk_f32_fp8((int)w.y, false); f[4] = t.x; f[5] = t.y;
  t = __builtin_amdgcn_cvt_pk_f32_fp8((int)w.y, true); f[6] = t.x; f[7] = t.y;
  t = __builtin_amdgcn_cvt_pk_f32_fp8((int)w.z, false); f[8] = t.x; f[9] = t.y;
  t = __builtin_amdgcn_cvt_pk_f32_fp8((int)w.z, true); f[10] = t.x; f[11] = t.y;
  t = __builtin_amdgcn_cvt_pk_f32_fp8((int)w.w, false); f[12] = t.x; f[13] = t.y;
  t = __builtin_amdgcn_cvt_pk_f32_fp8((int)w.w, true); f[14] = t.x; f[15] = t.y;
}
DI float sigmoidf_(float x) { return __builtin_amdgcn_rcpf(1.f + __expf(-x)); }
DI float siluf_(float x) { return x * __builtin_amdgcn_rcpf(1.f + __expf(-x)); }
DI float softplusf_(float y) { return fmaxf(y, 0.f) + log1pf(__expf(-fabsf(y))); }
DI int scanpos(int d, int pp) { return d ? (pp < LC ? LC - 1 - pp : LT + LC - 1 - pp) : pp; }
DI int rowmod(int n) { int b = n / LT; int pos = n - b * LT; return pos < LC ? 8 : b; }
DI const float* xin_row(const P& p, int n) {
  int b = n / LT, pos = n - b * LT;
  return pos < LC ? p.ctx + ((size_t)(b * LC + pos)) * DM : p.x + ((size_t)(b * SEQ + pos - LC)) * DM;
}

template <class Epi>
DI void gemm_tile(const int TIDX, const bf16_t* __restrict__ A, int lda, const bf16_t* __restrict__ Bt, int ldb, int K, int m0, int n0,
                  Epi epi, char* smem) {
  bf16_t* As = (bf16_t*)smem;
  bf16_t* Bs = As + 2 * 256 * 72;
  const int tid = TIDX, lane = tid & 63, wave = tid >> 6;
  const int wm = wave >> 1, wn = wave & 1;
  const int r = lane & 31, h8 = lane >> 5;
  f32x16 acc[2][2];
#pragma unroll
  for (int i = 0; i < 2; i++)
#pragma unroll
    for (int j = 0; j < 2; j++)
#pragma unroll
      for (int q = 0; q < 16; q++) acc[i][j][q] = 0.f;
  const int lrow = tid >> 3, lch = tid & 7;
  const bf16_t* Ap = A + (size_t)(m0 + lrow) * lda + lch * 8;
  const bf16_t* Bp = Bt + (size_t)(n0 + lrow) * ldb + lch * 8;
  const size_t sa = (size_t)64 * lda, sb_ = (size_t)64 * ldb;
  uint4 ra0 = *(const uint4*)(Ap), ra1 = *(const uint4*)(Ap + sa), ra2 = *(const uint4*)(Ap + 2 * sa), ra3 = *(const uint4*)(Ap + 3 * sa);
  uint4 rb0 = *(const uint4*)(Bp), rb1 = *(const uint4*)(Bp + sb_);
  __syncthreads();
  {
    bf16_t* Aw = As + lrow * 72 + lch * 8;
    bf16_t* Bw = Bs + lrow * 72 + lch * 8;
    *(uint4*)(Aw) = ra0; *(uint4*)(Aw + 64 * 72) = ra1; *(uint4*)(Aw + 128 * 72) = ra2; *(uint4*)(Aw + 192 * 72) = ra3;
    *(uint4*)(Bw) = rb0; *(uint4*)(Bw + 64 * 72) = rb1;
  }
  __syncthreads();
  const int nk = K >> 6;
  for (int kt = 0; kt < nk; kt++) {
    const int cur = kt & 1;
    const bool more = kt + 1 < nk;
    if (more) {
      const bf16_t* Aq = Ap + (kt + 1) * 64;
      const bf16_t* Bq = Bp + (kt + 1) * 64;
      ra0 = *(const uint4*)(Aq); ra1 = *(const uint4*)(Aq + sa); ra2 = *(const uint4*)(Aq + 2 * sa); ra3 = *(const uint4*)(Aq + 3 * sa);
      rb0 = *(const uint4*)(Bq); rb1 = *(const uint4*)(Bq + sb_);
    }
    const bf16_t* Ac = As + cur * 256 * 72 + (wm * 64 + r) * 72 + h8 * 8;
    const bf16_t* Bc = Bs + cur * 128 * 72 + (wn * 64 + r) * 72 + h8 * 8;
#pragma unroll
    for (int ks = 0; ks < 4; ks++) {
      bf16x8 a0 = *(const bf16x8*)(Ac + ks * 16);
      bf16x8 a1 = *(const bf16x8*)(Ac + 32 * 72 + ks * 16);
      bf16x8 b0 = *(const bf16x8*)(Bc + ks * 16);
      bf16x8 b1 = *(const bf16x8*)(Bc + 32 * 72 + ks * 16);
      acc[0][0] = __builtin_amdgcn_mfma_f32_32x32x16_bf16(a0, b0, acc[0][0], 0, 0, 0);
      acc[0][1] = __builtin_amdgcn_mfma_f32_32x32x16_bf16(a0, b1, acc[0][1], 0, 0, 0);
      acc[1][0] = __builtin_amdgcn_mfma_f32_32x32x16_bf16(a1, b0, acc[1][0], 0, 0, 0);
      acc[1][1] = __builtin_amdgcn_mfma_f32_32x32x16_bf16(a1, b1, acc[1][1], 0, 0, 0);
    }
    if (more) {
      const int nx = cur ^ 1;
      bf16_t* Aw = As + nx * 256 * 72 + lrow * 72 + lch * 8;
      bf16_t* Bw = Bs + nx * 128 * 72 + lrow * 72 + lch * 8;
      *(uint4*)(Aw) = ra0; *(uint4*)(Aw + 64 * 72) = ra1; *(uint4*)(Aw + 128 * 72) = ra2; *(uint4*)(Aw + 192 * 72) = ra3;
      *(uint4*)(Bw) = rb0; *(uint4*)(Bw + 64 * 72) = rb1;
    }
    __syncthreads();
  }
  float* Cs = (float*)smem;
#pragma unroll
  for (int mt = 0; mt < 2; mt++)
#pragma unroll
    for (int nt = 0; nt < 2; nt++)
#pragma unroll
      for (int q = 0; q < 16; q++)
        Cs[(wm * 64 + mt * 32 + (q & 3) + 8 * (q >> 2) + 4 * h8) * 132 + wn * 64 + nt * 32 + r] = acc[mt][nt][q];
  __syncthreads();
#pragma unroll
  for (int i = 0; i < 8; i++) {
    const int seg = i * NTHR + tid;
    const int row = seg >> 4, cs = (seg & 15) * 8;
    const float4 c0 = *(const float4*)(Cs + row * 132 + cs), c1 = *(const float4*)(Cs + row * 132 + cs + 4);
    float v[8] = {c0.x, c0.y, c0.z, c0.w, c1.x, c1.y, c1.z, c1.w};
    epi(m0 + row, n0 + cs, v);
  }
}

DI void tconv(const int TIDX, const float* __restrict__ src, int lds_, int K, int N, bf16_t* __restrict__ dst, int ldd, int koff, int bid,
              int nb, char* smem) {
  float* t = (float*)smem;
  const int tn = N >> 6, tk = K >> 6;
  for (int tile = bid; tile < tk * tn; tile += nb) {
    const int k0 = (tile / tn) * 64, n0 = (tile % tn) * 64;
    __syncthreads();
    for (int e = TIDX; e < 4096; e += NTHR) {
      int kk = e >> 6, nn = e & 63;
      t[kk * 65 + nn] = src[(size_t)(k0 + kk) * lds_ + n0 + nn];
    }
    __syncthreads();
    for (int e = TIDX; e < 4096; e += NTHR) {
      int nn = e >> 6, kk = e & 63;
      dst[(size_t)(n0 + nn) * ldd + koff + k0 + kk] = f2bf(t[kk * 65 + nn]);
    }
  }
}
DI void conv_flat(const int TIDX, const float* __restrict__ src, bf16_t* __restrict__ dst, size_t count, int bid, int nb) {
  const size_t n4 = count >> 2;
  for (size_t i = (size_t)bid * NTHR + TIDX; i < n4; i += (size_t)nb * NTHR) {
    float4 v = ((const float4*)src)[i];
    uint2 o; o.x = pack2(v.x, v.y); o.y = pack2(v.z, v.w);
    ((uint2*)dst)[i] = o;
  }
}
DI void conv_fp8(const int TIDX, const float* __restrict__ src, unsigned char* __restrict__ dst, float* __restrict__ scl, int bid, int nb) {
  const int lane = TIDX & 63, wave = TIDX >> 6;
  for (int row = bid * 8 + wave; row < 16384; row += nb * 8) {
    const float* sp = src + (size_t)row * 1024 + lane * 16;
    float4 v0 = *(const float4*)(sp), v1 = *(const float4*)(sp + 4), v2 = *(const float4*)(sp + 8), v3 = *(const float4*)(sp + 12);
    float am = fmaxf(fmaxf(fmaxf(fabsf(v0.x), fabsf(v0.y)), fmaxf(fabsf(v0.z), fabsf(v0.w))),
                     fmaxf(fmaxf(fabsf(v1.x), fabsf(v1.y)), fmaxf(fabsf(v1.z), fabsf(v1.w))));
    am = fmaxf(am, fmaxf(fmaxf(fmaxf(fabsf(v2.x), fabsf(v2.y)), fmaxf(fabsf(v2.z), fabsf(v2.w))),
                         fmaxf(fmaxf(fabsf(v3.x), fabsf(v3.y)), fmaxf(fabsf(v3.z), fabsf(v3.w)))));
#pragma unroll
    for (int o = 32; o > 0; o >>= 1) am = fmaxf(am, shx_(am, o, lane));
    const float sc = am > 0.f ? 224.f / am : 1.f;
    if (lane == 0) scl[row] = am > 0.f ? am * (1.f / 224.f) : 1.f;
    uint4 o;
    int t = 0;
    t = __builtin_amdgcn_cvt_pk_fp8_f32(v0.x * sc, v0.y * sc, t, false); t = __builtin_amdgcn_cvt_pk_fp8_f32(v0.z * sc, v0.w * sc, t, true); o.x = (unsigned)t;
    t = __builtin_amdgcn_cvt_pk_fp8_f32(v1.x * sc, v1.y * sc, t, false); t = __builtin_amdgcn_cvt_pk_fp8_f32(v1.z * sc, v1.w * sc, t, true); o.y = (unsigned)t;
    t = __builtin_amdgcn_cvt_pk_fp8_f32(v2.x * sc, v2.y * sc, t, false); t = __builtin_amdgcn_cvt_pk_fp8_f32(v2.z * sc, v2.w * sc, t, true); o.z = (unsigned)t;
    t = __builtin_amdgcn_cvt_pk_fp8_f32(v3.x * sc, v3.y * sc, t, false); t = __builtin_amdgcn_cvt_pk_fp8_f32(v3.z * sc, v3.w * sc, t, true); o.w = (unsigned)t;
    *(uint4*)(dst + (size_t)row * 1024 + lane * 16) = o;
  }
}
DI void mod_gemv(const int TIDX, const P& p, int bid, int nb, char* smem) {
  float* sc = (float*)smem;
  float* red = sc + 9 * 1024;
  float* modo = (float*)(p.ws + OFF_MOD);
  for (int task = bid; task < 192; task += nb) {
    const int l = task / 96, j0 = (task % 96) * 64;
    __syncthreads();
    for (int e = TIDX; e < 9 * 1024; e += NTHR) {
      int rr = e >> 10, k = e & 1023;
      float v = rr < 8 ? p.c[rr * 1024 + k] : p.c_ctx[k];
      sc[e] = v / (1.f + expf(-v));
    }
    __syncthreads();
    const int kg = TIDX >> 6, col = TIDX & 63;
    float acc[9];
#pragma unroll
    for (int q = 0; q < 9; q++) acc[q] = 0.f;
    const float* W = p.mod_w + (size_t)l * 1024 * 6144 + j0 + col;
#pragma unroll 4
    for (int k = kg * 128; k < kg * 128 + 128; ++k) {
      float w = W[(size_t)k * 6144];
#pragma unroll
      for (int q = 0; q < 9; q++) acc[q] += sc[q * 1024 + k] * w;
    }
#pragma unroll
    for (int q = 0; q < 9; q++) red[(kg * 9 + q) * 64 + col] = acc[q];
    __syncthreads();
    for (int e = TIDX; e < 9 * 64; e += NTHR) {
      int rr = e >> 6, cc = e & 63;
      float s = p.mod_b[l * 6144 + j0 + cc];
#pragma unroll
      for (int g = 0; g < 8; g++) s += red[(g * 9 + rr) * 64 + cc];
      modo[(size_t)(l * 9 + rr) * 6144 + j0 + cc] = s;
    }
  }
}

DI void norm_rows(const int TIDX, const P& p, int layer, int which, bool from_input, bool latent_only, int bid, int nb) {
  const int lane = TIDX & 63, wave = TIDX >> 6;
  const float* mod = (const float*)(p.ws + OFF_MOD);
  const float* X = (const float*)(p.ws + OFF_X);
  bf16_t* H = (bf16_t*)(p.ws + OFF_H);
  const float* g = (which ? p.n2g : p.n1g) + layer * 1024;
  for (int n = bid * 8 + wave; n < NTOK; n += nb * 8) {
    int b = n / LT, pos = n - b * LT;
    if (latent_only && pos < LC) continue;
    const float* src = from_input ? xin_row(p, n) : X + (size_t)n * DM;
    float4 v[4];
    float ss = 0.f;
#pragma unroll
    for (int i = 0; i < 4; i++) {
      v[i] = *(const float4*)(src + i * 256 + lane * 4);
      ss += v[i].x * v[i].x + v[i].y * v[i].y + v[i].z * v[i].z + v[i].w * v[i].w;
    }
    ss = wave_sum(ss);
    const float rs = rsqrtf(ss * (1.f / 1024.f) + 1e-6f);
    const int rr = pos < LC ? 8 : b;
    const float* msc = mod + (size_t)(layer * 9 + rr) * 6144 + (which ? 4 : 1) * 1024;
    const float* msh = mod + (size_t)(layer * 9 + rr) * 6144 + (which ? 3 : 0) * 1024;
#pragma unroll
    for (int i = 0; i < 4; i++) {
      int idx = i * 256 + lane * 4;
      float4 gg = *(const float4*)(g + idx), sc = *(const float4*)(msc + idx), sh = *(const float4*)(msh + idx);
      float y0 = v[i].x * rs * gg.x * (1.f + sc.x) + sh.x;
      float y1 = v[i].y * rs * gg.y * (1.f + sc.y) + sh.y;
      float y2 = v[i].z * rs * gg.z * (1.f + sc.z) + sh.z;
      float y3 = v[i].w * rs * gg.w * (1.f + sc.w) + sh.w;
      uint2 o; o.x = pack2(y0, y1); o.y = pack2(y2, y3);
      *(uint2*)(H + (size_t)n * DM + idx) = o;
    }
  }
}

DI void rope8(float* v, int e, int t, int lane) {
  const int half = e >> 2, isx2 = (e >> 1) & 1, ibase = (e & 1) * 8;
  const float posf = half ? (float)(t & 63) : (float)(t >> 6);
#pragma unroll
  for (int j = 0; j < 8; j++) {
    float pv = SHX(v[j], 2);
    float inv = exp2f(-(float)(ibase + j) * 0.83048202f);
    float ang = posf * inv;
    float rev = ang * 0.15915494309f;
    rev -= floorf(rev);
    float sn = __builtin_amdgcn_sinf(rev), cs = __builtin_amdgcn_cosf(rev);
    v[j] = isx2 ? (v[j] * cs + pv * sn) : (v[j] * cs - pv * sn);
  }
}
DI void prep0(const int TIDX, const P& p, int bid, int nb) {
  char* big = p.ws + OFF_BIG;
  const bf16_t* Z = (const bf16_t*)(big + B_Z0);
  bf16_t* QN = (bf16_t*)(big + B_QN); bf16_t* KN = (bf16_t*)(big + B_KN); bf16_t* VT = (bf16_t*)(big + B_VT);
  bf16_t* R = (bf16_t*)(big + B_R); bf16_t* KB = (bf16_t*)(big + B_KB); bf16_t* KK = (bf16_t*)(big + B_KK);
  bf16_t* V = (bf16_t*)(big + B_V); bf16_t* AW = (bf16_t*)(big + B_AW); bf16_t* AA = (bf16_t*)(big + B_AA);
  bf16_t* AG = (bf16_t*)(big + B_AG);
  const int lane = TIDX & 63, wave = TIDX >> 6;
  for (int n = bid * 8 + wave; n < NTOK; n += nb * 8) {
    const int b = n / LT, pos = n - b * LT;
    const bool lat = pos >= LC;
    const int t = pos - LC;
    const bf16_t* zr = Z + (size_t)n * 2560;
    {
      const int head = lane >> 3, e = lane & 7;
      uint4 raw = *(const uint4*)(zr + head * 64 + e * 8);
      float v[8]; unpack8(raw, v);
      float ss = 0.f;
#pragma unroll
      for (int j = 0; j < 8; j++) ss += v[j] * v[j];
      ss += SHX(ss, 1); ss += SHX(ss, 2); ss += SHX(ss, 4);
      const float rs = rsqrtf(ss * (1.f / 64.f) + 1e-6f);
#pragma unroll
      for (int j = 0; j < 8; j++) v[j] = v[j] * rs * p.qg[e * 8 + j];
      if (lat) rope8(v, e, t, lane);
#pragma unroll
      for (int j = 0; j < 8; j++) v[j] *= 0.18033688011f;
      *(uint4*)(QN + ((size_t)(b * 8 + head) * LT + pos) * 64 + e * 8) = pack8(v);
    }
    {
      const int hh = (lane >> 3) & 3, e = lane & 7;
      uint4 raw = make_uint4(0, 0, 0, 0);
      if (lane < 32) raw = *(const uint4*)(zr + 512 + hh * 64 + e * 8);
      float v[8]; unpack8(raw, v);
      float kv[8];
      float ss = 0.f;
#pragma unroll
      for (int j = 0; j < 8; j++) ss += v[j] * v[j];
      ss += SHX(ss, 1); ss += SHX(ss, 2); ss += SHX(ss, 4);
      const float rs = rsqrtf(ss * (1.f / 64.f) + 1e-6f);
#pragma unroll
      for (int j = 0; j < 8; j++) kv[j] = v[j] * rs * p.kg[e * 8 + j];
      if (lat) rope8(kv, e, t, lane);
      if (lane < 16) {
        *(uint4*)(KN + ((size_t)(b * 2 + hh) * LT + pos) * 64 + e * 8) = pack8(kv);
      } else if (lane < 32) {
        const int kvh = hh - 2;
#pragma unroll
        for (int j = 0; j < 8; j++) VT[((size_t)(b * 2 + kvh) * 64 + e * 8 + j) * LT + pos] = f2bf(v[j]);
      }
    }
    const bool hasp = (pos != 0 && pos != LC), hasn = (pos != LC - 1 && pos != LT - 1);
    const bf16_t* zc = zr + 768;
#pragma unroll
    for (int i = 0; i < 7; i++) {
      const int j = i * 256 + lane * 4;
      uint2 cu = *(const uint2*)(zc + j);
      uint2 pu = make_uint2(0, 0), nu = make_uint2(0, 0);
      if (hasp) pu = *(const uint2*)(zc - 2560 + j);
      if (hasn) nu = *(const uint2*)(zc + 2560 + j);
      float4 m4 = *(const float4*)(p.mu + j);
      float cv[4] = {lo2f(cu.x), hi2f(cu.x), lo2f(cu.y), hi2f(cu.y)};
      float pv[4] = {lo2f(pu.x), hi2f(pu.x), lo2f(pu.y), hi2f(pu.y)};
      float nv[4] = {lo2f(nu.x), hi2f(nu.x), lo2f(nu.y), hi2f(nu.y)};
      float mm[4] = {m4.x, m4.y, m4.z, m4.w};
      float zm[4];
#pragma unroll
      for (int q = 0; q < 4; q++) zm[q] = cv[q] + mm[q] * (0.5f * (pv[q] + nv[q]) - cv[q]);
      if (i < 6) {
        const int cc = (i & 1) * 256 + lane * 4;
        const int head = cc >> 6, within = cc & 63;
        const size_t oidx = ((size_t)(b * 8 + head) * LT + pos) * 64 + within;
        uint2 o; o.x = pack2(zm[0], zm[1]); o.y = pack2(zm[2], zm[3]);
        if (i < 2) {
          *(uint2*)(R + oidx) = o;
        } else if (i < 4) {
          *(uint2*)(KB + oidx) = o;
          float4 kk4 = *(const float4*)(p.k_k + cc);
          float k0 = zm[0] * kk4.x, k1 = zm[1] * kk4.y, k2 = zm[2] * kk4.z, k3 = zm[3] * kk4.w;
          float ss = k0 * k0 + k1 * k1 + k2 * k2 + k3 * k3;
          ss += SHX(ss, 1); ss += SHX(ss, 2); ss += SHX(ss, 4); ss += SHX(ss, 8);
          const float inv = 1.f / fmaxf(sqrtf(ss), 1e-12f);
          uint2 o2; o2.x = pack2(k0 * inv, k1 * inv); o2.y = pack2(k2 * inv, k3 * inv);
          *(uint2*)(KK + oidx) = o2;
        } else {
          *(uint2*)(V + oidx) = o;
        }
      } else {
        if (lane < 16) {
          uint2 o; o.x = pack2(tanhf(zm[0]), tanhf(zm[1])); o.y = pack2(tanhf(zm[2]), tanhf(zm[3]));
          *(uint2*)(AW + (size_t)n * 64 + lane * 4) = o;
        } else if (lane < 32) {
          uint2 o; o.x = pack2(zm[0], zm[1]); o.y = pack2(zm[2], zm[3]);
          *(uint2*)(AA + (size_t)n * 64 + (lane - 16) * 4) = o;
        } else {
          uint2 o; o.x = pack2(sigmoidf_(zm[0]), sigmoidf_(zm[1])); o.y = pack2(sigmoidf_(zm[2]), sigmoidf_(zm[3]));
          *(uint2*)(AG + (size_t)n * 128 + (lane - 32) * 4) = o;
        }
      }
    }
  }
}

DI float reduce16(float v) {
  v += dpp_f(v, 0);
  v += dpp_f(v, 1);
  v += dpp_f(v, 2);
  v += __builtin_bit_cast(float, __builtin_amdgcn_mov_dpp(__builtin_bit_cast(int, v), 0x140, 0xF, 0xF, true));
  return v;
}
DI void reduce16_2(float& a, float& b) {
  a += dpp_f(a, 0); b += dpp_f(b, 0);
  a += dpp_f(a, 1); b += dpp_f(b, 1);
  a += dpp_f(a, 2); b += dpp_f(b, 2);
  a += __builtin_bit_cast(float, __builtin_amdgcn_mov_dpp(__builtin_bit_cast(int, a), 0x140, 0xF, 0xF, true));
  b += __builtin_bit_cast(float, __builtin_amdgcn_mov_dpp(__builtin_bit_cast(int, b), 0x140, 0xF, 0xF, true));
}
DI void wkv2_task(const int TIDX, const P& p, int task, char* smem) {
  char* big = p.ws + OFF_BIG;
  const int rh = task & 1, d = (task >> 1) & 1, h = (task >> 2) & 7, b = task >> 5;
  const bf16_t* R = (const bf16_t*)(big + B_R); const bf16_t* KB = (const bf16_t*)(big + B_KB);
  const bf16_t* KK = (const bf16_t*)(big + B_KK); const bf16_t* V = (const bf16_t*)(big + B_V);
  const bf16_t* AL = (const bf16_t*)(big + B_AL) + (size_t)d * NB * 8 * LT * 64;
  const float* DEC = (const float*)(big + B_DEC) + (size_t)d * NB * 8 * LT * 64;
  bf16_t* OUT = (bf16_t*)(big + B_OUT) + (size_t)d * NB * 8 * LT * 64;
  float* BON = (float*)(p.ws + OFF_BON) + (size_t)d * NB * 8 * LT;
  float* bufs = (float*)smem;
  float* outb = bufs + 2 * 6 * 2048;
  const int tid = TIDX;
  const int row = tid >> 4, ks = tid & 15;
  const int ls = tid >> 4, li = (tid & 15) * 4;
  const size_t hb = (size_t)(b * 8 + h) * LT;
  const float4 ka = *(const float4*)(p.k_a + h * 64 + li);
  const float4 rk = *(const float4*)(p.r_k + h * 64 + li);
  f32x2 S01 = {0.f, 0.f}, S23 = {0.f, 0.f};
  float pr[24];
  auto gload = [&](int chunk) {
    const int pos = scanpos(d, chunk * 32 + ls);
    const size_t e0 = (hb + pos) * 64 + li;
    const uint2 r4 = *(const uint2*)(R + e0), k4 = *(const uint2*)(KB + e0), kk4 = *(const uint2*)(KK + e0);
    const uint2 v4 = *(const uint2*)(V + e0), a4 = *(const uint2*)(AL + e0);
    const float4 dc = *(const float4*)(DEC + e0);
    const float a0 = lo2f(a4.x), a1 = hi2f(a4.x), a2 = lo2f(a4.y), a3 = hi2f(a4.y);
    const float q0 = lo2f(kk4.x), q1 = hi2f(kk4.x), q2 = lo2f(kk4.y), q3 = hi2f(kk4.y);
    pr[0] = lo2f(r4.x); pr[1] = hi2f(r4.x); pr[2] = lo2f(r4.y); pr[3] = hi2f(r4.y);
    pr[4] = dc.x; pr[5] = dc.y; pr[6] = dc.z; pr[7] = dc.w;
    pr[8] = lo2f(k4.x) * (1.f + (a0 - 1.f) * ka.x); pr[9] = hi2f(k4.x) * (1.f + (a1 - 1.f) * ka.y);
    pr[10] = lo2f(k4.y) * (1.f + (a2 - 1.f) * ka.z); pr[11] = hi2f(k4.y) * (1.f + (a3 - 1.f) * ka.w);
    pr[12] = lo2f(v4.x); pr[13] = hi2f(v4.x); pr[14] = lo2f(v4.y); pr[15] = hi2f(v4.y);
    pr[16] = -q0; pr[17] = -q1; pr[18] = -q2; pr[19] = -q3;
    pr[20] = q0 * a0; pr[21] = q1 * a1; pr[22] = q2 * a2; pr[23] = q3 * a3;
    float bp = pr[0] * pr[8] * rk.x + pr[1] * pr[9] * rk.y + pr[2] * pr[10] * rk.z + pr[3] * pr[11] * rk.w;
    bp = reduce16(bp);
    if (rh == 0 && (tid & 15) == 0) BON[hb + pos] = bp;
  };
  auto lstore = [&](int bufi) {
    float* bb = bufs + bufi * 6 * 2048 + ls * 64 + li;
#pragma unroll
    for (int q = 0; q < 6; q++) *(float4*)(bb + q * 2048) = make_float4(pr[4 * q], pr[4 * q + 1], pr[4 * q + 2], pr[4 * q + 3]);
  };
  __syncthreads();
  gload(0);
  lstore(0);
  __syncthreads();
  const int nch = LT / 32;
  for (int ch = 0; ch < nch; ch++) {
    const int cur = ch & 1;
    if (ch + 1 < nch) gload(ch + 1);
    const float* bb = bufs + cur * 6 * 2048;
    const float* qb = bb + ks * 4;
    const float* vb = bb + 3 * 2048 + rh * 32 + row;
    float4 n_kn = *(const float4*)(qb + 4 * 2048), n_dc = *(const float4*)(qb + 1 * 2048), n_bv = *(const float4*)(qb + 5 * 2048);
    float4 n_kd = *(const float4*)(qb + 2 * 2048), n_rr = *(const float4*)(qb);
    float n_vv = vb[0];
    float upend = 0.f;
#pragma unroll 4
    for (int s = 0; s < 32; s++) {
      const float4 kn = n_kn, dc = n_dc, bv = n_bv, kd = n_kd, rr = n_rr;
      const float vv = n_vv;
      if (s + 1 < 32) {
        const float* q1 = qb + (s + 1) * 64;
        n_kn = *(const float4*)(q1 + 4 * 2048); n_dc = *(const float4*)(q1 + 1 * 2048); n_bv = *(const float4*)(q1 + 5 * 2048);
        n_kd = *(const float4*)(q1 + 2 * 2048); n_rr = *(const float4*)(q1);
        n_vv = vb[(s + 1) * 64];
      }
      f32x2 t = S01 * (f32x2){kn.x, kn.y};
      t = S23 * (f32x2){kn.z, kn.w} + t;
      float sa = t.x + t.y;
      reduce16_2(sa, upend);
      if (s > 0) outb[(s - 1) * 32 + row] = upend;
      const f32x2 sa2 = {sa, sa}, vv2 = {vv, vv};
      S01 = S01 * (f32x2){dc.x, dc.y} + sa2 * (f32x2){bv.x, bv.y} + vv2 * (f32x2){kd.x, kd.y};
      S23 = S23 * (f32x2){dc.z, dc.w} + sa2 * (f32x2){bv.z, bv.w} + vv2 * (f32x2){kd.z, kd.w};
      f32x2 u = S01 * (f32x2){rr.x, rr.y};
      u = S23 * (f32x2){rr.z, rr.w} + u;
      upend = u.x + u.y;
    }
    upend = reduce16(upend);
    outb[31 * 32 + row] = upend;
    __syncthreads();
    {
      const int idx = tid * 2, s = idx >> 5, r2 = idx & 31;
      const int pos = scanpos(d, ch * 32 + s);
      *(unsigned*)(OUT + (hb + pos) * 64 + rh * 32 + r2) = pack2(outb[idx], outb[idx + 1]);
    }
    if (ch + 1 < nch) lstore(cur ^ 1);
    __syncthreads();
  }
}
DI void wkv_finalize(const int TIDX, const P& p, int bid, int nb) {
  char* big = p.ws + OFF_BIG;
  const bf16_t* OUT = (const bf16_t*)(big + B_OUT);
  const float* BON = (const float*)(p.ws + OFF_BON);
  const bf16_t* V = (const bf16_t*)(big + B_V);
  const bf16_t* G = (const bf16_t*)(big + B_G);
  bf16_t* YM = (bf16_t*)(big + B_YMIX);
  const int lane = TIDX & 63, wave = TIDX >> 6;
  for (int item = bid * 8 + wave; item < NTOK * 8; item += nb * 8) {
    const int n = item >> 3, h = item & 7;
    const int b = n / LT, pos = n - b * LT;
    const size_t hb = (size_t)(b * 8 + h) * LT + pos;
    const int c = h * 64 + lane;
    const float vval = bf2f(V[hb * 64 + lane]);
    const float gw = p.gn_w[c], gb = p.gn_b[c];
    float y = 0.f;
#pragma unroll
    for (int d = 0; d < 2; d++) {
      const float o = bf2f(OUT[((size_t)d * NB * 8 * LT + hb) * 64 + lane]);
      const float mean = wave_sum_dpp(o, lane) * (1.f / 64.f);
      const float dd = o - mean;
      const float var = wave_sum_dpp(dd * dd, lane) * (1.f / 64.f);
      const float rstd = rsqrtf(var + 64e-5f);
      const float bon = BON[(size_t)d * NB * 8 * LT + hb];
      y += dd * rstd * gw + gb + bon * vval;
    }
    y *= bf2f(G[(size_t)n * 512 + c]);
    YM[(size_t)n * 1024 + 512 + c] = f2bf(y);
  }
}

DI void attn_task(const int TIDX, const P& p, int task, char* smem) {
  char* big = p.ws + OFF_BIG;
  int b, head, qt;
  if (task < 512) { qt = 1 + (task & 7); head = (task >> 3) & 7; b = task >> 6; }
  else { int t2 = task - 512; qt = 0; head = t2 & 7; b = t2 >> 3; }
  const int kvh = head >> 2;
  const int nkt = (qt == 0 ? 256 : LT) / 64;
  bf16_t* Ks = (bf16_t*)smem;
  bf16_t* Vs = Ks + 2 * 64 * 72;
  const bf16_t* Kg = (const bf16_t*)(big + B_KN) + (size_t)(b * 2 + kvh) * LT * 64;
  const bf16_t* Vg = (const bf16_t*)(big + B_VT) + (size_t)(b * 2 + kvh) * 64 * LT;
  const bf16_t* QN = (const bf16_t*)(big + B_QN);
  bf16_t* YM = (bf16_t*)(big + B_YMIX);
  const int tid = TIDX, lane = tid & 63, wave = tid >> 6;
  const int r = lane & 31, h8 = lane >> 5;
  const int q0 = qt * 256 + wave * 32;
  bf16x8 qf[4];
#pragma unroll
  for (int kk = 0; kk < 4; kk++)
    qf[kk] = *(const bf16x8*)(QN + ((size_t)(b * 8 + head) * LT + q0 + r) * 64 + kk * 16 + h8 * 8);
  f32x16 o0, o1;
#pragma unroll
  for (int q = 0; q < 16; q++) { o0[q] = 0.f; o1[q] = 0.f; }
  float m = -1e30f, l = 0.f;
  const int lr = tid >> 3, lc = tid & 7;
  uint4 kreg = *(const uint4*)(Kg + (size_t)lr * 64 + lc * 8);
  uint4 vreg = *(const uint4*)(Vg + (size_t)lr * LT + lc * 8);
  __syncthreads();
  *(uint4*)(Ks + lr * 72 + lc * 8) = kreg;
  *(uint4*)(Vs + lr * 72 + lc * 8) = vreg;
  __syncthreads();
  for (int kt = 0; kt < nkt; kt++) {
    const int cur = kt & 1;
    if (kt + 1 < nkt) {
      kreg = *(const uint4*)(Kg + (size_t)((kt + 1) * 64 + lr) * 64 + lc * 8);
      vreg = *(const uint4*)(Vg + (size_t)lr * LT + (kt + 1) * 64 + lc * 8);
    }
    const bf16_t* Kc = Ks + cur * 64 * 72;
    const bf16_t* Vc = Vs + cur * 64 * 72;
    f32x16 s0, s1;
#pragma unroll
    for (int q = 0; q < 16; q++) { s0[q] = 0.f; s1[q] = 0.f; }
#pragma unroll
    for (int kk = 0; kk < 4; kk++) {
      bf16x8 a0 = *(const bf16x8*)(Kc + r * 72 + kk * 16 + h8 * 8);
      bf16x8 a1 = *(const bf16x8*)(Kc + (32 + r) * 72 + kk * 16 + h8 * 8);
      s0 = __builtin_amdgcn_mfma_f32_32x32x16_bf16(a0, qf[kk], s0, 0, 0, 0);
      s1 = __builtin_amdgcn_mfma_f32_32x32x16_bf16(a1, qf[kk], s1, 0, 0, 0);
    }
    float mx = s0[0];
#pragma unroll
    for (int q = 1; q < 16; q++) mx = fmaxf(mx, s0[q]);
#pragma unroll
    for (int q = 0; q < 16; q++) mx = fmaxf(mx, s1[q]);
    mx = fmaxf(mx, SHX(mx, 32));
    const float mnew = fmaxf(m, mx);
    const float alpha = __builtin_amdgcn_exp2f(m - mnew);
    float sum = 0.f;
#pragma unroll
    for (int q = 0; q < 16; q++) { s0[q] = __builtin_amdgcn_exp2f(s0[q] - mnew); sum += s0[q]; }
#pragma unroll
    for (int q = 0; q < 16; q++) { s1[q] = __builtin_amdgcn_exp2f(s1[q] - mnew); sum += s1[q]; }
    l = l * alpha + sum;
    m = mnew;
#pragma unroll
    for (int q = 0; q < 16; q++) { o0[q] *= alpha; o1[q] *= alpha; }
#pragma unroll
    for (int t = 0; t < 2; t++) {
#pragma unroll
      for (int s = 0; s < 2; s++) {
        union { bf16x8 v; unsigned u[4]; } pf;
#pragma unroll
        for (int q = 0; q < 4; q++) {
          float x0 = t ? s1[8 * s + 2 * q] : s0[8 * s + 2 * q];
          float x1 = t ? s1[8 * s + 2 * q + 1] : s0[8 * s + 2 * q + 1];
          pf.u[q] = pack2(x0, x1);
        }
        const int kb = 32 * t + 16 * s + 4 * h8;
        union { bf16x8 v; uint2 u[2]; } v0, v1;
        v0.u[0] = *(const uint2*)(Vc + r * 72 + kb);
        v0.u[1] = *(const uint2*)(Vc + r * 72 + kb + 8);
        v1.u[0] = *(const uint2*)(Vc + (32 + r) * 72 + kb);
        v1.u[1] = *(const uint2*)(Vc + (32 + r) * 72 + kb + 8);
        o0 = __builtin_amdgcn_mfma_f32_32x32x16_bf16(v0.v, pf.v, o0, 0, 0, 0);
        o1 = __builtin_amdgcn_mfma_f32_32x32x16_bf16(v1.v, pf.v, o1, 0, 0, 0);
      }
    }
    if (kt + 1 < nkt) {
      *(uint4*)(Ks + (cur ^ 1) * 64 * 72 + lr * 72 + lc * 8) = kreg;
      *(uint4*)(Vs + (cur ^ 1) * 64 * 72 + lr * 72 + lc * 8) = vreg;
    }
    __syncthreads();
  }
  l += SHX(l, 32);
  const float inv = 1.f / l;
  bf16_t* orow = YM + (size_t)(b * LT + q0 + r) * 1024 + head * 64;
#pragma unroll
  for (int g4 = 0; g4 < 4; g4++) {
    uint2 w0, w1;
    w0.x = pack2(o0[4 * g4] * inv, o0[4 * g4 + 1] * inv); w0.y = pack2(o0[4 * g4 + 2] * inv, o0[4 * g4 + 3] * inv);
    w1.x = pack2(o1[4 * g4] * inv, o1[4 * g4 + 1] * inv); w1.y = pack2(o1[4 * g4 + 2] * inv, o1[4 * g4 + 3] * inv);
    *(uint2*)(orow + 8 * g4 + 4 * h8) = w0;
    *(uint2*)(orow + 32 + 8 * g4 + 4 * h8) = w1;
  }
}

DI void route_task(const int TIDX, const P& p, int n0, char* smem) {
  char* big = p.ws + OFF_BIG;
  const float* S = (const float*)(big + B_S);
  int* EI = (int*)(big + B_EI);
  float* EG = (float*)(big + B_EG);
  float* sc = (float*)smem;
  float* sv = sc + 256 * 129;
  unsigned char* si = (unsigned char*)(sv + 256 * 16);
  const int tid = TIDX;
  __syncthreads();
  for (int e = tid; e < 256 * 128; e += NTHR) {
    int row = e >> 7, j = e & 127;
    sc[row * 129 + j] = S[(size_t)n0 * 2048 + e];
  }
  __syncthreads();
  if (tid < 256) {
    const float* rowp = sc + tid * 129;
    float pv = __builtin_inff();
    int pi = -1;
    for (int k = 0; k < 16; k++) {
      float bv = -__builtin_inff();
      int bi = 0;
      for (int j = 0; j < 128; j++) {
        float x = rowp[j];
        bool elig = (x < pv) || (x == pv && j > pi);
        if (elig && x > bv) { bv = x; bi = j; }
      }
      sv[tid * 16 + k] = bv;
      si[tid * 16 + k] = (unsigned char)bi;
      pv = bv; pi = bi;
    }
  }
  __syncthreads();
  if (tid < 128) {
    const int tl = tid >> 3, head = tid & 7;
    const int r0 = tl * 16 + head * 2, r1 = r0 + 1;
    const float* a = sv + r0 * 16;
    const float* bq = sv + r1 * 16;
    float* eg = sc + tid * 17;
    const int n = n0 + tl;
    float pv = __builtin_inff();
    int pc = -1;
    float mx = 0.f, sum = 0.f;
    for (int k = 0; k < 16; k++) {
      float bv = -__builtin_inff();
      int bc = 0;
      for (int i = 0; i < 16; i++) {
        const int jn = 16 / (i + 1);
        const float ai = a[i];
        for (int j = 0; j < jn; j++) {
          float x = ai + bq[j];
          int c = i * 16 + j;
          bool elig = (x < pv) || (x == pv && c > pc);
          if (elig && x > bv) { bv = x; bc = c; }
        }
      }
      if (k == 0) mx = bv;
      float ev = __expf(bv - mx);
      sum += ev;
      eg[k] = ev;
      EI[(size_t)n * 128 + head * 16 + k] = (int)si[r0 * 16 + (bc >> 4)] * 128 + (int)si[r1 * 16 + (bc & 15)];
      pv = bv; pc = bc;
    }
    const float inv = 1.f / sum;
    for (int k = 0; k < 16; k++) EG[(size_t)n * 128 + head * 16 + k] = eg[k] * inv;
  }
}


DI int f2ord(float f) { int s = __float_as_int(f); return s ^ ((s >> 31) & 0x7fffffff); }
DI float ord2f(int s) { return __int_as_float(s ^ ((s >> 31) & 0x7fffffff)); }
DI void ce_desc(int& a, int& b) { int hi = max(a, b), lo = min(a, b); a = hi; b = lo; }
template <int N>
DI void bsort_desc(int* v) {
#pragma unroll
  for (int k = 2; k <= N; k <<= 1)
#pragma unroll
    for (int j = k >> 1; j > 0; j >>= 1)
#pragma unroll
      for (int i = 0; i < N; i++) {
        const int l = i ^ j;
        if (l > i) {
          if ((i & k) == 0) ce_desc(v[i], v[l]); else ce_desc(v[l], v[i]);
        }
      }
}
DI void merge16(int* a, const int* b) {
#pragma unroll
  for (int i = 0; i < 16; i++) a[i] = max(a[i], b[15 - i]);
#pragma unroll
  for (int j = 8; j > 0; j >>= 1)
#pragma unroll
    for (int i = 0; i < 16; i++) {
      const int l = i ^ j;
      if (l > i) ce_desc(a[i], a[l]);
    }
}
DI void top16_of_64(int* v) {
  bsort_desc<16>(v); bsort_desc<16>(v + 16); bsort_desc<16>(v + 32); bsort_desc<16>(v + 48);
  merge16(v, v + 16); merge16(v + 32, v + 48); merge16(v, v + 32);
}
DI void route2_task(const int TIDX, const P& p, int layer, int m0, int head, char* smem) {
  char* big = p.ws + OFF_BIG;
  const bf16_t* QP = (const bf16_t*)(big + B_QP);
  int* EI = (int*)(big + B_EI);
  float* EG = (float*)(big + B_EG);
  bf16_t* Ks = (bf16_t*)smem;
  unsigned char* sidx = (unsigned char*)(Ks + 256 * 136);
  const bf16_t* keys = (const bf16_t*)(p.ws + OFF_KEYS) + (size_t)(layer * 16 + head * 2) * 128 * 128;
  const int tid = TIDX, lane = tid & 63, wave = tid >> 6;
  const int r = lane & 31, h8 = lane >> 5;
  __syncthreads();
  {
    const int row = tid >> 1, half = tid & 1;
#pragma unroll
    for (int q = 0; q < 8; q++)
      *(uint4*)(Ks + row * 136 + half * 64 + q * 8) = *(const uint4*)(keys + (size_t)row * 128 + half * 64 + q * 8);
  }
  __syncthreads();
  const int tok = m0 + wave * 32 + r;
  int la[16], lb[16];
#pragma unroll
  for (int pp = 0; pp < 2; pp++) {
    bf16x8 qf[8];
#pragma unroll
    for (int ks = 0; ks < 8; ks++)
      qf[ks] = *(const bf16x8*)(QP + (size_t)tok * 2048 + head * 256 + pp * 128 + ks * 16 + h8 * 8);
    int v[64];
#pragma unroll
    for (int kt = 0; kt < 4; kt++) {
      f32x16 acc;
#pragma unroll
      for (int q = 0; q < 16; q++) acc[q] = 0.f;
#pragma unroll
      for (int ks = 0; ks < 8; ks++) {
        bf16x8 a = *(const bf16x8*)(Ks + (pp * 128 + kt * 32 + r) * 136 + ks * 16 + h8 * 8);
        acc = __builtin_amdgcn_mfma_f32_32x32x16_bf16(a, qf[ks], acc, 0, 0, 0);
      }
#pragma unroll
      for (int q = 0; q < 16; q++) v[kt * 16 + q] = (f2ord(acc[q]) & ~127) | (kt * 32 + (q & 3) + 8 * (q >> 2) + 4 * h8);
    }
    top16_of_64(v);
    int pr[16];
#pragma unroll
    for (int i = 0; i < 16; i++) pr[i] = __builtin_amdgcn_ds_bpermute((lane ^ 32) << 2, v[i]);
    merge16(v, pr);
#pragma unroll
    for (int i = 0; i < 16; i++) { if (pp == 0) la[i] = v[i]; else lb[i] = v[i]; }
  }
  {
    unsigned* sw = (unsigned*)(sidx + tid * 32);
#pragma unroll
    for (int i = 0; i < 4; i++) {
      sw[i] = (la[4 * i] & 127) | ((la[4 * i + 1] & 127) << 8) | ((la[4 * i + 2] & 127) << 16) | ((la[4 * i + 3] & 127) << 24);
      sw[4 + i] = (lb[4 * i] & 127) | ((lb[4 * i + 1] & 127) << 8) | ((lb[4 * i + 2] & 127) << 16) | ((lb[4 * i + 3] & 127) << 24);
    }
  }
  float fa[16], fb[16];
#pragma unroll
  for (int i = 0; i < 16; i++) { fa[i] = ord2f(la[i]); fb[i] = ord2f(lb[i]); }
  int c[64];
  {
    int cnt = 0;
#pragma unroll
    for (int i = 0; i < 16; i++)
#pragma unroll
      for (int j = 0; j < 16; j++)
        if ((i + 1) * (j + 1) <= 16) { c[cnt] = (f2ord(fa[i] + fb[j]) & ~255) | (i * 16 + j); cnt++; }
#pragma unroll
    for (int q = 50; q < 64; q++) c[q] = (int)0x80000000;
  }
  top16_of_64(c);
  const float mx = ord2f(c[0]);
  float ev[16], sum = 0.f;
#pragma unroll
  for (int k = 0; k < 16; k++) { ev[k] = __expf(ord2f(c[k]) - mx); sum += ev[k]; }
  const float inv = 1.f / sum;
  const size_t ob = (size_t)tok * 128 + head * 16;
#pragma unroll
  for (int k = 0; k < 16; k++) {
    const int code = c[k] & 255;
    const int ia = sidx[tid * 32 + (code >> 4)], ib = sidx[tid * 32 + 16 + (code & 15)];
    if (h8 == 0) EI[ob + k] = ia * 128 + ib; else EG[ob + k] = ev[k] * inv;
  }
}

DI void peer_gather(const int TIDX, const P& p, int layer, bool last, int bid, int nb, const bool dry) {
  char* big = p.ws + OFF_BIG;
  const int* EI = (const int*)(big + B_EI);
  const float* EG = (const float*)(big + B_EG);
  const unsigned char* UB = (const unsigned char*)(p.ws + OFF_UB);
  const unsigned char* VB = (const unsigned char*)(p.ws + OFF_VB);
  const float* US = (const float*)(p.ws + OFF_UB + 16777216);
  const float* VS = (const float*)(p.ws + OFF_VB + 16777216);
  const bf16_t* H = (const bf16_t*)(p.ws + OFF_H);
  const float* X = (const float*)(p.ws + OFF_X);
  bf16_t* Hw = dry ? (bf16_t*)(big + B_QP) : (bf16_t*)(p.ws + OFF_H);
  float* Xw = dry ? (float*)(big + B_S) : (float*)(p.ws + OFF_X);
  const float* mod = (const float*)(p.ws + OFF_MOD);
  const int lane = TIDX & 63, wave = TIDX >> 6;
  for (int n = bid * 8 + wave; n < NTOK; n += nb * 8) {
    const int b = n / LT, pos = n - b * LT;
    if (last && pos < LC) continue;
    float hv[16];
    {
      uint4 h0 = *(const uint4*)(H + (size_t)n * DM + lane * 16);
      uint4 h1 = *(const uint4*)(H + (size_t)n * DM + lane * 16 + 8);
      unpack8(h0, hv); unpack8(h1, hv + 8);
    }
    const int id_lo = EI[(size_t)n * 128 + lane], id_hi = EI[(size_t)n * 128 + 64 + lane];
    const float g_lo = EG[(size_t)n * 128 + lane], g_hi = EG[(size_t)n * 128 + 64 + lane];
    const float us_lo = US[id_lo], us_hi = US[id_hi], vs_lo = VS[id_lo], vs_hi = VS[id_hi];
    float act_lo = 0.f, act_hi = 0.f;
#pragma unroll 1
    for (int half = 0; half < 2; half++) {
      const int idv = half ? id_hi : id_lo;
      float actv = 0.f;
#pragma unroll 8
      for (int e = 0; e < 64; e++) {
        const int id = __builtin_amdgcn_readlane(idv, e);
        const uint4 w = *(const uint4*)(UB + (size_t)id * 1024 + lane * 16);
        float uv[16];
        cvt16_fp8(w, uv);
        float d0 = 0.f, d1 = 0.f;
#pragma unroll
        for (int j = 0; j < 8; j++) { d0 += hv[j] * uv[j]; d1 += hv[8 + j] * uv[8 + j]; }
        const float dsum = wave_sum_dpp(d0 + d1, lane);
        if (lane == e) actv = dsum;
      }
      if (half) act_hi = actv; else act_lo = actv;
    }
    act_lo *= us_lo; act_hi *= us_hi;
    const float cf_lo = g_lo * 0.5f * act_lo * (1.f + erff(act_lo * 0.70710678f)) * vs_lo;
    const float cf_hi = g_hi * 0.5f * act_hi * (1.f + erff(act_hi * 0.70710678f)) * vs_hi;
    float acc[16];
#pragma unroll
    for (int j = 0; j < 16; j++) acc[j] = 0.f;
#pragma unroll 1
    for (int half = 0; half < 2; half++) {
      const int idv = half ? id_hi : id_lo;
      const float cfv = half ? cf_hi : cf_lo;
#pragma unroll 8
      for (int e = 0; e < 64; e++) {
        const int id = __builtin_amdgcn_readlane(idv, e);
        const float cf = __builtin_bit_cast(float, __builtin_amdgcn_readlane(__builtin_bit_cast(int, cfv), e));
        const uint4 w = *(const uint4*)(VB + (size_t)id * 1024 + lane * 16);
        float uv[16];
        cvt16_fp8(w, uv);
#pragma unroll
        for (int j = 0; j < 16; j++) acc[j] += cf * uv[j];
      }
    }
    const int rr = pos < LC ? 8 : b;
    const float* gate = mod + (size_t)(layer * 9 + rr) * 6144 + 5 * 1024 + lane * 16;
    const float* xr = X + (size_t)n * DM + lane * 16;
    float xo[16];
#pragma unroll
    for (int q = 0; q < 4; q++) {
      float4 x0 = *(const float4*)(xr + q * 4), g0 = *(const float4*)(gate + q * 4);
      xo[q * 4 + 0] = x0.x + g0.x * acc[q * 4 + 0]; xo[q * 4 + 1] = x0.y + g0.y * acc[q * 4 + 1];
      xo[q * 4 + 2] = x0.z + g0.z * acc[q * 4 + 2]; xo[q * 4 + 3] = x0.w + g0.w * acc[q * 4 + 3];
    }
    if (last) {
      float* orow = p.out + ((size_t)(b * SEQ + pos - LC)) * DM + lane * 16;
#pragma unroll
      for (int q = 0; q < 4; q++) *(float4*)(orow + q * 4) = make_float4(xo[q * 4], xo[q * 4 + 1], xo[q * 4 + 2], xo[q * 4 + 3]);
    } else {
      float ss = 0.f;
#pragma unroll
      for (int j = 0; j < 16; j++) ss += xo[j] * xo[j];
      ss = wave_sum(ss);
      const float rs = rsqrtf(ss * (1.f / 1024.f) + 1e-6f);
      const float* g = p.n1g + (layer + 1) * 1024 + lane * 16;
      const float* msc = mod + (size_t)((layer + 1) * 9 + rr) * 6144 + 1 * 1024 + lane * 16;
      const float* msh = mod + (size_t)((layer + 1) * 9 + rr) * 6144 + lane * 16;
      float* xw = Xw + (size_t)n * DM + lane * 16;
#pragma unroll
      for (int q = 0; q < 4; q++) *(float4*)(xw + q * 4) = make_float4(xo[q * 4], xo[q * 4 + 1], xo[q * 4 + 2], xo[q * 4 + 3]);
      float y[16];
#pragma unroll
      for (int j = 0; j < 16; j++) y[j] = xo[j] * rs * g[j] * (1.f + msc[j]) + msh[j];
      *(uint4*)(Hw + (size_t)n * DM + lane * 16) = pack8(y);
      *(uint4*)(Hw + (size_t)n * DM + lane * 16 + 8) = pack8(y + 8);
    }
  }
}

DI void conv_phase(const int TIDX, const P& p, int bid, int nb) {
  char* big = p.ws + OFF_BIG;
  const bf16_t* ZX = (const bf16_t*)(big + B_ZX);
  bf16_t* XBC = (bf16_t*)(big + B_XBC);
  const int total = NTOK * 384;
  for (int it = bid * NTHR + TIDX; it < total; it += nb * NTHR) {
    const int n = it / 384, c8 = (it - n * 384) * 8;
    const int b = n / LT, pos = n - b * LT;
    const bool hasp = (pos != 0 && pos != LC), hasn = (pos != LC - 1 && pos != LT - 1);
    const bf16_t* zc = ZX + (size_t)n * 3072 + c8;
    uint4 cu = *(const uint4*)zc, pu = make_uint4(0, 0, 0, 0), nu = make_uint4(0, 0, 0, 0);
    if (hasp) pu = *(const uint4*)(zc - 3072);
    if (hasn) nu = *(const uint4*)(zc + 3072);
    float cv[8], pv[8], nv[8], y[8];
    unpack8(cu, cv); unpack8(pu, pv); unpack8(nu, nv);
#pragma unroll
    for (int j = 0; j < 8; j++) {
      float a = p.conv_b[c8 + j] + p.conv_w[c8 + j] * pv[j] + p.conv_w[3072 + c8 + j] * cv[j] + p.conv_w[6144 + c8 + j] * nv[j];
      y[j] = siluf_(a);
    }
    *(uint4*)(XBC + (size_t)n * 3072 + c8) = pack8(y);
  }
}

DI void ssd_task(const int TIDX, const P& p, int task, char* smem) {
  char* big = p.ws + OFF_BIG;
  const int b = task >> 5, h = task & 31, g = h >> 3;
  bf16_t* Cs = (bf16_t*)smem;
  bf16_t* Bs = Cs + 128 * 136;
  bf16_t* BT = Bs + 128 * 136;
  bf16_t* xT = BT + 128 * 136;
  bf16_t* sb = xT + 64 * 136;
  float* cum = (float*)(sb + 64 * 136);
  float* dtv = cum + 128;
  const bf16_t* XBC = (const bf16_t*)(big + B_XBC);
  const float* DT = (const float*)(big + B_DT);
  bf16_t* Y = (bf16_t*)(big + B_Y);
  const int tid = TIDX, lane = tid & 63, wave = tid >> 6;
  const int r = lane & 31, h8 = lane >> 5;
  const float dskip = p.ssd_d[h];
  for (int d = 0; d < 2; d++) {
    const float a = -expf(p.a_log[d * 32 + h]);
    const float bias = p.dt_bias[d * 32 + h];
    f32x16 sacc;
#pragma unroll
    for (int q = 0; q < 16; q++) sacc[q] = 0.f;
    __syncthreads();
    for (int e = tid; e < 64 * 136; e += NTHR) sb[e] = 0;
    for (int c = 0; c < 18; c++) {
      __syncthreads();
      if (wave == 0) {
        const int i0 = lane * 2, i1 = i0 + 1;
        const int p0 = scanpos(d, c * 128 + i0), p1 = scanpos(d, c * 128 + i1);
        const float dt0 = softplusf_(DT[(size_t)(b * LT + p0) * 64 + d * 32 + h] + bias);
        const float dt1 = softplusf_(DT[(size_t)(b * LT + p1) * 64 + d * 32 + h] + bias);
        const float a0 = a * dt0, a1 = a0 + a * dt1;
        float tot = a1;
#pragma unroll
        for (int off = 1; off < 64; off <<= 1) {
          float t = shup_(tot, off, lane);
          if (lane >= off) tot += t;
        }
        const float excl = tot - a1;
        cum[i0] = excl + a0; cum[i1] = excl + a1;
        dtv[i0] = dt0; dtv[i1] = dt1;
      }
      __syncthreads();
      const float cl = cum[127];
      {
        const int j = tid >> 2, part = tid & 3;
        const int pos = scanpos(d, c * 128 + j);
        const bf16_t* rowp = XBC + (size_t)(b * LT + pos) * 3072;
        const float wj = __expf(cl - cum[j]) * dtv[j];
#pragma unroll
        for (int q = 0; q < 4; q++) {
          const int col = part * 32 + q * 8;
          uint4 cvv = *(const uint4*)(rowp + 2560 + g * 128 + col);
          *(uint4*)(Cs + j * 136 + col) = cvv;
          uint4 bvv = *(const uint4*)(rowp + 2048 + g * 128 + col);
          *(uint4*)(Bs + j * 136 + col) = bvv;
          float bf[8]; unpack8(bvv, bf);
#pragma unroll
          for (int e = 0; e < 8; e++) BT[(col + e) * 136 + j] = f2bf(bf[e] * wj);
        }
#pragma unroll
        for (int q = 0; q < 2; q++) {
          const int col = part * 16 + q * 8;
          uint4 xv = *(const uint4*)(rowp + h * 64 + col);
          const bf16_t* xe = (const bf16_t*)&xv;
#pragma unroll
          for (int e = 0; e < 8; e++) xT[(col + e) * 136 + j] = xe[e];
        }
      }
      __syncthreads();
      const int it = wave >> 1;
      f32x16 G0, G1;
#pragma unroll
      for (int q = 0; q < 16; q++) { G0[q] = 0.f; G1[q] = 0.f; }
      {
        const int jt0 = (wave & 1) * 2, jt1 = jt0 + 1;
        if (jt0 <= it) {
#pragma unroll
          for (int ks = 0; ks < 8; ks++) {
            bf16x8 av = *(const bf16x8*)(Cs + (it * 32 + r) * 136 + ks * 16 + h8 * 8);
            bf16x8 b0 = *(const bf16x8*)(Bs + (jt0 * 32 + r) * 136 + ks * 16 + h8 * 8);
            G0 = __builtin_amdgcn_mfma_f32_32x32x16_bf16(av, b0, G0, 0, 0, 0);
            if (jt1 <= it) {
              bf16x8 b1 = *(const bf16x8*)(Bs + (jt1 * 32 + r) * 136 + ks * 16 + h8 * 8);
              G1 = __builtin_amdgcn_mfma_f32_32x32x16_bf16(av, b1, G1, 0, 0, 0);
            }
          }
        }
      }
      __syncthreads();
      {
        bf16_t* Ms = Bs;
        const int jt0 = (wave & 1) * 2;
        const int j0 = jt0 * 32 + r, j1 = j0 + 32;
        const float cj0 = cum[j0], cj1 = cum[j1], dj0 = dtv[j0], dj1 = dtv[j1];
#pragma unroll
        for (int q = 0; q < 16; q++) {
          const int i = it * 32 + (q & 3) + 8 * (q >> 2) + 4 * h8;
          const float ci = cum[i];
          float m0 = (j0 <= i) ? G0[q] * __expf(ci - cj0) * dj0 : 0.f;
          float m1 = (j1 <= i) ? G1[q] * __expf(ci - cj1) * dj1 : 0.f;
          Ms[i * 136 + j0] = f2bf(m0);
          Ms[i * 136 + j1] = f2bf(m1);
        }
      }
      __syncthreads();
      {
        const bf16_t* Ms = Bs;
        const int pt = wave & 1;
        f32x16 yd, yo;
#pragma unroll
        for (int q = 0; q < 16; q++) { yd[q] = 0.f; yo[q] = 0.f; }
#pragma unroll
        for (int ks = 0; ks < 8; ks++) {
          if (ks < (it + 1) * 2) {
            bf16x8 av = *(const bf16x8*)(Ms + (it * 32 + r) * 136 + ks * 16 + h8 * 8);
            bf16x8 bv = *(const bf16x8*)(xT + (pt * 32 + r) * 136 + ks * 16 + h8 * 8);
            yd = __builtin_amdgcn_mfma_f32_32x32x16_bf16(av, bv, yd, 0, 0, 0);
          }
          bf16x8 cv = *(const bf16x8*)(Cs + (it * 32 + r) * 136 + ks * 16 + h8 * 8);
          bf16x8 sv = *(const bf16x8*)(sb + (pt * 32 + r) * 136 + ks * 16 + h8 * 8);
          yo = __builtin_amdgcn_mfma_f32_32x32x16_bf16(cv, sv, yo, 0, 0, 0);
        }
        if (c >= 2) {
          const int pp = pt * 32 + r;
#pragma unroll
          for (int q = 0; q < 16; q++) {
            const int i = it * 32 + (q & 3) + 8 * (q >> 2) + 4 * h8;
            float y = yd[q] + __expf(cum[i]) * yo[q];
            const int pos = scanpos(d, c * 128 + i);
            const size_t idx = (size_t)(b * LT + pos) * 2048 + h * 64 + pp;
            if (d == 0) y += dskip * bf2f(xT[pp * 136 + i]);
            else y += bf2f(Y[idx]);
            Y[idx] = f2bf(y);
          }
        }
      }
      __syncthreads();
      {
        const int pt = wave & 1, nt = wave >> 1;
        const float ecl = __expf(cl);
#pragma unroll
        for (int q = 0; q < 16; q++) sacc[q] *= ecl;
#pragma unroll
        for (int ks = 0; ks < 8; ks++) {
          bf16x8 av = *(const bf16x8*)(xT + (pt * 32 + r) * 136 + ks * 16 + h8 * 8);
          bf16x8 bv = *(const bf16x8*)(BT + (nt * 32 + r) * 136 + ks * 16 + h8 * 8);
          sacc = __builtin_amdgcn_mfma_f32_32x32x16_bf16(av, bv, sacc, 0, 0, 0);
        }
#pragma unroll
        for (int q = 0; q < 16; q++) {
          const int pp = pt * 32 + (q & 3) + 8 * (q >> 2) + 4 * h8;
          sb[pp * 136 + nt * 32 + r] = f2bf(sacc[q]);
        }
      }
    }
  }
}

DI void gate_norm(const int TIDX, const P& p, int bid, int nb) {
  char* big = p.ws + OFF_BIG;
  const bf16_t* Y = (const bf16_t*)(big + B_Y);
  const bf16_t* ZG = (const bf16_t*)(big + B_ZG);
  bf16_t* YN = (bf16_t*)(big + B_YN);
  const int lane = TIDX & 63, wave = TIDX >> 6;
  for (int n = bid * 8 + wave; n < NTOK; n += nb * 8) {
    const int b = n / LT, pos = n - b * LT;
    if (pos < LC) continue;
#pragma unroll
    for (int gq = 0; gq < 4; gq++) {
      const int base = gq * 512 + lane * 8;
      uint4 yv = *(const uint4*)(Y + (size_t)n * 2048 + base);
      uint4 zv = *(const uint4*)(ZG + (size_t)n * 2048 + base);
      float y[8], z[8];
      unpack8(yv, y); unpack8(zv, z);
      float ss = 0.f;
#pragma unroll
      for (int j = 0; j < 8; j++) { y[j] = y[j] * siluf_(z[j]); ss += y[j] * y[j]; }
      ss = wave_sum(ss);
      const float rs = rsqrtf(ss * (1.f / 512.f) + 1e-6f);
#pragma unroll
      for (int j = 0; j < 8; j++) y[j] = y[j] * rs * p.ssd_nw[base + j];
      *(uint4*)(YN + (size_t)n * 2048 + base) = pack8(y);
    }
  }
}


#define XB_TMO      128
#define XB_XCNT(j)  (256  + 64 * (j))
#define XB_XSUB(j)  (1280 + 64 * (j))
#define XB_XGEN(j)  (2304 + 64 * (j))
#define XB_TOP      3328
#define XB_TOPGEN   3392
#define XCD_BAR_WORDS 3456
#define XB_SPIN_CAP (1u << 18)
#define LAS __attribute__((address_space(3)))
DI unsigned xb_ld(unsigned* p) { return __hip_atomic_load(p, __ATOMIC_RELAXED, __HIP_MEMORY_SCOPE_AGENT); }
DI unsigned xb_add(unsigned* p, unsigned v) { return __hip_atomic_fetch_add(p, v, __ATOMIC_RELAXED, __HIP_MEMORY_SCOPE_AGENT); }
DI unsigned xb_xcc_id() { return (unsigned)__builtin_amdgcn_s_getreg((3 << 11) | 20) & 0xFu; }
#define XB_SPIN(cond, bar) do { unsigned _sp = 0; while (cond) { __builtin_amdgcn_s_sleep(1); \
    if ((++_sp & 255u) == 0u) { if (xb_ld(&(bar)[XB_TMO])) break; if (_sp > XB_SPIN_CAP) { atomicAdd(&(bar)[XB_TMO], 1u); break; } } } } while (0)
struct XcdBarrier { unsigned* bar; unsigned x; volatile LAS unsigned* st; };
DI XcdBarrier xcd_barrier_post(unsigned* bar, volatile LAS unsigned* st) {
  XcdBarrier b; b.bar = bar; b.x = xb_xcc_id(); b.st = st;
  if (threadIdx.x == 0) (void)xb_add(&bar[XB_XCNT(b.x)], 1u);
  return b;
}
DI void xcd_barrier_complete(unsigned* bar, unsigned x, unsigned& nloc, unsigned& nx) {
  const unsigned G = gridDim.x * gridDim.y * gridDim.z;
  unsigned sum, cnt, mine, sp = 0u;
  for (;;) {
    sum = 0u; cnt = 0u; mine = 0u;
#pragma unroll
    for (unsigned j = 0; j < 16; ++j) { const unsigned c = xb_ld(&bar[XB_XCNT(j)]); sum += c; cnt += (c > 0u) ? 1u : 0u; mine = (j == x) ? c : mine; }
    if (sum == G) break;
    __builtin_amdgcn_s_sleep(1);
    if ((++sp & 255u) == 0u) { if (xb_ld(&bar[XB_TMO])) break; if (sp > XB_SPIN_CAP) { atomicAdd(&bar[XB_TMO], 1u); break; } }
  }
  nloc = mine > 0u ? mine : 1u; nx = cnt > 0u ? cnt : 1u;
}
DI void xcd_barrier(const XcdBarrier& b) {
  asm volatile("s_waitcnt vmcnt(0)" ::: "memory");
  __syncthreads();
  if (threadIdx.x == 0) {
    unsigned* bar = b.bar;
    __builtin_amdgcn_s_waitcnt(0);
    unsigned nloc = b.st[0], nx = b.st[1];
    if (nloc == 0u) { xcd_barrier_complete(bar, b.x, nloc, nx); b.st[0] = nloc; b.st[1] = nx; }
    const unsigned old = xb_add(&bar[XB_XSUB(b.x)], 1u);
    const unsigned gen = old / nloc;
    if (old + 1u == (gen + 1u) * nloc) {
      __builtin_amdgcn_fence(__ATOMIC_RELEASE, "agent");
      asm volatile("s_waitcnt vmcnt(0)" ::: "memory");
      const unsigned og = xb_add(&bar[XB_TOP], 1u);
      const unsigned tg = og / nx;
      if (og + 1u == (tg + 1u) * nx) xb_add(&bar[XB_TOPGEN], 1u);
      else XB_SPIN(xb_ld(&bar[XB_TOPGEN]) == tg, bar);
      __builtin_amdgcn_fence(__ATOMIC_ACQUIRE, "agent");
      xb_add(&bar[XB_XGEN(b.x)], 1u);
      asm volatile("s_waitcnt vmcnt(0)" ::: "memory");
    } else {
      XB_SPIN(xb_ld(&bar[XB_XGEN(b.x)]) == gen, bar);
      __builtin_amdgcn_fence(__ATOMIC_ACQUIRE, "agent");
      asm volatile("s_waitcnt vmcnt(0)" ::: "memory");
    }
  }
  __syncthreads();
}
constexpr size_t OFF_BAR = OFF_VB + 16777216 + 1048576;

DI void run_phase(const int TIDX, const P& p, int ph, int bid, int nb, char* smem, const bool dry = false) {
  char* ws = p.ws;
  char* big = ws + OFF_BIG;
  float* X = (float*)(ws + OFF_X);
  const float* mod = (const float*)(ws + OFF_MOD);
  bf16_t* H = (bf16_t*)(ws + OFF_H);
  switch (ph) {
    case 0: {
      mod_gemv(TIDX, p, bid, nb, smem);
      tconv(TIDX, p.ev_w_in, 2560, 1024, 2560, (bf16_t*)(ws + OFF_WIN0), 1024, 0, bid, nb, smem);
      tconv(TIDX, p.ev_w_out, 1024, 1024, 1024, (bf16_t*)(ws + OFF_WOUT0), 1024, 0, bid, nb, smem);
      tconv(TIDX, p.ssd_w_in, 5184, 1024, 5184, (bf16_t*)(ws + OFF_WIN1), 1024, 0, bid, nb, smem);
      tconv(TIDX, p.ssd_w_out, 1024, 2048, 1024, (bf16_t*)(ws + OFF_WOUT1), 2048, 0, bid, nb, smem);
      tconv(TIDX, p.pwq, 2048, 1024, 2048, (bf16_t*)(ws + OFF_WQ), 1024, 0, bid, nb, smem);
      tconv(TIDX, p.pwq + 1024 * 2048, 2048, 1024, 2048, (bf16_t*)(ws + OFF_WQ) + 2048 * 1024, 1024, 0, bid, nb, smem);
      tconv(TIDX, p.w2, 512, 64, 512, (bf16_t*)(ws + OFF_W2C), 64, 0, bid, nb, smem);
      tconv(TIDX, p.w2 + 64 * 512, 512, 64, 512, (bf16_t*)(ws + OFF_W2C) + 512 * 64, 64, 0, bid, nb, smem);
      tconv(TIDX, p.a2, 512, 64, 512, (bf16_t*)(ws + OFF_A2C), 64, 0, bid, nb, smem);
      tconv(TIDX, p.a2 + 64 * 512, 512, 64, 512, (bf16_t*)(ws + OFF_A2C) + 512 * 64, 64, 0, bid, nb, smem);
      tconv(TIDX, p.g2, 512, 128, 512, (bf16_t*)(ws + OFF_G2T), 128, 0, bid, nb, smem);
      conv_flat(TIDX, p.pkeys, (bf16_t*)(ws + OFF_KEYS), (size_t)2 * 16 * 128 * 128, bid, nb);
      conv_fp8(TIDX, p.pu, (unsigned char*)(ws + OFF_UB), (float*)(ws + OFF_UB + 16777216), bid, nb);
      conv_fp8(TIDX, p.pv, (unsigned char*)(ws + OFF_VB), (float*)(ws + OFF_VB + 16777216), bid, nb);
    } break;
    case 1: norm_rows(TIDX, p, 0, 0, true, false, bid, nb); break;
    case 2: {
      bf16_t* Z = (bf16_t*)(big + B_Z0);
      auto epi = [=](int m, int n, const float* v) { *(uint4*)(Z + (size_t)m * 2560 + n) = pack8(v); };
      for (int t = bid; t < 72 * 20; t += nb) {
        int mt = t / 20, nt = t % 20;
        gemm_tile(TIDX, H, 1024, (const bf16_t*)(ws + OFF_WIN0), 1024, 1024, mt * 256, nt * 128, epi, smem);
      }
    } break;
    case 3: prep0(TIDX, p, bid, nb); break;
    case 4: {
      float* DEC = (float*)(big + B_DEC);
      bf16_t* AL = (bf16_t*)(big + B_AL);
      bf16_t* G = (bf16_t*)(big + B_G);
      const float* w0 = p.w0; const float* a0 = p.a0;
      auto epi1 = [=](int m, int n, const float* v) {
        int d = n >> 9, c = n & 511, hh = c >> 6, i = c & 63;
        int b = m / LT, pos = m - b * LT;
        float o[8];
#pragma unroll
        for (int j = 0; j < 8; j++) {
          float x = w0[n + j] + v[j];
          float w = -softplusf_(-x) - 0.5f;
          o[j] = __expf(-__expf(w));
        }
        float* dp = DEC + (size_t)d * (NB * 8 * LT * 64) + ((size_t)(b * 8 + hh) * LT + pos) * 64 + i;
        *(float4*)dp = make_float4(o[0], o[1], o[2], o[3]);
        *(float4*)(dp + 4) = make_float4(o[4], o[5], o[6], o[7]);
      };
      auto epi2 = [=](int m, int n, const float* v) {
        int d = n >> 9, c = n & 511, hh = c >> 6, i = c & 63;
        int b = m / LT, pos = m - b * LT;
        float o[8];
#pragma unroll
        for (int j = 0; j < 8; j++) o[j] = sigmoidf_(a0[n + j] + v[j]);
        *(uint4*)(AL + (size_t)d * (NB * 8 * LT * 64) + ((size_t)(b * 8 + hh) * LT + pos) * 64 + i) = pack8(o);
      };
      auto epi3 = [=](int m, int n, const float* v) { *(uint4*)(G + (size_t)m * 512 + n) = pack8(v); };
      for (int t = bid; t < 1440; t += nb) {
        if (t < 576) {
          gemm_tile(TIDX, (const bf16_t*)(big + B_AW), 64, (const bf16_t*)(ws + OFF_W2C), 64, 64, (t >> 3) * 256, (t & 7) * 128, epi1, smem);
        } else if (t < 1152) {
          int t2 = t - 576;
          gemm_tile(TIDX, (const bf16_t*)(big + B_AA), 64, (const bf16_t*)(ws + OFF_A2C), 64, 64, (t2 >> 3) * 256, (t2 & 7) * 128, epi2, smem);
        } else {
          int t2 = t - 1152;
          gemm_tile(TIDX, (const bf16_t*)(big + B_AG), 128, (const bf16_t*)(ws + OFF_G2T), 128, 128, (t2 >> 2) * 256, (t2 & 3) * 128, epi3, smem);
        }
      }
    } break;
    case 5: {
      for (int t = bid; t < 256; t += nb) wkv2_task(TIDX, p, t, smem);
      for (int t = bid; t < 576; t += nb) attn_task(TIDX, p, t, smem);
    } break;
    case 22: wkv_finalize(TIDX, p, bid, nb); break;
    case 23: for (int t = bid; t < 256; t += nb) wkv2_task(TIDX, p, t, smem); break;
    case 24: for (int t = bid; t < 576; t += nb) attn_task(TIDX, p, t, smem); break;
    case 6: {
      const float* gate = mod;
      const float* xc_ = p.ctx; const float* xl_ = p.x;
      auto epi = [=](int m, int n, const float* v) {
        int b = m / LT, pos = m - b * LT;
        int rr = pos < LC ? 8 : b;
        const float* xr = (pos < LC ? xc_ + ((size_t)(b * LC + pos)) * DM : xl_ + ((size_t)(b * SEQ + pos - LC)) * DM) + n;
        const float* gp = gate + (size_t)rr * 6144 + 2 * 1024 + n;
        const float4 x0 = *(const float4*)xr, x1 = *(const float4*)(xr + 4), g0 = *(const float4*)gp, g1 = *(const float4*)(gp + 4);
        float* xo = X + (size_t)m * DM + n;
        *(float4*)xo = make_float4(x0.x + g0.x * v[0], x0.y + g0.y * v[1], x0.z + g0.z * v[2], x0.w + g0.w * v[3]);
        *(float4*)(xo + 4) = make_float4(x1.x + g1.x * v[4], x1.y + g1.y * v[5], x1.z + g1.z * v[6], x1.w + g1.w * v[7]);
      };
      for (int t = bid; t < 72 * 8; t += nb)
        gemm_tile(TIDX, (const bf16_t*)(big + B_YMIX), 1024, (const bf16_t*)(ws + OFF_WOUT0), 1024, 1024, (t >> 3) * 256, (t & 7) * 128, epi, smem);
    } break;
    case 7: norm_rows(TIDX, p, 0, 1, false, false, bid, nb); break;
    case 8: {
      bf16_t* QP = (bf16_t*)(big + B_QP);
      auto epi = [=](int m, int n, const float* v) { *(uint4*)(QP + (size_t)m * 2048 + n) = pack8(v); };
      for (int t = bid; t < 72 * 16; t += nb)
        gemm_tile(TIDX, H, 1024, (const bf16_t*)(ws + OFF_WQ), 1024, 1024, (t >> 4) * 256, (t & 15) * 128, epi, smem);
    } break;
    case 9: break;
    case 10:
      for (int t = bid; t < 72 * 8; t += nb) route2_task(TIDX, p, 0, (t >> 3) * 256, t & 7, smem);
      break;
    case 11: peer_gather(TIDX, p, 0, false, bid, nb, dry); break;
    case 12: {
      bf16_t* ZG = (bf16_t*)(big + B_ZG);
      bf16_t* ZX = (bf16_t*)(big + B_ZX);
      float* DT = (float*)(big + B_DT);
      auto epi = [=](int m, int n, const float* v) {
        if (n < 2048) *(uint4*)(ZG + (size_t)m * 2048 + n) = pack8(v);
        else if (n < 5120) *(uint4*)(ZX + (size_t)m * 3072 + n - 2048) = pack8(v);
        else if (n < 5184) {
          float* dp = DT + (size_t)m * 64 + n - 5120;
          *(float4*)dp = make_float4(v[0], v[1], v[2], v[3]);
          *(float4*)(dp + 4) = make_float4(v[4], v[5], v[6], v[7]);
        }
      };
      for (int t = bid; t < 72 * 41; t += nb) {
        int mt = t / 41, nt = t % 41;
        gemm_tile(TIDX, H, 1024, (const bf16_t*)(ws + OFF_WIN1), 1024, 1024, mt * 256, nt * 128, epi, smem);
      }
    } break;
    case 13: {
      conv_phase(TIDX, p, bid, nb);
      conv_fp8(TIDX, p.pu + (size_t)16384 * 1024, (unsigned char*)(ws + OFF_UB), (float*)(ws + OFF_UB + 16777216), bid, nb);
      conv_fp8(TIDX, p.pv + (size_t)16384 * 1024, (unsigned char*)(ws + OFF_VB), (float*)(ws + OFF_VB + 16777216), bid, nb);
    } break;
    case 14:
      for (int t = bid; t < 256; t += nb) ssd_task(TIDX, p, t, smem);
      break;
    case 15: gate_norm(TIDX, p, bid, nb); break;
    case 16: {
      const float* gate = mod + (size_t)9 * 6144;
      auto epi = [=](int m, int n, const float* v) {
        int b = m / LT;
        const float* gp = gate + (size_t)b * 6144 + 2 * 1024 + n;
        const float4 g0 = *(const float4*)gp, g1 = *(const float4*)(gp + 4);
        float* xo = X + (size_t)m * DM + n;
        const float4 x0 = *(const float4*)xo, x1 = *(const float4*)(xo + 4);
        *(float4*)xo = make_float4(x0.x + g0.x * v[0], x0.y + g0.y * v[1], x0.z + g0.z * v[2], x0.w + g0.w * v[3]);
        *(float4*)(xo + 4) = make_float4(x1.x + g1.x * v[4], x1.y + g1.y * v[5], x1.z + g1.z * v[6], x1.w + g1.w * v[7]);
      };
      for (int t = bid; t < 64 * 8; t += nb) {
        int mtl = t >> 3, b = mtl >> 3, mt = b * 9 + 1 + (mtl & 7);
        gemm_tile(TIDX, (const bf16_t*)(big + B_YN), 2048, (const bf16_t*)(ws + OFF_WOUT1), 2048, 2048, mt * 256, (t & 7) * 128, epi, smem);
      }
    } break;
    case 17: norm_rows(TIDX, p, 1, 1, false, true, bid, nb); break;
    case 18: {
      bf16_t* QP = (bf16_t*)(big + B_QP);
      auto epi = [=](int m, int n, const float* v) { *(uint4*)(QP + (size_t)m * 2048 + n) = pack8(v); };
      for (int t = bid; t < 64 * 16; t += nb) {
        int mtl = t >> 4, b = mtl >> 3, mt = b * 9 + 1 + (mtl & 7);
        gemm_tile(TIDX, H, 1024, (const bf16_t*)(ws + OFF_WQ) + 2048 * 1024, 1024, 1024, mt * 256, (t & 15) * 128, epi, smem);
      }
    } break;
    case 19: break;
    case 20:
      for (int t = bid; t < 64 * 8; t += nb) {
        int mtl = t >> 3, b = mtl >> 3, mt = b * 9 + 1 + (mtl & 7);
        route2_task(TIDX, p, 1, mt * 256, t & 7, smem);
      }
      break;
    case 21: peer_gather(TIDX, p, 1, true, bid, nb, false); break;
  }
}
constexpr int NPHASE = 22;
#ifndef EXTRA
#define EXTRA
#endif
#ifndef DUP_MASK
#define DUP_MASK 0u
#endif

__global__ void __launch_bounds__(NTHR) mega(P p) {
  __shared__ __attribute__((aligned(16))) char smem[SMEM_BYTES];
  cg::grid_group grid = cg::this_grid();
  __shared__ uint4 xb_words;
  if (threadIdx.x == 0) xb_words = make_uint4(0u, 0u, 0u, 0u);
  __syncthreads();
  XcdBarrier xb = xcd_barrier_post((unsigned*)(p.ws + OFF_BAR), (volatile LAS unsigned*)&xb_words);
#define PHC(i, last)                                             \
  {                                                              \
    P q = p;                                                     \
    int bid = blockIdx.x, nb = gridDim.x;                        \
    char* sm = smem;                                             \
    int TIDX = __builtin_amdgcn_workitem_id_x();                 \
    asm volatile("" : "+s"(q.ws), "+s"(bid), "+s"(nb), "+v"(TIDX)); \
    if ((DUP_MASK >> i) & 1) { run_phase(TIDX, q, i, bid, nb, sm, true); xcd_barrier(xb); } \
    run_phase(TIDX, q, i, bid, nb, sm);                          \
    if (!last) { if (i == 0) grid.sync(); else xcd_barrier(xb); } \
  }
  PHC(0, 0) PHC(1, 0) PHC(2, 0) PHC(3, 0) PHC(4, 0) PHC(5, 0) EXTRA PHC(22, 0) PHC(6, 0) PHC(7, 0) PHC(8, 0) PHC(10, 0)
  PHC(11, 0) PHC(12, 0) PHC(13, 0) PHC(14, 0) PHC(15, 0) PHC(16, 0) PHC(17, 0) PHC(18, 0) PHC(20, 0) PHC(21, 1)
}

extern "C" void kernel_launch(void* const* d_in, const int* in_sizes, int n_in, void* d_out, int out_size, void* d_ws,
                              size_t ws_size, hipStream_t stream) {
  static int grid_blocks = 0;
  if (!grid_blocks) {
    int dev = 0, cus = 0, per_cu = 0;
    hipGetDevice(&dev);
    hipDeviceGetAttribute(&cus, hipDeviceAttributeMultiprocessorCount, dev);
    hipOccupancyMaxActiveBlocksPerMultiprocessor(&per_cu, mega, NTHR, 0);
    if (per_cu < 1) per_cu = 1;
    grid_blocks = cus * per_cu;
  }
  P p;
  memset(&p, 0, sizeof(p));
  const float** fp = (const float**)&p;
  for (int i = 0; i < 35; i++) fp[i] = (const float*)d_in[i];
  p.out = (float*)d_out;
  p.ws = (char*)d_ws;
  if (ws_size < WS_NEED) fprintf(stderr, "workspace too small: %zu < %zu\n", ws_size, (size_t)WS_NEED);
  hipMemsetAsync((char*)d_ws + OFF_BAR, 0, XCD_BAR_WORDS * sizeof(unsigned), stream);
  void* args[] = {&p};
  hipError_t e = hipLaunchCooperativeKernel((void*)mega, dim3(grid_blocks), dim3(NTHR), args, 0, stream);
  if (e != hipSuccess) fprintf(stderr, "cooperative launch failed: %s (grid %d)\n", hipGetErrorString(e), grid_blocks);
}
```

```cpp
#include <hip/hip_runtime.h>
#include <hip/hip_cooperative_groups.h>
#include <stdint.h>
#include <string.h>
#include <stdio.h>
namespace cg = cooperative_groups;

#define DI __device__ __forceinline__
typedef unsigned short bf16_t;
typedef short bf16x8 __attribute__((ext_vector_type(8)));
typedef float f32x16 __attribute__((ext_vector_type(16)));

constexpr int NB = 8, SEQ = 2048, LC = 256, LT = 2304, NTOK = 18432, DM = 1024;
constexpr int NTHR = 512;

constexpr size_t OFF_UB = 0;
constexpr size_t OFF_VB = OFF_UB + 33554432;
constexpr size_t OFF_WIN0 = OFF_VB + 33554432;
constexpr size_t OFF_WOUT0 = OFF_WIN0 + 5242880;
constexpr size_t OFF_WIN1 = OFF_WOUT0 + 3145728;
constexpr size_t OFF_WOUT1 = OFF_WIN1 + 11010048;
constexpr size_t OFF_WQ = OFF_WOUT1 + 4194304;
constexpr size_t OFF_KEYS = OFF_WQ + 8388608;
constexpr size_t OFF_W2C = OFF_KEYS + 1048576;
constexpr size_t OFF_A2C = OFF_W2C + 131072;
constexpr size_t OFF_G2T = OFF_A2C + 131072;
constexpr size_t OFF_MOD = OFF_G2T + 131072;
constexpr size_t OFF_X = OFF_MOD + 442368;
constexpr size_t OFF_H = OFF_X + 75497472;
constexpr size_t OFF_BIG = OFF_H + 37748736;
constexpr size_t B_Z0 = 0;
constexpr size_t B_DEC = 0;
constexpr size_t B_G = 75497472;
constexpr size_t B_QN = 94371840;
constexpr size_t B_KN = B_QN + 18874368;
constexpr size_t B_VT = B_KN + 4718592;
constexpr size_t B_R = B_VT + 4718592;
constexpr size_t B_KB = B_R + 18874368;
constexpr size_t B_KK = B_KB + 18874368;
constexpr size_t B_V = B_KK + 18874368;
constexpr size_t B_AL = B_V + 18874368;
constexpr size_t B_AW = B_AL + 37748736;
constexpr size_t B_AA = B_AW + 2359296;
constexpr size_t B_AG = B_AA + 2359296;
constexpr size_t B_YMIX = B_AW;
constexpr size_t B_OUT = B_YMIX + 37748736;
constexpr size_t B_L0END = B_OUT + 37748736;
constexpr size_t OFF_BON = OFF_UB + 16777216 + 1048576;
constexpr size_t B_QP = 0;
constexpr size_t B_S = 75497472;
constexpr size_t B_EI = B_S + 150994944;
constexpr size_t B_EG = B_EI + 9437184;
constexpr size_t B_PEND = B_EG + 9437184;
constexpr size_t B_ZG = 0;
constexpr size_t B_ZX = 75497472;
constexpr size_t B_Y = B_ZX;
constexpr size_t B_DT = B_ZX + 113246208;
constexpr size_t B_XBC = B_DT + 4718592;
constexpr size_t B_YN = B_XBC;
constexpr size_t B_L1END = B_XBC + 113246208;
constexpr size_t BIG_SZ = B_L1END > B_L0END ? (B_L1END > B_PEND ? B_L1END : B_PEND) : (B_L0END > B_PEND ? B_L0END : B_PEND);
constexpr size_t WS_NEED = OFF_BIG + BIG_SZ;
static_assert(WS_NEED <= 536870912, "workspace too large");

constexpr int SMEM_BYTES = 157696;

struct P {
  const float *x, *c, *ctx, *c_ctx, *mod_w, *mod_b, *n1g, *n2g, *ev_w_in, *ev_w_out, *qg, *kg, *mu, *w0, *w2, *a0, *a2, *g2,
      *k_k, *k_a, *r_k, *gn_w, *gn_b, *ssd_w_in, *conv_w, *conv_b, *dt_bias, *a_log, *ssd_d, *ssd_nw, *ssd_w_out, *pwq, *pkeys,
      *pu, *pv;
  float* out;
  char* ws;
};

typedef float f32x2 __attribute__((ext_vector_type(2)));
typedef __bf16 bf16x2_t __attribute__((ext_vector_type(2)));
DI bf16_t f2bf(float f) { return __builtin_bit_cast(bf16_t, (__bf16)f); }
DI float bf2f(bf16_t b) { return __uint_as_float(((unsigned)b) << 16); }
DI unsigned pack2(float a, float b) {
  f32x2 f = {a, b};
  return __builtin_bit_cast(unsigned, __builtin_convertvector(f, bf16x2_t));
}
DI float lo2f(unsigned u) { return __uint_as_float(u << 16); }
DI float hi2f(unsigned u) { return __uint_as_float(u & 0xffff0000u); }
DI void unpack8(const uint4& r, float* v) {
  v[0] = lo2f(r.x); v[1] = hi2f(r.x); v[2] = lo2f(r.y); v[3] = hi2f(r.y);
  v[4] = lo2f(r.z); v[5] = hi2f(r.z); v[6] = lo2f(r.w); v[7] = hi2f(r.w);
}
DI uint4 pack8(const float* v) {
  uint4 r; r.x = pack2(v[0], v[1]); r.y = pack2(v[2], v[3]); r.z = pack2(v[4], v[5]); r.w = pack2(v[6], v[7]);
  return r;
}
DI float shx_(float v, int off, int lane) {
  return __builtin_bit_cast(float, __builtin_amdgcn_ds_bpermute((lane ^ off) << 2, __builtin_bit_cast(int, v)));
}
DI float shup_(float v, int off, int lane) {
  return __builtin_bit_cast(float, __builtin_amdgcn_ds_bpermute((lane - off) << 2, __builtin_bit_cast(int, v)));
}
#define SHX(v, o) shx_((v), (o), lane)
DI float wave_sum_(float v, int lane) {
#pragma unroll
  for (int o = 32; o > 0; o >>= 1) v += shx_(v, o, lane);
  return v;
}
#define wave_sum(v) wave_sum_((v), lane)
DI float dpp_f(float v, const int ctrl_sel) {
  int x = __builtin_bit_cast(int, v);
  int y;
  if (ctrl_sel == 0) y = __builtin_amdgcn_mov_dpp(x, 0xB1, 0xF, 0xF, true);
  else if (ctrl_sel == 1) y = __builtin_amdgcn_mov_dpp(x, 0x4E, 0xF, 0xF, true);
  else y = __builtin_amdgcn_mov_dpp(x, 0x141, 0xF, 0xF, true);
  return __builtin_bit_cast(float, y);
}
DI float reduce8(float v) {
  v += dpp_f(v, 0);
  v += dpp_f(v, 1);
  v += dpp_f(v, 2);
  return v;
}
DI float wave_sum_dpp(float v, int lane) {
  v += dpp_f(v, 0);
  v += dpp_f(v, 1);
  v += dpp_f(v, 2);
  v += __builtin_bit_cast(float, __builtin_amdgcn_mov_dpp(__builtin_bit_cast(int, v), 0x140, 0xF, 0xF, true));
  v += shx_(v, 16, lane);
  v += shx_(v, 32, lane);
  return v;
}
DI void cvt16_fp8(const uint4& w, float* f) {
  f32x2 t;
  t = __builtin_amdgcn_cvt_pk_f32_fp8((int)w.x, false); f[0] = t.x; f[1] = t.y;
  t = __builtin_amdgcn_cvt_pk_f32_fp8((int)w.x, true); f[2] = t.x; f[3] = t.y;
  t = __builtin_amdgcn_cvt_pk_f32_fp8((int)w.y, false); f[4] = t.x; f[5] = t.y;
  t = __builtin_amdgcn_cvt_pk_f32_fp8((int)w.y, true); f[6] = t.x; f[7] = t.y;
  t = __builtin_amdgcn_cvt_pk_f32_fp8((int)w.z, false); f[8] = t.x; f[9] = t.y;
  t = __builtin_amdgcn_cvt_pk_f32_fp8((int)w.z, true); f[10] = t.x; f[11] = t.y;
  t = __builtin_amdgcn_cvt_pk_f32_fp8((int)w.w, false); f[12] = t.x; f[13] = t.y;
  t = __builtin_amdgcn_cvt_pk_f32_fp8((int)w.w, true); f[14] = t.x; f[15] = t.y;
}
DI float sigmoidf_(float x) { return __builtin_amdgcn_rcpf(1.f + __expf(-x)); }
DI float siluf_(float x) { return x * __builtin_amdgcn_rcpf(1.f + __expf(-x)); }
DI float softplusf_(float y) { return fmaxf(y, 0.f) + __logf(1.f + __expf(-fabsf(y))); }
DI int scanpos(int d, int pp) { return d ? (pp < LC ? LC - 1 - pp : LT + LC - 1 - pp) : pp; }
DI int rowmod(int n) { int b = n / LT; int pos = n - b * LT; return pos < LC ? 8 : b; }
DI const float* xin_row(const P& p, int n) {
  int b = n / LT, pos = n - b * LT;
  return pos < LC ? p.ctx + ((size_t)(b * LC + pos)) * DM : p.x + ((size_t)(b * SEQ + pos - LC)) * DM;
}

template <class Epi>
DI void gemm_tile(const int TIDX, const bf16_t* __restrict__ A, int lda, const bf16_t* __restrict__ Bt, int ldb, int K, int m0, int n0,
                  Epi epi, char* smem) {
  bf16_t* As = (bf16_t*)smem;
  bf16_t* Bs = As + 2 * 256 * 72;
  const int tid = TIDX, lane = tid & 63, wave = tid >> 6;
  const int wm = wave >> 1, wn = wave & 1;
  const int r = lane & 31, h8 = lane >> 5;
  f32x16 acc[2][2];
#pragma unroll
  for (int i = 0; i < 2; i++)
#pragma unroll
    for (int j = 0; j < 2; j++)
#pragma unroll
      for (int q = 0; q < 16; q++) acc[i][j][q] = 0.f;
  const int lrow = tid >> 3, lch = tid & 7;
  const bf16_t* Ap = A + (size_t)(m0 + lrow) * lda + lch * 8;
  const bf16_t* Bp = Bt + (size_t)(n0 + lrow) * ldb + lch * 8;
  const size_t sa = (size_t)64 * lda, sb_ = (size_t)64 * ldb;
  uint4 ra0 = *(const uint4*)(Ap), ra1 = *(const uint4*)(Ap + sa), ra2 = *(const uint4*)(Ap + 2 * sa), ra3 = *(const uint4*)(Ap + 3 * sa);
  uint4 rb0 = *(const uint4*)(Bp), rb1 = *(const uint4*)(Bp + sb_);
  __syncthreads();
  {
    bf16_t* Aw = As + lrow * 72 + lch * 8;
    bf16_t* Bw = Bs + lrow * 72 + lch * 8;
    *(uint4*)(Aw) = ra0; *(uint4*)(Aw + 64 * 72) = ra1; *(uint4*)(Aw + 128 * 72) = ra2; *(uint4*)(Aw + 192 * 72) = ra3;
    *(uint4*)(Bw) = rb0; *(uint4*)(Bw + 64 * 72) = rb1;
  }
  __syncthreads();
  const int nk = K >> 6;
  for (int kt = 0; kt < nk; kt++) {
    const int cur = kt & 1;
    const bool more = kt + 1 < nk;
    if (more) {
      const bf16_t* Aq = Ap + (kt + 1) * 64;
      const bf16_t* Bq = Bp + (kt + 1) * 64;
      ra0 = *(const uint4*)(Aq); ra1 = *(const uint4*)(Aq + sa); ra2 = *(const uint4*)(Aq + 2 * sa); ra3 = *(const uint4*)(Aq + 3 * sa);
      rb0 = *(const uint4*)(Bq); rb1 = *(const uint4*)(Bq + sb_);
    }
    const bf16_t* Ac = As + cur * 256 * 72 + (wm * 64 + r) * 72 + h8 * 8;
    const bf16_t* Bc = Bs + cur * 128 * 72 + (wn * 64 + r) * 72 + h8 * 8;
#pragma unroll
    for (int ks = 0; ks < 4; ks++) {
      bf16x8 a0 = *(const bf16x8*)(Ac + ks * 16);
      bf16x8 a1 = *(const bf16x8*)(Ac + 32 * 72 + ks * 16);
      bf16x8 b0 = *(const bf16x8*)(Bc + ks * 16);
      bf16x8 b1 = *(const bf16x8*)(Bc + 32 * 72 + ks * 16);
      acc[0][0] = __builtin_amdgcn_mfma_f32_32x32x16_bf16(a0, b0, acc[0][0], 0, 0, 0);
      acc[0][1] = __builtin_amdgcn_mfma_f32_32x32x16_bf16(a0, b1, acc[0][1], 0, 0, 0);
      acc[1][0] = __builtin_amdgcn_mfma_f32_32x32x16_bf16(a1, b0, acc[1][0], 0, 0, 0);
      acc[1][1] = __builtin_amdgcn_mfma_f32_32x32x16_bf16(a1, b1, acc[1][1], 0, 0, 0);
    }
    if (more) {
      const int nx = cur ^ 1;
      bf16_t* Aw = As + nx * 256 * 72 + lrow * 72 + lch * 8;
      bf16_t* Bw = Bs + nx * 128 * 72 + lrow * 72 + lch * 8;
      *(uint4*)(Aw) = ra0; *(uint4*)(Aw + 64 * 72) = ra1; *(uint4*)(Aw + 128 * 72) = ra2; *(uint4*)(Aw + 192 * 72) = ra3;
      *(uint4*)(Bw) = rb0; *(uint4*)(Bw + 64 * 72) = rb1;
    }
    __syncthreads();
  }
  float* Cs = (float*)smem;
#pragma unroll
  for (int mt = 0; mt < 2; mt++)
#pragma unroll
    for (int nt = 0; nt < 2; nt++)
#pragma unroll
      for (int q = 0; q < 16; q++)
        Cs[(wm * 64 + mt * 32 + (q & 3) + 8 * (q >> 2) + 4 * h8) * 132 + wn * 64 + nt * 32 + r] = acc[mt][nt][q];
  __syncthreads();
#pragma unroll
  for (int i = 0; i < 8; i++) {
    const int seg = i * NTHR + tid;
    const int row = seg >> 4, cs = (seg & 15) * 8;
    const float4 c0 = *(const float4*)(Cs + row * 132 + cs), c1 = *(const float4*)(Cs + row * 132 + cs + 4);
    float v[8] = {c0.x, c0.y, c0.z, c0.w, c1.x, c1.y, c1.z, c1.w};
    epi(m0 + row, n0 + cs, v);
  }
}

namespace pg8 {
#define PG8_LAS __attribute__((address_space(3)))
typedef unsigned short bf16_t;
typedef short bf16x8 __attribute__((ext_vector_type(8)));
typedef float f32x4 __attribute__((ext_vector_type(4)));
typedef unsigned u32x4 __attribute__((ext_vector_type(4)));
constexpr int BM = 256, BK = 64, HALF = 128, HTB = HALF * BK * 2  , STAGE_BYTES = 8 * HTB, NXCD = 8, WGM = 8;

__host__ __device__ __forceinline__ int lds_byte(int r, int c) { const int st = (r >> 4) * 2 + (c >> 5), rr = r & 15, cc = c & 31, ob = rr * 64 + cc * 2; return st * 1024 + (ob ^ (((ob >> 9) & 1) << 5)); }
__host__ __device__ __forceinline__ void stage_rc(int b, int& R, int& C) { const int st = b / 1024, sb = b % 1024, swz = sb ^ (((sb >> 9) & 1) << 5); R = (st >> 1) * 16 + swz / 64; C = (st & 1) * 32 + (swz % 64) / 2; }
__host__ __device__ __forceinline__ int perm32(int rho) { const int n = rho >> 4, i = rho & 15; return 8 * (i >> 2) + 4 * n + (i & 3); }

struct Unit { int pm, pn; };
struct Gemm { const bf16_t* A; const bf16_t* Bt; int M, N, K; };

struct TileOrder {
    int nN, nwg, G, c, latent;
    __device__ __forceinline__ void init(int nM_, int nN_, int G_, int c_, int latent_) { nN = nN_; nwg = nM_ * nN_; G = G_; c = c_; latent = latent_; }
    __device__ __forceinline__ bool next(int i, Unit& u) const {
        const int L = i * G + c; if (L >= nwg) return false;
        int wgid = L; { const int q = nwg / NXCD, r = nwg % NXCD, xcd = wgid % NXCD, off = wgid / NXCD; wgid = (xcd < r ? xcd * (q + 1) : r * (q + 1) + (xcd - r) * q) + off; }
        const int nM = nwg / nN;
        const int nig = WGM * nN, gid = wgid / nig, fm = gid * WGM, gsz = (nM - fm) < WGM ? (nM - fm) : WGM;
        int pm = fm + ((wgid % nig) % gsz); u.pn = (wgid % nig) / gsz;
        if (latent) { const int b = pm >> 3; pm = b * 9 + 1 + (pm & 7); }
        u.pm = pm; return true;
    }
    __device__ __forceinline__ void a_ready(const Unit&) const {}
    __device__ __forceinline__ void done(const Unit&) const {}
};
template <class F> struct EpiAdapt {
    static constexpr bool PERM = true, AFTER_DRAIN = false;
    F f;
    __device__ __forceinline__ void operator()(const f32x4 (&acc)[2][2][4][2], const Unit& u, int wr, int wc, int fr, int fq) const {
#pragma unroll
        for (int ai = 0; ai < 2; ++ai)
#pragma unroll
            for (int m = 0; m < 4; ++m) {
                const int row = u.pm * BM + ai * HALF + wr * 64 + m * 16 + fr;
#pragma unroll
                for (int bj = 0; bj < 2; ++bj) {
                    const int col = u.pn * BM + bj * HALF + wc * 32 + 8 * fq;
                    const f32x4 a0 = acc[ai][bj][m][0], a1 = acc[ai][bj][m][1];
                    float v[8] = {a0[0], a0[1], a0[2], a0[3], a1[0], a1[1], a1[2], a1[3]};
                    f(row, col, v);
                }
            }
    }
};

template <class Epi, class Sched, bool ALIGN_EPI = false, bool SP2 = false>
__device__ __forceinline__ void gemm_phase(const int TIDX, PG8_LAS unsigned char* lds, const Gemm g, const Sched& S, const Epi& E) {
    const int tid = TIDX, wid = __builtin_amdgcn_readfirstlane(tid >> 6), lane = tid & 63, wr = wid >> 2, wc = wid & 3, fr = lane & 15, fq = lane >> 4;
    const int K = g.K, nt = K / BK;
    unsigned voffA[2], voffB[2];
#pragma unroll
    for (int i = 0; i < 2; ++i) { int R, C; stage_rc(tid * 16 + i * 8192, R, C); const int Rb = Epi::PERM ? ((R & ~31) + perm32(R & 31)) : R;
        voffA[i] = (unsigned)(R * K + C) * 2u; voffB[i] = (unsigned)(Rb * K + C) * 2u; }
    const size_t kstep = (size_t)(BK * 2);
    const size_t hstep = (size_t)HALF * K * 2;
    const size_t tstep = 2 * hstep;
    const unsigned ldsw = (unsigned)wid * 1024u;
    const int aoff = lds_byte(wr * 64 + fr, fq * 8), boff = lds_byte(wc * 32 + fr, fq * 8);
#define PG8_SA(b, h) (((b) * 2 + (h)) * HTB)
#define PG8_SB(b, h) ((4 + (b) * 2 + (h)) * HTB)
#define PG8_STAGE(bufoff, gbase, voff) do { _Pragma("unroll") for (int _i = 0; _i < 2; ++_i) \
        __builtin_amdgcn_global_load_lds((const unsigned*)((const char*)(gbase) + (voff)[_i]), (PG8_LAS unsigned*)(lds + (bufoff) + ldsw + _i * 8192), 16, 0, 0); } while (0)
#define PG8_LDA(dst, b, h) do { _Pragma("unroll") for (int m = 0; m < 4; ++m) _Pragma("unroll") for (int k = 0; k < 2; ++k) dst[m][k] = *(const PG8_LAS bf16x8*)(lds + PG8_SA(b, h) + aoff + m * 2048 + k * 1024); } while (0)
#define PG8_LDB(dst, b, h) do { _Pragma("unroll") for (int n = 0; n < 2; ++n) _Pragma("unroll") for (int k = 0; k < 2; ++k) dst[n][k] = *(const PG8_LAS bf16x8*)(lds + PG8_SB(b, h) + boff + n * 2048 + k * 1024); } while (0)
#define PG8_MMA(ai, bj, At, Bt) do { __builtin_amdgcn_s_setprio(1); _Pragma("unroll") for (int m = 0; m < 4; ++m) _Pragma("unroll") for (int n = 0; n < 2; ++n) _Pragma("unroll") for (int k = 0; k < 2; ++k) \
        acc[ai][bj][m][n] = __builtin_amdgcn_mfma_f32_16x16x32_bf16(Bt[n][k], At[m][k], acc[ai][bj][m][n], 0, 0, 0); __builtin_amdgcn_s_setprio(0); } while (0)
#define PG8_WAIT_V(n) asm volatile("s_waitcnt vmcnt(" #n ")" ::: "memory")
#define PG8_WAIT_L(n) asm volatile("s_waitcnt lgkmcnt(" #n ")" ::: "memory")
#define PG8_BAR __builtin_amdgcn_s_barrier()
#define PG8_SCHED __builtin_amdgcn_sched_barrier(0)
    Unit cur, nxt; int ui = 0;
    if (!S.next(0, cur)) return;
    f32x4 acc[2][2][4][2];
#pragma unroll
    for (int a = 0; a < 2; ++a)
#pragma unroll
        for (int b = 0; b < 2; ++b)
#pragma unroll
            for (int m = 0; m < 4; ++m)
#pragma unroll
                for (int n = 0; n < 2; ++n) acc[a][b][m][n] = (f32x4){0.f, 0.f, 0.f, 0.f};
    bf16x8 At[4][2], B0[2][2], B1[2][2];
    const char* cA = (const char*)g.A + (size_t)cur.pm * tstep; const char* cB = (const char*)g.Bt + (size_t)cur.pn * tstep;
    S.a_ready(cur);
    if constexpr (SP2) {
        PG8_STAGE(PG8_SB(0, 0), cB, voffB); PG8_STAGE(PG8_SB(0, 1), cB + hstep, voffB); PG8_STAGE(PG8_SA(0, 0), cA, voffA); PG8_STAGE(PG8_SA(0, 1), cA + hstep, voffA);
        if (wr == 1) PG8_BAR;
        PG8_WAIT_V(2); PG8_BAR;
        PG8_STAGE(PG8_SB(1, 0), cB + kstep, voffB); PG8_STAGE(PG8_SA(1, 0), cA + kstep, voffA); PG8_STAGE(PG8_SB(1, 1), cB + hstep + kstep, voffB);
        PG8_WAIT_V(6); PG8_BAR;
    } else {
        PG8_STAGE(PG8_SB(0, 0), cB, voffB); PG8_STAGE(PG8_SA(0, 0), cA, voffA); PG8_STAGE(PG8_SB(0, 1), cB + hstep, voffB); PG8_STAGE(PG8_SA(0, 1), cA + hstep, voffA);
        if (wr == 1) PG8_BAR;
        PG8_WAIT_V(4); PG8_BAR;
        PG8_STAGE(PG8_SB(1, 0), cB + kstep, voffB); PG8_STAGE(PG8_SA(1, 0), cA + kstep, voffA); PG8_STAGE(PG8_SB(1, 1), cB + hstep + kstep, voffB);
        PG8_WAIT_V(6); PG8_BAR;
    }
    for (;;) {
        const bool has_next = S.next(ui + 1, nxt);
        const char* nA = has_next ? (const char*)g.A + (size_t)nxt.pm * tstep : cA; const char* nB = has_next ? (const char*)g.Bt + (size_t)nxt.pn * tstep : cB;
        for (int t = 0; t < nt; t += 2) {
            const bool last = (t == nt - 2);
            const char* a1 = cA + (size_t)(t + 1) * kstep;
            const char* a2 = last ? nA : cA + (size_t)(t + 2) * kstep; const char* b2 = last ? nB : cB + (size_t)(t + 2) * kstep;
            const char* a3 = a2 + kstep; const char* b3 = b2 + kstep;
            if (last && has_next) S.a_ready(nxt);
            if constexpr (SP2) {
            PG8_LDB(B0, 0, 0); PG8_LDB(B1, 0, 1); PG8_SCHED; PG8_LDA(At, 0, 0); PG8_STAGE(PG8_SA(1, 1), a1 + hstep, voffA);
            PG8_WAIT_V(8); PG8_WAIT_L(0); PG8_BAR; PG8_MMA(0, 0, At, B0); PG8_MMA(0, 1, At, B1); PG8_BAR; PG8_SCHED;
            PG8_LDA(At, 0, 1); PG8_STAGE(PG8_SB(0, 0), b2, voffB); PG8_STAGE(PG8_SB(0, 1), b2 + hstep, voffB); PG8_STAGE(PG8_SA(0, 0), a2, voffA);
            PG8_WAIT_V(8); PG8_WAIT_L(0); PG8_BAR; PG8_MMA(1, 0, At, B0); PG8_MMA(1, 1, At, B1); PG8_BAR; PG8_SCHED;
            PG8_LDB(B0, 1, 0); PG8_LDB(B1, 1, 1); PG8_SCHED; PG8_LDA(At, 1, 0); PG8_STAGE(PG8_SA(0, 1), a2 + hstep, voffA);
            PG8_WAIT_V(8); PG8_WAIT_L(0); PG8_BAR; PG8_MMA(0, 0, At, B0); PG8_MMA(0, 1, At, B1); PG8_BAR; PG8_SCHED;
            PG8_LDA(At, 1, 1); PG8_STAGE(PG8_SB(1, 0), b3, voffB); PG8_STAGE(PG8_SB(1, 1), b3 + hstep, voffB); PG8_STAGE(PG8_SA(1, 0), a3, voffA);
            PG8_WAIT_V(8); PG8_WAIT_L(0); PG8_BAR; PG8_MMA(1, 0, At, B0); PG8_MMA(1, 1, At, B1); PG8_BAR; PG8_SCHED;
            } else {
            PG8_LDB(B0, 0, 0); PG8_SCHED; PG8_LDA(At, 0, 0); PG8_STAGE(PG8_SA(1, 1), a1 + hstep, voffA);
            PG8_WAIT_L(8); PG8_BAR; PG8_WAIT_L(0); PG8_MMA(0, 0, At, B0); PG8_BAR; PG8_SCHED;
            PG8_LDB(B1, 0, 1); PG8_STAGE(PG8_SB(0, 0), b2, voffB);
            PG8_BAR; PG8_WAIT_L(0); PG8_MMA(0, 1, At, B1); PG8_BAR;
            PG8_LDA(At, 0, 1); PG8_STAGE(PG8_SA(0, 0), a2, voffA);
            PG8_BAR; PG8_WAIT_L(0); PG8_MMA(1, 0, At, B0); PG8_BAR; PG8_SCHED;
            PG8_STAGE(PG8_SB(0, 1), b2 + hstep, voffB);
            PG8_WAIT_V(6); PG8_BAR; PG8_MMA(1, 1, At, B1); PG8_BAR;
            PG8_LDB(B0, 1, 0); PG8_SCHED; PG8_LDA(At, 1, 0); PG8_STAGE(PG8_SA(0, 1), a2 + hstep, voffA);
            PG8_WAIT_L(8); PG8_BAR; PG8_WAIT_L(0); PG8_MMA(0, 0, At, B0); PG8_BAR; PG8_SCHED;
            PG8_LDB(B1, 1, 1); PG8_STAGE(PG8_SB(1, 0), b3, voffB);
            PG8_BAR; PG8_WAIT_L(0); PG8_MMA(0, 1, At, B1); PG8_BAR;
            PG8_LDA(At, 1, 1); PG8_STAGE(PG8_SA(1, 0), a3, voffA);
            PG8_BAR; PG8_WAIT_L(0); PG8_MMA(1, 0, At, B0); PG8_BAR; PG8_SCHED;
            PG8_STAGE(PG8_SB(1, 1), b3 + hstep, voffB);
            PG8_WAIT_V(6); PG8_BAR; PG8_MMA(1, 1, At, B1); PG8_BAR;
            }
        }
        if constexpr (ALIGN_EPI) { if (wr == 0) PG8_BAR; }
        if constexpr (!Epi::AFTER_DRAIN) { E(acc, cur, wr, wc, fr, fq); S.done(cur); }
        if (!has_next) break;
#pragma unroll
        for (int a = 0; a < 2; ++a)
#pragma unroll
            for (int b = 0; b < 2; ++b)
#pragma unroll
                for (int m = 0; m < 4; ++m)
#pragma unroll
                    for (int n = 0; n < 2; ++n) acc[a][b][m][n] = (f32x4){0.f, 0.f, 0.f, 0.f};
        cur = nxt; cA = nA; cB = nB; ++ui;
        if constexpr (ALIGN_EPI) { if (wr == 1) PG8_BAR; }
    }
    PG8_WAIT_V(0);
    if constexpr (!ALIGN_EPI) { if (wr == 0) PG8_BAR; }
    PG8_BAR;
    if constexpr (Epi::AFTER_DRAIN) { E.fused(acc, cur, wr, wc, fr, fq, lds, wid, lane); S.done(cur); }
#undef PG8_SA
#undef PG8_SB
#undef PG8_STAGE
#undef PG8_LDA
#undef PG8_LDB
#undef PG8_MMA
#undef PG8_WAIT_V
#undef PG8_WAIT_L
#undef PG8_BAR
#undef PG8_SCHED
}
}


#ifndef GEMM_ALIGN_EPI
#define GEMM_ALIGN_EPI true
#endif
template <class F>
DI void big_gemm(const int TIDX, const bf16_t* A, const bf16_t* Bt, int K, int nM, int nN, int latent, F f, int bid, int nb, char* smem) {
  pg8::Gemm g; g.A = A; g.Bt = Bt; g.M = 0; g.N = 0; g.K = K;
  pg8::TileOrder S; S.init(nM, nN, nb, bid, latent);
  pg8::EpiAdapt<F> E{f};
  __syncthreads();
  pg8::gemm_phase<pg8::EpiAdapt<F>, pg8::TileOrder, GEMM_ALIGN_EPI, true>(TIDX, (PG8_LAS unsigned char*)smem, g, S, E);
  __syncthreads();
}

DI void tconv(const int TIDX, const float* __restrict__ src, int lds_, int K, int N, bf16_t* __restrict__ dst, int ldd, int koff, int bid,
              int nb, char* smem) {
  float* t = (float*)smem;
  const int tn = N >> 6, tk = K >> 6;
  const int lk = TIDX >> 4, ln = (TIDX & 15) * 4;
  const int on = TIDX >> 3, ok = (TIDX & 7) * 8;
  for (int tile = bid; tile < tk * tn; tile += nb) {
    const int k0 = (tile / tn) * 64, n0 = (tile % tn) * 64;
    const float4 v0 = *(const float4*)(src + (size_t)(k0 + lk) * lds_ + n0 + ln);
    const float4 v1 = *(const float4*)(src + (size_t)(k0 + 32 + lk) * lds_ + n0 + ln);
    __syncthreads();
    *(float4*)(t + lk * 68 + ln) = v0;
    *(float4*)(t + (32 + lk) * 68 + ln) = v1;
    __syncthreads();
    float o[8];
#pragma unroll
    for (int j = 0; j < 8; j++) o[j] = t[(ok + j) * 68 + on];
    *(uint4*)(dst + (size_t)(n0 + on) * ldd + koff + k0 + ok) = pack8(o);
  }
}
DI void conv_flat(const int TIDX, const float* __restrict__ src, bf16_t* __restrict__ dst, size_t count, int bid, int nb) {
  const size_t n4 = count >> 2;
  for (size_t i = (size_t)bid * NTHR + TIDX; i < n4; i += (size_t)nb * NTHR) {
    float4 v = ((const float4*)src)[i];
    uint2 o; o.x = pack2(v.x, v.y); o.y = pack2(v.z, v.w);
    ((uint2*)dst)[i] = o;
  }
}
DI void conv_fp8(const int TIDX, const float* __restrict__ src, unsigned char* __restrict__ dst, float* __restrict__ scl, int bid, int nb) {
  const int lane = TIDX & 63, wave = TIDX >> 6;
  for (int row = bid * 8 + wave; row < 16384; row += nb * 8) {
    const float* sp = src + (size_t)row * 1024 + lane * 16;
    float4 v0 = *(const float4*)(sp), v1 = *(const float4*)(sp + 4), v2 = *(const float4*)(sp + 8), v3 = *(const float4*)(sp + 12);
    float am = fmaxf(fmaxf(fmaxf(fabsf(v0.x), fabsf(v0.y)), fmaxf(fabsf(v0.z), fabsf(v0.w))),
                     fmaxf(fmaxf(fabsf(v1.x), fabsf(v1.y)), fmaxf(fabsf(v1.z), fabsf(v1.w))));
    am = fmaxf(am, fmaxf(fmaxf(fmaxf(fabsf(v2.x), fabsf(v2.y)), fmaxf(fabsf(v2.z), fabsf(v2.w))),
                         fmaxf(fmaxf(fabsf(v3.x), fabsf(v3.y)), fmaxf(fabsf(v3.z), fabsf(v3.w)))));
#pragma unroll
    for (int o = 32; o > 0; o >>= 1) am = fmaxf(am, shx_(am, o, lane));
    const float sc = am > 0.f ? 224.f / am : 1.f;
    if (lane == 0) scl[row] = am > 0.f ? am * (1.f / 224.f) : 1.f;
    uint4 o;
    int t = 0;
    t = __builtin_amdgcn_cvt_pk_fp8_f32(v0.x * sc, v0.y * sc, t, false); t = __builtin_amdgcn_cvt_pk_fp8_f32(v0.z * sc, v0.w * sc, t, true); o.x = (unsigned)t;
    t = __builtin_amdgcn_cvt_pk_fp8_f32(v1.x * sc, v1.y * sc, t, false); t = __builtin_amdgcn_cvt_pk_fp8_f32(v1.z * sc, v1.w * sc, t, true); o.y = (unsigned)t;
    t = __builtin_amdgcn_cvt_pk_fp8_f32(v2.x * sc, v2.y * sc, t, false); t = __builtin_amdgcn_cvt_pk_fp8_f32(v2.z * sc, v2.w * sc, t, true); o.z = (unsigned)t;
    t = __builtin_amdgcn_cvt_pk_fp8_f32(v3.x * sc, v3.y * sc, t, false); t = __builtin_amdgcn_cvt_pk_fp8_f32(v3.z * sc, v3.w * sc, t, true); o.w = (unsigned)t;
    *(uint4*)(dst + (size_t)row * 1024 + lane * 16) = o;
  }
}
DI void mod_gemv(const int TIDX, const P& p, int layer_sel, int bid, int nb, char* smem) {
  float* sc = (float*)smem;
  float* red = sc + 9 * 1024;
  float* modo = (float*)(p.ws + OFF_MOD);
  for (int task = nb - 1 - bid; task < 96; task += nb) {
    const int l = layer_sel, j0 = task * 64;
    __syncthreads();
    for (int e = TIDX; e < 9 * 1024; e += NTHR) {
      int rr = e >> 10, k = e & 1023;
      float v = rr < 8 ? p.c[rr * 1024 + k] : p.c_ctx[k];
      sc[e] = v / (1.f + expf(-v));
    }
    __syncthreads();
    const int kg = TIDX >> 6, col = TIDX & 63;
    float acc[9];
#pragma unroll
    for (int q = 0; q < 9; q++) acc[q] = 0.f;
    const float* W = p.mod_w + (size_t)l * 1024 * 6144 + j0 + col;
#pragma unroll 16
    for (int k = kg * 128; k < kg * 128 + 128; ++k) {
      float w = W[(size_t)k * 6144];
#pragma unroll
      for (int q = 0; q < 9; q++) acc[q] += sc[q * 1024 + k] * w;
    }
#pragma unroll
    for (int q = 0; q < 9; q++) red[(kg * 9 + q) * 64 + col] = acc[q];
    __syncthreads();
    for (int e = TIDX; e < 9 * 64; e += NTHR) {
      int rr = e >> 6, cc = e & 63;
      float s = p.mod_b[l * 6144 + j0 + cc];
#pragma unroll
      for (int g = 0; g < 8; g++) s += red[(g * 9 + rr) * 64 + cc];
      modo[(size_t)(l * 9 + rr) * 6144 + j0 + cc] = s;
    }
  }
}

DI void norm_rows(const int TIDX, const P& p, int layer, int which, bool from_input, bool latent_only, int bid, int nb) {
  const int lane = TIDX & 63, wave = TIDX >> 6;
  const float* mod = (const float*)(p.ws + OFF_MOD);
  const float* X = (const float*)(p.ws + OFF_X);
  bf16_t* H = (bf16_t*)(p.ws + OFF_H);
  const float* g = (which ? p.n2g : p.n1g) + layer * 1024;
  const int ntok = latent_only ? NB * SEQ : NTOK;
  const int nw = nb * 8;
  for (int it = bid * 8 + wave; it < ntok; it += 4 * nw) {
    int nn[4];
    bool val[4];
    float4 v[4][4];
#pragma unroll
    for (int t = 0; t < 4; t++) {
      int ti = it + t * nw;
      val[t] = ti < ntok;
      if (!val[t]) ti = it;
      nn[t] = latent_only ? ((ti >> 11) * LT + LC + (ti & 2047)) : ti;
      const float* src = from_input ? xin_row(p, nn[t]) : X + (size_t)nn[t] * DM;
#pragma unroll
      for (int i = 0; i < 4; i++) v[t][i] = *(const float4*)(src + i * 256 + lane * 4);
    }
#pragma unroll
    for (int t = 0; t < 4; t++) {
      float ss = 0.f;
#pragma unroll
      for (int i = 0; i < 4; i++) ss += v[t][i].x * v[t][i].x + v[t][i].y * v[t][i].y + v[t][i].z * v[t][i].z + v[t][i].w * v[t][i].w;
      ss = wave_sum_dpp(ss, lane);
      const float rs = rsqrtf(ss * (1.f / 1024.f) + 1e-6f);
      const int n = nn[t];
      const int b = n / LT, pos = n - b * LT;
      const int rr = pos < LC ? 8 : b;
      const float* msc = mod + (size_t)(layer * 9 + rr) * 6144 + (which ? 4 : 1) * 1024;
      const float* msh = mod + (size_t)(layer * 9 + rr) * 6144 + (which ? 3 : 0) * 1024;
      if (val[t]) {
#pragma unroll
        for (int i = 0; i < 4; i++) {
          int idx = i * 256 + lane * 4;
          float4 gg = *(const float4*)(g + idx), sc = *(const float4*)(msc + idx), sh = *(const float4*)(msh + idx);
          float y0 = v[t][i].x * rs * gg.x * (1.f + sc.x) + sh.x;
          float y1 = v[t][i].y * rs * gg.y * (1.f + sc.y) + sh.y;
          float y2 = v[t][i].z * rs * gg.z * (1.f + sc.z) + sh.z;
          float y3 = v[t][i].w * rs * gg.w * (1.f + sc.w) + sh.w;
          uint2 o; o.x = pack2(y0, y1); o.y = pack2(y2, y3);
          *(uint2*)(H + (size_t)n * DM + idx) = o;
        }
      }
    }
  }
}

DI void rope8(float* v, int e, int t, int lane) {
  const int half = e >> 2, isx2 = (e >> 1) & 1, ibase = (e & 1) * 8;
  const float posf = half ? (float)(t & 63) : (float)(t >> 6);
#pragma unroll
  for (int j = 0; j < 8; j++) {
    float pv = SHX(v[j], 2);
    float inv = exp2f(-(float)(ibase + j) * 0.83048202f);
    float ang = posf * inv;
    float rev = ang * 0.15915494309f;
    rev -= floorf(rev);
    float sn = __builtin_amdgcn_sinf(rev), cs = __builtin_amdgcn_cosf(rev);
    v[j] = isx2 ? (v[j] * cs + pv * sn) : (v[j] * cs - pv * sn);
  }
}
DI void prep0(const int TIDX, const P& p, int bid, int nb) {
  char* big = p.ws + OFF_BIG;
  const bf16_t* Z = (const bf16_t*)(big + B_Z0);
  bf16_t* QN = (bf16_t*)(big + B_QN); bf16_t* KN = (bf16_t*)(big + B_KN); bf16_t* VT = (bf16_t*)(big + B_VT);
  bf16_t* R = (bf16_t*)(big + B_R); bf16_t* KB = (bf16_t*)(big + B_KB); bf16_t* KK = (bf16_t*)(big + B_KK);
  bf16_t* V = (bf16_t*)(big + B_V); bf16_t* AW = (bf16_t*)(big + B_AW); bf16_t* AA = (bf16_t*)(big + B_AA);
  bf16_t* AG = (bf16_t*)(big + B_AG);
  const int lane = TIDX & 63, wave = TIDX >> 6;
  for (int n = bid * 8 + wave; n < NTOK; n += nb * 8) {
    const int b = n / LT, pos = n - b * LT;
    const bool lat = pos >= LC;
    const int t = pos - LC;
    const bf16_t* zr = Z + (size_t)n * 2560;
    const bool hasp = (pos != 0 && pos != LC), hasn = (pos != LC - 1 && pos != LT - 1);
    const bf16_t* zc = zr + 768;
    const uint4 rawq = *(const uint4*)(zr + (lane >> 3) * 64 + (lane & 7) * 8);
    uint4 rawkv = make_uint4(0, 0, 0, 0);
    if (lane < 32) rawkv = *(const uint4*)(zr + 512 + ((lane >> 3) & 3) * 64 + (lane & 7) * 8);
    uint2 cuA[7], puA[7], nuA[7];
#pragma unroll
    for (int i = 0; i < 7; i++) {
      const int j = i * 256 + lane * 4;
      cuA[i] = *(const uint2*)(zc + j);
      puA[i] = make_uint2(0, 0); nuA[i] = make_uint2(0, 0);
      if (hasp) puA[i] = *(const uint2*)(zc - 2560 + j);
      if (hasn) nuA[i] = *(const uint2*)(zc + 2560 + j);
    }
    {
      const int head = lane >> 3, e = lane & 7;
      float v[8]; unpack8(rawq, v);
      float ss = 0.f;
#pragma unroll
      for (int j = 0; j < 8; j++) ss += v[j] * v[j];
      ss += SHX(ss, 1); ss += SHX(ss, 2); ss += SHX(ss, 4);
      const float rs = rsqrtf(ss * (1.f / 64.f) + 1e-6f);
#pragma unroll
      for (int j = 0; j < 8; j++) v[j] = v[j] * rs * p.qg[e * 8 + j];
      if (lat) rope8(v, e, t, lane);
#pragma unroll
      for (int j = 0; j < 8; j++) v[j] *= 0.18033688011f;
      *(uint4*)(QN + ((size_t)(b * 8 + head) * LT + pos) * 64 + e * 8) = pack8(v);
    }
    {
      const int hh = (lane >> 3) & 3, e = lane & 7;
      float v[8]; unpack8(rawkv, v);
      float kv[8];
      float ss = 0.f;
#pragma unroll
      for (int j = 0; j < 8; j++) ss += v[j] * v[j];
      ss += SHX(ss, 1); ss += SHX(ss, 2); ss += SHX(ss, 4);
      const float rs = rsqrtf(ss * (1.f / 64.f) + 1e-6f);
#pragma unroll
      for (int j = 0; j < 8; j++) kv[j] = v[j] * rs * p.kg[e * 8 + j];
      if (lat) rope8(kv, e, t, lane);
      if (lane < 16) {
        *(uint4*)(KN + ((size_t)(b * 2 + hh) * LT + pos) * 64 + e * 8) = pack8(kv);
      } else if (lane < 32) {
        const int kvh = hh - 2;
#pragma unroll
        for (int j = 0; j < 8; j++) VT[((size_t)(b * 2 + kvh) * 64 + e * 8 + j) * LT + pos] = f2bf(v[j]);
      }
    }
#pragma unroll
    for (int i = 0; i < 7; i++) {
      const int j = i * 256 + lane * 4;
      const uint2 cu = cuA[i], pu = puA[i], nu = nuA[i];
      float4 m4 = *(const float4*)(p.mu + j);
      float cv[4] = {lo2f(cu.x), hi2f(cu.x), lo2f(cu.y), hi2f(cu.y)};
      float pv[4] = {lo2f(pu.x), hi2f(pu.x), lo2f(pu.y), hi2f(pu.y)};
      float nv[4] = {lo2f(nu.x), hi2f(nu.x), lo2f(nu.y), hi2f(nu.y)};
      float mm[4] = {m4.x, m4.y, m4.z, m4.w};
      float zm[4];
#pragma unroll
      for (int q = 0; q < 4; q++) zm[q] = cv[q] + mm[q] * (0.5f * (pv[q] + nv[q]) - cv[q]);
      if (i < 6) {
        const int cc = (i & 1) * 256 + lane * 4;
        const int head = cc >> 6, within = cc & 63;
        const size_t oidx = ((size_t)(b * 8 + head) * LT + pos) * 64 + within;
        uint2 o; o.x = pack2(zm[0], zm[1]); o.y = pack2(zm[2], zm[3]);
        if (i < 2) {
          *(uint2*)(R + oidx) = o;
        } else if (i < 4) {
          *(uint2*)(KB + oidx) = o;
          float4 kk4 = *(const float4*)(p.k_k + cc);
          float k0 = zm[0] * kk4.x, k1 = zm[1] * kk4.y, k2 = zm[2] * kk4.z, k3 = zm[3] * kk4.w;
          float ss = k0 * k0 + k1 * k1 + k2 * k2 + k3 * k3;
          ss += SHX(ss, 1); ss += SHX(ss, 2); ss += SHX(ss, 4); ss += SHX(ss, 8);
          const float inv = 1.f / fmaxf(sqrtf(ss), 1e-12f);
          uint2 o2; o2.x = pack2(k0 * inv, k1 * inv); o2.y = pack2(k2 * inv, k3 * inv);
          *(uint2*)(KK + oidx) = o2;
        } else {
          *(uint2*)(V + oidx) = o;
        }
      } else {
        if (lane < 16) {
          uint2 o; o.x = pack2(tanhf(zm[0]), tanhf(zm[1])); o.y = pack2(tanhf(zm[2]), tanhf(zm[3]));
          *(uint2*)(AW + (size_t)n * 64 + lane * 4) = o;
        } else if (lane < 32) {
          uint2 o; o.x = pack2(zm[0], zm[1]); o.y = pack2(zm[2], zm[3]);
          *(uint2*)(AA + (size_t)n * 64 + (lane - 16) * 4) = o;
        } else {
          uint2 o; o.x = pack2(sigmoidf_(zm[0]), sigmoidf_(zm[1])); o.y = pack2(sigmoidf_(zm[2]), sigmoidf_(zm[3]));
          *(uint2*)(AG + (size_t)n * 128 + (lane - 32) * 4) = o;
        }
      }
    }
  }
}

DI void lds_barrier() {
  asm volatile("s_waitcnt lgkmcnt(0)" ::: "memory");
  __builtin_amdgcn_s_barrier();
  asm volatile("" ::: "memory");
}
DI float reduce16(float v) {
  v += dpp_f(v, 0);
  v += dpp_f(v, 1);
  v += dpp_f(v, 2);
  v += __builtin_bit_cast(float, __builtin_amdgcn_mov_dpp(__builtin_bit_cast(int, v), 0x140, 0xF, 0xF, true));
  return v;
}
DI void reduce16_2(float& a, float& b) {
  a += dpp_f(a, 0); b += dpp_f(b, 0);
  a += dpp_f(a, 1); b += dpp_f(b, 1);
  a += dpp_f(a, 2); b += dpp_f(b, 2);
  a += __builtin_bit_cast(float, __builtin_amdgcn_mov_dpp(__builtin_bit_cast(int, a), 0x140, 0xF, 0xF, true));
  b += __builtin_bit_cast(float, __builtin_amdgcn_mov_dpp(__builtin_bit_cast(int, b), 0x140, 0xF, 0xF, true));
}
DI void wkv2_task(const int TIDX, const P& p, int task, char* smem) {
  char* big = p.ws + OFF_BIG;
  const int rh = task & 1, d = (task >> 1) & 1, h = (task >> 2) & 7, b = task >> 5;
  const bf16_t* R = (const bf16_t*)(big + B_R); const bf16_t* KB = (const bf16_t*)(big + B_KB);
  const bf16_t* KK = (const bf16_t*)(big + B_KK); const bf16_t* V = (const bf16_t*)(big + B_V);
  const bf16_t* AL = (const bf16_t*)(big + B_AL) + (size_t)d * NB * 8 * LT * 64;
  const float* DEC = (const float*)(big + B_DEC) + (size_t)d * NB * 8 * LT * 64;
  bf16_t* OUT = (bf16_t*)(big + B_OUT) + (size_t)d * NB * 8 * LT * 64;
  float* BON = (float*)(p.ws + OFF_BON) + (size_t)d * NB * 8 * LT;
  float* bufs = (float*)smem;
  float* outb = bufs + 2 * 6 * 2048;
  const int tid = TIDX;
  const int row = tid >> 4, ks = tid & 15;
  const int ls = tid >> 4, li = (tid & 15) * 4;
  const size_t hb = (size_t)(b * 8 + h) * LT;
  const float4 ka = *(const float4*)(p.k_a + h * 64 + li);
  const float4 rk = *(const float4*)(p.r_k + h * 64 + li);
  f32x2 S01 = {0.f, 0.f}, S23 = {0.f, 0.f};
  float pr[24];
  auto gload = [&](int chunk) {
    const int pos = scanpos(d, chunk * 32 + ls);
    const size_t e0 = (hb + pos) * 64 + li;
    const uint2 r4 = *(const uint2*)(R + e0), k4 = *(const uint2*)(KB + e0), kk4 = *(const uint2*)(KK + e0);
    const uint2 v4 = *(const uint2*)(V + e0), a4 = *(const uint2*)(AL + e0);
    const float4 dc = *(const float4*)(DEC + e0);
    const float a0 = lo2f(a4.x), a1 = hi2f(a4.x), a2 = lo2f(a4.y), a3 = hi2f(a4.y);
    const float q0 = lo2f(kk4.x), q1 = hi2f(kk4.x), q2 = lo2f(kk4.y), q3 = hi2f(kk4.y);
    pr[0] = lo2f(r4.x); pr[1] = hi2f(r4.x); pr[2] = lo2f(r4.y); pr[3] = hi2f(r4.y);
    pr[4] = dc.x; pr[5] = dc.y; pr[6] = dc.z; pr[7] = dc.w;
    pr[8] = lo2f(k4.x) * (1.f + (a0 - 1.f) * ka.x); pr[9] = hi2f(k4.x) * (1.f + (a1 - 1.f) * ka.y);
    pr[10] = lo2f(k4.y) * (1.f + (a2 - 1.f) * ka.z); pr[11] = hi2f(k4.y) * (1.f + (a3 - 1.f) * ka.w);
    pr[12] = lo2f(v4.x); pr[13] = hi2f(v4.x); pr[14] = lo2f(v4.y); pr[15] = hi2f(v4.y);
    pr[16] = -q0; pr[17] = -q1; pr[18] = -q2; pr[19] = -q3;
    pr[20] = q0 * a0; pr[21] = q1 * a1; pr[22] = q2 * a2; pr[23] = q3 * a3;
    float bp = pr[0] * pr[8] * rk.x + pr[1] * pr[9] * rk.y + pr[2] * pr[10] * rk.z + pr[3] * pr[11] * rk.w;
    bp = reduce16(bp);
    if (rh == 0 && (tid & 15) == 0) BON[hb + pos] = bp;
  };
  auto lstore = [&](int bufi) {
    float* bb = bufs + bufi * 6 * 2048 + ls * 64 + li;
#pragma unroll
    for (int q = 0; q < 6; q++) *(float4*)(bb + q * 2048) = make_float4(pr[4 * q], pr[4 * q + 1], pr[4 * q + 2], pr[4 * q + 3]);
  };
  __syncthreads();
  gload(0);
  lstore(0);
  __syncthreads();
  const int nch = LT / 32;
  for (int ch = 0; ch < nch; ch++) {
    const int cur = ch & 1;
    if (ch + 1 < nch) gload(ch + 1);
    const float* bb = bufs + cur * 6 * 2048;
    float* ob = outb + cur * 1024;
    const float* qb = bb + ks * 4;
    const float* vb = bb + 3 * 2048 + rh * 32 + row;
    float4 n_kn = *(const float4*)(qb + 4 * 2048), n_dc = *(const float4*)(qb + 1 * 2048), n_bv = *(const float4*)(qb + 5 * 2048);
    float4 n_kd = *(const float4*)(qb + 2 * 2048), n_rr = *(const float4*)(qb);
    float n_vv = vb[0];
    float upend = 0.f;
#pragma unroll 4
    for (int s = 0; s < 32; s++) {
      const float4 kn = n_kn, dc = n_dc, bv = n_bv, kd = n_kd, rr = n_rr;
      const float vv = n_vv;
      if (s + 1 < 32) {
        const float* q1 = qb + (s + 1) * 64;
        n_kn = *(const float4*)(q1 + 4 * 2048); n_dc = *(const float4*)(q1 + 1 * 2048); n_bv = *(const float4*)(q1 + 5 * 2048);
        n_kd = *(const float4*)(q1 + 2 * 2048); n_rr = *(const float4*)(q1);
        n_vv = vb[(s + 1) * 64];
      }
      f32x2 t = S01 * (f32x2){kn.x, kn.y};
      t = S23 * (f32x2){kn.z, kn.w} + t;
      float sa = t.x + t.y;
      reduce16_2(sa, upend);
      if (s > 0) ob[(s - 1) * 32 + row] = upend;
      const f32x2 sa2 = {sa, sa}, vv2 = {vv, vv};
      S01 = S01 * (f32x2){dc.x, dc.y} + sa2 * (f32x2){bv.x, bv.y} + vv2 * (f32x2){kd.x, kd.y};
      S23 = S23 * (f32x2){dc.z, dc.w} + sa2 * (f32x2){bv.z, bv.w} + vv2 * (f32x2){kd.z, kd.w};
      f32x2 u = S01 * (f32x2){rr.x, rr.y};
      u = S23 * (f32x2){rr.z, rr.w} + u;
      upend = u.x + u.y;
    }
    upend = reduce16(upend);
    ob[31 * 32 + row] = upend;
    if (ch + 1 < nch) lstore(cur ^ 1);
    lds_barrier();
    {
      const int idx = tid * 2, s = idx >> 5, r2 = idx & 31;
      const int pos = scanpos(d, ch * 32 + s);
      *(unsigned*)(OUT + (hb + pos) * 64 + rh * 32 + r2) = pack2(ob[idx], ob[idx + 1]);
    }
  }
  __syncthreads();
}
DI void wkv_finalize(const int TIDX, const P& p, int bid, int nb) {
  char* big = p.ws + OFF_BIG;
  const bf16_t* OUT = (const bf16_t*)(big + B_OUT);
  const float* BON = (const float*)(p.ws + OFF_BON);
  const bf16_t* V = (const bf16_t*)(big + B_V);
  const bf16_t* G = (const bf16_t*)(big + B_G);
  bf16_t* YM = (bf16_t*)(big + B_YMIX);
  const int lane = TIDX & 63, wave = TIDX >> 6;
  for (int item = bid * 8 + wave; item < NTOK * 8; item += nb * 8) {
    const int n = item >> 3, h = item & 7;
    const int b = n / LT, pos = n - b * LT;
    const size_t hb = (size_t)(b * 8 + h) * LT + pos;
    const int c = h * 64 + lane;
    const float vval = bf2f(V[hb * 64 + lane]);
    const float gw = p.gn_w[c], gb = p.gn_b[c];
    float y = 0.f;
#pragma unroll
    for (int d = 0; d < 2; d++) {
      const float o = bf2f(OUT[((size_t)d * NB * 8 * LT + hb) * 64 + lane]);
      const float mean = wave_sum_dpp(o, lane) * (1.f / 64.f);
      const float dd = o - mean;
      const float var = wave_sum_dpp(dd * dd, lane) * (1.f / 64.f);
      const float rstd = rsqrtf(var + 64e-5f);
      const float bon = BON[(size_t)d * NB * 8 * LT + hb];
      y += dd * rstd * gw + gb + bon * vval;
    }
    y *= bf2f(G[(size_t)n * 512 + c]);
    YM[(size_t)n * 1024 + 512 + c] = f2bf(y);
  }
}

DI void attn_body(const int TIDX, const P& p, int b, int head, int qt, char* smem);
DI void attn_task(const int TIDX, const P& p, int task, char* smem) {
  int b, head, qt;
  if (task < 512) { qt = 1 + (task & 7); head = (task >> 3) & 7; b = task >> 6; }
  else { int t2 = task - 512; qt = 0; head = t2 & 7; b = t2 >> 3; }
  attn_body(TIDX, p, b, head, qt, smem);
}
DI void attn_xcd(const int TIDX, const P& p, int bid, int nb, char* smem) {
  const int xcd = bid & 7, lb = bid >> 3, st = nb >> 3;
  for (int j = lb; j < 72; j += st) {
    int pair, head4, qt;
    if (j < 64) { pair = 2 * xcd + (j >> 5); head4 = (j & 31) >> 3; qt = 1 + (j & 7); }
    else { pair = 2 * xcd + ((j - 64) >> 2); head4 = (j - 64) & 3; qt = 0; }
    attn_body(TIDX, p, pair >> 1, (pair & 1) * 4 + head4, qt, smem);
  }
}
DI void attn_body(const int TIDX, const P& p, int b, int head, int qt, char* smem) {
  char* big = p.ws + OFF_BIG;
  const int kvh = head >> 2;
  const int nkt = (qt == 0 ? 256 : LT) / 64;
  bf16_t* Ks = (bf16_t*)smem;
  bf16_t* Vs = Ks + 2 * 64 * 72;
  const bf16_t* Kg = (const bf16_t*)(big + B_KN) + (size_t)(b * 2 + kvh) * LT * 64;
  const bf16_t* Vg = (const bf16_t*)(big + B_VT) + (size_t)(b * 2 + kvh) * 64 * LT;
  const bf16_t* QN = (const bf16_t*)(big + B_QN);
  bf16_t* YM = (bf16_t*)(big + B_YMIX);
  const int tid = TIDX, lane = tid & 63, wave = tid >> 6;
  const int r = lane & 31, h8 = lane >> 5;
  const int q0 = qt * 256 + wave * 32;
  bf16x8 qf[4];
#pragma unroll
  for (int kk = 0; kk < 4; kk++)
    qf[kk] = *(const bf16x8*)(QN + ((size_t)(b * 8 + head) * LT + q0 + r) * 64 + kk * 16 + h8 * 8);
  f32x16 o0, o1;
#pragma unroll
  for (int q = 0; q < 16; q++) { o0[q] = 0.f; o1[q] = 0.f; }
  float m = -1e30f, l = 0.f;
  const int lr = tid >> 3, lc = tid & 7;
  uint4 kreg = *(const uint4*)(Kg + (size_t)lr * 64 + lc * 8);
  uint4 vreg = *(const uint4*)(Vg + (size_t)lr * LT + lc * 8);
  __syncthreads();
  *(uint4*)(Ks + lr * 72 + lc * 8) = kreg;
  *(uint2*)(Vs + lr * 68 + lc * 8) = make_uint2(vreg.x, vreg.y);
  *(uint2*)(Vs + lr * 68 + lc * 8 + 4) = make_uint2(vreg.z, vreg.w);
  __syncthreads();
  for (int kt = 0; kt < nkt; kt++) {
    const int cur = kt & 1;
    if (kt + 1 < nkt) {
      kreg = *(const uint4*)(Kg + (size_t)((kt + 1) * 64 + lr) * 64 + lc * 8);
      vreg = *(const uint4*)(Vg + (size_t)lr * LT + (kt + 1) * 64 + lc * 8);
    }
    const bf16_t* Kc = Ks + cur * 64 * 72;
    const bf16_t* Vc = Vs + cur * 64 * 68;
    f32x16 s0, s1;
#pragma unroll
    for (int q = 0; q < 16; q++) { s0[q] = 0.f; s1[q] = 0.f; }
#pragma unroll
    for (int kk = 0; kk < 4; kk++) {
      bf16x8 a0 = *(const bf16x8*)(Kc + r * 72 + kk * 16 + h8 * 8);
      bf16x8 a1 = *(const bf16x8*)(Kc + (32 + r) * 72 + kk * 16 + h8 * 8);
      s0 = __builtin_amdgcn_mfma_f32_32x32x16_bf16(a0, qf[kk], s0, 0, 0, 0);
      s1 = __builtin_amdgcn_mfma_f32_32x32x16_bf16(a1, qf[kk], s1, 0, 0, 0);
    }
    float mx = s0[0];
#pragma unroll
    for (int q = 1; q < 16; q++) mx = fmaxf(mx, s0[q]);
#pragma unroll
    for (int q = 0; q < 16; q++) mx = fmaxf(mx, s1[q]);
    mx = fmaxf(mx, SHX(mx, 32));
    const float mnew = fmaxf(m, mx);
    const float alpha = __builtin_amdgcn_exp2f(m - mnew);
    float sum = 0.f;
#pragma unroll
    for (int q = 0; q < 16; q++) { s0[q] = __builtin_amdgcn_exp2f(s0[q] - mnew); sum += s0[q]; }
#pragma unroll
    for (int q = 0; q < 16; q++) { s1[q] = __builtin_amdgcn_exp2f(s1[q] - mnew); sum += s1[q]; }
    l = l * alpha + sum;
    m = mnew;
#pragma unroll
    for (int q = 0; q < 16; q++) { o0[q] *= alpha; o1[q] *= alpha; }
#pragma unroll
    for (int t = 0; t < 2; t++) {
#pragma unroll
      for (int s = 0; s < 2; s++) {
        union { bf16x8 v; unsigned u[4]; } pf;
#pragma unroll
        for (int q = 0; q < 4; q++) {
          float x0 = t ? s1[8 * s + 2 * q] : s0[8 * s + 2 * q];
          float x1 = t ? s1[8 * s + 2 * q + 1] : s0[8 * s + 2 * q + 1];
          pf.u[q] = pack2(x0, x1);
        }
        const int kb = 32 * t + 16 * s + 4 * h8;
        union { bf16x8 v; uint2 u[2]; } v0, v1;
        v0.u[0] = *(const uint2*)(Vc + r * 68 + kb);
        v0.u[1] = *(const uint2*)(Vc + r * 68 + kb + 8);
        v1.u[0] = *(const uint2*)(Vc + (32 + r) * 68 + kb);
        v1.u[1] = *(const uint2*)(Vc + (32 + r) * 68 + kb + 8);
        o0 = __builtin_amdgcn_mfma_f32_32x32x16_bf16(v0.v, pf.v, o0, 0, 0, 0);
        o1 = __builtin_amdgcn_mfma_f32_32x32x16_bf16(v1.v, pf.v, o1, 0, 0, 0);
      }
    }
    if (kt + 1 < nkt) {
      *(uint4*)(Ks + (cur ^ 1) * 64 * 72 + lr * 72 + lc * 8) = kreg;
      *(uint2*)(Vs + (cur ^ 1) * 64 * 68 + lr * 68 + lc * 8) = make_uint2(vreg.x, vreg.y);
      *(uint2*)(Vs + (cur ^ 1) * 64 * 68 + lr * 68 + lc * 8 + 4) = make_uint2(vreg.z, vreg.w);
    }
    __syncthreads();
  }
  l += SHX(l, 32);
  const float inv = 1.f / l;
  bf16_t* orow = YM + (size_t)(b * LT + q0 + r) * 1024 + head * 64;
#pragma unroll
  for (int g4 = 0; g4 < 4; g4++) {
    uint2 w0, w1;
    w0.x = pack2(o0[4 * g4] * inv, o0[4 * g4 + 1] * inv); w0.y = pack2(o0[4 * g4 + 2] * inv, o0[4 * g4 + 3] * inv);
    w1.x = pack2(o1[4 * g4] * inv, o1[4 * g4 + 1] * inv); w1.y = pack2(o1[4 * g4 + 2] * inv, o1[4 * g4 + 3] * inv);
    *(uint2*)(orow + 8 * g4 + 4 * h8) = w0;
    *(uint2*)(orow + 32 + 8 * g4 + 4 * h8) = w1;
  }
}

DI void route_task(const int TIDX, const P& p, int n0, char* smem) {
  char* big = p.ws + OFF_BIG;
  const float* S = (const float*)(big + B_S);
  int* EI = (int*)(big + B_EI);
  float* EG = (float*)(big + B_EG);
  float* sc = (float*)smem;
  float* sv = sc + 256 * 129;
  unsigned char* si = (unsigned char*)(sv + 256 * 16);
  const int tid = TIDX;
  __syncthreads();
  for (int e = tid; e < 256 * 128; e += NTHR) {
    int row = e >> 7, j = e & 127;
    sc[row * 129 + j] = S[(size_t)n0 * 2048 + e];
  }
  __syncthreads();
  if (tid < 256) {
    const float* rowp = sc + tid * 129;
    float pv = __builtin_inff();
    int pi = -1;
    for (int k = 0; k < 16; k++) {
      float bv = -__builtin_inff();
      int bi = 0;
      for (int j = 0; j < 128; j++) {
        float x = rowp[j];
        bool elig = (x < pv) || (x == pv && j > pi);
        if (elig && x > bv) { bv = x; bi = j; }
      }
      sv[tid * 16 + k] = bv;
      si[tid * 16 + k] = (unsigned char)bi;
      pv = bv; pi = bi;
    }
  }
  __syncthreads();
  if (tid < 128) {
    const int tl = tid >> 3, head = tid & 7;
    const int r0 = tl * 16 + head * 2, r1 = r0 + 1;
    const float* a = sv + r0 * 16;
    const float* bq = sv + r1 * 16;
    float* eg = sc + tid * 17;
    const int n = n0 + tl;
    float pv = __builtin_inff();
    int pc = -1;
    float mx = 0.f, sum = 0.f;
    for (int k = 0; k < 16; k++) {
      float bv = -__builtin_inff();
      int bc = 0;
      for (int i = 0; i < 16; i++) {
        const int jn = 16 / (i + 1);
        const float ai = a[i];
        for (int j = 0; j < jn; j++) {
          float x = ai + bq[j];
          int c = i * 16 + j;
          bool elig = (x < pv) || (x == pv && c > pc);
          if (elig && x > bv) { bv = x; bc = c; }
        }
      }
      if (k == 0) mx = bv;
      float ev = __expf(bv - mx);
      sum += ev;
      eg[k] = ev;
      EI[(size_t)n * 128 + head * 16 + k] = (int)si[r0 * 16 + (bc >> 4)] * 128 + (int)si[r1 * 16 + (bc & 15)];
      pv = bv; pc = bc;
    }
    const float inv = 1.f / sum;
    for (int k = 0; k < 16; k++) EG[(size_t)n * 128 + head * 16 + k] = eg[k] * inv;
  }
}


DI int f2ord(float f) { int s = __float_as_int(f); return s ^ ((s >> 31) & 0x7fffffff); }
DI float ord2f(int s) { return __int_as_float(s ^ ((s >> 31) & 0x7fffffff)); }
DI void ce_desc(int& a, int& b) { int hi = max(a, b), lo = min(a, b); a = hi; b = lo; }
template <int N>
DI void bsort_desc(int* v) {
#pragma unroll
  for (int k = 2; k <= N; k <<= 1)
#pragma unroll
    for (int j = k >> 1; j > 0; j >>= 1)
#pragma unroll
      for (int i = 0; i < N; i++) {
        const int l = i ^ j;
        if (l > i) {
          if ((i & k) == 0) ce_desc(v[i], v[l]); else ce_desc(v[l], v[i]);
        }
      }
}
DI void merge16(int* a, const int* b) {
#pragma unroll
  for (int i = 0; i < 16; i++) a[i] = max(a[i], b[15 - i]);
#pragma unroll
  for (int j = 8; j > 0; j >>= 1)
#pragma unroll
    for (int i = 0; i < 16; i++) {
      const int l = i ^ j;
      if (l > i) ce_desc(a[i], a[l]);
    }
}
DI void top16_of_64(int* v) {
  bsort_desc<16>(v); bsort_desc<16>(v + 16); bsort_desc<16>(v + 32); bsort_desc<16>(v + 48);
  merge16(v, v + 16); merge16(v + 32, v + 48); merge16(v, v + 32);
}
DI void route2_task(const int TIDX, const P& p, int layer, int m0, int head, char* smem, const bool load_keys = true) {
  char* big = p.ws + OFF_BIG;
  const bf16_t* QP = (const bf16_t*)(big + B_QP);
  int* EI = (int*)(big + B_EI);
  float* EG = (float*)(big + B_EG);
  bf16_t* Ks = (bf16_t*)smem;
  unsigned char* sidx = (unsigned char*)(Ks + 256 * 136);
  const bf16_t* keys = (const bf16_t*)(p.ws + OFF_KEYS) + (size_t)(layer * 16 + head * 2) * 128 * 128;
  const int tid = TIDX, lane = tid & 63, wave = tid >> 6;
  const int r = lane & 31, h8 = lane >> 5;
  __syncthreads();
  if (load_keys) {
    const int row = tid >> 1, half = tid & 1;
#pragma unroll
    for (int q = 0; q < 8; q++)
      *(uint4*)(Ks + row * 136 + half * 64 + q * 8) = *(const uint4*)(keys + (size_t)row * 128 + half * 64 + q * 8);
  }
  __syncthreads();
  const int tok = m0 + wave * 32 + r;
  int la[16], lb[16];
#pragma unroll
  for (int pp = 0; pp < 2; pp++) {
    bf16x8 qf[8];
#pragma unroll
    for (int ks = 0; ks < 8; ks++)
      qf[ks] = *(const bf16x8*)(QP + (size_t)tok * 2048 + head * 256 + pp * 128 + ks * 16 + h8 * 8);
    int v[64];
#pragma unroll
    for (int kt = 0; kt < 4; kt++) {
      f32x16 acc;
#pragma unroll
      for (int q = 0; q < 16; q++) acc[q] = 0.f;
#pragma unroll
      for (int ks = 0; ks < 8; ks++) {
        bf16x8 a = *(const bf16x8*)(Ks + (pp * 128 + kt * 32 + r) * 136 + ks * 16 + h8 * 8);
        acc = __builtin_amdgcn_mfma_f32_32x32x16_bf16(a, qf[ks], acc, 0, 0, 0);
      }
#pragma unroll
      for (int q = 0; q < 16; q++) v[kt * 16 + q] = (f2ord(acc[q]) & ~127) | (kt * 32 + (q & 3) + 8 * (q >> 2) + 4 * h8);
    }
    top16_of_64(v);
    int pr[16];
#pragma unroll
    for (int i = 0; i < 16; i++) pr[i] = __builtin_amdgcn_ds_bpermute((lane ^ 32) << 2, v[i]);
    merge16(v, pr);
#pragma unroll
    for (int i = 0; i < 16; i++) { if (pp == 0) la[i] = v[i]; else lb[i] = v[i]; }
  }
  {
    unsigned* sw = (unsigned*)(sidx + tid * 32);
#pragma unroll
    for (int i = 0; i < 4; i++) {
      sw[i] = (la[4 * i] & 127) | ((la[4 * i + 1] & 127) << 8) | ((la[4 * i + 2] & 127) << 16) | ((la[4 * i + 3] & 127) << 24);
      sw[4 + i] = (lb[4 * i] & 127) | ((lb[4 * i + 1] & 127) << 8) | ((lb[4 * i + 2] & 127) << 16) | ((lb[4 * i + 3] & 127) << 24);
    }
  }
  float fa[16], fb[16];
#pragma unroll
  for (int i = 0; i < 16; i++) { fa[i] = ord2f(la[i]); fb[i] = ord2f(lb[i]); }
  int c[64];
  {
    int cnt = 0;
#pragma unroll
    for (int i = 0; i < 16; i++)
#pragma unroll
      for (int j = 0; j < 16; j++)
        if ((i + 1) * (j + 1) <= 16) { c[cnt] = (f2ord(fa[i] + fb[j]) & ~255) | (i * 16 + j); cnt++; }
#pragma unroll
    for (int q = 50; q < 64; q++) c[q] = (int)0x80000000;
  }
  top16_of_64(c);
  const float mx = ord2f(c[0]);
  float ev[16], sum = 0.f;
#pragma unroll
  for (int k = 0; k < 16; k++) { ev[k] = __expf(ord2f(c[k]) - mx); sum += ev[k]; }
  const float inv = 1.f / sum;
  const size_t ob = (size_t)tok * 128 + head * 16;
#pragma unroll
  for (int k = 0; k < 16; k++) {
    const int code = c[k] & 255;
    const int ia = sidx[tid * 32 + (code >> 4)], ib = sidx[tid * 32 + 16 + (code & 15)];
    if (h8 == 0) EI[ob + k] = ia * 128 + ib; else EG[ob + k] = ev[k] * inv;
  }
}

DI void peer_u2(const int TIDX, const P& p, bool last, int bid, int nb) {
  char* big = p.ws + OFF_BIG;
  const int* EI = (const int*)(big + B_EI);
  float* ACT = (float*)(big + B_S);
  const unsigned char* UB = (const unsigned char*)(p.ws + OFF_UB);
  const float* US = (const float*)(p.ws + OFF_UB + 16777216);
  const bf16_t* H = (const bf16_t*)(p.ws + OFF_H);
  const int lane = TIDX & 63, wave = TIDX >> 6;
  const bool dry = false;
  for (int n = bid * 8 + wave; n < NTOK; n += nb * 8) {
    const int b = n / LT, pos = n - b * LT;
    if (last && pos < LC) continue;
    float hv[16];
    {
      uint4 h0 = *(const uint4*)(H + (size_t)n * DM + lane * 16);
      uint4 h1 = *(const uint4*)(H + (size_t)n * DM + lane * 16 + 8);
      unpack8(h0, hv); unpack8(h1, hv + 8);
    }
    const int id_lo = EI[(size_t)n * 128 + lane], id_hi = EI[(size_t)n * 128 + 64 + lane];
    const float us_lo = US[id_lo], us_hi = US[id_hi];
    float act_lo = 0.f, act_hi = 0.f;
#pragma unroll 1
    for (int half = 0; half < 2; half++) {
      const int idv = half ? id_hi : id_lo;
      float actv = 0.f;
#pragma unroll 8
      for (int e = 0; e < 64; e++) {
        const int id = __builtin_amdgcn_readlane(idv, e);
        const uint4 w = *(const uint4*)(UB + (size_t)id * 1024 + lane * 16);
        float uv[16];
        cvt16_fp8(w, uv);
        float d0 = 0.f, d1 = 0.f;
#pragma unroll
        for (int j = 0; j < 8; j++) { d0 += hv[j] * uv[j]; d1 += hv[8 + j] * uv[8 + j]; }
        const float dsum = wave_sum_dpp(d0 + d1, lane);
        if (lane == e) actv = dsum;
      }
      if (half) act_hi = actv; else act_lo = actv;
    }
    ACT[(size_t)n * 128 + lane] = act_lo * us_lo;
    ACT[(size_t)n * 128 + 64 + lane] = act_hi * us_hi;
  }
}

DI void peer_gather(const int TIDX, const P& p, int layer, bool last, int bid, int nb, const bool dry) {
  char* big = p.ws + OFF_BIG;
  const int* EI = (const int*)(big + B_EI);
  const float* EG = (const float*)(big + B_EG);
  const unsigned char* UB = (const unsigned char*)(p.ws + OFF_UB);
  const unsigned char* VB = (const unsigned char*)(p.ws + OFF_VB);
  const float* ACT = (const float*)(big + B_S);
  const float* VS = (const float*)(p.ws + OFF_VB + 16777216);
  const bf16_t* H = (const bf16_t*)(p.ws + OFF_H);
  const float* X = (const float*)(p.ws + OFF_X);
  bf16_t* Hw = dry ? (bf16_t*)(big + B_QP) : (bf16_t*)(p.ws + OFF_H);
  float* Xw = dry ? (float*)(big + B_S + 16777216) : (float*)(p.ws + OFF_X);
  const float* mod = (const float*)(p.ws + OFF_MOD);
  const int lane = TIDX & 63, wave = TIDX >> 6;
  for (int n = bid * 8 + wave; n < NTOK; n += nb * 8) {
    const int b = n / LT, pos = n - b * LT;
    if (last && pos < LC) continue;
    const int id_lo = EI[(size_t)n * 128 + lane], id_hi = EI[(size_t)n * 128 + 64 + lane];
    const float g_lo = EG[(size_t)n * 128 + lane], g_hi = EG[(size_t)n * 128 + 64 + lane];
    const float vs_lo = VS[id_lo], vs_hi = VS[id_hi];
    const float act_lo = ACT[(size_t)n * 128 + lane], act_hi = ACT[(size_t)n * 128 + 64 + lane];
    const float cf_lo = g_lo * 0.5f * act_lo * (1.f + erff(act_lo * 0.70710678f)) * vs_lo;
    const float cf_hi = g_hi * 0.5f * act_hi * (1.f + erff(act_hi * 0.70710678f)) * vs_hi;
    float acc[16];
#pragma unroll
    for (int j = 0; j < 16; j++) acc[j] = 0.f;
#pragma unroll 1
    for (int half = 0; half < 2; half++) {
      const int idv = half ? id_hi : id_lo;
      const float cfv = half ? cf_hi : cf_lo;
#pragma unroll 8
      for (int e = 0; e < 64; e++) {
        const int id = __builtin_amdgcn_readlane(idv, e);
        const float cf = __builtin_bit_cast(float, __builtin_amdgcn_readlane(__builtin_bit_cast(int, cfv), e));
        const uint4 w = *(const uint4*)(VB + (size_t)id * 1024 + lane * 16);
        float uv[16];
        cvt16_fp8(w, uv);
#pragma unroll
        for (int j = 0; j < 16; j++) acc[j] += cf * uv[j];
      }
    }
    const int rr = pos < LC ? 8 : b;
    const float* gate = mod + (size_t)(layer * 9 + rr) * 6144 + 5 * 1024 + lane * 16;
    const float* xr = X + (size_t)n * DM + lane * 16;
    float xo[16];
#pragma unroll
    for (int q = 0; q < 4; q++) {
      float4 x0 = *(const float4*)(xr + q * 4), g0 = *(const float4*)(gate + q * 4);
      xo[q * 4 + 0] = x0.x + g0.x * acc[q * 4 + 0]; xo[q * 4 + 1] = x0.y + g0.y * acc[q * 4 + 1];
      xo[q * 4 + 2] = x0.z + g0.z * acc[q * 4 + 2]; xo[q * 4 + 3] = x0.w + g0.w * acc[q * 4 + 3];
    }
    if (last) {
      float* orow = p.out + ((size_t)(b * SEQ + pos - LC)) * DM + lane * 16;
#pragma unroll
      for (int q = 0; q < 4; q++) *(float4*)(orow + q * 4) = make_float4(xo[q * 4], xo[q * 4 + 1], xo[q * 4 + 2], xo[q * 4 + 3]);
    } else {
      float ss = 0.f;
#pragma unroll
      for (int j = 0; j < 16; j++) ss += xo[j] * xo[j];
      ss = wave_sum(ss);
      const float rs = rsqrtf(ss * (1.f / 1024.f) + 1e-6f);
      const float* g = p.n1g + (layer + 1) * 1024 + lane * 16;
      const float* msc = mod + (size_t)((layer + 1) * 9 + rr) * 6144 + 1 * 1024 + lane * 16;
      const float* msh = mod + (size_t)((layer + 1) * 9 + rr) * 6144 + lane * 16;
      float* xw = Xw + (size_t)n * DM + lane * 16;
#pragma unroll
      for (int q = 0; q < 4; q++) *(float4*)(xw + q * 4) = make_float4(xo[q * 4], xo[q * 4 + 1], xo[q * 4 + 2], xo[q * 4 + 3]);
      float y[16];
#pragma unroll
      for (int j = 0; j < 16; j++) y[j] = xo[j] * rs * g[j] * (1.f + msc[j]) + msh[j];
      *(uint4*)(Hw + (size_t)n * DM + lane * 16) = pack8(y);
      *(uint4*)(Hw + (size_t)n * DM + lane * 16 + 8) = pack8(y + 8);
    }
  }
}

DI void conv_phase(const int TIDX, const P& p, int bid, int nb) {
  char* big = p.ws + OFF_BIG;
  const bf16_t* ZX = (const bf16_t*)(big + B_ZX);
  bf16_t* XBC = (bf16_t*)(big + B_XBC);
  const int total = NTOK * 384;
  for (int it = bid * NTHR + TIDX; it < total; it += nb * NTHR) {
    const int n = it / 384, c8 = (it - n * 384) * 8;
    const int b = n / LT, pos = n - b * LT;
    const bool hasp = (pos != 0 && pos != LC), hasn = (pos != LC - 1 && pos != LT - 1);
    const bf16_t* zc = ZX + (size_t)n * 3072 + c8;
    uint4 cu = *(const uint4*)zc, pu = make_uint4(0, 0, 0, 0), nu = make_uint4(0, 0, 0, 0);
    if (hasp) pu = *(const uint4*)(zc - 3072);
    if (hasn) nu = *(const uint4*)(zc + 3072);
    float cv[8], pv[8], nv[8], y[8];
    unpack8(cu, cv); unpack8(pu, pv); unpack8(nu, nv);
#pragma unroll
    for (int j = 0; j < 8; j++) {
      float a = p.conv_b[c8 + j] + p.conv_w[c8 + j] * pv[j] + p.conv_w[3072 + c8 + j] * cv[j] + p.conv_w[6144 + c8 + j] * nv[j];
      y[j] = siluf_(a);
    }
    *(uint4*)(XBC + (size_t)n * 3072 + c8) = pack8(y);
  }
}

DI void ssd_task(const int TIDX, const P& p, int task, char* smem) {
  char* big = p.ws + OFF_BIG;
  const int b = task >> 5, h = task & 31, g = h >> 3;
  bf16_t* Cs = (bf16_t*)smem;
  bf16_t* Bs = Cs + 128 * 136;
  bf16_t* BT = Bs + 128 * 136;
  bf16_t* xT = BT + 128 * 136;
  bf16_t* sb = xT + 64 * 136;
  float* cumb = (float*)(sb + 64 * 136);
  float* dtvb = cumb + 256;
  const bf16_t* XBC = (const bf16_t*)(big + B_XBC);
  const float* DT = (const float*)(big + B_DT);
  bf16_t* Y = (bf16_t*)(big + B_Y);
  const int tid = TIDX, lane = tid & 63, wave = tid >> 6;
  const int r = lane & 31, h8 = lane >> 5;
  const float dskip = p.ssd_d[h];
  const int lj = tid >> 2, lpart = tid & 3;
  uint4 pc0, pc1, pc2, pc3, pb0, pb1, pb2, pb3, px0, px1;
  float pdt0 = 0.f, pdt1 = 0.f;
  auto prefetch = [&](int itn) {
    const int dn = itn >= 18 ? 1 : 0, cn = itn - dn * 18;
    const int pos = scanpos(dn, cn * 128 + lj);
    const bf16_t* rowp = XBC + (size_t)(b * LT + pos) * 3072;
    const bf16_t* cp = rowp + 2560 + g * 128 + lpart * 32;
    const bf16_t* bp = rowp + 2048 + g * 128 + lpart * 32;
    const bf16_t* xp = rowp + h * 64 + lpart * 16;
    pc0 = *(const uint4*)(cp); pc1 = *(const uint4*)(cp + 8); pc2 = *(const uint4*)(cp + 16); pc3 = *(const uint4*)(cp + 24);
    pb0 = *(const uint4*)(bp); pb1 = *(const uint4*)(bp + 8); pb2 = *(const uint4*)(bp + 16); pb3 = *(const uint4*)(bp + 24);
    px0 = *(const uint4*)(xp); px1 = *(const uint4*)(xp + 8);
    if (wave == 1) {
      const int p0 = scanpos(dn, cn * 128 + lane * 2), p1 = scanpos(dn, cn * 128 + lane * 2 + 1);
      pdt0 = DT[(size_t)(b * LT + p0) * 64 + dn * 32 + h];
      pdt1 = DT[(size_t)(b * LT + p1) * 64 + dn * 32 + h];
    }
  };
  const float aA[2] = {-expf(p.a_log[h]), -expf(p.a_log[32 + h])};
  const float biasA[2] = {p.dt_bias[h], p.dt_bias[32 + h]};
  auto cumcalc = [&](int itn) {
    const int dn = itn >= 18 ? 1 : 0;
    const float an = dn ? aA[1] : aA[0], bn = dn ? biasA[1] : biasA[0];
    float* cw = cumb + (itn & 1) * 128;
    float* dw = dtvb + (itn & 1) * 128;
    const int i0 = lane * 2, i1 = i0 + 1;
    const float dt0 = softplusf_(pdt0 + bn), dt1 = softplusf_(pdt1 + bn);
    const float a0 = an * dt0, a1 = a0 + an * dt1;
    float tot = a1;
#pragma unroll
    for (int off = 1; off < 64; off <<= 1) {
      float t = shup_(tot, off, lane);
      if (lane >= off) tot += t;
    }
    const float excl = tot - a1;
    cw[i0] = excl + a0; cw[i1] = excl + a1;
    dw[i0] = dt0; dw[i1] = dt1;
  };
  __syncthreads();
  prefetch(0);
  if (wave == 1) cumcalc(0);
  f32x16 sacc;
  for (int it = 0; it < 36; it++) {
    const int d = it >= 18 ? 1 : 0, c = it - d * 18;
    const float* cum = cumb + (it & 1) * 128;
    const float* dtv = dtvb + (it & 1) * 128;
    lds_barrier();
    if (c == 0) {
#pragma unroll
      for (int q = 0; q < 16; q++) sacc[q] = 0.f;
      for (int e = tid; e < 64 * 136; e += NTHR) sb[e] = 0;
    }
    const float cl = cum[127];
    {
      const int j = lj;
      const float wj = __expf(cl - cum[j]) * dtv[j];
      const int col0 = lpart * 32;
      *(uint4*)(Cs + j * 136 + col0) = pc0; *(uint4*)(Cs + j * 136 + col0 + 8) = pc1;
      *(uint4*)(Cs + j * 136 + col0 + 16) = pc2; *(uint4*)(Cs + j * 136 + col0 + 24) = pc3;
      *(uint4*)(Bs + j * 136 + col0) = pb0; *(uint4*)(Bs + j * 136 + col0 + 8) = pb1;
      *(uint4*)(Bs + j * 136 + col0 + 16) = pb2; *(uint4*)(Bs + j * 136 + col0 + 24) = pb3;
      float bf[8];
      unpack8(pb0, bf);
#pragma unroll
      for (int e = 0; e < 8; e++) BT[(col0 + e) * 136 + j] = f2bf(bf[e] * wj);
      unpack8(pb1, bf);
#pragma unroll
      for (int e = 0; e < 8; e++) BT[(col0 + 8 + e) * 136 + j] = f2bf(bf[e] * wj);
      unpack8(pb2, bf);
#pragma unroll
      for (int e = 0; e < 8; e++) BT[(col0 + 16 + e) * 136 + j] = f2bf(bf[e] * wj);
      unpack8(pb3, bf);
#pragma unroll
      for (int e = 0; e < 8; e++) BT[(col0 + 24 + e) * 136 + j] = f2bf(bf[e] * wj);
      const int xc0 = lpart * 16;
      {
        const unsigned w[8] = {px0.x, px0.y, px0.z, px0.w, px1.x, px1.y, px1.z, px1.w};
#pragma unroll
        for (int e = 0; e < 8; e++) {
          xT[(xc0 + 2 * e) * 136 + j] = (bf16_t)(w[e] & 0xffffu);
          xT[(xc0 + 2 * e + 1) * 136 + j] = (bf16_t)(w[e] >> 16);
        }
      }
    }
    if (it + 1 < 36) prefetch(it + 1);
    lds_barrier();
    if (wave == 1 && it + 1 < 36) cumcalc(it + 1);
    const int itl = wave >> 1;
    if (c >= 2) {
    f32x16 G0, G1;
#pragma unroll
    for (int q = 0; q < 16; q++) { G0[q] = 0.f; G1[q] = 0.f; }
    {
      const int jt0 = (wave & 1) * 2, jt1 = jt0 + 1;
      if (jt0 <= itl) {
#pragma unroll
        for (int ks = 0; ks < 8; ks++) {
          bf16x8 av = *(const bf16x8*)(Cs + (itl * 32 + r) * 136 + ks * 16 + h8 * 8);
          bf16x8 b0 = *(const bf16x8*)(Bs + (jt0 * 32 + r) * 136 + ks * 16 + h8 * 8);
          G0 = __builtin_amdgcn_mfma_f32_32x32x16_bf16(av, b0, G0, 0, 0, 0);
          if (jt1 <= itl) {
            bf16x8 b1 = *(const bf16x8*)(Bs + (jt1 * 32 + r) * 136 + ks * 16 + h8 * 8);
            G1 = __builtin_amdgcn_mfma_f32_32x32x16_bf16(av, b1, G1, 0, 0, 0);
          }
        }
      }
    }
    lds_barrier();
    {
      bf16_t* Ms = Bs;
      const int jt0 = (wave & 1) * 2;
      const int j0 = jt0 * 32 + r, j1 = j0 + 32;
      const float cj0 = cum[j0], cj1 = cum[j1], dj0 = dtv[j0], dj1 = dtv[j1];
#pragma unroll
      for (int q = 0; q < 16; q++) {
        const int i = itl * 32 + (q & 3) + 8 * (q >> 2) + 4 * h8;
        const float ci = cum[i];
        float m0 = (j0 <= i) ? G0[q] * __expf(ci - cj0) * dj0 : 0.f;
        float m1 = (j1 <= i) ? G1[q] * __expf(ci - cj1) * dj1 : 0.f;
        Ms[i * 136 + j0] = f2bf(m0);
        Ms[i * 136 + j1] = f2bf(m1);
      }
    }
    lds_barrier();
    {
      const bf16_t* Ms = Bs;
      const int pt = wave & 1;
      const int pp = pt * 32 + r;
      bf16_t yold[16];
      if (d == 1 && c >= 2) {
#pragma unroll
        for (int q = 0; q < 16; q++) {
          const int i = itl * 32 + (q & 3) + 8 * (q >> 2) + 4 * h8;
          const int pos = scanpos(1, c * 128 + i);
          yold[q] = Y[(size_t)(b * LT + pos) * 2048 + h * 64 + pp];
        }
      }
      f32x16 yd, yo;
#pragma unroll
      for (int q = 0; q < 16; q++) { yd[q] = 0.f; yo[q] = 0.f; }
#pragma unroll
      for (int ks = 0; ks < 8; ks++) {
        if (ks < (itl + 1) * 2) {
          bf16x8 av = *(const bf16x8*)(Ms + (itl * 32 + r) * 136 + ks * 16 + h8 * 8);
          bf16x8 bv = *(const bf16x8*)(xT + (pt * 32 + r) * 136 + ks * 16 + h8 * 8);
          yd = __builtin_amdgcn_mfma_f32_32x32x16_bf16(av, bv, yd, 0, 0, 0);
        }
        bf16x8 cv = *(const bf16x8*)(Cs + (itl * 32 + r) * 136 + ks * 16 + h8 * 8);
        bf16x8 sv = *(const bf16x8*)(sb + (pt * 32 + r) * 136 + ks * 16 + h8 * 8);
        yo = __builtin_amdgcn_mfma_f32_32x32x16_bf16(cv, sv, yo, 0, 0, 0);
      }
      if (c >= 2) {
#pragma unroll
        for (int q = 0; q < 16; q++) {
          const int i = itl * 32 + (q & 3) + 8 * (q >> 2) + 4 * h8;
          float y = yd[q] + __expf(cum[i]) * yo[q];
          const int pos = scanpos(d, c * 128 + i);
          const size_t idx = (size_t)(b * LT + pos) * 2048 + h * 64 + pp;
          if (d == 0) y += dskip * bf2f(xT[pp * 136 + i]);
          else y += bf2f(yold[q]);
          Y[idx] = f2bf(y);
        }
      }
    }
    lds_barrier();
    }
    {
      const int pt = wave & 1, nt = wave >> 1;
      const float ecl = __expf(cl);
#pragma unroll
      for (int q = 0; q < 16; q++) sacc[q] *= ecl;
#pragma unroll
      for (int ks = 0; ks < 8; ks++) {
        bf16x8 av = *(const bf16x8*)(xT + (pt * 32 + r) * 136 + ks * 16 + h8 * 8);
        bf16x8 bv = *(const bf16x8*)(BT + (nt * 32 + r) * 136 + ks * 16 + h8 * 8);
        sacc = __builtin_amdgcn_mfma_f32_32x32x16_bf16(av, bv, sacc, 0, 0, 0);
      }
#pragma unroll
      for (int q = 0; q < 16; q++) {
        const int pp = pt * 32 + (q & 3) + 8 * (q >> 2) + 4 * h8;
        sb[pp * 136 + nt * 32 + r] = f2bf(sacc[q]);
      }
    }
  }
  __syncthreads();
}

DI void gate_norm(const int TIDX, const P& p, int bid, int nb) {
  char* big = p.ws + OFF_BIG;
  const bf16_t* Y = (const bf16_t*)(big + B_Y);
  const bf16_t* ZG = (const bf16_t*)(big + B_ZG);
  bf16_t* YN = (bf16_t*)(big + B_YN);
  const int lane = TIDX & 63, wave = TIDX >> 6;
  const int ntok = NB * SEQ, nw = nb * 8;
  for (int it = bid * 8 + wave; it < ntok; it += 2 * nw) {
    uint4 yv[2][4], zv[2][4];
    int nn[2];
    bool val[2];
#pragma unroll
    for (int t = 0; t < 2; t++) {
      int ti = it + t * nw;
      val[t] = ti < ntok;
      if (!val[t]) ti = it;
      nn[t] = (ti >> 11) * LT + LC + (ti & 2047);
#pragma unroll
      for (int gq = 0; gq < 4; gq++) {
        yv[t][gq] = *(const uint4*)(Y + (size_t)nn[t] * 2048 + gq * 512 + lane * 8);
        zv[t][gq] = *(const uint4*)(ZG + (size_t)nn[t] * 2048 + gq * 512 + lane * 8);
      }
    }
#pragma unroll
    for (int t = 0; t < 2; t++) {
      if (!val[t]) continue;
#pragma unroll
      for (int gq = 0; gq < 4; gq++) {
        const int base = gq * 512 + lane * 8;
        float y[8], z[8];
        unpack8(yv[t][gq], y); unpack8(zv[t][gq], z);
        float ss = 0.f;
#pragma unroll
        for (int j = 0; j < 8; j++) { y[j] = y[j] * siluf_(z[j]); ss += y[j] * y[j]; }
        ss = wave_sum_dpp(ss, lane);
        const float rs = rsqrtf(ss * (1.f / 512.f) + 1e-6f);
#pragma unroll
        for (int j = 0; j < 8; j++) y[j] = y[j] * rs * p.ssd_nw[base + j];
        *(uint4*)(YN + (size_t)nn[t] * 2048 + base) = pack8(y);
      }
    }
  }
}

#define XB_TMO      128
#define XB_XCNT(j)  (256  + 64 * (j))
#define XB_XSUB(j)  (1280 + 64 * (j))
#define XB_XGEN(j)  (2304 + 64 * (j))
#define XB_TOP      3328
#define XB_TOPGEN   3392
#define XCD_BAR_WORDS 3456
#define XB_SPIN_CAP (1u << 18)
#define LAS __attribute__((address_space(3)))
DI unsigned xb_ld(unsigned* p) { return __hip_atomic_load(p, __ATOMIC_RELAXED, __HIP_MEMORY_SCOPE_AGENT); }
DI unsigned xb_add(unsigned* p, unsigned v) { return __hip_atomic_fetch_add(p, v, __ATOMIC_RELAXED, __HIP_MEMORY_SCOPE_AGENT); }
DI unsigned xb_xcc_id() { return (unsigned)__builtin_amdgcn_s_getreg((3 << 11) | 20) & 0xFu; }
#define XB_SPIN(cond, bar) do { unsigned _sp = 0; while (cond) { __builtin_amdgcn_s_sleep(1); \
    if ((++_sp & 255u) == 0u) { if (xb_ld(&(bar)[XB_TMO])) break; if (_sp > XB_SPIN_CAP) { atomicAdd(&(bar)[XB_TMO], 1u); break; } } } } while (0)
struct XcdBarrier { unsigned* bar; unsigned x; volatile LAS unsigned* st; };
DI XcdBarrier xcd_barrier_post(unsigned* bar, volatile LAS unsigned* st) {
  XcdBarrier b; b.bar = bar; b.x = xb_xcc_id(); b.st = st;
  if (threadIdx.x == 0) (void)xb_add(&bar[XB_XCNT(b.x)], 1u);
  return b;
}
DI void xcd_barrier_complete(unsigned* bar, unsigned x, unsigned& nloc, unsigned& nx) {
  const unsigned G = gridDim.x * gridDim.y * gridDim.z;
  unsigned sum, cnt, mine, sp = 0u;
  for (;;) {
    sum = 0u; cnt = 0u; mine = 0u;
#pragma unroll
    for (unsigned j = 0; j < 16; ++j) { const unsigned c = xb_ld(&bar[XB_XCNT(j)]); sum += c; cnt += (c > 0u) ? 1u : 0u; mine = (j == x) ? c : mine; }
    if (sum == G) break;
    __builtin_amdgcn_s_sleep(1);
    if ((++sp & 255u) == 0u) { if (xb_ld(&bar[XB_TMO])) break; if (sp > XB_SPIN_CAP) { atomicAdd(&bar[XB_TMO], 1u); break; } }
  }
  nloc = mine > 0u ? mine : 1u; nx = cnt > 0u ? cnt : 1u;
}
DI void xcd_barrier(const XcdBarrier& b) {
  asm volatile("s_waitcnt vmcnt(0)" ::: "memory");
  __syncthreads();
  if (threadIdx.x == 0) {
    unsigned* bar = b.bar;
    __builtin_amdgcn_s_waitcnt(0);
    unsigned nloc = b.st[0], nx = b.st[1];
    if (nloc == 0u) { xcd_barrier_complete(bar, b.x, nloc, nx); b.st[0] = nloc; b.st[1] = nx; }
    const unsigned old = xb_add(&bar[XB_XSUB(b.x)], 1u);
    const unsigned gen = old / nloc;
    if (old + 1u == (gen + 1u) * nloc) {
      __builtin_amdgcn_fence(__ATOMIC_RELEASE, "agent");
      asm volatile("s_waitcnt vmcnt(0)" ::: "memory");
      const unsigned og = xb_add(&bar[XB_TOP], 1u);
      const unsigned tg = og / nx;
      if (og + 1u == (tg + 1u) * nx) xb_add(&bar[XB_TOPGEN], 1u);
      else XB_SPIN(xb_ld(&bar[XB_TOPGEN]) == tg, bar);
      __builtin_amdgcn_fence(__ATOMIC_ACQUIRE, "agent");
      xb_add(&bar[XB_XGEN(b.x)], 1u);
      asm volatile("s_waitcnt vmcnt(0)" ::: "memory");
    } else {
      XB_SPIN(xb_ld(&bar[XB_XGEN(b.x)]) == gen, bar);
      __builtin_amdgcn_fence(__ATOMIC_ACQUIRE, "agent");
      asm volatile("s_waitcnt vmcnt(0)" ::: "memory");
    }
  }
  __syncthreads();
}
constexpr size_t OFF_BAR = OFF_VB + 16777216 + 1048576;

DI void run_phase(const int TIDX, const P& p, int ph, int bid, int nb, char* smem, const bool dry = false) {
  char* ws = p.ws;
  char* big = ws + OFF_BIG;
  float* X = (float*)(ws + OFF_X);
  const float* mod = (const float*)(ws + OFF_MOD);
  bf16_t* H = (bf16_t*)(ws + OFF_H);
  switch (ph) {
    case 0: {
      mod_gemv(TIDX, p, 0, bid, nb, smem);
      tconv(TIDX, p.ev_w_in, 2560, 1024, 2560, (bf16_t*)(ws + OFF_WIN0), 1024, 0, bid, nb, smem);
      tconv(TIDX, p.ev_w_out, 1024, 1024, 1024, (bf16_t*)(ws + OFF_WOUT0), 1024, 0, bid, nb, smem);
      tconv(TIDX, p.pwq, 2048, 1024, 2048, (bf16_t*)(ws + OFF_WQ), 1024, 0, bid, nb, smem);
      tconv(TIDX, p.w2, 512, 64, 512, (bf16_t*)(ws + OFF_W2C), 64, 0, bid, nb, smem);
      tconv(TIDX, p.w2 + 64 * 512, 512, 64, 512, (bf16_t*)(ws + OFF_W2C) + 512 * 64, 64, 0, bid, nb, smem);
      tconv(TIDX, p.a2, 512, 64, 512, (bf16_t*)(ws + OFF_A2C), 64, 0, bid, nb, smem);
      tconv(TIDX, p.a2 + 64 * 512, 512, 64, 512, (bf16_t*)(ws + OFF_A2C) + 512 * 64, 64, 0, bid, nb, smem);
      tconv(TIDX, p.g2, 512, 128, 512, (bf16_t*)(ws + OFF_G2T), 128, 0, bid, nb, smem);
      conv_flat(TIDX, p.pkeys, (bf16_t*)(ws + OFF_KEYS), (size_t)2 * 16 * 128 * 128, bid, nb);
    } break;
    case 1: norm_rows(TIDX, p, 0, 0, true, false, bid, nb); break;
    case 2: {
      bf16_t* Z = (bf16_t*)(big + B_Z0);
      auto epi = [=](int m, int n, const float* v) { *(uint4*)(Z + (size_t)m * 2560 + n) = pack8(v); };
      big_gemm(TIDX, H, (const bf16_t*)(ws + OFF_WIN0), 1024, 72, 10, 0, epi, bid, nb, smem);
    } break;
    case 3: prep0(TIDX, p, bid, nb); break;
    case 4: {
      float* DEC = (float*)(big + B_DEC);
      bf16_t* AL = (bf16_t*)(big + B_AL);
      bf16_t* G = (bf16_t*)(big + B_G);
      const float* w0 = p.w0; const float* a0 = p.a0;
      auto epi1 = [=](int m, int n, const float* v) {
        int d = n >> 9, c = n & 511, hh = c >> 6, i = c & 63;
        int b = m / LT, pos = m - b * LT;
        float o[8];
#pragma unroll
        for (int j = 0; j < 8; j++) {
          float x = w0[n + j] + v[j];
          float w = -softplusf_(-x) - 0.5f;
          o[j] = __expf(-__expf(w));
        }
        float* dp = DEC + (size_t)d * (NB * 8 * LT * 64) + ((size_t)(b * 8 + hh) * LT + pos) * 64 + i;
        *(float4*)dp = make_float4(o[0], o[1], o[2], o[3]);
        *(float4*)(dp + 4) = make_float4(o[4], o[5], o[6], o[7]);
      };
      auto epi2 = [=](int m, int n, const float* v) {
        int d = n >> 9, c = n & 511, hh = c >> 6, i = c & 63;
        int b = m / LT, pos = m - b * LT;
        float o[8];
#pragma unroll
        for (int j = 0; j < 8; j++) o[j] = sigmoidf_(a0[n + j] + v[j]);
        *(uint4*)(AL + (size_t)d * (NB * 8 * LT * 64) + ((size_t)(b * 8 + hh) * LT + pos) * 64 + i) = pack8(o);
      };
      auto epi3 = [=](int m, int n, const float* v) { *(uint4*)(G + (size_t)m * 512 + n) = pack8(v); };
      for (int t = bid; t < 1440; t += nb) {
        if (t < 576) {
          gemm_tile(TIDX, (const bf16_t*)(big + B_AW), 64, (const bf16_t*)(ws + OFF_W2C), 64, 64, (t >> 3) * 256, (t & 7) * 128, epi1, smem);
        } else if (t < 1152) {
          int t2 = t - 576;
          gemm_tile(TIDX, (const bf16_t*)(big + B_AA), 64, (const bf16_t*)(ws + OFF_A2C), 64, 64, (t2 >> 3) * 256, (t2 & 7) * 128, epi2, smem);
        } else {
          int t2 = t - 1152;
          gemm_tile(TIDX, (const bf16_t*)(big + B_AG), 128, (const bf16_t*)(ws + OFF_G2T), 128, 128, (t2 >> 2) * 256, (t2 & 3) * 128, epi3, smem);
        }
      }
    } break;
    case 5: {
      if ((nb & 7) == 0) {
        const int hh = bid & 7;
        for (int lb = bid >> 3; lb < 32; lb += nb >> 3) wkv2_task(TIDX, p, (lb >> 2) * 32 + hh * 4 + (lb & 3), smem);
      } else {
        for (int t = bid; t < 256; t += nb) wkv2_task(TIDX, p, t, smem);
      }
      if ((nb & 7) == 0) attn_xcd(TIDX, p, bid, nb, smem);
      else for (int t = bid; t < 576; t += nb) attn_task(TIDX, p, t, smem);
    } break;
    case 22: wkv_finalize(TIDX, p, bid, nb); break;
    case 23: for (int t = bid; t < 256; t += nb) wkv2_task(TIDX, p, t, smem); break;
    case 24: for (int t = bid; t < 576; t += nb) attn_task(TIDX, p, t, smem); break;
    case 6: {
      const float* gate = mod;
      const float* xc_ = p.ctx; const float* xl_ = p.x;
      auto epi = [=](int m, int n, const float* v) {
        int b = m / LT, pos = m - b * LT;
        int rr = pos < LC ? 8 : b;
        const float* xr = (pos < LC ? xc_ + ((size_t)(b * LC + pos)) * DM : xl_ + ((size_t)(b * SEQ + pos - LC)) * DM) + n;
        const float* gp = gate + (size_t)rr * 6144 + 2 * 1024 + n;
        const float4 x0 = *(const float4*)xr, x1 = *(const float4*)(xr + 4), g0 = *(const float4*)gp, g1 = *(const float4*)(gp + 4);
        float* xo = X + (size_t)m * DM + n;
        *(float4*)xo = make_float4(x0.x + g0.x * v[0], x0.y + g0.y * v[1], x0.z + g0.z * v[2], x0.w + g0.w * v[3]);
        *(float4*)(xo + 4) = make_float4(x1.x + g1.x * v[4], x1.y + g1.y * v[5], x1.z + g1.z * v[6], x1.w + g1.w * v[7]);
      };
      big_gemm(TIDX, (const bf16_t*)(big + B_YMIX), (const bf16_t*)(ws + OFF_WOUT0), 1024, 72, 4, 0, epi, bid, nb, smem);
      if (nb > 64 && bid >= 32) {
        mod_gemv(TIDX, p, 1, bid - 32, nb - 32, smem);
        tconv(TIDX, p.ssd_w_in, 5184, 1024, 5184, (bf16_t*)(ws + OFF_WIN1), 1024, 0, bid - 32, nb - 32, smem);
        tconv(TIDX, p.ssd_w_out, 1024, 2048, 1024, (bf16_t*)(ws + OFF_WOUT1), 2048, 0, bid - 32, nb - 32, smem);
        tconv(TIDX, p.pwq + 1024 * 2048, 2048, 1024, 2048, (bf16_t*)(ws + OFF_WQ) + 2048 * 1024, 1024, 0, bid - 32, nb - 32, smem);
      } else if (nb <= 64) {
        mod_gemv(TIDX, p, 1, bid, nb, smem);
        tconv(TIDX, p.ssd_w_in, 5184, 1024, 5184, (bf16_t*)(ws + OFF_WIN1), 1024, 0, bid, nb, smem);
        tconv(TIDX, p.ssd_w_out, 1024, 2048, 1024, (bf16_t*)(ws + OFF_WOUT1), 2048, 0, bid, nb, smem);
        tconv(TIDX, p.pwq + 1024 * 2048, 2048, 1024, 2048, (bf16_t*)(ws + OFF_WQ) + 2048 * 1024, 1024, 0, bid, nb, smem);
      }
    } break;
    case 7: norm_rows(TIDX, p, 0, 1, false, false, bid, nb); break;
    case 8: {
      bf16_t* QP = (bf16_t*)(big + B_QP);
      auto epi = [=](int m, int n, const float* v) { *(uint4*)(QP + (size_t)m * 2048 + n) = pack8(v); };
      big_gemm(TIDX, H, (const bf16_t*)(ws + OFF_WQ), 1024, 72, 8, 0, epi, bid, nb, smem);
      if (nb > 128 && bid >= 64) {
        conv_fp8(TIDX, p.pu, (unsigned char*)(ws + OFF_UB), (float*)(ws + OFF_UB + 16777216), bid - 64, nb - 64);
        conv_fp8(TIDX, p.pv, (unsigned char*)(ws + OFF_VB), (float*)(ws + OFF_VB + 16777216), bid - 64, nb - 64);
      } else if (nb <= 128) {
        conv_fp8(TIDX, p.pu, (unsigned char*)(ws + OFF_UB), (float*)(ws + OFF_UB + 16777216), bid, nb);
        conv_fp8(TIDX, p.pv, (unsigned char*)(ws + OFF_VB), (float*)(ws + OFF_VB + 16777216), bid, nb);
      }
    } break;
    case 9: break;
    case 10:
      if ((nb & 7) == 0) { for (int tile = bid >> 3; tile < 72; tile += nb >> 3) route2_task(TIDX, p, 0, tile * 256, bid & 7, smem, tile == (bid >> 3)); }
      else for (int t = bid; t < 72 * 8; t += nb) route2_task(TIDX, p, 0, (t >> 3) * 256, t & 7, smem);
      break;
    case 26: peer_u2(TIDX, p, false, bid, nb); break;
    case 27: peer_u2(TIDX, p, true, bid, nb); break;
    case 11: peer_gather(TIDX, p, 0, false, bid, nb, dry); break;
    case 12: {
      bf16_t* ZG = (bf16_t*)(big + B_ZG);
      bf16_t* ZX = (bf16_t*)(big + B_ZX);
      float* DT = (float*)(big + B_DT);
      auto epi = [=](int m, int n, const float* v) {
        if (n < 2048) *(uint4*)(ZG + (size_t)m * 2048 + n) = pack8(v);
        else if (n < 5120) *(uint4*)(ZX + (size_t)m * 3072 + n - 2048) = pack8(v);
        else if (n < 5184) {
          float* dp = DT + (size_t)m * 64 + n - 5120;
          *(float4*)dp = make_float4(v[0], v[1], v[2], v[3]);
          *(float4*)(dp + 4) = make_float4(v[4], v[5], v[6], v[7]);
        }
      };
      big_gemm(TIDX, H, (const bf16_t*)(ws + OFF_WIN1), 1024, 72, 21, 0, epi, bid, nb, smem);
    } break;
    case 13: {
      conv_phase(TIDX, p, bid, nb);
      conv_fp8(TIDX, p.pu + (size_t)16384 * 1024, (unsigned char*)(ws + OFF_UB), (float*)(ws + OFF_UB + 16777216), bid, nb);
      conv_fp8(TIDX, p.pv + (size_t)16384 * 1024, (unsigned char*)(ws + OFF_VB), (float*)(ws + OFF_VB + 16777216), bid, nb);
    } break;
    case 14:
      if ((nb & 7) == 0) {
        const int xcd = bid & 7, st = nb >> 3;
        for (int lb = bid >> 3; lb < 32; lb += st) {
          const int gi = xcd + 8 * (lb >> 3), hh = lb & 7;
          ssd_task(TIDX, p, (gi >> 2) * 32 + (gi & 3) * 8 + hh, smem);
        }
      } else {
        for (int t = bid; t < 256; t += nb) ssd_task(TIDX, p, t, smem);
      }
      break;
    case 15: gate_norm(TIDX, p, bid, nb); break;
    case 16: {
      const float* gate = mod + (size_t)9 * 6144;
      auto epi = [=](int m, int n, const float* v) {
        int b = m / LT;
        const float* gp = gate + (size_t)b * 6144 + 2 * 1024 + n;
        const float4 g0 = *(const float4*)gp, g1 = *(const float4*)(gp + 4);
        float* xo = X + (size_t)m * DM + n;
        const float4 x0 = *(const float4*)xo, x1 = *(const float4*)(xo + 4);
        *(float4*)xo = make_float4(x0.x + g0.x * v[0], x0.y + g0.y * v[1], x0.z + g0.z * v[2], x0.w + g0.w * v[3]);
        *(float4*)(xo + 4) = make_float4(x1.x + g1.x * v[4], x1.y + g1.y * v[5], x1.z + g1.z * v[6], x1.w + g1.w * v[7]);
      };
      big_gemm(TIDX, (const bf16_t*)(big + B_YN), (const bf16_t*)(ws + OFF_WOUT1), 2048, 64, 4, 1, epi, bid, nb, smem);
    } break;
    case 17: norm_rows(TIDX, p, 1, 1, false, true, bid, nb); break;
    case 18: {
      bf16_t* QP = (bf16_t*)(big + B_QP);
      auto epi = [=](int m, int n, const float* v) { *(uint4*)(QP + (size_t)m * 2048 + n) = pack8(v); };
      big_gemm(TIDX, H, (const bf16_t*)(ws + OFF_WQ) + 2048 * 1024, 1024, 64, 8, 1, epi, bid, nb, smem);
    } break;
    case 19: break;
    case 20:
      if ((nb & 7) == 0) {
        for (int mtl = bid >> 3; mtl < 64; mtl += nb >> 3) {
          int b = mtl >> 3, mt = b * 9 + 1 + (mtl & 7);
          route2_task(TIDX, p, 1, mt * 256, bid & 7, smem, mtl == (bid >> 3));
        }
      } else
      for (int t = bid; t < 64 * 8; t += nb) {
        int mtl = t >> 3, b = mtl >> 3, mt = b * 9 + 1 + (mtl & 7);
        route2_task(TIDX, p, 1, mt * 256, t & 7, smem);
      }
      break;
    case 21: peer_gather(TIDX, p, 1, true, bid, nb, false); break;
  }
}
constexpr int NPHASE = 22;
#ifndef EXTRA
#define EXTRA
#endif
#ifndef DUP_MASK
#define DUP_MASK 0u
#endif

__global__ void __launch_bounds__(NTHR) mega(P p) {
  __shared__ __attribute__((aligned(16))) char smem[SMEM_BYTES];
  cg::grid_group grid = cg::this_grid();
  __shared__ uint4 xb_words;
  if (threadIdx.x == 0) xb_words = make_uint4(0u, 0u, 0u, 0u);
  __syncthreads();
  XcdBarrier xb = xcd_barrier_post((unsigned*)(p.ws + OFF_BAR), (volatile LAS unsigned*)&xb_words);
  if (gridDim.x == 0x7fffffffu) grid.sync();
#define PHC(i, last)                                             \
  {                                                              \
    P q = p;                                                     \
    int bid = blockIdx.x, nb = gridDim.x;                        \
    char* sm = smem;                                             \
    int TIDX = __builtin_amdgcn_workitem_id_x();                 \
    asm volatile("" : "+s"(q.ws), "+s"(bid), "+s"(nb), "+v"(TIDX)); \
    if ((DUP_MASK >> i) & 1) { run_phase(TIDX, q, i, bid, nb, sm, true); xcd_barrier(xb); } \
    run_phase(TIDX, q, i, bid, nb, sm);                          \
    if (!last) xcd_barrier(xb);                                  \
  }
#define PHN(i)                                                   \
  {                                                              \
    P q = p;                                                     \
    int bid = blockIdx.x, nb = gridDim.x;                        \
    char* sm = smem;                                             \
    int TIDX = __builtin_amdgcn_workitem_id_x();                 \
    asm volatile("" : "+s"(q.ws), "+s"(bid), "+s"(nb), "+v"(TIDX)); \
    run_phase(TIDX, q, i, bid, nb, sm);                          \
    __syncthreads();                                             \
  }
  PHC(0, 0) PHC(1, 0) PHC(2, 0) PHC(3, 0) PHC(4, 0) PHC(5, 0) EXTRA PHC(22, 0) PHC(6, 0) PHC(7, 0) PHC(8, 0) PHC(10, 0) PHN(26)
  PHC(11, 0) PHC(12, 0) PHC(13, 0) PHC(14, 0) PHC(15, 0) PHC(16, 0) PHC(17, 0) PHC(18, 0) PHC(20, 0) PHN(27) PHC(21, 1)
}

extern "C" void kernel_launch(void* const* d_in, const int* in_sizes, int n_in, void* d_out, int out_size, void* d_ws,
                              size_t ws_size, hipStream_t stream) {
  static int grid_blocks = 0;
  if (!grid_blocks) {
    int dev = 0, cus = 0, per_cu = 0;
    hipGetDevice(&dev);
    hipDeviceGetAttribute(&cus, hipDeviceAttributeMultiprocessorCount, dev);
    hipOccupancyMaxActiveBlocksPerMultiprocessor(&per_cu, mega, NTHR, 0);
    if (per_cu < 1) per_cu = 1;
    grid_blocks = cus * per_cu;
  }
  P p;
  memset(&p, 0, sizeof(p));
  const float** fp = (const float**)&p;
  for (int i = 0; i < 35; i++) fp[i] = (const float*)d_in[i];
  p.out = (float*)d_out;
  p.ws = (char*)d_ws;
  if (ws_size < WS_NEED) fprintf(stderr, "workspace too small: %zu < %zu\n", ws_size, (size_t)WS_NEED);
  hipMemsetAsync((char*)d_ws + OFF_BAR, 0, XCD_BAR_WORDS * sizeof(unsigned), stream);
  void* args[] = {&p};
  hipError_t e = hipLaunchCooperativeKernel((void*)mega, dim3(grid_blocks), dim3(NTHR), args, 0, stream);
  if (e != hipSuccess) fprintf(stderr, "cooperative launch failed: %s (grid %d)\n", hipGetErrorString(e), grid_blocks);
}
```

```cpp
#include <hip/hip_runtime.h>
#include <hip/hip_cooperative_groups.h>
#include <stdint.h>
#include <string.h>
#include <stdio.h>
namespace cg = cooperative_groups;

#define DI __device__ __forceinline__
typedef unsigned short bf16_t;
typedef short bf16x8 __attribute__((ext_vector_type(8)));
typedef float f32x16 __attribute__((ext_vector_type(16)));

constexpr int NB = 8, SEQ = 2048, LC = 256, LT = 2304, NTOK = 18432, DM = 1024;
constexpr int NTHR = 512;

constexpr size_t OFF_UB = 0;
constexpr size_t OFF_VB = OFF_UB + 33554432;
constexpr size_t OFF_WIN0 = OFF_VB + 33554432;
constexpr size_t OFF_WOUT0 = OFF_WIN0 + 5242880;
constexpr size_t OFF_WIN1 = OFF_WOUT0 + 3145728;
constexpr size_t OFF_WOUT1 = OFF_WIN1 + 11010048;
constexpr size_t OFF_WQ = OFF_WOUT1 + 4194304;
constexpr size_t OFF_KEYS = OFF_WQ + 8388608;
constexpr size_t OFF_W2C = OFF_KEYS + 1048576;
constexpr size_t OFF_A2C = OFF_W2C + 131072;
constexpr size_t OFF_G2T = OFF_A2C + 131072;
constexpr size_t OFF_MOD = OFF_G2T + 131072;
constexpr size_t OFF_X = OFF_MOD + 442368;
constexpr size_t OFF_H = OFF_X + 75497472;
constexpr size_t OFF_BIG = OFF_H + 37748736;
constexpr size_t B_Z0 = 0;
constexpr size_t B_DEC = 0;
constexpr size_t B_G = 75497472;
constexpr size_t B_QN = 94371840;
constexpr size_t B_KN = B_QN + 18874368;
constexpr size_t B_VT = B_KN + 4718592;
constexpr size_t B_R = B_VT + 4718592;
constexpr size_t B_KB = B_R + 18874368;
constexpr size_t B_KK = B_KB + 18874368;
constexpr size_t B_V = B_KK + 18874368;
constexpr size_t B_AL = B_V + 18874368;
constexpr size_t B_AW = B_AL + 37748736;
constexpr size_t B_AA = B_AW + 2359296;
constexpr size_t B_AG = B_AA + 2359296;
constexpr size_t B_YMIX = B_AW;
constexpr size_t B_OUT = B_YMIX + 37748736;
constexpr size_t B_L0END = B_OUT + 37748736;
constexpr size_t OFF_BON = OFF_UB + 16777216 + 1048576;
constexpr size_t B_QP = 0;
constexpr size_t B_S = 75497472;
constexpr size_t B_EI = B_S + 150994944;
constexpr size_t B_EG = B_EI + 9437184;
constexpr size_t B_PEND = B_EG + 9437184;
constexpr size_t B_ZG = 0;
constexpr size_t B_ZX = 75497472;
constexpr size_t B_Y = B_ZX;
constexpr size_t B_DT = B_ZX + 113246208;
constexpr size_t B_XBC = B_DT + 4718592;
constexpr size_t B_YN = B_XBC;
constexpr size_t B_L1END = B_XBC + 113246208;
constexpr size_t BIG_SZ = B_L1END > B_L0END ? (B_L1END > B_PEND ? B_L1END : B_PEND) : (B_L0END > B_PEND ? B_L0END : B_PEND);
constexpr size_t WS_NEED = OFF_BIG + BIG_SZ;
static_assert(WS_NEED <= 536870912, "workspace too large");

constexpr int SMEM_BYTES = 157696;

struct P {
  const float *x, *c, *ctx, *c_ctx, *mod_w, *mod_b, *n1g, *n2g, *ev_w_in, *ev_w_out, *qg, *kg, *mu, *w0, *w2, *a0, *a2, *g2,
      *k_k, *k_a, *r_k, *gn_w, *gn_b, *ssd_w_in, *conv_w, *conv_b, *dt_bias, *a_log, *ssd_d, *ssd_nw, *ssd_w_out, *pwq, *pkeys,
      *pu, *pv;
  float* out;
  char* ws;
};

typedef float f32x2 __attribute__((ext_vector_type(2)));
typedef __bf16 bf16x2_t __attribute__((ext_vector_type(2)));
DI bf16_t f2bf(float f) { return __builtin_bit_cast(bf16_t, (__bf16)f); }
DI float bf2f(bf16_t b) { return __uint_as_float(((unsigned)b) << 16); }
DI unsigned pack2(float a, float b) {
  f32x2 f = {a, b};
  return __builtin_bit_cast(unsigned, __builtin_convertvector(f, bf16x2_t));
}
DI float lo2f(unsigned u) { return __uint_as_float(u << 16); }
DI float hi2f(unsigned u) { return __uint_as_float(u & 0xffff0000u); }
DI void unpack8(const uint4& r, float* v) {
  v[0] = lo2f(r.x); v[1] = hi2f(r.x); v[2] = lo2f(r.y); v[3] = hi2f(r.y);
  v[4] = lo2f(r.z); v[5] = hi2f(r.z); v[6] = lo2f(r.w); v[7] = hi2f(r.w);
}
DI uint4 pack8(const float* v) {
  uint4 r; r.x = pack2(v[0], v[1]); r.y = pack2(v[2], v[3]); r.z = pack2(v[4], v[5]); r.w = pack2(v[6], v[7]);
  return r;
}
DI float shx_(float v, int off, int lane) {
  return __builtin_bit_cast(float, __builtin_amdgcn_ds_bpermute((lane ^ off) << 2, __builtin_bit_cast(int, v)));
}
DI float shup_(float v, int off, int lane) {
  return __builtin_bit_cast(float, __builtin_amdgcn_ds_bpermute((lane - off) << 2, __builtin_bit_cast(int, v)));
}
#define SHX(v, o) shx_((v), (o), lane)
DI float wave_sum_(float v, int lane) {
#pragma unroll
  for (int o = 32; o > 0; o >>= 1) v += shx_(v, o, lane);
  return v;
}
#define wave_sum(v) wave_sum_((v), lane)
DI float dpp_f(float v, const int ctrl_sel) {
  int x = __builtin_bit_cast(int, v);
  int y;
  if (ctrl_sel == 0) y = __builtin_amdgcn_mov_dpp(x, 0xB1, 0xF, 0xF, true);
  else if (ctrl_sel == 1) y = __builtin_amdgcn_mov_dpp(x, 0x4E, 0xF, 0xF, true);
  else y = __builtin_amdgcn_mov_dpp(x, 0x141, 0xF, 0xF, true);
  return __builtin_bit_cast(float, y);
}
DI float reduce8(float v) {
  v += dpp_f(v, 0);
  v += dpp_f(v, 1);
  v += dpp_f(v, 2);
  return v;
}
DI float wave_sum_dpp(float v, int lane) {
  v += dpp_f(v, 0);
  v += dpp_f(v, 1);
  v += dpp_f(v, 2);
  v += __builtin_bit_cast(float, __builtin_amdgcn_mov_dpp(__builtin_bit_cast(int, v), 0x140, 0xF, 0xF, true));
  v += shx_(v, 16, lane);
  v += shx_(v, 32, lane);
  return v;
}
DI void cvt16_fp8(const uint4& w, float* f) {
  f32x2 t;
  t = __builtin_amdgcn_cvt_pk_f32_fp8((int)w.x, false); f[0] = t.x; f[1] = t.y;
  t = __builtin_amdgcn_cvt_pk_f32_fp8((int)w.x, true); f[2] = t.x; f[3] = t.y;
  t = __builtin_amdgcn_cvt_pk_f32_fp8((int)w.y, false); f[4] = t.x; f[5] = t.y;
  t = __builtin_amdgcn_cvt_pk_f32_fp8((int)w.y, true); f[6] = t.x; f[7] = t.y;
  t = __builtin_amdgcn_cvt_pk_f32_fp8((int)w.z, false); f[8] = t.x; f[9] = t.y;
  t = __builtin_amdgcn_cvt_pk_f32_fp8((int)w.z, true); f[10] = t.x; f[11] = t.y;
  t = __builtin_amdgcn_cvt_pk_f32_fp8((int)w.w, false); f[12] = t.x; f[13] = t.y;
  t = __builtin_amdgcn_cvt_pk_f32_fp8((int)w.w, true); f[14] = t.x; f[15] = t.y;
}
DI float sigmoidf_(float x) { return __builtin_amdgcn_rcpf(1.f + __expf(-x)); }
DI float siluf_(float x) { return x * __builtin_amdgcn_rcpf(1.f + __expf(-x)); }
DI float softplusf_(float y) { return fmaxf(y, 0.f) + __logf(1.f + __expf(-fabsf(y))); }
DI int scanpos(int d, int pp) { return d ? (pp < LC ? LC - 1 - pp : LT + LC - 1 - pp) : pp; }
DI int rowmod(int n) { int b = n / LT; int pos = n - b * LT; return pos < LC ? 8 : b; }
DI const float* xin_row(const P& p, int n) {
  int b = n / LT, pos = n - b * LT;
  return pos < LC ? p.ctx + ((size_t)(b * LC + pos)) * DM : p.x + ((size_t)(b * SEQ + pos - LC)) * DM;
}

template <class Epi>
DI void gemm_tile(const int TIDX, const bf16_t* __restrict__ A, int lda, const bf16_t* __restrict__ Bt, int ldb, int K, int m0, int n0,
                  Epi epi, char* smem) {
  bf16_t* As = (bf16_t*)smem;
  bf16_t* Bs = As + 2 * 256 * 72;
  const int tid = TIDX, lane = tid & 63, wave = tid >> 6;
  const int wm = wave >> 1, wn = wave & 1;
  const int r = lane & 31, h8 = lane >> 5;
  f32x16 acc[2][2];
#pragma unroll
  for (int i = 0; i < 2; i++)
#pragma unroll
    for (int j = 0; j < 2; j++)
#pragma unroll
      for (int q = 0; q < 16; q++) acc[i][j][q] = 0.f;
  const int lrow = tid >> 3, lch = tid & 7;
  const bf16_t* Ap = A + (size_t)(m0 + lrow) * lda + lch * 8;
  const bf16_t* Bp = Bt + (size_t)(n0 + lrow) * ldb + lch * 8;
  const size_t sa = (size_t)64 * lda, sb_ = (size_t)64 * ldb;
  uint4 ra0 = *(const uint4*)(Ap), ra1 = *(const uint4*)(Ap + sa), ra2 = *(const uint4*)(Ap + 2 * sa), ra3 = *(const uint4*)(Ap + 3 * sa);
  uint4 rb0 = *(const uint4*)(Bp), rb1 = *(const uint4*)(Bp + sb_);
  __syncthreads();
  {
    bf16_t* Aw = As + lrow * 72 + lch * 8;
    bf16_t* Bw = Bs + lrow * 72 + lch * 8;
    *(uint4*)(Aw) = ra0; *(uint4*)(Aw + 64 * 72) = ra1; *(uint4*)(Aw + 128 * 72) = ra2; *(uint4*)(Aw + 192 * 72) = ra3;
    *(uint4*)(Bw) = rb0; *(uint4*)(Bw + 64 * 72) = rb1;
  }
  __syncthreads();
  const int nk = K >> 6;
  for (int kt = 0; kt < nk; kt++) {
    const int cur = kt & 1;
    const bool more = kt + 1 < nk;
    if (more) {
      const bf16_t* Aq = Ap + (kt + 1) * 64;
      const bf16_t* Bq = Bp + (kt + 1) * 64;
      ra0 = *(const uint4*)(Aq); ra1 = *(const uint4*)(Aq + sa); ra2 = *(const uint4*)(Aq + 2 * sa); ra3 = *(const uint4*)(Aq + 3 * sa);
      rb0 = *(const uint4*)(Bq); rb1 = *(const uint4*)(Bq + sb_);
    }
    const bf16_t* Ac = As + cur * 256 * 72 + (wm * 64 + r) * 72 + h8 * 8;
    const bf16_t* Bc = Bs + cur * 128 * 72 + (wn * 64 + r) * 72 + h8 * 8;
#pragma unroll
    for (int ks = 0; ks < 4; ks++) {
      bf16x8 a0 = *(const bf16x8*)(Ac + ks * 16);
      bf16x8 a1 = *(const bf16x8*)(Ac + 32 * 72 + ks * 16);
      bf16x8 b0 = *(const bf16x8*)(Bc + ks * 16);
      bf16x8 b1 = *(const bf16x8*)(Bc + 32 * 72 + ks * 16);
      acc[0][0] = __builtin_amdgcn_mfma_f32_32x32x16_bf16(a0, b0, acc[0][0], 0, 0, 0);
      acc[0][1] = __builtin_amdgcn_mfma_f32_32x32x16_bf16(a0, b1, acc[0][1], 0, 0, 0);
      acc[1][0] = __builtin_amdgcn_mfma_f32_32x32x16_bf16(a1, b0, acc[1][0], 0, 0, 0);
      acc[1][1] = __builtin_amdgcn_mfma_f32_32x32x16_bf16(a1, b1, acc[1][1], 0, 0, 0);
    }
    if (more) {
      const int nx = cur ^ 1;
      bf16_t* Aw = As + nx * 256 * 72 + lrow * 72 + lch * 8;
      bf16_t* Bw = Bs + nx * 128 * 72 + lrow * 72 + lch * 8;
      *(uint4*)(Aw) = ra0; *(uint4*)(Aw + 64 * 72) = ra1; *(uint4*)(Aw + 128 * 72) = ra2; *(uint4*)(Aw + 192 * 72) = ra3;
      *(uint4*)(Bw) = rb0; *(uint4*)(Bw + 64 * 72) = rb1;
    }
    __syncthreads();
  }
  float* Cs = (float*)smem;
#pragma unroll
  for (int mt = 0; mt < 2; mt++)
#pragma unroll
    for (int nt = 0; nt < 2; nt++)
#pragma unroll
      for (int q = 0; q < 16; q++)
        Cs[(wm * 64 + mt * 32 + (q & 3) + 8 * (q >> 2) + 4 * h8) * 132 + wn * 64 + nt * 32 + r] = acc[mt][nt][q];
  __syncthreads();
#pragma unroll
  for (int i = 0; i < 8; i++) {
    const int seg = i * NTHR + tid;
    const int row = seg >> 4, cs = (seg & 15) * 8;
    const float4 c0 = *(const float4*)(Cs + row * 132 + cs), c1 = *(const float4*)(Cs + row * 132 + cs + 4);
    float v[8] = {c0.x, c0.y, c0.z, c0.w, c1.x, c1.y, c1.z, c1.w};
    epi(m0 + row, n0 + cs, v);
  }
}

namespace pg8 {
#define PG8_LAS __attribute__((address_space(3)))
typedef unsigned short bf16_t;
typedef short bf16x8 __attribute__((ext_vector_type(8)));
typedef float f32x4 __attribute__((ext_vector_type(4)));
typedef unsigned u32x4 __attribute__((ext_vector_type(4)));
constexpr int BM = 256, BK = 64, HALF = 128, HTB = HALF * BK * 2  , STAGE_BYTES = 8 * HTB, NXCD = 8, WGM = 8;

__host__ __device__ __forceinline__ int lds_byte(int r, int c) { const int st = (r >> 4) * 2 + (c >> 5), rr = r & 15, cc = c & 31, ob = rr * 64 + cc * 2; return st * 1024 + (ob ^ (((ob >> 9) & 1) << 5)); }
__host__ __device__ __forceinline__ void stage_rc(int b, int& R, int& C) { const int st = b / 1024, sb = b % 1024, swz = sb ^ (((sb >> 9) & 1) << 5); R = (st >> 1) * 16 + swz / 64; C = (st & 1) * 32 + (swz % 64) / 2; }
__host__ __device__ __forceinline__ int perm32(int rho) { const int n = rho >> 4, i = rho & 15; return 8 * (i >> 2) + 4 * n + (i & 3); }

struct Unit { int pm, pn; };
struct Gemm { const bf16_t* A; const bf16_t* Bt; int M, N, K; };

struct TileOrder {
    int nN, nwg, G, c, latent;
    __device__ __forceinline__ void init(int nM_, int nN_, int G_, int c_, int latent_) { nN = nN_; nwg = nM_ * nN_; G = G_; c = c_; latent = latent_; }
    __device__ __forceinline__ bool next(int i, Unit& u) const {
        const int L = i * G + c; if (L >= nwg) return false;
        int wgid = L; { const int q = nwg / NXCD, r = nwg % NXCD, xcd = wgid % NXCD, off = wgid / NXCD; wgid = (xcd < r ? xcd * (q + 1) : r * (q + 1) + (xcd - r) * q) + off; }
        const int nM = nwg / nN;
        const int nig = WGM * nN, gid = wgid / nig, fm = gid * WGM, gsz = (nM - fm) < WGM ? (nM - fm) : WGM;
        int pm = fm + ((wgid % nig) % gsz); u.pn = (wgid % nig) / gsz;
        if (latent) { const int b = pm >> 3; pm = b * 9 + 1 + (pm & 7); }
        u.pm = pm; return true;
    }
    __device__ __forceinline__ void a_ready(const Unit&) const {}
    __device__ __forceinline__ void done(const Unit&) const {}
};
template <class F> struct EpiAdapt {
    static constexpr bool PERM = true, AFTER_DRAIN = false;
    F f;
    __device__ __forceinline__ void operator()(const f32x4 (&acc)[2][2][4][2], const Unit& u, int wr, int wc, int fr, int fq) const {
#pragma unroll
        for (int ai = 0; ai < 2; ++ai)
#pragma unroll
            for (int m = 0; m < 4; ++m) {
                const int row = u.pm * BM + ai * HALF + wr * 64 + m * 16 + fr;
#pragma unroll
                for (int bj = 0; bj < 2; ++bj) {
                    const int col = u.pn * BM + bj * HALF + wc * 32 + 8 * fq;
                    const f32x4 a0 = acc[ai][bj][m][0], a1 = acc[ai][bj][m][1];
                    float v[8] = {a0[0], a0[1], a0[2], a0[3], a1[0], a1[1], a1[2], a1[3]};
                    f(row, col, v);
                }
            }
    }
};

template <class Epi, class Sched, bool ALIGN_EPI = false, bool SP2 = false>
__device__ __forceinline__ void gemm_phase(const int TIDX, PG8_LAS unsigned char* lds, const Gemm g, const Sched& S, const Epi& E) {
    const int tid = TIDX, wid = __builtin_amdgcn_readfirstlane(tid >> 6), lane = tid & 63, wr = wid >> 2, wc = wid & 3, fr = lane & 15, fq = lane >> 4;
    const int K = g.K, nt = K / BK;
    unsigned voffA[2], voffB[2];
#pragma unroll
    for (int i = 0; i < 2; ++i) { int R, C; stage_rc(tid * 16 + i * 8192, R, C); const int Rb = Epi::PERM ? ((R & ~31) + perm32(R & 31)) : R;
        voffA[i] = (unsigned)(R * K + C) * 2u; voffB[i] = (unsigned)(Rb * K + C) * 2u; }
    const size_t kstep = (size_t)(BK * 2);
    const size_t hstep = (size_t)HALF * K * 2;
    const size_t tstep = 2 * hstep;
    const unsigned ldsw = (unsigned)wid * 1024u;
    const int aoff = lds_byte(wr * 64 + fr, fq * 8), boff = lds_byte(wc * 32 + fr, fq * 8);
#define PG8_SA(b, h) (((b) * 2 + (h)) * HTB)
#define PG8_SB(b, h) ((4 + (b) * 2 + (h)) * HTB)
#define PG8_STAGE(bufoff, gbase, voff) do { _Pragma("unroll") for (int _i = 0; _i < 2; ++_i) \
        __builtin_amdgcn_global_load_lds((const unsigned*)((const char*)(gbase) + (voff)[_i]), (PG8_LAS unsigned*)(lds + (bufoff) + ldsw + _i * 8192), 16, 0, 0); } while (0)
#define PG8_LDA(dst, b, h) do { _Pragma("unroll") for (int m = 0; m < 4; ++m) _Pragma("unroll") for (int k = 0; k < 2; ++k) dst[m][k] = *(const PG8_LAS bf16x8*)(lds + PG8_SA(b, h) + aoff + m * 2048 + k * 1024); } while (0)
#define PG8_LDB(dst, b, h) do { _Pragma("unroll") for (int n = 0; n < 2; ++n) _Pragma("unroll") for (int k = 0; k < 2; ++k) dst[n][k] = *(const PG8_LAS bf16x8*)(lds + PG8_SB(b, h) + boff + n * 2048 + k * 1024); } while (0)
#define PG8_MMA(ai, bj, At, Bt) do { __builtin_amdgcn_s_setprio(1); _Pragma("unroll") for (int m = 0; m < 4; ++m) _Pragma("unroll") for (int n = 0; n < 2; ++n) _Pragma("unroll") for (int k = 0; k < 2; ++k) \
        acc[ai][bj][m][n] = __builtin_amdgcn_mfma_f32_16x16x32_bf16(Bt[n][k], At[m][k], acc[ai][bj][m][n], 0, 0, 0); __builtin_amdgcn_s_setprio(0); } while (0)
#define PG8_WAIT_V(n) asm volatile("s_waitcnt vmcnt(" #n ")" ::: "memory")
#define PG8_WAIT_L(n) asm volatile("s_waitcnt lgkmcnt(" #n ")" ::: "memory")
#define PG8_BAR __builtin_amdgcn_s_barrier()
#define PG8_SCHED __builtin_amdgcn_sched_barrier(0)
    Unit cur, nxt; int ui = 0;
    if (!S.next(0, cur)) return;
    f32x4 acc[2][2][4][2];
#pragma unroll
    for (int a = 0; a < 2; ++a)
#pragma unroll
        for (int b = 0; b < 2; ++b)
#pragma unroll
            for (int m = 0; m < 4; ++m)
#pragma unroll
                for (int n = 0; n < 2; ++n) acc[a][b][m][n] = (f32x4){0.f, 0.f, 0.f, 0.f};
    bf16x8 At[4][2], B0[2][2], B1[2][2];
    const char* cA = (const char*)g.A + (size_t)cur.pm * tstep; const char* cB = (const char*)g.Bt + (size_t)cur.pn * tstep;
    S.a_ready(cur);
    if constexpr (SP2) {
        PG8_STAGE(PG8_SB(0, 0), cB, voffB); PG8_STAGE(PG8_SB(0, 1), cB + hstep, voffB); PG8_STAGE(PG8_SA(0, 0), cA, voffA); PG8_STAGE(PG8_SA(0, 1), cA + hstep, voffA);
        if (wr == 1) PG8_BAR;
        PG8_WAIT_V(2); PG8_BAR;
        PG8_STAGE(PG8_SB(1, 0), cB + kstep, voffB); PG8_STAGE(PG8_SA(1, 0), cA + kstep, voffA); PG8_STAGE(PG8_SB(1, 1), cB + hstep + kstep, voffB);
        PG8_WAIT_V(6); PG8_BAR;
    } else {
        PG8_STAGE(PG8_SB(0, 0), cB, voffB); PG8_STAGE(PG8_SA(0, 0), cA, voffA); PG8_STAGE(PG8_SB(0, 1), cB + hstep, voffB); PG8_STAGE(PG8_SA(0, 1), cA + hstep, voffA);
        if (wr == 1) PG8_BAR;
        PG8_WAIT_V(4); PG8_BAR;
        PG8_STAGE(PG8_SB(1, 0), cB + kstep, voffB); PG8_STAGE(PG8_SA(1, 0), cA + kstep, voffA); PG8_STAGE(PG8_SB(1, 1), cB + hstep + kstep, voffB);
        PG8_WAIT_V(6); PG8_BAR;
    }
    for (;;) {
        const bool has_next = S.next(ui + 1, nxt);
        const char* nA = has_next ? (const char*)g.A + (size_t)nxt.pm * tstep : cA; const char* nB = has_next ? (const char*)g.Bt + (size_t)nxt.pn * tstep : cB;
        for (int t = 0; t < nt; t += 2) {
            const bool last = (t == nt - 2);
            const char* a1 = cA + (size_t)(t + 1) * kstep;
            const char* a2 = last ? nA : cA + (size_t)(t + 2) * kstep; const char* b2 = last ? nB : cB + (size_t)(t + 2) * kstep;
            const char* a3 = a2 + kstep; const char* b3 = b2 + kstep;
            if (last && has_next) S.a_ready(nxt);
            if constexpr (SP2) {
            PG8_LDB(B0, 0, 0); PG8_LDB(B1, 0, 1); PG8_SCHED; PG8_LDA(At, 0, 0); PG8_STAGE(PG8_SA(1, 1), a1 + hstep, voffA);
            PG8_WAIT_V(8); PG8_WAIT_L(0); PG8_BAR; PG8_MMA(0, 0, At, B0); PG8_MMA(0, 1, At, B1); PG8_BAR; PG8_SCHED;
            PG8_LDA(At, 0, 1); PG8_STAGE(PG8_SB(0, 0), b2, voffB); PG8_STAGE(PG8_SB(0, 1), b2 + hstep, voffB); PG8_STAGE(PG8_SA(0, 0), a2, voffA);
            PG8_WAIT_V(8); PG8_WAIT_L(0); PG8_BAR; PG8_MMA(1, 0, At, B0); PG8_MMA(1, 1, At, B1); PG8_BAR; PG8_SCHED;
            PG8_LDB(B0, 1, 0); PG8_LDB(B1, 1, 1); PG8_SCHED; PG8_LDA(At, 1, 0); PG8_STAGE(PG8_SA(0, 1), a2 + hstep, voffA);
            PG8_WAIT_V(8); PG8_WAIT_L(0); PG8_BAR; PG8_MMA(0, 0, At, B0); PG8_MMA(0, 1, At, B1); PG8_BAR; PG8_SCHED;
            PG8_LDA(At, 1, 1); PG8_STAGE(PG8_SB(1, 0), b3, voffB); PG8_STAGE(PG8_SB(1, 1), b3 + hstep, voffB); PG8_STAGE(PG8_SA(1, 0), a3, voffA);
            PG8_WAIT_V(8); PG8_WAIT_L(0); PG8_BAR; PG8_MMA(1, 0, At, B0); PG8_MMA(1, 1, At, B1); PG8_BAR; PG8_SCHED;
            } else {
            PG8_LDB(B0, 0, 0); PG8_SCHED; PG8_LDA(At, 0, 0); PG8_STAGE(PG8_SA(1, 1), a1 + hstep, voffA);
            PG8_WAIT_L(8); PG8_BAR; PG8_WAIT_L(0); PG8_MMA(0, 0, At, B0); PG8_BAR; PG8_SCHED;
            PG8_LDB(B1, 0, 1); PG8_STAGE(PG8_SB(0, 0), b2, voffB);
            PG8_BAR; PG8_WAIT_L(0); PG8_MMA(0, 1, At, B1); PG8_BAR;
            PG8_LDA(At, 0, 1); PG8_STAGE(PG8_SA(0, 0), a2, voffA);
            PG8_BAR; PG8_WAIT_L(0); PG8_MMA(1, 0, At, B0); PG8_BAR; PG8_SCHED;
            PG8_STAGE(PG8_SB(0, 1), b2 + hstep, voffB);
            PG8_WAIT_V(6); PG8_BAR; PG8_MMA(1, 1, At, B1); PG8_BAR;
            PG8_LDB(B0, 1, 0); PG8_SCHED; PG8_LDA(At, 1, 0); PG8_STAGE(PG8_SA(0, 1), a2 + hstep, voffA);
            PG8_WAIT_L(8); PG8_BAR; PG8_WAIT_L(0); PG8_MMA(0, 0, At, B0); PG8_BAR; PG8_SCHED;
            PG8_LDB(B1, 1, 1); PG8_STAGE(PG8_SB(1, 0), b3, voffB);
            PG8_BAR; PG8_WAIT_L(0); PG8_MMA(0, 1, At, B1); PG8_BAR;
            PG8_LDA(At, 1, 1); PG8_STAGE(PG8_SA(1, 0), a3, voffA);
            PG8_BAR; PG8_WAIT_L(0); PG8_MMA(1, 0, At, B0); PG8_BAR; PG8_SCHED;
            PG8_STAGE(PG8_SB(1, 1), b3 + hstep, voffB);
            PG8_WAIT_V(6); PG8_BAR; PG8_MMA(1, 1, At, B1); PG8_BAR;
            }
        }
        if constexpr (ALIGN_EPI) { if (wr == 0) PG8_BAR; }
        if constexpr (!Epi::AFTER_DRAIN) { E(acc, cur, wr, wc, fr, fq); S.done(cur); }
        if (!has_next) break;
#pragma unroll
        for (int a = 0; a < 2; ++a)
#pragma unroll
            for (int b = 0; b < 2; ++b)
#pragma unroll
                for (int m = 0; m < 4; ++m)
#pragma unroll
                    for (int n = 0; n < 2; ++n) acc[a][b][m][n] = (f32x4){0.f, 0.f, 0.f, 0.f};
        cur = nxt; cA = nA; cB = nB; ++ui;
        if constexpr (ALIGN_EPI) { if (wr == 1) PG8_BAR; }
    }
    PG8_WAIT_V(0);
    if constexpr (!ALIGN_EPI) { if (wr == 0) PG8_BAR; }
    PG8_BAR;
    if constexpr (Epi::AFTER_DRAIN) { E.fused(acc, cur, wr, wc, fr, fq, lds, wid, lane); S.done(cur); }
#undef PG8_SA
#undef PG8_SB
#undef PG8_STAGE
#undef PG8_LDA
#undef PG8_LDB
#undef PG8_MMA
#undef PG8_WAIT_V
#undef PG8_WAIT_L
#undef PG8_BAR
#undef PG8_SCHED
}
}


#ifndef GEMM_ALIGN_EPI
#define GEMM_ALIGN_EPI true
#endif
template <class F>
DI void big_gemm(const int TIDX, const bf16_t* A, const bf16_t* Bt, int K, int nM, int nN, int latent, F f, int bid, int nb, char* smem) {
  pg8::Gemm g; g.A = A; g.Bt = Bt; g.M = 0; g.N = 0; g.K = K;
  pg8::TileOrder S; S.init(nM, nN, nb, bid, latent);
  pg8::EpiAdapt<F> E{f};
  __syncthreads();
  pg8::gemm_phase<pg8::EpiAdapt<F>, pg8::TileOrder, GEMM_ALIGN_EPI, true>(TIDX, (PG8_LAS unsigned char*)smem, g, S, E);
  __syncthreads();
}

DI void tconv(const int TIDX, const float* __restrict__ src, int lds_, int K, int N, bf16_t* __restrict__ dst, int ldd, int koff, int bid,
              int nb, char* smem) {
  float* t = (float*)smem;
  const int tn = N >> 6, tk = K >> 6;
  const int lk = TIDX >> 4, ln = (TIDX & 15) * 4;
  const int on = TIDX >> 3, ok = (TIDX & 7) * 8;
  for (int tile = bid; tile < tk * tn; tile += nb) {
    const int k0 = (tile / tn) * 64, n0 = (tile % tn) * 64;
    const float4 v0 = *(const float4*)(src + (size_t)(k0 + lk) * lds_ + n0 + ln);
    const float4 v1 = *(const float4*)(src + (size_t)(k0 + 32 + lk) * lds_ + n0 + ln);
    __syncthreads();
    *(float4*)(t + lk * 68 + ln) = v0;
    *(float4*)(t + (32 + lk) * 68 + ln) = v1;
    __syncthreads();
    float o[8];
#pragma unroll
    for (int j = 0; j < 8; j++) o[j] = t[(ok + j) * 68 + on];
    *(uint4*)(dst + (size_t)(n0 + on) * ldd + koff + k0 + ok) = pack8(o);
  }
}
DI void conv_flat(const int TIDX, const float* __restrict__ src, bf16_t* __restrict__ dst, size_t count, int bid, int nb) {
  const size_t n4 = count >> 2;
  for (size_t i = (size_t)bid * NTHR + TIDX; i < n4; i += (size_t)nb * NTHR) {
    float4 v = ((const float4*)src)[i];
    uint2 o; o.x = pack2(v.x, v.y); o.y = pack2(v.z, v.w);
    ((uint2*)dst)[i] = o;
  }
}
DI void conv_fp8(const int TIDX, const float* __restrict__ src, unsigned char* __restrict__ dst, float* __restrict__ scl, int bid, int nb) {
  const int lane = TIDX & 63, wave = TIDX >> 6;
  for (int row = bid * 8 + wave; row < 16384; row += nb * 8) {
    const float* sp = src + (size_t)row * 1024 + lane * 16;
    float4 v0 = *(const float4*)(sp), v1 = *(const float4*)(sp + 4), v2 = *(const float4*)(sp + 8), v3 = *(const float4*)(sp + 12);
    float am = fmaxf(fmaxf(fmaxf(fabsf(v0.x), fabsf(v0.y)), fmaxf(fabsf(v0.z), fabsf(v0.w))),
                     fmaxf(fmaxf(fabsf(v1.x), fabsf(v1.y)), fmaxf(fabsf(v1.z), fabsf(v1.w))));
    am = fmaxf(am, fmaxf(fmaxf(fmaxf(fabsf(v2.x), fabsf(v2.y)), fmaxf(fabsf(v2.z), fabsf(v2.w))),
                         fmaxf(fmaxf(fabsf(v3.x), fabsf(v3.y)), fmaxf(fabsf(v3.z), fabsf(v3.w)))));
#pragma unroll
    for (int o = 32; o > 0; o >>= 1) am = fmaxf(am, shx_(am, o, lane));
    const float sc = am > 0.f ? 224.f / am : 1.f;
    if (lane == 0) scl[row] = am > 0.f ? am * (1.f / 224.f) : 1.f;
    uint4 o;
    int t = 0;
    t = __builtin_amdgcn_cvt_pk_fp8_f32(v0.x * sc, v0.y * sc, t, false); t = __builtin_amdgcn_cvt_pk_fp8_f32(v0.z * sc, v0.w * sc, t, true); o.x = (unsigned)t;
    t = __builtin_amdgcn_cvt_pk_fp8_f32(v1.x * sc, v1.y * sc, t, false); t = __builtin_amdgcn_cvt_pk_fp8_f32(v1.z * sc, v1.w * sc, t, true); o.y = (unsigned)t;
    t = __builtin_amdgcn_cvt_pk_fp8_f32(v2.x * sc, v2.y * sc, t, false); t = __builtin_amdgcn_cvt_pk_fp8_f32(v2.z * sc, v2.w * sc, t, true); o.z = (unsigned)t;
    t = __builtin_amdgcn_cvt_pk_fp8_f32(v3.x * sc, v3.y * sc, t, false); t = __builtin_amdgcn_cvt_pk_fp8_f32(v3.z * sc, v3.w * sc, t, true); o.w = (unsigned)t;
    *(uint4*)(dst + (size_t)row * 1024 + lane * 16) = o;
  }
}
DI void mod_gemv(const int TIDX, const P& p, int layer_sel, int bid, int nb, char* smem) {
  float* sc = (float*)smem;
  float* red = sc + 9 * 1024;
  float* modo = (float*)(p.ws + OFF_MOD);
  for (int task = nb - 1 - bid; task < 96; task += nb) {
    const int l = layer_sel, j0 = task * 64;
    __syncthreads();
    for (int e = TIDX; e < 9 * 1024; e += NTHR) {
      int rr = e >> 10, k = e & 1023;
      float v = rr < 8 ? p.c[rr * 1024 + k] : p.c_ctx[k];
      sc[e] = v / (1.f + expf(-v));
    }
    __syncthreads();
    const int kg = TIDX >> 6, col = TIDX & 63;
    float acc[9];
#pragma unroll
    for (int q = 0; q < 9; q++) acc[q] = 0.f;
    const float* W = p.mod_w + (size_t)l * 1024 * 6144 + j0 + col;
#pragma unroll 16
    for (int k = kg * 128; k < kg * 128 + 128; ++k) {
      float w = W[(size_t)k * 6144];
#pragma unroll
      for (int q = 0; q < 9; q++) acc[q] += sc[q * 1024 + k] * w;
    }
#pragma unroll
    for (int q = 0; q < 9; q++) red[(kg * 9 + q) * 64 + col] = acc[q];
    __syncthreads();
    for (int e = TIDX; e < 9 * 64; e += NTHR) {
      int rr = e >> 6, cc = e & 63;
      float s = p.mod_b[l * 6144 + j0 + cc];
#pragma unroll
      for (int g = 0; g < 8; g++) s += red[(g * 9 + rr) * 64 + cc];
      modo[(size_t)(l * 9 + rr) * 6144 + j0 + cc] = s;
    }
  }
}

DI void norm_rows(const int TIDX, const P& p, int layer, int which, bool from_input, bool latent_only, int bid, int nb) {
  const int lane = TIDX & 63, wave = TIDX >> 6;
  const float* mod = (const float*)(p.ws + OFF_MOD);
  const float* X = (const float*)(p.ws + OFF_X);
  bf16_t* H = (bf16_t*)(p.ws + OFF_H);
  const float* g = (which ? p.n2g : p.n1g) + layer * 1024;
  const int ntok = latent_only ? NB * SEQ : NTOK;
  const int nw = nb * 8;
  for (int it = bid * 8 + wave; it < ntok; it += 4 * nw) {
    int nn[4];
    bool val[4];
    float4 v[4][4];
#pragma unroll
    for (int t = 0; t < 4; t++) {
      int ti = it + t * nw;
      val[t] = ti < ntok;
      if (!val[t]) ti = it;
      nn[t] = latent_only ? ((ti >> 11) * LT + LC + (ti & 2047)) : ti;
      const float* src = from_input ? xin_row(p, nn[t]) : X + (size_t)nn[t] * DM;
#pragma unroll
      for (int i = 0; i < 4; i++) v[t][i] = *(const float4*)(src + i * 256 + lane * 4);
    }
#pragma unroll
    for (int t = 0; t < 4; t++) {
      float ss = 0.f;
#pragma unroll
      for (int i = 0; i < 4; i++) ss += v[t][i].x * v[t][i].x + v[t][i].y * v[t][i].y + v[t][i].z * v[t][i].z + v[t][i].w * v[t][i].w;
      ss = wave_sum_dpp(ss, lane);
      const float rs = rsqrtf(ss * (1.f / 1024.f) + 1e-6f);
      const int n = nn[t];
      const int b = n / LT, pos = n - b * LT;
      const int rr = pos < LC ? 8 : b;
      const float* msc = mod + (size_t)(layer * 9 + rr) * 6144 + (which ? 4 : 1) * 1024;
      const float* msh = mod + (size_t)(layer * 9 + rr) * 6144 + (which ? 3 : 0) * 1024;
      if (val[t]) {
#pragma unroll
        for (int i = 0; i < 4; i++) {
          int idx = i * 256 + lane * 4;
          float4 gg = *(const float4*)(g + idx), sc = *(const float4*)(msc + idx), sh = *(const float4*)(msh + idx);
          float y0 = v[t][i].x * rs * gg.x * (1.f + sc.x) + sh.x;
          float y1 = v[t][i].y * rs * gg.y * (1.f + sc.y) + sh.y;
          float y2 = v[t][i].z * rs * gg.z * (1.f + sc.z) + sh.z;
          float y3 = v[t][i].w * rs * gg.w * (1.f + sc.w) + sh.w;
          uint2 o; o.x = pack2(y0, y1); o.y = pack2(y2, y3);
          *(uint2*)(H + (size_t)n * DM + idx) = o;
        }
      }
    }
  }
}

DI void rope8(float* v, int e, int t, int lane) {
  const int half = e >> 2, isx2 = (e >> 1) & 1, ibase = (e & 1) * 8;
  const float posf = half ? (float)(t & 63) : (float)(t >> 6);
#pragma unroll
  for (int j = 0; j < 8; j++) {
    float pv = SHX(v[j], 2);
    float inv = exp2f(-(float)(ibase + j) * 0.83048202f);
    float ang = posf * inv;
    float rev = ang * 0.15915494309f;
    rev -= floorf(rev);
    float sn = __builtin_amdgcn_sinf(rev), cs = __builtin_amdgcn_cosf(rev);
    v[j] = isx2 ? (v[j] * cs + pv * sn) : (v[j] * cs - pv * sn);
  }
}
DI void prep0(const int TIDX, const P& p, int bid, int nb) {
  char* big = p.ws + OFF_BIG;
  const bf16_t* Z = (const bf16_t*)(big + B_Z0);
  bf16_t* QN = (bf16_t*)(big + B_QN); bf16_t* KN = (bf16_t*)(big + B_KN); bf16_t* VT = (bf16_t*)(big + B_VT);
  bf16_t* R = (bf16_t*)(big + B_R); bf16_t* KB = (bf16_t*)(big + B_KB); bf16_t* KK = (bf16_t*)(big + B_KK);
  bf16_t* V = (bf16_t*)(big + B_V); bf16_t* AW = (bf16_t*)(big + B_AW); bf16_t* AA = (bf16_t*)(big + B_AA);
  bf16_t* AG = (bf16_t*)(big + B_AG);
  const int lane = TIDX & 63, wave = TIDX >> 6;
  for (int n = bid * 8 + wave; n < NTOK; n += nb * 8) {
    const int b = n / LT, pos = n - b * LT;
    const bool lat = pos >= LC;
    const int t = pos - LC;
    const bf16_t* zr = Z + (size_t)n * 2560;
    const bool hasp = (pos != 0 && pos != LC), hasn = (pos != LC - 1 && pos != LT - 1);
    const bf16_t* zc = zr + 768;
    const uint4 rawq = *(const uint4*)(zr + (lane >> 3) * 64 + (lane & 7) * 8);
    uint4 rawkv = make_uint4(0, 0, 0, 0);
    if (lane < 32) rawkv = *(const uint4*)(zr + 512 + ((lane >> 3) & 3) * 64 + (lane & 7) * 8);
    uint2 cuA[7], puA[7], nuA[7];
#pragma unroll
    for (int i = 0; i < 7; i++) {
      const int j = i * 256 + lane * 4;
      cuA[i] = *(const uint2*)(zc + j);
      puA[i] = make_uint2(0, 0); nuA[i] = make_uint2(0, 0);
      if (hasp) puA[i] = *(const uint2*)(zc - 2560 + j);
      if (hasn) nuA[i] = *(const uint2*)(zc + 2560 + j);
    }
    {
      const int head = lane >> 3, e = lane & 7;
      float v[8]; unpack8(rawq, v);
      float ss = 0.f;
#pragma unroll
      for (int j = 0; j < 8; j++) ss += v[j] * v[j];
      ss += SHX(ss, 1); ss += SHX(ss, 2); ss += SHX(ss, 4);
      const float rs = rsqrtf(ss * (1.f / 64.f) + 1e-6f);
#pragma unroll
      for (int j = 0; j < 8; j++) v[j] = v[j] * rs * p.qg[e * 8 + j];
      if (lat) rope8(v, e, t, lane);
#pragma unroll
      for (int j = 0; j < 8; j++) v[j] *= 0.18033688011f;
      *(uint4*)(QN + ((size_t)(b * 8 + head) * LT + pos) * 64 + e * 8) = pack8(v);
    }
    {
      const int hh = (lane >> 3) & 3, e = lane & 7;
      float v[8]; unpack8(rawkv, v);
      float kv[8];
      float ss = 0.f;
#pragma unroll
      for (int j = 0; j < 8; j++) ss += v[j] * v[j];
      ss += SHX(ss, 1); ss += SHX(ss, 2); ss += SHX(ss, 4);
      const float rs = rsqrtf(ss * (1.f / 64.f) + 1e-6f);
#pragma unroll
      for (int j = 0; j < 8; j++) kv[j] = v[j] * rs * p.kg[e * 8 + j];
      if (lat) rope8(kv, e, t, lane);
      if (lane < 16) {
        *(uint4*)(KN + ((size_t)(b * 2 + hh) * LT + pos) * 64 + e * 8) = pack8(kv);
      } else if (lane < 32) {
        const int kvh = hh - 2;
#pragma unroll
        for (int j = 0; j < 8; j++) VT[((size_t)(b * 2 + kvh) * 64 + e * 8 + j) * LT + pos] = f2bf(v[j]);
      }
    }
#pragma unroll
    for (int i = 0; i < 7; i++) {
      const int j = i * 256 + lane * 4;
      const uint2 cu = cuA[i], pu = puA[i], nu = nuA[i];
      float4 m4 = *(const float4*)(p.mu + j);
      float cv[4] = {lo2f(cu.x), hi2f(cu.x), lo2f(cu.y), hi2f(cu.y)};
      float pv[4] = {lo2f(pu.x), hi2f(pu.x), lo2f(pu.y), hi2f(pu.y)};
      float nv[4] = {lo2f(nu.x), hi2f(nu.x), lo2f(nu.y), hi2f(nu.y)};
      float mm[4] = {m4.x, m4.y, m4.z, m4.w};
      float zm[4];
#pragma unroll
      for (int q = 0; q < 4; q++) zm[q] = cv[q] + mm[q] * (0.5f * (pv[q] + nv[q]) - cv[q]);
      if (i < 6) {
        const int cc = (i & 1) * 256 + lane * 4;
        const int head = cc >> 6, within = cc & 63;
        const size_t oidx = ((size_t)(b * 8 + head) * LT + pos) * 64 + within;
        uint2 o; o.x = pack2(zm[0], zm[1]); o.y = pack2(zm[2], zm[3]);
        if (i < 2) {
          *(uint2*)(R + oidx) = o;
        } else if (i < 4) {
          *(uint2*)(KB + oidx) = o;
          float4 kk4 = *(const float4*)(p.k_k + cc);
          float k0 = zm[0] * kk4.x, k1 = zm[1] * kk4.y, k2 = zm[2] * kk4.z, k3 = zm[3] * kk4.w;
          float ss = k0 * k0 + k1 * k1 + k2 * k2 + k3 * k3;
          ss += SHX(ss, 1); ss += SHX(ss, 2); ss += SHX(ss, 4); ss += SHX(ss, 8);
          const float inv = 1.f / fmaxf(sqrtf(ss), 1e-12f);
          uint2 o2; o2.x = pack2(k0 * inv, k1 * inv); o2.y = pack2(k2 * inv, k3 * inv);
          *(uint2*)(KK + oidx) = o2;
        } else {
          *(uint2*)(V + oidx) = o;
        }
      } else {
        if (lane < 16) {
          uint2 o; o.x = pack2(tanhf(zm[0]), tanhf(zm[1])); o.y = pack2(tanhf(zm[2]), tanhf(zm[3]));
          *(uint2*)(AW + (size_t)n * 64 + lane * 4) = o;
        } else if (lane < 32) {
          uint2 o; o.x = pack2(zm[0], zm[1]); o.y = pack2(zm[2], zm[3]);
          *(uint2*)(AA + (size_t)n * 64 + (lane - 16) * 4) = o;
        } else {
          uint2 o; o.x = pack2(sigmoidf_(zm[0]), sigmoidf_(zm[1])); o.y = pack2(sigmoidf_(zm[2]), sigmoidf_(zm[3]));
          *(uint2*)(AG + (size_t)n * 128 + (lane - 32) * 4) = o;
        }
      }
    }
  }
}

DI void lds_barrier() {
  asm volatile("s_waitcnt lgkmcnt(0)" ::: "memory");
  __builtin_amdgcn_s_barrier();
  asm volatile("" ::: "memory");
}
DI float reduce16(float v) {
  v += dpp_f(v, 0);
  v += dpp_f(v, 1);
  v += dpp_f(v, 2);
  v += __builtin_bit_cast(float, __builtin_amdgcn_mov_dpp(__builtin_bit_cast(int, v), 0x140, 0xF, 0xF, true));
  return v;
}
DI void reduce16_2(float& a, float& b) {
  a += dpp_f(a, 0); b += dpp_f(b, 0);
  a += dpp_f(a, 1); b += dpp_f(b, 1);
  a += dpp_f(a, 2); b += dpp_f(b, 2);
  a += __builtin_bit_cast(float, __builtin_amdgcn_mov_dpp(__builtin_bit_cast(int, a), 0x140, 0xF, 0xF, true));
  b += __builtin_bit_cast(float, __builtin_amdgcn_mov_dpp(__builtin_bit_cast(int, b), 0x140, 0xF, 0xF, true));
}
DI void wkv2_task(const int TIDX, const P& p, int task, char* smem) {
  char* big = p.ws + OFF_BIG;
  const int rh = task & 1, d = (task >> 1) & 1, h = (task >> 2) & 7, b = task >> 5;
  const bf16_t* R = (const bf16_t*)(big + B_R); const bf16_t* KB = (const bf16_t*)(big + B_KB);
  const bf16_t* KK = (const bf16_t*)(big + B_KK); const bf16_t* V = (const bf16_t*)(big + B_V);
  const bf16_t* AL = (const bf16_t*)(big + B_AL) + (size_t)d * NB * 8 * LT * 64;
  const float* DEC = (const float*)(big + B_DEC) + (size_t)d * NB * 8 * LT * 64;
  bf16_t* OUT = (bf16_t*)(big + B_OUT) + (size_t)d * NB * 8 * LT * 64;
  float* BON = (float*)(p.ws + OFF_BON) + (size_t)d * NB * 8 * LT;
  float* bufs = (float*)smem;
  float* outb = bufs + 2 * 6 * 2048;
  const int tid = TIDX;
  const int row = tid >> 4, ks = tid & 15;
  const int ls = tid >> 4, li = (tid & 15) * 4;
  const size_t hb = (size_t)(b * 8 + h) * LT;
  const float4 ka = *(const float4*)(p.k_a + h * 64 + li);
  const float4 rk = *(const float4*)(p.r_k + h * 64 + li);
  f32x2 S01 = {0.f, 0.f}, S23 = {0.f, 0.f};
  float pr[24];
  auto gload = [&](int chunk) {
    const int pos = scanpos(d, chunk * 32 + ls);
    const size_t e0 = (hb + pos) * 64 + li;
    const uint2 r4 = *(const uint2*)(R + e0), k4 = *(const uint2*)(KB + e0), kk4 = *(const uint2*)(KK + e0);
    const uint2 v4 = *(const uint2*)(V + e0), a4 = *(const uint2*)(AL + e0);
    const float4 dc = *(const float4*)(DEC + e0);
    const float a0 = lo2f(a4.x), a1 = hi2f(a4.x), a2 = lo2f(a4.y), a3 = hi2f(a4.y);
    const float q0 = lo2f(kk4.x), q1 = hi2f(kk4.x), q2 = lo2f(kk4.y), q3 = hi2f(kk4.y);
    pr[0] = lo2f(r4.x); pr[1] = hi2f(r4.x); pr[2] = lo2f(r4.y); pr[3] = hi2f(r4.y);
    pr[4] = dc.x; pr[5] = dc.y; pr[6] = dc.z; pr[7] = dc.w;
    pr[8] = lo2f(k4.x) * (1.f + (a0 - 1.f) * ka.x); pr[9] = hi2f(k4.x) * (1.f + (a1 - 1.f) * ka.y);
    pr[10] = lo2f(k4.y) * (1.f + (a2 - 1.f) * ka.z); pr[11] = hi2f(k4.y) * (1.f + (a3 - 1.f) * ka.w);
    pr[12] = lo2f(v4.x); pr[13] = hi2f(v4.x); pr[14] = lo2f(v4.y); pr[15] = hi2f(v4.y);
    pr[16] = -q0; pr[17] = -q1; pr[18] = -q2; pr[19] = -q3;
    pr[20] = q0 * a0; pr[21] = q1 * a1; pr[22] = q2 * a2; pr[23] = q3 * a3;
    float bp = pr[0] * pr[8] * rk.x + pr[1] * pr[9] * rk.y + pr[2] * pr[10] * rk.z + pr[3] * pr[11] * rk.w;
    bp = reduce16(bp);
    if (rh == 0 && (tid & 15) == 0) BON[hb + pos] = bp;
  };
  auto lstore = [&](int bufi) {
    float* bb = bufs + bufi * 6 * 2048 + ls * 64 + li;
#pragma unroll
    for (int q = 0; q < 6; q++) *(float4*)(bb + q * 2048) = make_float4(pr[4 * q], pr[4 * q + 1], pr[4 * q + 2], pr[4 * q + 3]);
  };
  __syncthreads();
  gload(0);
  lstore(0);
  __syncthreads();
  const int nch = LT / 32;
  for (int ch = 0; ch < nch; ch++) {
    const int cur = ch & 1;
    if (ch + 1 < nch) gload(ch + 1);
    const float* bb = bufs + cur * 6 * 2048;
    float* ob = outb + cur * 1024;
    const float* qb = bb + ks * 4;
    const float* vb = bb + 3 * 2048 + rh * 32 + row;
    float4 n_kn = *(const float4*)(qb + 4 * 2048), n_dc = *(const float4*)(qb + 1 * 2048), n_bv = *(const float4*)(qb + 5 * 2048);
    float4 n_kd = *(const float4*)(qb + 2 * 2048), n_rr = *(const float4*)(qb);
    float n_vv = vb[0];
    float upend = 0.f;
#pragma unroll 4
    for (int s = 0; s < 32; s++) {
      const float4 kn = n_kn, dc = n_dc, bv = n_bv, kd = n_kd, rr = n_rr;
      const float vv = n_vv;
      if (s + 1 < 32) {
        const float* q1 = qb + (s + 1) * 64;
        n_kn = *(const float4*)(q1 + 4 * 2048); n_dc = *(const float4*)(q1 + 1 * 2048); n_bv = *(const float4*)(q1 + 5 * 2048);
        n_kd = *(const float4*)(q1 + 2 * 2048); n_rr = *(const float4*)(q1);
        n_vv = vb[(s + 1) * 64];
      }
      f32x2 t = S01 * (f32x2){kn.x, kn.y};
      t = S23 * (f32x2){kn.z, kn.w} + t;
      float sa = t.x + t.y;
      reduce16_2(sa, upend);
      if (s > 0) ob[(s - 1) * 32 + row] = upend;
      const f32x2 sa2 = {sa, sa}, vv2 = {vv, vv};
      S01 = S01 * (f32x2){dc.x, dc.y} + sa2 * (f32x2){bv.x, bv.y} + vv2 * (f32x2){kd.x, kd.y};
      S23 = S23 * (f32x2){dc.z, dc.w} + sa2 * (f32x2){bv.z, bv.w} + vv2 * (f32x2){kd.z, kd.w};
      f32x2 u = S01 * (f32x2){rr.x, rr.y};
      u = S23 * (f32x2){rr.z, rr.w} + u;
      upend = u.x + u.y;
    }
    upend = reduce16(upend);
    ob[31 * 32 + row] = upend;
    if (ch + 1 < nch) lstore(cur ^ 1);
    lds_barrier();
    {
      const int idx = tid * 2, s = idx >> 5, r2 = idx & 31;
      const int pos = scanpos(d, ch * 32 + s);
      *(unsigned*)(OUT + (hb + pos) * 64 + rh * 32 + r2) = pack2(ob[idx], ob[idx + 1]);
    }
  }
  __syncthreads();
}
DI void wkv_finalize(const int TIDX, const P& p, int bid, int nb) {
  char* big = p.ws + OFF_BIG;
  const bf16_t* OUT = (const bf16_t*)(big + B_OUT);
  const float* BON = (const float*)(p.ws + OFF_BON);
  const bf16_t* V = (const bf16_t*)(big + B_V);
  const bf16_t* G = (const bf16_t*)(big + B_G);
  bf16_t* YM = (bf16_t*)(big + B_YMIX);
  const int lane = TIDX & 63, wave = TIDX >> 6;
  for (int item = bid * 8 + wave; item < NTOK * 8; item += nb * 8) {
    const int n = item >> 3, h = item & 7;
    const int b = n / LT, pos = n - b * LT;
    const size_t hb = (size_t)(b * 8 + h) * LT + pos;
    const int c = h * 64 + lane;
    const float vval = bf2f(V[hb * 64 + lane]);
    const float gw = p.gn_w[c], gb = p.gn_b[c];
    float y = 0.f;
#pragma unroll
    for (int d = 0; d < 2; d++) {
      const float o = bf2f(OUT[((size_t)d * NB * 8 * LT + hb) * 64 + lane]);
      const float mean = wave_sum_dpp(o, lane) * (1.f / 64.f);
      const float dd = o - mean;
      const float var = wave_sum_dpp(dd * dd, lane) * (1.f / 64.f);
      const float rstd = rsqrtf(var + 64e-5f);
      const float bon = BON[(size_t)d * NB * 8 * LT + hb];
      y += dd * rstd * gw + gb + bon * vval;
    }
    y *= bf2f(G[(size_t)n * 512 + c]);
    YM[(size_t)n * 1024 + 512 + c] = f2bf(y);
  }
}

DI void attn_body(const int TIDX, const P& p, int b, int head, int qt, char* smem);
DI void attn_task(const int TIDX, const P& p, int task, char* smem) {
  int b, head, qt;
  if (task < 512) { qt = 1 + (task & 7); head = (task >> 3) & 7; b = task >> 6; }
  else { int t2 = task - 512; qt = 0; head = t2 & 7; b = t2 >> 3; }
  attn_body(TIDX, p, b, head, qt, smem);
}
DI void attn_xcd(const int TIDX, const P& p, int bid, int nb, char* smem) {
  const int xcd = bid & 7, lb = bid >> 3, st = nb >> 3;
  for (int j = lb; j < 72; j += st) {
    int pair, head4, qt;
    if (j < 64) { pair = 2 * xcd + (j >> 5); head4 = (j & 31) >> 3; qt = 1 + (j & 7); }
    else { pair = 2 * xcd + ((j - 64) >> 2); head4 = (j - 64) & 3; qt = 0; }
    attn_body(TIDX, p, pair >> 1, (pair & 1) * 4 + head4, qt, smem);
  }
}
DI void attn_body(const int TIDX, const P& p, int b, int head, int qt, char* smem) {
  char* big = p.ws + OFF_BIG;
  const int kvh = head >> 2;
  const int nkt = (qt == 0 ? 256 : LT) / 64;
  bf16_t* Ks = (bf16_t*)smem;
  bf16_t* Vs = Ks + 2 * 64 * 72;
  const bf16_t* Kg = (const bf16_t*)(big + B_KN) + (size_t)(b * 2 + kvh) * LT * 64;
  const bf16_t* Vg = (const bf16_t*)(big + B_VT) + (size_t)(b * 2 + kvh) * 64 * LT;
  const bf16_t* QN = (const bf16_t*)(big + B_QN);
  bf16_t* YM = (bf16_t*)(big + B_YMIX);
  const int tid = TIDX, lane = tid & 63, wave = tid >> 6;
  const int r = lane & 31, h8 = lane >> 5;
  const int q0 = qt * 256 + wave * 32;
  bf16x8 qf[4];
#pragma unroll
  for (int kk = 0; kk < 4; kk++)
    qf[kk] = *(const bf16x8*)(QN + ((size_t)(b * 8 + head) * LT + q0 + r) * 64 + kk * 16 + h8 * 8);
  f32x16 o0, o1;
#pragma unroll
  for (int q = 0; q < 16; q++) { o0[q] = 0.f; o1[q] = 0.f; }
  float m = -1e30f, l = 0.f;
  const int lr = tid >> 3, lc = tid & 7;
  uint4 kreg = *(const uint4*)(Kg + (size_t)lr * 64 + lc * 8);
  uint4 vreg = *(const uint4*)(Vg + (size_t)lr * LT + lc * 8);
  __syncthreads();
  *(uint4*)(Ks + lr * 72 + lc * 8) = kreg;
  *(uint4*)(Vs + lr * 72 + lc * 8) = vreg;
  __syncthreads();
  for (int kt = 0; kt < nkt; kt++) {
    const int cur = kt & 1;
    if (kt + 1 < nkt) {
      kreg = *(const uint4*)(Kg + (size_t)((kt + 1) * 64 + lr) * 64 + lc * 8);
      vreg = *(const uint4*)(Vg + (size_t)lr * LT + (kt + 1) * 64 + lc * 8);
    }
    const bf16_t* Kc = Ks + cur * 64 * 72;
    const bf16_t* Vc = Vs + cur * 64 * 72;
    f32x16 s0, s1;
#pragma unroll
    for (int q = 0; q < 16; q++) { s0[q] = 0.f; s1[q] = 0.f; }
#pragma unroll
    for (int kk = 0; kk < 4; kk++) {
      bf16x8 a0 = *(const bf16x8*)(Kc + r * 72 + kk * 16 + h8 * 8);
      bf16x8 a1 = *(const bf16x8*)(Kc + (32 + r) * 72 + kk * 16 + h8 * 8);
      s0 = __builtin_amdgcn_mfma_f32_32x32x16_bf16(a0, qf[kk], s0, 0, 0, 0);
      s1 = __builtin_amdgcn_mfma_f32_32x32x16_bf16(a1, qf[kk], s1, 0, 0, 0);
    }
    float mx = s0[0];
#pragma unroll
    for (int q = 1; q < 16; q++) mx = fmaxf(mx, s0[q]);
#pragma unroll
    for (int q = 0; q < 16; q++) mx = fmaxf(mx, s1[q]);
    mx = fmaxf(mx, SHX(mx, 32));
    const float mnew = fmaxf(m, mx);
    const float alpha = __builtin_amdgcn_exp2f(m - mnew);
    float sum = 0.f;
#pragma unroll
    for (int q = 0; q < 16; q++) { s0[q] = __builtin_amdgcn_exp2f(s0[q] - mnew); sum += s0[q]; }
#pragma unroll
    for (int q = 0; q < 16; q++) { s1[q] = __builtin_amdgcn_exp2f(s1[q] - mnew); sum += s1[q]; }
    l = l * alpha + sum;
    m = mnew;
#pragma unroll
    for (int q = 0; q < 16; q++) { o0[q] *= alpha; o1[q] *= alpha; }
#pragma unroll
    for (int t = 0; t < 2; t++) {
#pragma unroll
      for (int s = 0; s < 2; s++) {
        union { bf16x8 v; unsigned u[4]; } pf;
#pragma unroll
        for (int q = 0; q < 4; q++) {
          float x0 = t ? s1[8 * s + 2 * q] : s0[8 * s + 2 * q];
          float x1 = t ? s1[8 * s + 2 * q + 1] : s0[8 * s + 2 * q + 1];
          pf.u[q] = pack2(x0, x1);
        }
        const int kb = 32 * t + 16 * s + 4 * h8;
        union { bf16x8 v; uint2 u[2]; } v0, v1;
        v0.u[0] = *(const uint2*)(Vc + r * 72 + kb);
        v0.u[1] = *(const uint2*)(Vc + r * 72 + kb + 8);
        v1.u[0] = *(const uint2*)(Vc + (32 + r) * 72 + kb);
        v1.u[1] = *(const uint2*)(Vc + (32 + r) * 72 + kb + 8);
        o0 = __builtin_amdgcn_mfma_f32_32x32x16_bf16(v0.v, pf.v, o0, 0, 0, 0);
        o1 = __builtin_amdgcn_mfma_f32_32x32x16_bf16(v1.v, pf.v, o1, 0, 0, 0);
      }
    }
    if (kt + 1 < nkt) {
      *(uint4*)(Ks + (cur ^ 1) * 64 * 72 + lr * 72 + lc * 8) = kreg;
      *(uint4*)(Vs + (cur ^ 1) * 64 * 72 + lr * 72 + lc * 8) = vreg;
    }
    __syncthreads();
  }
  l += SHX(l, 32);
  const float inv = 1.f / l;
  bf16_t* orow = YM + (size_t)(b * LT + q0 + r) * 1024 + head * 64;
#pragma unroll
  for (int g4 = 0; g4 < 4; g4++) {
    uint2 w0, w1;
    w0.x = pack2(o0[4 * g4] * inv, o0[4 * g4 + 1] * inv); w0.y = pack2(o0[4 * g4 + 2] * inv, o0[4 * g4 + 3] * inv);
    w1.x = pack2(o1[4 * g4] * inv, o1[4 * g4 + 1] * inv); w1.y = pack2(o1[4 * g4 + 2] * inv, o1[4 * g4 + 3] * inv);
    *(uint2*)(orow + 8 * g4 + 4 * h8) = w0;
    *(uint2*)(orow + 32 + 8 * g4 + 4 * h8) = w1;
  }
}

DI void route_task(const int TIDX, const P& p, int n0, char* smem) {
  char* big = p.ws + OFF_BIG;
  const float* S = (const float*)(big + B_S);
  int* EI = (int*)(big + B_EI);
  float* EG = (float*)(big + B_EG);
  float* sc = (float*)smem;
  float* sv = sc + 256 * 129;
  unsigned char* si = (unsigned char*)(sv + 256 * 16);
  const int tid = TIDX;
  __syncthreads();
  for (int e = tid; e < 256 * 128; e += NTHR) {
    int row = e >> 7, j = e & 127;
    sc[row * 129 + j] = S[(size_t)n0 * 2048 + e];
  }
  __syncthreads();
  if (tid < 256) {
    const float* rowp = sc + tid * 129;
    float pv = __builtin_inff();
    int pi = -1;
    for (int k = 0; k < 16; k++) {
      float bv = -__builtin_inff();
      int bi = 0;
      for (int j = 0; j < 128; j++) {
        float x = rowp[j];
        bool elig = (x < pv) || (x == pv && j > pi);
        if (elig && x > bv) { bv = x; bi = j; }
      }
      sv[tid * 16 + k] = bv;
      si[tid * 16 + k] = (unsigned char)bi;
      pv = bv; pi = bi;
    }
  }
  __syncthreads();
  if (tid < 128) {
    const int tl = tid >> 3, head = tid & 7;
    const int r0 = tl * 16 + head * 2, r1 = r0 + 1;
    const float* a = sv + r0 * 16;
    const float* bq = sv + r1 * 16;
    float* eg = sc + tid * 17;
    const int n = n0 + tl;
    float pv = __builtin_inff();
    int pc = -1;
    float mx = 0.f, sum = 0.f;
    for (int k = 0; k < 16; k++) {
      float bv = -__builtin_inff();
      int bc = 0;
      for (int i = 0; i < 16; i++) {
        const int jn = 16 / (i + 1);
        const float ai = a[i];
        for (int j = 0; j < jn; j++) {
          float x = ai + bq[j];
          int c = i * 16 + j;
          bool elig = (x < pv) || (x == pv && c > pc);
          if (elig && x > bv) { bv = x; bc = c; }
        }
      }
      if (k == 0) mx = bv;
      float ev = __expf(bv - mx);
      sum += ev;
      eg[k] = ev;
      EI[(size_t)n * 128 + head * 16 + k] = (int)si[r0 * 16 + (bc >> 4)] * 128 + (int)si[r1 * 16 + (bc & 15)];
      pv = bv; pc = bc;
    }
    const float inv = 1.f / sum;
    for (int k = 0; k < 16; k++) EG[(size_t)n * 128 + head * 16 + k] = eg[k] * inv;
  }
}


DI int f2ord(float f) { int s = __float_as_int(f); return s ^ ((s >> 31) & 0x7fffffff); }
DI float ord2f(int s) { return __int_as_float(s ^ ((s >> 31) & 0x7fffffff)); }
DI void ce_desc(int& a, int& b) { int hi = max(a, b), lo = min(a, b); a = hi; b = lo; }
template <int N>
DI void bsort_desc(int* v) {
#pragma unroll
  for (int k = 2; k <= N; k <<= 1)
#pragma unroll
    for (int j = k >> 1; j > 0; j >>= 1)
#pragma unroll
      for (int i = 0; i < N; i++) {
        const int l = i ^ j;
        if (l > i) {
          if ((i & k) == 0) ce_desc(v[i], v[l]); else ce_desc(v[l], v[i]);
        }
      }
}
DI void merge16(int* a, const int* b) {
#pragma unroll
  for (int i = 0; i < 16; i++) a[i] = max(a[i], b[15 - i]);
#pragma unroll
  for (int j = 8; j > 0; j >>= 1)
#pragma unroll
    for (int i = 0; i < 16; i++) {
      const int l = i ^ j;
      if (l > i) ce_desc(a[i], a[l]);
    }
}
DI void top16_of_64(int* v) {
  bsort_desc<16>(v); bsort_desc<16>(v + 16); bsort_desc<16>(v + 32); bsort_desc<16>(v + 48);
  merge16(v, v + 16); merge16(v + 32, v + 48); merge16(v, v + 32);
}
DI void route2_task(const int TIDX, const P& p, int layer, int m0, int head, char* smem, const bool load_keys = true) {
  char* big = p.ws + OFF_BIG;
  const bf16_t* QP = (const bf16_t*)(big + B_QP);
  int* EI = (int*)(big + B_EI);
  float* EG = (float*)(big + B_EG);
  bf16_t* Ks = (bf16_t*)smem;
  unsigned char* sidx = (unsigned char*)(Ks + 256 * 136);
  const bf16_t* keys = (const bf16_t*)(p.ws + OFF_KEYS) + (size_t)(layer * 16 + head * 2) * 128 * 128;
  const int tid = TIDX, lane = tid & 63, wave = tid >> 6;
  const int r = lane & 31, h8 = lane >> 5;
  __syncthreads();
  if (load_keys) {
    const int row = tid >> 1, half = tid & 1;
#pragma unroll
    for (int q = 0; q < 8; q++)
      *(uint4*)(Ks + row * 136 + half * 64 + q * 8) = *(const uint4*)(keys + (size_t)row * 128 + half * 64 + q * 8);
  }
  __syncthreads();
  const int tok = m0 + wave * 32 + r;
  int la[16], lb[16];
#pragma unroll
  for (int pp = 0; pp < 2; pp++) {
    bf16x8 qf[8];
#pragma unroll
    for (int ks = 0; ks < 8; ks++)
      qf[ks] = *(const bf16x8*)(QP + (size_t)tok * 2048 + head * 256 + pp * 128 + ks * 16 + h8 * 8);
    int v[64];
#pragma unroll
    for (int kt = 0; kt < 4; kt++) {
      f32x16 acc;
#pragma unroll
      for (int q = 0; q < 16; q++) acc[q] = 0.f;
#pragma unroll
      for (int ks = 0; ks < 8; ks++) {
        bf16x8 a = *(const bf16x8*)(Ks + (pp * 128 + kt * 32 + r) * 136 + ks * 16 + h8 * 8);
        acc = __builtin_amdgcn_mfma_f32_32x32x16_bf16(a, qf[ks], acc, 0, 0, 0);
      }
#pragma unroll
      for (int q = 0; q < 16; q++) v[kt * 16 + q] = (f2ord(acc[q]) & ~127) | (kt * 32 + (q & 3) + 8 * (q >> 2) + 4 * h8);
    }
    top16_of_64(v);
    int pr[16];
#pragma unroll
    for (int i = 0; i < 16; i++) pr[i] = __builtin_amdgcn_ds_bpermute((lane ^ 32) << 2, v[i]);
    merge16(v, pr);
#pragma unroll
    for (int i = 0; i < 16; i++) { if (pp == 0) la[i] = v[i]; else lb[i] = v[i]; }
  }
  {
    unsigned* sw = (unsigned*)(sidx + tid * 32);
#pragma unroll
    for (int i = 0; i < 4; i++) {
      sw[i] = (la[4 * i] & 127) | ((la[4 * i + 1] & 127) << 8) | ((la[4 * i + 2] & 127) << 16) | ((la[4 * i + 3] & 127) << 24);
      sw[4 + i] = (lb[4 * i] & 127) | ((lb[4 * i + 1] & 127) << 8) | ((lb[4 * i + 2] & 127) << 16) | ((lb[4 * i + 3] & 127) << 24);
    }
  }
  float fa[16], fb[16];
#pragma unroll
  for (int i = 0; i < 16; i++) { fa[i] = ord2f(la[i]); fb[i] = ord2f(lb[i]); }
  int c[64];
  {
    int cnt = 0;
#pragma unroll
    for (int i = 0; i < 16; i++)
#pragma unroll
      for (int j = 0; j < 16; j++)
        if ((i + 1) * (j + 1) <= 16) { c[cnt] = (f2ord(fa[i] + fb[j]) & ~255) | (i * 16 + j); cnt++; }
#pragma unroll
    for (int q = 50; q < 64; q++) c[q] = (int)0x80000000;
  }
  top16_of_64(c);
  const float mx = ord2f(c[0]);
  float ev[16], sum = 0.f;
#pragma unroll
  for (int k = 0; k < 16; k++) { ev[k] = __expf(ord2f(c[k]) - mx); sum += ev[k]; }
  const float inv = 1.f / sum;
  const size_t ob = (size_t)tok * 128 + head * 16;
#pragma unroll
  for (int k = 0; k < 16; k++) {
    const int code = c[k] & 255;
    const int ia = sidx[tid * 32 + (code >> 4)], ib = sidx[tid * 32 + 16 + (code & 15)];
    if (h8 == 0) EI[ob + k] = ia * 128 + ib; else EG[ob + k] = ev[k] * inv;
  }
}

DI void peer_u2(const int TIDX, const P& p, bool last, int bid, int nb) {
  char* big = p.ws + OFF_BIG;
  const int* EI = (const int*)(big + B_EI);
  float* ACT = (float*)(big + B_S);
  const unsigned char* UB = (const unsigned char*)(p.ws + OFF_UB);
  const float* US = (const float*)(p.ws + OFF_UB + 16777216);
  const bf16_t* H = (const bf16_t*)(p.ws + OFF_H);
  const int lane = TIDX & 63, wave = TIDX >> 6;
  const bool dry = false;
  for (int n = bid * 8 + wave; n < NTOK; n += nb * 8) {
    const int b = n / LT, pos = n - b * LT;
    if (last && pos < LC) continue;
    float hv[16];
    {
      uint4 h0 = *(const uint4*)(H + (size_t)n * DM + lane * 16);
      uint4 h1 = *(const uint4*)(H + (size_t)n * DM + lane * 16 + 8);
      unpack8(h0, hv); unpack8(h1, hv + 8);
    }
    const int id_lo = EI[(size_t)n * 128 + lane], id_hi = EI[(size_t)n * 128 + 64 + lane];
    const float us_lo = US[id_lo], us_hi = US[id_hi];
    float act_lo = 0.f, act_hi = 0.f;
#pragma unroll 1
    for (int half = 0; half < 2; half++) {
      const int idv = half ? id_hi : id_lo;
      float actv = 0.f;
#pragma unroll 8
      for (int e = 0; e < 64; e++) {
        const int id = __builtin_amdgcn_readlane(idv, e);
        const uint4 w = *(const uint4*)(UB + (size_t)id * 1024 + lane * 16);
        float uv[16];
        cvt16_fp8(w, uv);
        float d0 = 0.f, d1 = 0.f;
#pragma unroll
        for (int j = 0; j < 8; j++) { d0 += hv[j] * uv[j]; d1 += hv[8 + j] * uv[8 + j]; }
        const float dsum = wave_sum_dpp(d0 + d1, lane);
        if (lane == e) actv = dsum;
      }
      if (half) act_hi = actv; else act_lo = actv;
    }
    ACT[(size_t)n * 128 + lane] = act_lo * us_lo;
    ACT[(size_t)n * 128 + 64 + lane] = act_hi * us_hi;
  }
}

DI void peer_gather(const int TIDX, const P& p, int layer, bool last, int bid, int nb, const bool dry) {
  char* big = p.ws + OFF_BIG;
  const int* EI = (const int*)(big + B_EI);
  const float* EG = (const float*)(big + B_EG);
  const unsigned char* UB = (const unsigned char*)(p.ws + OFF_UB);
  const unsigned char* VB = (const unsigned char*)(p.ws + OFF_VB);
  const float* ACT = (const float*)(big + B_S);
  const float* VS = (const float*)(p.ws + OFF_VB + 16777216);
  const bf16_t* H = (const bf16_t*)(p.ws + OFF_H);
  const float* X = (const float*)(p.ws + OFF_X);
  bf16_t* Hw = dry ? (bf16_t*)(big + B_QP) : (bf16_t*)(p.ws + OFF_H);
  float* Xw = dry ? (float*)(big + B_S + 16777216) : (float*)(p.ws + OFF_X);
  const float* mod = (const float*)(p.ws + OFF_MOD);
  const int lane = TIDX & 63, wave = TIDX >> 6;
  for (int n = bid * 8 + wave; n < NTOK; n += nb * 8) {
    const int b = n / LT, pos = n - b * LT;
    if (last && pos < LC) continue;
    const int id_lo = EI[(size_t)n * 128 + lane], id_hi = EI[(size_t)n * 128 + 64 + lane];
    const float g_lo = EG[(size_t)n * 128 + lane], g_hi = EG[(size_t)n * 128 + 64 + lane];
    const float vs_lo = VS[id_lo], vs_hi = VS[id_hi];
    const float act_lo = ACT[(size_t)n * 128 + lane], act_hi = ACT[(size_t)n * 128 + 64 + lane];
    const float cf_lo = g_lo * 0.5f * act_lo * (1.f + erff(act_lo * 0.70710678f)) * vs_lo;
    const float cf_hi = g_hi * 0.5f * act_hi * (1.f + erff(act_hi * 0.70710678f)) * vs_hi;
    float acc[16];
#pragma unroll
    for (int j = 0; j < 16; j++) acc[j] = 0.f;
#pragma unroll 1
    for (int half = 0; half < 2; half++) {
      const int idv = half ? id_hi : id_lo;
      const float cfv = half ? cf_hi : cf_lo;
#pragma unroll 8
      for (int e = 0; e < 64; e++) {
        const int id = __builtin_amdgcn_readlane(idv, e);
        const float cf = __builtin_bit_cast(float, __builtin_amdgcn_readlane(__builtin_bit_cast(int, cfv), e));
        const uint4 w = *(const uint4*)(VB + (size_t)id * 1024 + lane * 16);
        float uv[16];
        cvt16_fp8(w, uv);
#pragma unroll
        for (int j = 0; j < 16; j++) acc[j] += cf * uv[j];
      }
    }
    const int rr = pos < LC ? 8 : b;
    const float* gate = mod + (size_t)(layer * 9 + rr) * 6144 + 5 * 1024 + lane * 16;
    const float* xr = X + (size_t)n * DM + lane * 16;
    float xo[16];
#pragma unroll
    for (int q = 0; q < 4; q++) {
      float4 x0 = *(const float4*)(xr + q * 4), g0 = *(const float4*)(gate + q * 4);
      xo[q * 4 + 0] = x0.x + g0.x * acc[q * 4 + 0]; xo[q * 4 + 1] = x0.y + g0.y * acc[q * 4 + 1];
      xo[q * 4 + 2] = x0.z + g0.z * acc[q * 4 + 2]; xo[q * 4 + 3] = x0.w + g0.w * acc[q * 4 + 3];
    }
    if (last) {
      float* orow = p.out + ((size_t)(b * SEQ + pos - LC)) * DM + lane * 16;
#pragma unroll
      for (int q = 0; q < 4; q++) *(float4*)(orow + q * 4) = make_float4(xo[q * 4], xo[q * 4 + 1], xo[q * 4 + 2], xo[q * 4 + 3]);
    } else {
      float ss = 0.f;
#pragma unroll
      for (int j = 0; j < 16; j++) ss += xo[j] * xo[j];
      ss = wave_sum(ss);
      const float rs = rsqrtf(ss * (1.f / 1024.f) + 1e-6f);
      const float* g = p.n1g + (layer + 1) * 1024 + lane * 16;
      const float* msc = mod + (size_t)((layer + 1) * 9 + rr) * 6144 + 1 * 1024 + lane * 16;
      const float* msh = mod + (size_t)((layer + 1) * 9 + rr) * 6144 + lane * 16;
      float* xw = Xw + (size_t)n * DM + lane * 16;
#pragma unroll
      for (int q = 0; q < 4; q++) *(float4*)(xw + q * 4) = make_float4(xo[q * 4], xo[q * 4 + 1], xo[q * 4 + 2], xo[q * 4 + 3]);
      float y[16];
#pragma unroll
      for (int j = 0; j < 16; j++) y[j] = xo[j] * rs * g[j] * (1.f + msc[j]) + msh[j];
      *(uint4*)(Hw + (size_t)n * DM + lane * 16) = pack8(y);
      *(uint4*)(Hw + (size_t)n * DM + lane * 16 + 8) = pack8(y + 8);
    }
  }
}

DI void conv_phase(const int TIDX, const P& p, int bid, int nb) {
  char* big = p.ws + OFF_BIG;
  const bf16_t* ZX = (const bf16_t*)(big + B_ZX);
  bf16_t* XBC = (bf16_t*)(big + B_XBC);
  const int total = NTOK * 384;
  for (int it = bid * NTHR + TIDX; it < total; it += nb * NTHR) {
    const int n = it / 384, c8 = (it - n * 384) * 8;
    const int b = n / LT, pos = n - b * LT;
    const bool hasp = (pos != 0 && pos != LC), hasn = (pos != LC - 1 && pos != LT - 1);
    const bf16_t* zc = ZX + (size_t)n * 3072 + c8;
    uint4 cu = *(const uint4*)zc, pu = make_uint4(0, 0, 0, 0), nu = make_uint4(0, 0, 0, 0);
    if (hasp) pu = *(const uint4*)(zc - 3072);
    if (hasn) nu = *(const uint4*)(zc + 3072);
    float cv[8], pv[8], nv[8], y[8];
    unpack8(cu, cv); unpack8(pu, pv); unpack8(nu, nv);
#pragma unroll
    for (int j = 0; j < 8; j++) {
      float a = p.conv_b[c8 + j] + p.conv_w[c8 + j] * pv[j] + p.conv_w[3072 + c8 + j] * cv[j] + p.conv_w[6144 + c8 + j] * nv[j];
      y[j] = siluf_(a);
    }
    *(uint4*)(XBC + (size_t)n * 3072 + c8) = pack8(y);
  }
}

DI void ssd_task(const int TIDX, const P& p, int task, char* smem) {
  char* big = p.ws + OFF_BIG;
  const int b = task >> 5, h = task & 31, g = h >> 3;
  bf16_t* Cs = (bf16_t*)smem;
  bf16_t* Bs = Cs + 128 * 136;
  bf16_t* BT = Bs + 128 * 136;
  bf16_t* xT = BT + 128 * 136;
  bf16_t* sb = xT + 64 * 136;
  float* cumb = (float*)(sb + 64 * 136);
  float* dtvb = cumb + 256;
  const bf16_t* XBC = (const bf16_t*)(big + B_XBC);
  const float* DT = (const float*)(big + B_DT);
  bf16_t* Y = (bf16_t*)(big + B_Y);
  const int tid = TIDX, lane = tid & 63, wave = tid >> 6;
  const int r = lane & 31, h8 = lane >> 5;
  const float dskip = p.ssd_d[h];
  const int lj = tid >> 2, lpart = tid & 3;
  uint4 pc0, pc1, pc2, pc3, pb0, pb1, pb2, pb3, px0, px1;
  float pdt0 = 0.f, pdt1 = 0.f;
  auto prefetch = [&](int itn) {
    const int dn = itn >= 18 ? 1 : 0, cn = itn - dn * 18;
    const int pos = scanpos(dn, cn * 128 + lj);
    const bf16_t* rowp = XBC + (size_t)(b * LT + pos) * 3072;
    const bf16_t* cp = rowp + 2560 + g * 128 + lpart * 32;
    const bf16_t* bp = rowp + 2048 + g * 128 + lpart * 32;
    const bf16_t* xp = rowp + h * 64 + lpart * 16;
    pc0 = *(const uint4*)(cp); pc1 = *(const uint4*)(cp + 8); pc2 = *(const uint4*)(cp + 16); pc3 = *(const uint4*)(cp + 24);
    pb0 = *(const uint4*)(bp); pb1 = *(const uint4*)(bp + 8); pb2 = *(const uint4*)(bp + 16); pb3 = *(const uint4*)(bp + 24);
    px0 = *(const uint4*)(xp); px1 = *(const uint4*)(xp + 8);
    if (wave == 1) {
      const int p0 = scanpos(dn, cn * 128 + lane * 2), p1 = scanpos(dn, cn * 128 + lane * 2 + 1);
      pdt0 = DT[(size_t)(b * LT + p0) * 64 + dn * 32 + h];
      pdt1 = DT[(size_t)(b * LT + p1) * 64 + dn * 32 + h];
    }
  };
  const float aA[2] = {-expf(p.a_log[h]), -expf(p.a_log[32 + h])};
  const float biasA[2] = {p.dt_bias[h], p.dt_bias[32 + h]};
  auto cumcalc = [&](int itn) {
    const int dn = itn >= 18 ? 1 : 0;
    const float an = dn ? aA[1] : aA[0], bn = dn ? biasA[1] : biasA[0];
    float* cw = cumb + (itn & 1) * 128;
    float* dw = dtvb + (itn & 1) * 128;
    const int i0 = lane * 2, i1 = i0 + 1;
    const float dt0 = softplusf_(pdt0 + bn), dt1 = softplusf_(pdt1 + bn);
    const float a0 = an * dt0, a1 = a0 + an * dt1;
    float tot = a1;
#pragma unroll
    for (int off = 1; off < 64; off <<= 1) {
      float t = shup_(tot, off, lane);
      if (lane >= off) tot += t;
    }
    const float excl = tot - a1;
    cw[i0] = excl + a0; cw[i1] = excl + a1;
    dw[i0] = dt0; dw[i1] = dt1;
  };
  __syncthreads();
  prefetch(0);
  if (wave == 1) cumcalc(0);
  f32x16 sacc;
  for (int it = 0; it < 36; it++) {
    const int d = it >= 18 ? 1 : 0, c = it - d * 18;
    const float* cum = cumb + (it & 1) * 128;
    const float* dtv = dtvb + (it & 1) * 128;
    lds_barrier();
    if (c == 0) {
#pragma unroll
      for (int q = 0; q < 16; q++) sacc[q] = 0.f;
      for (int e = tid; e < 64 * 136; e += NTHR) sb[e] = 0;
    }
    const float cl = cum[127];
    {
      const int j = lj;
      const float wj = __expf(cl - cum[j]) * dtv[j];
      const int col0 = lpart * 32;
      *(uint4*)(Cs + j * 136 + col0) = pc0; *(uint4*)(Cs + j * 136 + col0 + 8) = pc1;
      *(uint4*)(Cs + j * 136 + col0 + 16) = pc2; *(uint4*)(Cs + j * 136 + col0 + 24) = pc3;
      *(uint4*)(Bs + j * 136 + col0) = pb0; *(uint4*)(Bs + j * 136 + col0 + 8) = pb1;
      *(uint4*)(Bs + j * 136 + col0 + 16) = pb2; *(uint4*)(Bs + j * 136 + col0 + 24) = pb3;
      float bf[8];
      unpack8(pb0, bf);
#pragma unroll
      for (int e = 0; e < 8; e++) BT[(col0 + e) * 136 + j] = f2bf(bf[e] * wj);
      unpack8(pb1, bf);
#pragma unroll
      for (int e = 0; e < 8; e++) BT[(col0 + 8 + e) * 136 + j] = f2bf(bf[e] * wj);
      unpack8(pb2, bf);
#pragma unroll
      for (int e = 0; e < 8; e++) BT[(col0 + 16 + e) * 136 + j] = f2bf(bf[e] * wj);
      unpack8(pb3, bf);
#pragma unroll
      for (int e = 0; e < 8; e++) BT[(col0 + 24 + e) * 136 + j] = f2bf(bf[e] * wj);
      const int xc0 = lpart * 16;
      {
        const unsigned w[8] = {px0.x, px0.y, px0.z, px0.w, px1.x, px1.y, px1.z, px1.w};
#pragma unroll
        for (int e = 0; e < 8; e++) {
          xT[(xc0 + 2 * e) * 136 + j] = (bf16_t)(w[e] & 0xffffu);
          xT[(xc0 + 2 * e + 1) * 136 + j] = (bf16_t)(w[e] >> 16);
        }
      }
    }
    if (it + 1 < 36) prefetch(it + 1);
    lds_barrier();
    if (wave == 1 && it + 1 < 36) cumcalc(it + 1);
    const int itl = wave >> 1;
    if (c >= 2) {
    f32x16 G0, G1;
#pragma unroll
    for (int q = 0; q < 16; q++) { G0[q] = 0.f; G1[q] = 0.f; }
    {
      const int jt0 = (wave & 1) * 2, jt1 = jt0 + 1;
      if (jt0 <= itl) {
#pragma unroll
        for (int ks = 0; ks < 8; ks++) {
          bf16x8 av = *(const bf16x8*)(Cs + (itl * 32 + r) * 136 + ks * 16 + h8 * 8);
          bf16x8 b0 = *(const bf16x8*)(Bs + (jt0 * 32 + r) * 136 + ks * 16 + h8 * 8);
          G0 = __builtin_amdgcn_mfma_f32_32x32x16_bf16(av, b0, G0, 0, 0, 0);
          if (jt1 <= itl) {
            bf16x8 b1 = *(const bf16x8*)(Bs + (jt1 * 32 + r) * 136 + ks * 16 + h8 * 8);
            G1 = __builtin_amdgcn_mfma_f32_32x32x16_bf16(av, b1, G1, 0, 0, 0);
          }
        }
      }
    }
    lds_barrier();
    {
      bf16_t* Ms = Bs;
      const int jt0 = (wave & 1) * 2;
      const int j0 = jt0 * 32 + r, j1 = j0 + 32;
      const float cj0 = cum[j0], cj1 = cum[j1], dj0 = dtv[j0], dj1 = dtv[j1];
#pragma unroll
      for (int q = 0; q < 16; q++) {
        const int i = itl * 32 + (q & 3) + 8 * (q >> 2) + 4 * h8;
        const float ci = cum[i];
        float m0 = (j0 <= i) ? G0[q] * __expf(ci - cj0) * dj0 : 0.f;
        float m1 = (j1 <= i) ? G1[q] * __expf(ci - cj1) * dj1 : 0.f;
        Ms[i * 136 + j0] = f2bf(m0);
        Ms[i * 136 + j1] = f2bf(m1);
      }
    }
    lds_barrier();
    {
      const bf16_t* Ms = Bs;
      const int pt = wave & 1;
      const int pp = pt * 32 + r;
      bf16_t yold[16];
      if (d == 1 && c >= 2) {
#pragma unroll
        for (int q = 0; q < 16; q++) {
          const int i = itl * 32 + (q & 3) + 8 * (q >> 2) + 4 * h8;
          const int pos = scanpos(1, c * 128 + i);
          yold[q] = Y[(size_t)(b * LT + pos) * 2048 + h * 64 + pp];
        }
      }
      f32x16 yd, yo;
#pragma unroll
      for (int q = 0; q < 16; q++) { yd[q] = 0.f; yo[q] = 0.f; }
#pragma unroll
      for (int ks = 0; ks < 8; ks++) {
        if (ks < (itl + 1) * 2) {
          bf16x8 av = *(const bf16x8*)(Ms + (itl * 32 + r) * 136 + ks * 16 + h8 * 8);
          bf16x8 bv = *(const bf16x8*)(xT + (pt * 32 + r) * 136 + ks * 16 + h8 * 8);
          yd = __builtin_amdgcn_mfma_f32_32x32x16_bf16(av, bv, yd, 0, 0, 0);
        }
        bf16x8 cv = *(const bf16x8*)(Cs + (itl * 32 + r) * 136 + ks * 16 + h8 * 8);
        bf16x8 sv = *(const bf16x8*)(sb + (pt * 32 + r) * 136 + ks * 16 + h8 * 8);
        yo = __builtin_amdgcn_mfma_f32_32x32x16_bf16(cv, sv, yo, 0, 0, 0);
      }
      if (c >= 2) {
#pragma unroll
        for (int q = 0; q < 16; q++) {
          const int i = itl * 32 + (q & 3) + 8 * (q >> 2) + 4 * h8;
          float y = yd[q] + __expf(cum[i]) * yo[q];
          const int pos = scanpos(d, c * 128 + i);
          const size_t idx = (size_t)(b * LT + pos) * 2048 + h * 64 + pp;
          if (d == 0) y += dskip * bf2f(xT[pp * 136 + i]);
          else y += bf2f(yold[q]);
          Y[idx] = f2bf(y);
        }
      }
    }
    lds_barrier();
    }
    {
      const int pt = wave & 1, nt = wave >> 1;
      const float ecl = __expf(cl);
#pragma unroll
      for (int q = 0; q < 16; q++) sacc[q] *= ecl;
#pragma unroll
      for (int ks = 0; ks < 8; ks++) {
        bf16x8 av = *(const bf16x8*)(xT + (pt * 32 + r) * 136 + ks * 16 + h8 * 8);
        bf16x8 bv = *(const bf16x8*)(BT + (nt * 32 + r) * 136 + ks * 16 + h8 * 8);
        sacc = __builtin_amdgcn_mfma_f32_32x32x16_bf16(av, bv, sacc, 0, 0, 0);
      }
#pragma unroll
      for (int q = 0; q < 16; q++) {
        const int pp = pt * 32 + (q & 3) + 8 * (q >> 2) + 4 * h8;
        sb[pp * 136 + nt * 32 + r] = f2bf(sacc[q]);
      }
    }
  }
  __syncthreads();
}

DI void gate_norm(const int TIDX, const P& p, int bid, int nb) {
  char* big = p.ws + OFF_BIG;
  const bf16_t* Y = (const bf16_t*)(big + B_Y);
  const bf16_t* ZG = (const bf16_t*)(big + B_ZG);
  bf16_t* YN = (bf16_t*)(big + B_YN);
  const int lane = TIDX & 63, wave = TIDX >> 6;
  const int ntok = NB * SEQ, nw = nb * 8;
  for (int it = bid * 8 + wave; it < ntok; it += 2 * nw) {
    uint4 yv[2][4], zv[2][4];
    int nn[2];
    bool val[2];
#pragma unroll
    for (int t = 0; t < 2; t++) {
      int ti = it + t * nw;
      val[t] = ti < ntok;
      if (!val[t]) ti = it;
      nn[t] = (ti >> 11) * LT + LC + (ti & 2047);
#pragma unroll
      for (int gq = 0; gq < 4; gq++) {
        yv[t][gq] = *(const uint4*)(Y + (size_t)nn[t] * 2048 + gq * 512 + lane * 8);
        zv[t][gq] = *(const uint4*)(ZG + (size_t)nn[t] * 2048 + gq * 512 + lane * 8);
      }
    }
#pragma unroll
    for (int t = 0; t < 2; t++) {
      if (!val[t]) continue;
#pragma unroll
      for (int gq = 0; gq < 4; gq++) {
        const int base = gq * 512 + lane * 8;
        float y[8], z[8];
        unpack8(yv[t][gq], y); unpack8(zv[t][gq], z);
        float ss = 0.f;
#pragma unroll
        for (int j = 0; j < 8; j++) { y[j] = y[j] * siluf_(z[j]); ss += y[j] * y[j]; }
        ss = wave_sum_dpp(ss, lane);
        const float rs = rsqrtf(ss * (1.f / 512.f) + 1e-6f);
#pragma unroll
        for (int j = 0; j < 8; j++) y[j] = y[j] * rs * p.ssd_nw[base + j];
        *(uint4*)(YN + (size_t)nn[t] * 2048 + base) = pack8(y);
      }
    }
  }
}

#define XB_TMO      128
#define XB_XCNT(j)  (256  + 64 * (j))
#define XB_XSUB(j)  (1280 + 64 * (j))
#define XB_XGEN(j)  (2304 + 64 * (j))
#define XB_TOP      3328
#define XB_TOPGEN   3392
#define XCD_BAR_WORDS 3456
#define XB_SPIN_CAP (1u << 18)
#define LAS __attribute__((address_space(3)))
DI unsigned xb_ld(unsigned* p) { return __hip_atomic_load(p, __ATOMIC_RELAXED, __HIP_MEMORY_SCOPE_AGENT); }
DI unsigned xb_add(unsigned* p, unsigned v) { return __hip_atomic_fetch_add(p, v, __ATOMIC_RELAXED, __HIP_MEMORY_SCOPE_AGENT); }
DI unsigned xb_xcc_id() { return (unsigned)__builtin_amdgcn_s_getreg((3 << 11) | 20) & 0xFu; }
#define XB_SPIN(cond, bar) do { unsigned _sp = 0; while (cond) { __builtin_amdgcn_s_sleep(1); \
    if ((++_sp & 255u) == 0u) { if (xb_ld(&(bar)[XB_TMO])) break; if (_sp > XB_SPIN_CAP) { atomicAdd(&(bar)[XB_TMO], 1u); break; } } } } while (0)
struct XcdBarrier { unsigned* bar; unsigned x; volatile LAS unsigned* st; };
DI XcdBarrier xcd_barrier_post(unsigned* bar, volatile LAS unsigned* st) {
  XcdBarrier b; b.bar = bar; b.x = xb_xcc_id(); b.st = st;
  if (threadIdx.x == 0) (void)xb_add(&bar[XB_XCNT(b.x)], 1u);
  return b;
}
DI void xcd_barrier_complete(unsigned* bar, unsigned x, unsigned& nloc, unsigned& nx) {
  const unsigned G = gridDim.x * gridDim.y * gridDim.z;
  unsigned sum, cnt, mine, sp = 0u;
  for (;;) {
    sum = 0u; cnt = 0u; mine = 0u;
#pragma unroll
    for (unsigned j = 0; j < 16; ++j) { const unsigned c = xb_ld(&bar[XB_XCNT(j)]); sum += c; cnt += (c > 0u) ? 1u : 0u; mine = (j == x) ? c : mine; }
    if (sum == G) break;
    __builtin_amdgcn_s_sleep(1);
    if ((++sp & 255u) == 0u) { if (xb_ld(&bar[XB_TMO])) break; if (sp > XB_SPIN_CAP) { atomicAdd(&bar[XB_TMO], 1u); break; } }
  }
  nloc = mine > 0u ? mine : 1u; nx = cnt > 0u ? cnt : 1u;
}
DI void xcd_barrier(const XcdBarrier& b) {
  asm volatile("s_waitcnt vmcnt(0)" ::: "memory");
  __syncthreads();
  if (threadIdx.x == 0) {
    unsigned* bar = b.bar;
    __builtin_amdgcn_s_waitcnt(0);
    unsigned nloc = b.st[0], nx = b.st[1];
    if (nloc == 0u) { xcd_barrier_complete(bar, b.x, nloc, nx); b.st[0] = nloc; b.st[1] = nx; }
    const unsigned old = xb_add(&bar[XB_XSUB(b.x)], 1u);
    const unsigned gen = old / nloc;
    if (old + 1u == (gen + 1u) * nloc) {
      __builtin_amdgcn_fence(__ATOMIC_RELEASE, "agent");
      asm volatile("s_waitcnt vmcnt(0)" ::: "memory");
      const unsigned og = xb_add(&bar[XB_TOP], 1u);
      const unsigned tg = og / nx;
      if (og + 1u == (tg + 1u) * nx) xb_add(&bar[XB_TOPGEN], 1u);
      else XB_SPIN(xb_ld(&bar[XB_TOPGEN]) == tg, bar);
      __builtin_amdgcn_fence(__ATOMIC_ACQUIRE, "agent");
      xb_add(&bar[XB_XGEN(b.x)], 1u);
      asm volatile("s_waitcnt vmcnt(0)" ::: "memory");
    } else {
      XB_SPIN(xb_ld(&bar[XB_XGEN(b.x)]) == gen, bar);
      __builtin_amdgcn_fence(__ATOMIC_ACQUIRE, "agent");
      asm volatile("s_waitcnt vmcnt(0)" ::: "memory");
    }
  }
  __syncthreads();
}
constexpr size_t OFF_BAR = OFF_VB + 16777216 + 1048576;

DI void run_phase(const int TIDX, const P& p, int ph, int bid, int nb, char* smem, const bool dry = false) {
  char* ws = p.ws;
  char* big = ws + OFF_BIG;
  float* X = (float*)(ws + OFF_X);
  const float* mod = (const float*)(ws + OFF_MOD);
  bf16_t* H = (bf16_t*)(ws + OFF_H);
  switch (ph) {
    case 0: {
      mod_gemv(TIDX, p, 0, bid, nb, smem);
      tconv(TIDX, p.ev_w_in, 2560, 1024, 2560, (bf16_t*)(ws + OFF_WIN0), 1024, 0, bid, nb, smem);
      tconv(TIDX, p.ev_w_out, 1024, 1024, 1024, (bf16_t*)(ws + OFF_WOUT0), 1024, 0, bid, nb, smem);
      tconv(TIDX, p.pwq, 2048, 1024, 2048, (bf16_t*)(ws + OFF_WQ), 1024, 0, bid, nb, smem);
      tconv(TIDX, p.w2, 512, 64, 512, (bf16_t*)(ws + OFF_W2C), 64, 0, bid, nb, smem);
      tconv(TIDX, p.w2 + 64 * 512, 512, 64, 512, (bf16_t*)(ws + OFF_W2C) + 512 * 64, 64, 0, bid, nb, smem);
      tconv(TIDX, p.a2, 512, 64, 512, (bf16_t*)(ws + OFF_A2C), 64, 0, bid, nb, smem);
      tconv(TIDX, p.a2 + 64 * 512, 512, 64, 512, (bf16_t*)(ws + OFF_A2C) + 512 * 64, 64, 0, bid, nb, smem);
      tconv(TIDX, p.g2, 512, 128, 512, (bf16_t*)(ws + OFF_G2T), 128, 0, bid, nb, smem);
      conv_flat(TIDX, p.pkeys, (bf16_t*)(ws + OFF_KEYS), (size_t)2 * 16 * 128 * 128, bid, nb);
    } break;
    case 1: norm_rows(TIDX, p, 0, 0, true, false, bid, nb); break;
    case 2: {
      bf16_t* Z = (bf16_t*)(big + B_Z0);
      auto epi = [=](int m, int n, const float* v) { *(uint4*)(Z + (size_t)m * 2560 + n) = pack8(v); };
      big_gemm(TIDX, H, (const bf16_t*)(ws + OFF_WIN0), 1024, 72, 10, 0, epi, bid, nb, smem);
    } break;
    case 3: prep0(TIDX, p, bid, nb); break;
    case 4: {
      float* DEC = (float*)(big + B_DEC);
      bf16_t* AL = (bf16_t*)(big + B_AL);
      bf16_t* G = (bf16_t*)(big + B_G);
      const float* w0 = p.w0; const float* a0 = p.a0;
      auto epi1 = [=](int m, int n, const float* v) {
        int d = n >> 9, c = n & 511, hh = c >> 6, i = c & 63;
        int b = m / LT, pos = m - b * LT;
        float o[8];
#pragma unroll
        for (int j = 0; j < 8; j++) {
          float x = w0[n + j] + v[j];
          float w = -softplusf_(-x) - 0.5f;
          o[j] = __expf(-__expf(w));
        }
        float* dp = DEC + (size_t)d * (NB * 8 * LT * 64) + ((size_t)(b * 8 + hh) * LT + pos) * 64 + i;
        *(float4*)dp = make_float4(o[0], o[1], o[2], o[3]);
        *(float4*)(dp + 4) = make_float4(o[4], o[5], o[6], o[7]);
      };
      auto epi2 = [=](int m, int n, const float* v) {
        int d = n >> 9, c = n & 511, hh = c >> 6, i = c & 63;
        int b = m / LT, pos = m - b * LT;
        float o[8];
#pragma unroll
        for (int j = 0; j < 8; j++) o[j] = sigmoidf_(a0[n + j] + v[j]);
        *(uint4*)(AL + (size_t)d * (NB * 8 * LT * 64) + ((size_t)(b * 8 + hh) * LT + pos) * 64 + i) = pack8(o);
      };
      auto epi3 = [=](int m, int n, const float* v) { *(uint4*)(G + (size_t)m * 512 + n) = pack8(v); };
      for (int t0 = bid; t0 < 1440; t0 += nb) {
        int t = t0;
        if ((nb & 7) == 0) {
          const int xcd = t0 & 7, j = t0 >> 3;
          const int mt = xcd + 8 * (j / 20), ct = j % 20;
          t = ct < 8 ? mt * 8 + ct : (ct < 16 ? 576 + mt * 8 + (ct - 8) : 1152 + mt * 4 + (ct - 16));
        }
        if (t < 576) {
          gemm_tile(TIDX, (const bf16_t*)(big + B_AW), 64, (const bf16_t*)(ws + OFF_W2C), 64, 64, (t >> 3) * 256, (t & 7) * 128, epi1, smem);
        } else if (t < 1152) {
          int t2 = t - 576;
          gemm_tile(TIDX, (const bf16_t*)(big + B_AA), 64, (const bf16_t*)(ws + OFF_A2C), 64, 64, (t2 >> 3) * 256, (t2 & 7) * 128, epi2, smem);
        } else {
          int t2 = t - 1152;
          gemm_tile(TIDX, (const bf16_t*)(big + B_AG), 128, (const bf16_t*)(ws + OFF_G2T), 128, 128, (t2 >> 2) * 256, (t2 & 3) * 128, epi3, smem);
        }
      }
    } break;
    case 5: {
      if ((nb & 7) == 0) {
        const int hh = bid & 7;
        for (int lb = bid >> 3; lb < 32; lb += nb >> 3) wkv2_task(TIDX, p, (lb >> 2) * 32 + hh * 4 + (lb & 3), smem);
      } else {
        for (int t = bid; t < 256; t += nb) wkv2_task(TIDX, p, t, smem);
      }
      if ((nb & 7) == 0) attn_xcd(TIDX, p, bid, nb, smem);
      else for (int t = bid; t < 576; t += nb) attn_task(TIDX, p, t, smem);
    } break;
    case 22: wkv_finalize(TIDX, p, bid, nb); break;
    case 23: for (int t = bid; t < 256; t += nb) wkv2_task(TIDX, p, t, smem); break;
    case 24: for (int t = bid; t < 576; t += nb) attn_task(TIDX, p, t, smem); break;
    case 6: {
      const float* gate = mod;
      const float* xc_ = p.ctx; const float* xl_ = p.x;
      auto epi = [=](int m, int n, const float* v) {
        int b = m / LT, pos = m - b * LT;
        int rr = pos < LC ? 8 : b;
        const float* xr = (pos < LC ? xc_ + ((size_t)(b * LC + pos)) * DM : xl_ + ((size_t)(b * SEQ + pos - LC)) * DM) + n;
        const float* gp = gate + (size_t)rr * 6144 + 2 * 1024 + n;
        const float4 x0 = *(const float4*)xr, x1 = *(const float4*)(xr + 4), g0 = *(const float4*)gp, g1 = *(const float4*)(gp + 4);
        float* xo = X + (size_t)m * DM + n;
        *(float4*)xo = make_float4(x0.x + g0.x * v[0], x0.y + g0.y * v[1], x0.z + g0.z * v[2], x0.w + g0.w * v[3]);
        *(float4*)(xo + 4) = make_float4(x1.x + g1.x * v[4], x1.y + g1.y * v[5], x1.z + g1.z * v[6], x1.w + g1.w * v[7]);
      };
      big_gemm(TIDX, (const bf16_t*)(big + B_YMIX), (const bf16_t*)(ws + OFF_WOUT0), 1024, 72, 4, 0, epi, bid, nb, smem);
      if (nb > 64 && bid >= 32) {
        mod_gemv(TIDX, p, 1, bid - 32, nb - 32, smem);
        tconv(TIDX, p.ssd_w_in, 5184, 1024, 5184, (bf16_t*)(ws + OFF_WIN1), 1024, 0, bid - 32, nb - 32, smem);
        tconv(TIDX, p.ssd_w_out, 1024, 2048, 1024, (bf16_t*)(ws + OFF_WOUT1), 2048, 0, bid - 32, nb - 32, smem);
        tconv(TIDX, p.pwq + 1024 * 2048, 2048, 1024, 2048, (bf16_t*)(ws + OFF_WQ) + 2048 * 1024, 1024, 0, bid - 32, nb - 32, smem);
      } else if (nb <= 64) {
        mod_gemv(TIDX, p, 1, bid, nb, smem);
        tconv(TIDX, p.ssd_w_in, 5184, 1024, 5184, (bf16_t*)(ws + OFF_WIN1), 1024, 0, bid, nb, smem);
        tconv(TIDX, p.ssd_w_out, 1024, 2048, 1024, (bf16_t*)(ws + OFF_WOUT1), 2048, 0, bid, nb, smem);
        tconv(TIDX, p.pwq + 1024 * 2048, 2048, 1024, 2048, (bf16_t*)(ws + OFF_WQ) + 2048 * 1024, 1024, 0, bid, nb, smem);
      }
    } break;
    case 7: norm_rows(TIDX, p, 0, 1, false, false, bid, nb); break;
    case 8: {
      bf16_t* QP = (bf16_t*)(big + B_QP);
      auto epi = [=](int m, int n, const float* v) { *(uint4*)(QP + (size_t)m * 2048 + n) = pack8(v); };
      big_gemm(TIDX, H, (const bf16_t*)(ws + OFF_WQ), 1024, 72, 8, 0, epi, bid, nb, smem);
      if (nb > 128 && bid >= 64) {
        conv_fp8(TIDX, p.pu, (unsigned char*)(ws + OFF_UB), (float*)(ws + OFF_UB + 16777216), bid - 64, nb - 64);
        conv_fp8(TIDX, p.pv, (unsigned char*)(ws + OFF_VB), (float*)(ws + OFF_VB + 16777216), bid - 64, nb - 64);
      } else if (nb <= 128) {
        conv_fp8(TIDX, p.pu, (unsigned char*)(ws + OFF_UB), (float*)(ws + OFF_UB + 16777216), bid, nb);
        conv_fp8(TIDX, p.pv, (unsigned char*)(ws + OFF_VB), (float*)(ws + OFF_VB + 16777216), bid, nb);
      }
    } break;
    case 9: break;
    case 10:
      if ((nb & 7) == 0) { for (int tile = bid >> 3; tile < 72; tile += nb >> 3) route2_task(TIDX, p, 0, tile * 256, bid & 7, smem, tile == (bid >> 3)); }
      else for (int t = bid; t < 72 * 8; t += nb) route2_task(TIDX, p, 0, (t >> 3) * 256, t & 7, smem);
      break;
    case 26: peer_u2(TIDX, p, false, bid, nb); break;
    case 27: peer_u2(TIDX, p, true, bid, nb); break;
    case 11: peer_gather(TIDX, p, 0, false, bid, nb, dry); break;
    case 12: {
      bf16_t* ZG = (bf16_t*)(big + B_ZG);
      bf16_t* ZX = (bf16_t*)(big + B_ZX);
      float* DT = (float*)(big + B_DT);
      auto epi = [=](int m, int n, const float* v) {
        if (n < 2048) *(uint4*)(ZG + (size_t)m * 2048 + n) = pack8(v);
        else if (n < 5120) *(uint4*)(ZX + (size_t)m * 3072 + n - 2048) = pack8(v);
        else if (n < 5184) {
          float* dp = DT + (size_t)m * 64 + n - 5120;
          *(float4*)dp = make_float4(v[0], v[1], v[2], v[3]);
          *(float4*)(dp + 4) = make_float4(v[4], v[5], v[6], v[7]);
        }
      };
      big_gemm(TIDX, H, (const bf16_t*)(ws + OFF_WIN1), 1024, 72, 21, 0, epi, bid, nb, smem);
    } break;
    case 13: {
      conv_phase(TIDX, p, bid, nb);
      conv_fp8(TIDX, p.pu + (size_t)16384 * 1024, (unsigned char*)(ws + OFF_UB), (float*)(ws + OFF_UB + 16777216), bid, nb);
      conv_fp8(TIDX, p.pv + (size_t)16384 * 1024, (unsigned char*)(ws + OFF_VB), (float*)(ws + OFF_VB + 16777216), bid, nb);
    } break;
    case 14:
      if ((nb & 7) == 0) {
        const int xcd = bid & 7, st = nb >> 3;
        for (int lb = bid >> 3; lb < 32; lb += st) {
          const int gi = xcd + 8 * (lb >> 3), hh = lb & 7;
          ssd_task(TIDX, p, (gi >> 2) * 32 + (gi & 3) * 8 + hh, smem);
        }
      } else {
        for (int t = bid; t < 256; t += nb) ssd_task(TIDX, p, t, smem);
      }
      break;
    case 15: gate_norm(TIDX, p, bid, nb); break;
    case 16: {
      const float* gate = mod + (size_t)9 * 6144;
      auto epi = [=](int m, int n, const float* v) {
        int b = m / LT;
        const float* gp = gate + (size_t)b * 6144 + 2 * 1024 + n;
        const float4 g0 = *(const float4*)gp, g1 = *(const float4*)(gp + 4);
        float* xo = X + (size_t)m * DM + n;
        const float4 x0 = *(const float4*)xo, x1 = *(const float4*)(xo + 4);
        *(float4*)xo = make_float4(x0.x + g0.x * v[0], x0.y + g0.y * v[1], x0.z + g0.z * v[2], x0.w + g0.w * v[3]);
        *(float4*)(xo + 4) = make_float4(x1.x + g1.x * v[4], x1.y + g1.y * v[5], x1.z + g1.z * v[6], x1.w + g1.w * v[7]);
      };
      big_gemm(TIDX, (const bf16_t*)(big + B_YN), (const bf16_t*)(ws + OFF_WOUT1), 2048, 64, 4, 1, epi, bid, nb, smem);
    } break;
    case 17: norm_rows(TIDX, p, 1, 1, false, true, bid, nb); break;
    case 18: {
      bf16_t* QP = (bf16_t*)(big + B_QP);
      auto epi = [=](int m, int n, const float* v) { *(uint4*)(QP + (size_t)m * 2048 + n) = pack8(v); };
      big_gemm(TIDX, H, (const bf16_t*)(ws + OFF_WQ) + 2048 * 1024, 1024, 64, 8, 1, epi, bid, nb, smem);
    } break;
    case 19: break;
    case 20:
      if ((nb & 7) == 0) {
        for (int mtl = bid >> 3; mtl < 64; mtl += nb >> 3) {
          int b = mtl >> 3, mt = b * 9 + 1 + (mtl & 7);
          route2_task(TIDX, p, 1, mt * 256, bid & 7, smem, mtl == (bid >> 3));
        }
      } else
      for (int t = bid; t < 64 * 8; t += nb) {
        int mtl = t >> 3, b = mtl >> 3, mt = b * 9 + 1 + (mtl & 7);
        route2_task(TIDX, p, 1, mt * 256, t & 7, smem);
      }
      break;
    case 21: peer_gather(TIDX, p, 1, true, bid, nb, false); break;
  }
}
constexpr int NPHASE = 22;
#ifndef EXTRA
#define EXTRA
#endif
#ifndef DUP_MASK
#define DUP_MASK 0u
#endif

__global__ void __launch_bounds__(NTHR) mega(P p) {
  __shared__ __attribute__((aligned(16))) char smem[SMEM_BYTES];
  cg::grid_group grid = cg::this_grid();
  __shared__ uint4 xb_words;
  if (threadIdx.x == 0) xb_words = make_uint4(0u, 0u, 0u, 0u);
  __syncthreads();
  XcdBarrier xb = xcd_barrier_post((unsigned*)(p.ws + OFF_BAR), (volatile LAS unsigned*)&xb_words);
  if (gridDim.x == 0x7fffffffu) grid.sync();
#define PHC(i, last)                                             \
  {                                                              \
    P q = p;                                                     \
    int bid = blockIdx.x, nb = gridDim.x;                        \
    char* sm = smem;                                             \
    int TIDX = __builtin_amdgcn_workitem_id_x();                 \
    asm volatile("" : "+s"(q.ws), "+s"(bid), "+s"(nb), "+v"(TIDX)); \
    if ((DUP_MASK >> i) & 1) { run_phase(TIDX, q, i, bid, nb, sm, true); xcd_barrier(xb); } \
    run_phase(TIDX, q, i, bid, nb, sm);                          \
    if (!last) xcd_barrier(xb);                                  \
  }
#define PHN(i)                                                   \
  {                                                              \
    P q = p;                                                     \
    int bid = blockIdx.x, nb = gridDim.x;                        \
    char* sm = smem;                                             \
    int TIDX = __builtin_amdgcn_workitem_id_x();                 \
    asm volatile("" : "+s"(q.ws), "+s"(bid), "+s"(nb), "+v"(TIDX)); \
    run_phase(TIDX, q, i, bid, nb, sm);                          \
    __syncthreads();                                             \
  }
  PHC(0, 0) PHC(1, 0) PHC(2, 0) PHC(3, 0) PHC(4, 0) PHC(5, 0) EXTRA PHC(22, 0) PHC(6, 0) PHC(7, 0) PHC(8, 0) PHC(10, 0) PHN(26)
  PHC(11, 0) PHC(12, 0) PHC(13, 0) PHC(14, 0) PHC(15, 0) PHC(16, 0) PHC(17, 0) PHC(18, 0) PHC(20, 0) PHN(27) PHC(21, 1)
}

extern "C" void kernel_launch(void* const* d_in, const int* in_sizes, int n_in, void* d_out, int out_size, void* d_ws,
                              size_t ws_size, hipStream_t stream) {
  static int grid_blocks = 0;
  if (!grid_blocks) {
    int dev = 0, cus = 0, per_cu = 0;
    hipGetDevice(&dev);
    hipDeviceGetAttribute(&cus, hipDeviceAttributeMultiprocessorCount, dev);
    hipOccupancyMaxActiveBlocksPerMultiprocessor(&per_cu, mega, NTHR, 0);
    if (per_cu < 1) per_cu = 1;
    grid_blocks = cus * per_cu;
  }
  P p;
  memset(&p, 0, sizeof(p));
  const float** fp = (const float**)&p;
  for (int i = 0; i < 35; i++) fp[i] = (const float*)d_in[i];
  p.out = (float*)d_out;
  p.ws = (char*)d_ws;
  if (ws_size < WS_NEED) fprintf(stderr, "workspace too small: %zu < %zu\n", ws_size, (size_t)WS_NEED);
  hipMemsetAsync((char*)d_ws + OFF_BAR, 0, XCD_BAR_WORDS * sizeof(unsigned), stream);
  void* args[] = {&p};
  hipError_t e = hipLaunchCooperativeKernel((void*)mega, dim3(grid_blocks), dim3(NTHR), args, 0, stream);
  if (e != hipSuccess) fprintf(stderr, "cooperative launch failed: %s (grid %d)\n", hipGetErrorString(e), grid_blocks);
}
```

```cpp
#include <hip/hip_runtime.h>
#include <hip/hip_cooperative_groups.h>
#include <stdint.h>
#include <string.h>
#include <stdio.h>
namespace cg = cooperative_groups;

#define DI __device__ __forceinline__
typedef unsigned short bf16_t;
typedef short bf16x8 __attribute__((ext_vector_type(8)));
typedef float f32x16 __attribute__((ext_vector_type(16)));

constexpr int NB = 8, SEQ = 2048, LC = 256, LT = 2304, NTOK = 18432, DM = 1024;
constexpr int NTHR = 512;

constexpr size_t OFF_UB = 0;
constexpr size_t OFF_VB = OFF_UB + 33554432;
constexpr size_t OFF_WIN0 = OFF_VB + 33554432;
constexpr size_t OFF_WOUT0 = OFF_WIN0 + 5242880;
constexpr size_t OFF_WIN1 = OFF_WOUT0 + 3145728;
constexpr size_t OFF_WOUT1 = OFF_WIN1 + 11010048;
constexpr size_t OFF_WQ = OFF_WOUT1 + 4194304;
constexpr size_t OFF_KEYS = OFF_WQ + 8388608;
constexpr size_t OFF_W2C = OFF_KEYS + 1048576;
constexpr size_t OFF_A2C = OFF_W2C + 131072;
constexpr size_t OFF_G2T = OFF_A2C + 131072;
constexpr size_t OFF_MOD = OFF_G2T + 131072;
constexpr size_t OFF_X = OFF_MOD + 442368;
constexpr size_t OFF_H = OFF_X + 75497472;
constexpr size_t OFF_BIG = OFF_H + 37748736;
constexpr size_t B_Z0 = 0;
constexpr size_t B_DEC = 0;
constexpr size_t B_G = 75497472;
constexpr size_t B_QN = 94371840;
constexpr size_t B_KN = B_QN + 18874368;
constexpr size_t B_VT = B_KN + 4718592;
constexpr size_t B_R = B_VT + 4718592;
constexpr size_t B_KB = B_R + 18874368;
constexpr size_t B_KK = B_KB + 18874368;
constexpr size_t B_V = B_KK + 18874368;
constexpr size_t B_AL = B_V + 18874368;
constexpr size_t B_AW = B_AL + 37748736;
constexpr size_t B_AA = B_AW + 2359296;
constexpr size_t B_AG = B_AA + 2359296;
constexpr size_t B_YMIX = B_AW;
constexpr size_t B_OUT = B_YMIX + 37748736;
constexpr size_t B_L0END = B_OUT + 37748736;
constexpr size_t OFF_BON = OFF_UB + 16777216 + 1048576;
constexpr size_t B_QP = 0;
constexpr size_t B_S = 75497472;
constexpr size_t B_EI = B_S + 150994944;
constexpr size_t B_EG = B_EI + 9437184;
constexpr size_t B_PEND = B_EG + 9437184;
constexpr size_t B_ZG = 0;
constexpr size_t B_ZX = 75497472;
constexpr size_t B_Y = B_ZX;
constexpr size_t B_DT = B_ZX + 113246208;
constexpr size_t B_XBC = B_DT + 4718592;
constexpr size_t B_YN = B_XBC;
constexpr size_t B_L1END = B_XBC + 113246208;
constexpr size_t BIG_SZ = B_L1END > B_L0END ? (B_L1END > B_PEND ? B_L1END : B_PEND) : (B_L0END > B_PEND ? B_L0END : B_PEND);
constexpr size_t WS_NEED = OFF_BIG + BIG_SZ;
static_assert(WS_NEED <= 536870912, "workspace too large");

constexpr int SMEM_BYTES = 157696;

struct P {
  const float *x, *c, *ctx, *c_ctx, *mod_w, *mod_b, *n1g, *n2g, *ev_w_in, *ev_w_out, *qg, *kg, *mu, *w0, *w2, *a0, *a2, *g2,
      *k_k, *k_a, *r_k, *gn_w, *gn_b, *ssd_w_in, *conv_w, *conv_b, *dt_bias, *a_log, *ssd_d, *ssd_nw, *ssd_w_out, *pwq, *pkeys,
      *pu, *pv;
  float* out;
  char* ws;
};

typedef float f32x2 __attribute__((ext_vector_type(2)));
typedef __bf16 bf16x2_t __attribute__((ext_vector_type(2)));
DI bf16_t f2bf(float f) { return __builtin_bit_cast(bf16_t, (__bf16)f); }
DI float bf2f(bf16_t b) { return __uint_as_float(((unsigned)b) << 16); }
DI unsigned pack2(float a, float b) {
  f32x2 f = {a, b};
  return __builtin_bit_cast(unsigned, __builtin_convertvector(f, bf16x2_t));
}
DI float lo2f(unsigned u) { return __uint_as_float(u << 16); }
DI float hi2f(unsigned u) { return __uint_as_float(u & 0xffff0000u); }
DI void unpack8(const uint4& r, float* v) {
  v[0] = lo2f(r.x); v[1] = hi2f(r.x); v[2] = lo2f(r.y); v[3] = hi2f(r.y);
  v[4] = lo2f(r.z); v[5] = hi2f(r.z); v[6] = lo2f(r.w); v[7] = hi2f(r.w);
}
DI uint4 pack8(const float* v) {
  uint4 r; r.x = pack2(v[0], v[1]); r.y = pack2(v[2], v[3]); r.z = pack2(v[4], v[5]); r.w = pack2(v[6], v[7]);
  return r;
}
DI float shx_(float v, int off, int lane) {
  return __builtin_bit_cast(float, __builtin_amdgcn_ds_bpermute((lane ^ off) << 2, __builtin_bit_cast(int, v)));
}
DI float shup_(float v, int off, int lane) {
  return __builtin_bit_cast(float, __builtin_amdgcn_ds_bpermute((lane - off) << 2, __builtin_bit_cast(int, v)));
}
#define SHX(v, o) shx_((v), (o), lane)
DI float wave_sum_(float v, int lane) {
#pragma unroll
  for (int o = 32; o > 0; o >>= 1) v += shx_(v, o, lane);
  return v;
}
#define wave_sum(v) wave_sum_((v), lane)
DI float dpp_f(float v, const int ctrl_sel) {
  int x = __builtin_bit_cast(int, v);
  int y;
  if (ctrl_sel == 0) y = __builtin_amdgcn_mov_dpp(x, 0xB1, 0xF, 0xF, true);
  else if (ctrl_sel == 1) y = __builtin_amdgcn_mov_dpp(x, 0x4E, 0xF, 0xF, true);
  else y = __builtin_amdgcn_mov_dpp(x, 0x141, 0xF, 0xF, true);
  return __builtin_bit_cast(float, y);
}
DI float reduce8(float v) {
  v += dpp_f(v, 0);
  v += dpp_f(v, 1);
  v += dpp_f(v, 2);
  return v;
}
DI float wave_sum_dpp(float v, int lane) {
  v += dpp_f(v, 0);
  v += dpp_f(v, 1);
  v += dpp_f(v, 2);
  v += __builtin_bit_cast(float, __builtin_amdgcn_mov_dpp(__builtin_bit_cast(int, v), 0x140, 0xF, 0xF, true));
  v += shx_(v, 16, lane);
  v += shx_(v, 32, lane);
  return v;
}
DI void cvt16_fp8(const uint4& w, float* f) {
  f32x2 t;
  t = __builtin_amdgcn_cvt_pk_f32_fp8((int)w.x, false); f[0] = t.x; f[1] = t.y;
  t = __builtin_amdgcn_cvt_pk_f32_fp8((int)w.x, true); f[2] = t.x; f[3] = t.y;
  t = __builtin_amdgcn_cvt_pk_f32_fp8((int)w.y, false); f[4] = t.x; f[5] = t.y;
  t = __builtin_amdgcn_cvt_pk_f32_fp8((int)w.y, true); f[6] = t.x; f[7] = t.y;
  t = __builtin_amdgcn_cvt_pk_f32_fp8((int)w.z, false); f[8] = t.x; f[9] = t.y;
  t = __builtin_amdgcn_cvt_pk_f32_fp8((int)w.z, true); f[10] = t.x; f[11] = t.y;
  t = __builtin_amdgcn_cvt_pk_f32_fp8((int)w.w, false); f[12] = t.x; f[13] = t.y;
  t = __builtin_amdgcn_cvt_pk_f32_fp8((int)w.w, true); f[14] = t.x; f[15] = t.y;
}
DI float sigmoidf_(float x) { return __builtin_amdgcn_rcpf(1.f + __expf(-x)); }
DI float siluf_(float x) { return x * __builtin_amdgcn_rcpf(1.f + __expf(-x)); }
DI float softplusf_(float y) { return fmaxf(y, 0.f) + __logf(1.f + __expf(-fabsf(y))); }
DI int scanpos(int d, int pp) { return d ? (pp < LC ? LC - 1 - pp : LT + LC - 1 - pp) : pp; }
DI int rowmod(int n) { int b = n / LT; int pos = n - b * LT; return pos < LC ? 8 : b; }
DI const float* xin_row(const P& p, int n) {
  int b = n / LT, pos = n - b * LT;
  return pos < LC ? p.ctx + ((size_t)(b * LC + pos)) * DM : p.x + ((size_t)(b * SEQ + pos - LC)) * DM;
}

template <class Epi>
DI void gemm_tile(const int TIDX, const bf16_t* __restrict__ A, int lda, const bf16_t* __restrict__ Bt, int ldb, int K, int m0, int n0,
                  Epi epi, char* smem) {
  bf16_t* As = (bf16_t*)smem;
  bf16_t* Bs = As + 2 * 256 * 72;
  const int tid = TIDX, lane = tid & 63, wave = tid >> 6;
  const int wm = wave >> 1, wn = wave & 1;
  const int r = lane & 31, h8 = lane >> 5;
  f32x16 acc[2][2];
#pragma unroll
  for (int i = 0; i < 2; i++)
#pragma unroll
    for (int j = 0; j < 2; j++)
#pragma unroll
      for (int q = 0; q < 16; q++) acc[i][j][q] = 0.f;
  const int lrow = tid >> 3, lch = tid & 7;
  const bf16_t* Ap = A + (size_t)(m0 + lrow) * lda + lch * 8;
  const bf16_t* Bp = Bt + (size_t)(n0 + lrow) * ldb + lch * 8;
  const size_t sa = (size_t)64 * lda, sb_ = (size_t)64 * ldb;
  uint4 ra0 = *(const uint4*)(Ap), ra1 = *(const uint4*)(Ap + sa), ra2 = *(const uint4*)(Ap + 2 * sa), ra3 = *(const uint4*)(Ap + 3 * sa);
  uint4 rb0 = *(const uint4*)(Bp), rb1 = *(const uint4*)(Bp + sb_);
  __syncthreads();
  {
    bf16_t* Aw = As + lrow * 72 + lch * 8;
    bf16_t* Bw = Bs + lrow * 72 + lch * 8;
    *(uint4*)(Aw) = ra0; *(uint4*)(Aw + 64 * 72) = ra1; *(uint4*)(Aw + 128 * 72) = ra2; *(uint4*)(Aw + 192 * 72) = ra3;
    *(uint4*)(Bw) = rb0; *(uint4*)(Bw + 64 * 72) = rb1;
  }
  __syncthreads();
  const int nk = K >> 6;
  for (int kt = 0; kt < nk; kt++) {
    const int cur = kt & 1;
    const bool more = kt + 1 < nk;
    if (more) {
      const bf16_t* Aq = Ap + (kt + 1) * 64;
      const bf16_t* Bq = Bp + (kt + 1) * 64;
      ra0 = *(const uint4*)(Aq); ra1 = *(const uint4*)(Aq + sa); ra2 = *(const uint4*)(Aq + 2 * sa); ra3 = *(const uint4*)(Aq + 3 * sa);
      rb0 = *(const uint4*)(Bq); rb1 = *(const uint4*)(Bq + sb_);
    }
    const bf16_t* Ac = As + cur * 256 * 72 + (wm * 64 + r) * 72 + h8 * 8;
    const bf16_t* Bc = Bs + cur * 128 * 72 + (wn * 64 + r) * 72 + h8 * 8;
#pragma unroll
    for (int ks = 0; ks < 4; ks++) {
      bf16x8 a0 = *(const bf16x8*)(Ac + ks * 16);
      bf16x8 a1 = *(const bf16x8*)(Ac + 32 * 72 + ks * 16);
      bf16x8 b0 = *(const bf16x8*)(Bc + ks * 16);
      bf16x8 b1 = *(const bf16x8*)(Bc + 32 * 72 + ks * 16);
      acc[0][0] = __builtin_amdgcn_mfma_f32_32x32x16_bf16(a0, b0, acc[0][0], 0, 0, 0);
      acc[0][1] = __builtin_amdgcn_mfma_f32_32x32x16_bf16(a0, b1, acc[0][1], 0, 0, 0);
      acc[1][0] = __builtin_amdgcn_mfma_f32_32x32x16_bf16(a1, b0, acc[1][0], 0, 0, 0);
      acc[1][1] = __builtin_amdgcn_mfma_f32_32x32x16_bf16(a1, b1, acc[1][1], 0, 0, 0);
    }
    if (more) {
      const int nx = cur ^ 1;
      bf16_t* Aw = As + nx * 256 * 72 + lrow * 72 + lch * 8;
      bf16_t* Bw = Bs + nx * 128 * 72 + lrow * 72 + lch * 8;
      *(uint4*)(Aw) = ra0; *(uint4*)(Aw + 64 * 72) = ra1; *(uint4*)(Aw + 128 * 72) = ra2; *(uint4*)(Aw + 192 * 72) = ra3;
      *(uint4*)(Bw) = rb0; *(uint4*)(Bw + 64 * 72) = rb1;
    }
    __syncthreads();
  }
  float* Cs = (float*)smem;
#pragma unroll
  for (int mt = 0; mt < 2; mt++)
#pragma unroll
    for (int nt = 0; nt < 2; nt++)
#pragma unroll
      for (int q = 0; q < 16; q++)
        Cs[(wm * 64 + mt * 32 + (q & 3) + 8 * (q >> 2) + 4 * h8) * 132 + wn * 64 + nt * 32 + r] = acc[mt][nt][q];
  __syncthreads();
#pragma unroll
  for (int i = 0; i < 8; i++) {
    const int seg = i * NTHR + tid;
    const int row = seg >> 4, cs = (seg & 15) * 8;
    const float4 c0 = *(const float4*)(Cs + row * 132 + cs), c1 = *(const float4*)(Cs + row * 132 + cs + 4);
    float v[8] = {c0.x, c0.y, c0.z, c0.w, c1.x, c1.y, c1.z, c1.w};
    epi(m0 + row, n0 + cs, v);
  }
}

namespace pg8 {
#define PG8_LAS __attribute__((address_space(3)))
typedef unsigned short bf16_t;
typedef short bf16x8 __attribute__((ext_vector_type(8)));
typedef float f32x4 __attribute__((ext_vector_type(4)));
typedef unsigned u32x4 __attribute__((ext_vector_type(4)));
constexpr int BM = 256, BK = 64, HALF = 128, HTB = HALF * BK * 2  , STAGE_BYTES = 8 * HTB, NXCD = 8, WGM = 8;

__host__ __device__ __forceinline__ int lds_byte(int r, int c) { const int st = (r >> 4) * 2 + (c >> 5), rr = r & 15, cc = c & 31, ob = rr * 64 + cc * 2; return st * 1024 + (ob ^ (((ob >> 9) & 1) << 5)); }
__host__ __device__ __forceinline__ void stage_rc(int b, int& R, int& C) { const int st = b / 1024, sb = b % 1024, swz = sb ^ (((sb >> 9) & 1) << 5); R = (st >> 1) * 16 + swz / 64; C = (st & 1) * 32 + (swz % 64) / 2; }
__host__ __device__ __forceinline__ int perm32(int rho) { const int n = rho >> 4, i = rho & 15; return 8 * (i >> 2) + 4 * n + (i & 3); }

struct Unit { int pm, pn; };
struct Gemm { const bf16_t* A; const bf16_t* Bt; int M, N, K; };

struct TileOrder {
    int nN, nwg, G, c, latent;
    __device__ __forceinline__ void init(int nM_, int nN_, int G_, int c_, int latent_) { nN = nN_; nwg = nM_ * nN_; G = G_; c = c_; latent = latent_; }
    __device__ __forceinline__ bool next(int i, Unit& u) const {
        const int L = i * G + c; if (L >= nwg) return false;
        int wgid = L; { const int q = nwg / NXCD, r = nwg % NXCD, xcd = wgid % NXCD, off = wgid / NXCD; wgid = (xcd < r ? xcd * (q + 1) : r * (q + 1) + (xcd - r) * q) + off; }
        const int nM = nwg / nN;
        const int nig = WGM * nN, gid = wgid / nig, fm = gid * WGM, gsz = (nM - fm) < WGM ? (nM - fm) : WGM;
        int pm = fm + ((wgid % nig) % gsz); u.pn = (wgid % nig) / gsz;
        if (latent) { const int b = pm >> 3; pm = b * 9 + 1 + (pm & 7); }
        u.pm = pm; return true;
    }
    __device__ __forceinline__ void a_ready(const Unit&) const {}
    __device__ __forceinline__ void done(const Unit&) const {}
};
template <class F> struct EpiAdapt {
    static constexpr bool PERM = true, AFTER_DRAIN = false;
    F f;
    __device__ __forceinline__ void operator()(const f32x4 (&acc)[2][2][4][2], const Unit& u, int wr, int wc, int fr, int fq) const {
#pragma unroll
        for (int ai = 0; ai < 2; ++ai)
#pragma unroll
            for (int m = 0; m < 4; ++m) {
                const int row = u.pm * BM + ai * HALF + wr * 64 + m * 16 + fr;
#pragma unroll
                for (int bj = 0; bj < 2; ++bj) {
                    const int col = u.pn * BM + bj * HALF + wc * 32 + 8 * fq;
                    const f32x4 a0 = acc[ai][bj][m][0], a1 = acc[ai][bj][m][1];
                    float v[8] = {a0[0], a0[1], a0[2], a0[3], a1[0], a1[1], a1[2], a1[3]};
                    f(row, col, v);
                }
            }
    }
};

template <class Epi, class Sched, bool ALIGN_EPI = false, bool SP2 = false>
__device__ __forceinline__ void gemm_phase(const int TIDX, PG8_LAS unsigned char* lds, const Gemm g, const Sched& S, const Epi& E) {
    const int tid = TIDX, wid = __builtin_amdgcn_readfirstlane(tid >> 6), lane = tid & 63, wr = wid >> 2, wc = wid & 3, fr = lane & 15, fq = lane >> 4;
    const int K = g.K, nt = K / BK;
    unsigned voffA[2], voffB[2];
#pragma unroll
    for (int i = 0; i < 2; ++i) { int R, C; stage_rc(tid * 16 + i * 8192, R, C); const int Rb = Epi::PERM ? ((R & ~31) + perm32(R & 31)) : R;
        voffA[i] = (unsigned)(R * K + C) * 2u; voffB[i] = (unsigned)(Rb * K + C) * 2u; }
    const size_t kstep = (size_t)(BK * 2);
    const size_t hstep = (size_t)HALF * K * 2;
    const size_t tstep = 2 * hstep;
    const unsigned ldsw = (unsigned)wid * 1024u;
    const int aoff = lds_byte(wr * 64 + fr, fq * 8), boff = lds_byte(wc * 32 + fr, fq * 8);
#define PG8_SA(b, h) (((b) * 2 + (h)) * HTB)
#define PG8_SB(b, h) ((4 + (b) * 2 + (h)) * HTB)
#define PG8_STAGE(bufoff, gbase, voff) do { _Pragma("unroll") for (int _i = 0; _i < 2; ++_i) \
        __builtin_amdgcn_global_load_lds((const unsigned*)((const char*)(gbase) + (voff)[_i]), (PG8_LAS unsigned*)(lds + (bufoff) + ldsw + _i * 8192), 16, 0, 0); } while (0)
#define PG8_LDA(dst, b, h) do { _Pragma("unroll") for (int m = 0; m < 4; ++m) _Pragma("unroll") for (int k = 0; k < 2; ++k) dst[m][k] = *(const PG8_LAS bf16x8*)(lds + PG8_SA(b, h) + aoff + m * 2048 + k * 1024); } while (0)
#define PG8_LDB(dst, b, h) do { _Pragma("unroll") for (int n = 0; n < 2; ++n) _Pragma("unroll") for (int k = 0; k < 2; ++k) dst[n][k] = *(const PG8_LAS bf16x8*)(lds + PG8_SB(b, h) + boff + n * 2048 + k * 1024); } while (0)
#define PG8_MMA(ai, bj, At, Bt) do { __builtin_amdgcn_s_setprio(1); _Pragma("unroll") for (int m = 0; m < 4; ++m) _Pragma("unroll") for (int n = 0; n < 2; ++n) _Pragma("unroll") for (int k = 0; k < 2; ++k) \
        acc[ai][bj][m][n] = __builtin_amdgcn_mfma_f32_16x16x32_bf16(Bt[n][k], At[m][k], acc[ai][bj][m][n], 0, 0, 0); __builtin_amdgcn_s_setprio(0); } while (0)
#define PG8_WAIT_V(n) asm volatile("s_waitcnt vmcnt(" #n ")" ::: "memory")
#define PG8_WAIT_L(n) asm volatile("s_waitcnt lgkmcnt(" #n ")" ::: "memory")
#define PG8_BAR __builtin_amdgcn_s_barrier()
#define PG8_SCHED __builtin_amdgcn_sched_barrier(0)
    Unit cur, nxt; int ui = 0;
    if (!S.next(0, cur)) return;
    f32x4 acc[2][2][4][2];
#pragma unroll
    for (int a = 0; a < 2; ++a)
#pragma unroll
        for (int b = 0; b < 2; ++b)
#pragma unroll
            for (int m = 0; m < 4; ++m)
#pragma unroll
                for (int n = 0; n < 2; ++n) acc[a][b][m][n] = (f32x4){0.f, 0.f, 0.f, 0.f};
    bf16x8 At[4][2], B0[2][2], B1[2][2];
    const char* cA = (const char*)g.A + (size_t)cur.pm * tstep; const char* cB = (const char*)g.Bt + (size_t)cur.pn * tstep;
    S.a_ready(cur);
    if constexpr (SP2) {
        PG8_STAGE(PG8_SB(0, 0), cB, voffB); PG8_STAGE(PG8_SB(0, 1), cB + hstep, voffB); PG8_STAGE(PG8_SA(0, 0), cA, voffA); PG8_STAGE(PG8_SA(0, 1), cA + hstep, voffA);
        if (wr == 1) PG8_BAR;
        PG8_WAIT_V(2); PG8_BAR;
        PG8_STAGE(PG8_SB(1, 0), cB + kstep, voffB); PG8_STAGE(PG8_SA(1, 0), cA + kstep, voffA); PG8_STAGE(PG8_SB(1, 1), cB + hstep + kstep, voffB);
        PG8_WAIT_V(6); PG8_BAR;
    } else {
        PG8_STAGE(PG8_SB(0, 0), cB, voffB); PG8_STAGE(PG8_SA(0, 0), cA, voffA); PG8_STAGE(PG8_SB(0, 1), cB + hstep, voffB); PG8_STAGE(PG8_SA(0, 1), cA + hstep, voffA);
        if (wr == 1) PG8_BAR;
        PG8_WAIT_V(4); PG8_BAR;
        PG8_STAGE(PG8_SB(1, 0), cB + kstep, voffB); PG8_STAGE(PG8_SA(1, 0), cA + kstep, voffA); PG8_STAGE(PG8_SB(1, 1), cB + hstep + kstep, voffB);
        PG8_WAIT_V(6); PG8_BAR;
    }
    for (;;) {
        const bool has_next = S.next(ui + 1, nxt);
        const char* nA = has_next ? (const char*)g.A + (size_t)nxt.pm * tstep : cA; const char* nB = has_next ? (const char*)g.Bt + (size_t)nxt.pn * tstep : cB;
        for (int t = 0; t < nt; t += 2) {
            const bool last = (t == nt - 2);
            const char* a1 = cA + (size_t)(t + 1) * kstep;
            const char* a2 = last ? nA : cA + (size_t)(t + 2) * kstep; const char* b2 = last ? nB : cB + (size_t)(t + 2) * kstep;
            const char* a3 = a2 + kstep; const char* b3 = b2 + kstep;
            if (last && has_next) S.a_ready(nxt);
            if constexpr (SP2) {
            PG8_LDB(B0, 0, 0); PG8_LDB(B1, 0, 1); PG8_SCHED; PG8_LDA(At, 0, 0); PG8_STAGE(PG8_SA(1, 1), a1 + hstep, voffA);
            PG8_WAIT_V(8); PG8_WAIT_L(0); PG8_BAR; PG8_MMA(0, 0, At, B0); PG8_MMA(0, 1, At, B1); PG8_BAR; PG8_SCHED;
            PG8_LDA(At, 0, 1); PG8_STAGE(PG8_SB(0, 0), b2, voffB); PG8_STAGE(PG8_SB(0, 1), b2 + hstep, voffB); PG8_STAGE(PG8_SA(0, 0), a2, voffA);
            PG8_WAIT_V(8); PG8_WAIT_L(0); PG8_BAR; PG8_MMA(1, 0, At, B0); PG8_MMA(1, 1, At, B1); PG8_BAR; PG8_SCHED;
            PG8_LDB(B0, 1, 0); PG8_LDB(B1, 1, 1); PG8_SCHED; PG8_LDA(At, 1, 0); PG8_STAGE(PG8_SA(0, 1), a2 + hstep, voffA);
            PG8_WAIT_V(8); PG8_WAIT_L(0); PG8_BAR; PG8_MMA(0, 0, At, B0); PG8_MMA(0, 1, At, B1); PG8_BAR; PG8_SCHED;
            PG8_LDA(At, 1, 1); PG8_STAGE(PG8_SB(1, 0), b3, voffB); PG8_STAGE(PG8_SB(1, 1), b3 + hstep, voffB); PG8_STAGE(PG8_SA(1, 0), a3, voffA);
            PG8_WAIT_V(8); PG8_WAIT_L(0); PG8_BAR; PG8_MMA(1, 0, At, B0); PG8_MMA(1, 1, At, B1); PG8_BAR; PG8_SCHED;
            } else {
            PG8_LDB(B0, 0, 0); PG8_SCHED; PG8_LDA(At, 0, 0); PG8_STAGE(PG8_SA(1, 1), a1 + hstep, voffA);
            PG8_WAIT_L(8); PG8_BAR; PG8_WAIT_L(0); PG8_MMA(0, 0, At, B0); PG8_BAR; PG8_SCHED;
            PG8_LDB(B1, 0, 1); PG8_STAGE(PG8_SB(0, 0), b2, voffB);
            PG8_BAR; PG8_WAIT_L(0); PG8_MMA(0, 1, At, B1); PG8_BAR;
            PG8_LDA(At, 0, 1); PG8_STAGE(PG8_SA(0, 0), a2, voffA);
            PG8_BAR; PG8_WAIT_L(0); PG8_MMA(1, 0, At, B0); PG8_BAR; PG8_SCHED;
            PG8_STAGE(PG8_SB(0, 1), b2 + hstep, voffB);
            PG8_WAIT_V(6); PG8_BAR; PG8_MMA(1, 1, At, B1); PG8_BAR;
            PG8_LDB(B0, 1, 0); PG8_SCHED; PG8_LDA(At, 1, 0); PG8_STAGE(PG8_SA(0, 1), a2 + hstep, voffA);
            PG8_WAIT_L(8); PG8_BAR; PG8_WAIT_L(0); PG8_MMA(0, 0, At, B0); PG8_BAR; PG8_SCHED;
            PG8_LDB(B1, 1, 1); PG8_STAGE(PG8_SB(1, 0), b3, voffB);
            PG8_BAR; PG8_WAIT_L(0); PG8_MMA(0, 1, At, B1); PG8_BAR;
            PG8_LDA(At, 1, 1); PG8_STAGE(PG8_SA(1, 0), a3, voffA);
            PG8_BAR; PG8_WAIT_L(0); PG8_MMA(1, 0, At, B0); PG8_BAR; PG8_SCHED;
            PG8_STAGE(PG8_SB(1, 1), b3 + hstep, voffB);
            PG8_WAIT_V(6); PG8_BAR; PG8_MMA(1, 1, At, B1); PG8_BAR;
            }
        }
        if constexpr (ALIGN_EPI) { if (wr == 0) PG8_BAR; }
        if constexpr (!Epi::AFTER_DRAIN) { E(acc, cur, wr, wc, fr, fq); S.done(cur); }
        if (!has_next) break;
#pragma unroll
        for (int a = 0; a < 2; ++a)
#pragma unroll
            for (int b = 0; b < 2; ++b)
#pragma unroll
                for (int m = 0; m < 4; ++m)
#pragma unroll
                    for (int n = 0; n < 2; ++n) acc[a][b][m][n] = (f32x4){0.f, 0.f, 0.f, 0.f};
        cur = nxt; cA = nA; cB = nB; ++ui;
        if constexpr (ALIGN_EPI) { if (wr == 1) PG8_BAR; }
    }
    PG8_WAIT_V(0);
    if constexpr (!ALIGN_EPI) { if (wr == 0) PG8_BAR; }
    PG8_BAR;
    if constexpr (Epi::AFTER_DRAIN) { E.fused(acc, cur, wr, wc, fr, fq, lds, wid, lane); S.done(cur); }
#undef PG8_SA
#undef PG8_SB
#undef PG8_STAGE
#undef PG8_LDA
#undef PG8_LDB
#undef PG8_MMA
#undef PG8_WAIT_V
#undef PG8_WAIT_L
#undef PG8_BAR
#undef PG8_SCHED
}
}


#ifndef GEMM_ALIGN_EPI
#define GEMM_ALIGN_EPI true
#endif
template <class F>
DI void big_gemm(const int TIDX, const bf16_t* A, const bf16_t* Bt, int K, int nM, int nN, int latent, F f, int bid, int nb, char* smem) {
  pg8::Gemm g; g.A = A; g.Bt = Bt; g.M = 0; g.N = 0; g.K = K;
  pg8::TileOrder S; S.init(nM, nN, nb, bid, latent);
  pg8::EpiAdapt<F> E{f};
  __syncthreads();
  pg8::gemm_phase<pg8::EpiAdapt<F>, pg8::TileOrder, GEMM_ALIGN_EPI, true>(TIDX, (PG8_LAS unsigned char*)smem, g, S, E);
  __syncthreads();
}

DI void tconv(const int TIDX, const float* __restrict__ src, int lds_, int K, int N, bf16_t* __restrict__ dst, int ldd, int koff, int bid,
              int nb, char* smem) {
  float* t = (float*)smem;
  const int tn = N >> 6, tk = K >> 6;
  const int lk = TIDX >> 4, ln = (TIDX & 15) * 4;
  const int on = TIDX >> 3, ok = (TIDX & 7) * 8;
  for (int tile = bid; tile < tk * tn; tile += nb) {
    const int k0 = (tile / tn) * 64, n0 = (tile % tn) * 64;
    const float4 v0 = *(const float4*)(src + (size_t)(k0 + lk) * lds_ + n0 + ln);
    const float4 v1 = *(const float4*)(src + (size_t)(k0 + 32 + lk) * lds_ + n0 + ln);
    __syncthreads();
    *(float4*)(t + lk * 68 + ln) = v0;
    *(float4*)(t + (32 + lk) * 68 + ln) = v1;
    __syncthreads();
    float o[8];
#pragma unroll
    for (int j = 0; j < 8; j++) o[j] = t[(ok + j) * 68 + on];
    *(uint4*)(dst + (size_t)(n0 + on) * ldd + koff + k0 + ok) = pack8(o);
  }
}
DI void conv_flat(const int TIDX, const float* __restrict__ src, bf16_t* __restrict__ dst, size_t count, int bid, int nb) {
  const size_t n4 = count >> 2;
  for (size_t i = (size_t)bid * NTHR + TIDX; i < n4; i += (size_t)nb * NTHR) {
    float4 v = ((const float4*)src)[i];
    uint2 o; o.x = pack2(v.x, v.y); o.y = pack2(v.z, v.w);
    ((uint2*)dst)[i] = o;
  }
}
DI void conv_fp8(const int TIDX, const float* __restrict__ src, unsigned char* __restrict__ dst, float* __restrict__ scl, int bid, int nb) {
  const int lane = TIDX & 63, wave = TIDX >> 6;
  for (int row = bid * 8 + wave; row < 16384; row += nb * 8) {
    const float* sp = src + (size_t)row * 1024 + lane * 16;
    float4 v0 = *(const float4*)(sp), v1 = *(const float4*)(sp + 4), v2 = *(const float4*)(sp + 8), v3 = *(const float4*)(sp + 12);
    float am = fmaxf(fmaxf(fmaxf(fabsf(v0.x), fabsf(v0.y)), fmaxf(fabsf(v0.z), fabsf(v0.w))),
                     fmaxf(fmaxf(fabsf(v1.x), fabsf(v1.y)), fmaxf(fabsf(v1.z), fabsf(v1.w))));
    am = fmaxf(am, fmaxf(fmaxf(fmaxf(fabsf(v2.x), fabsf(v2.y)), fmaxf(fabsf(v2.z), fabsf(v2.w))),
                         fmaxf(fmaxf(fabsf(v3.x), fabsf(v3.y)), fmaxf(fabsf(v3.z), fabsf(v3.w)))));
#pragma unroll
    for (int o = 32; o > 0; o >>= 1) am = fmaxf(am, shx_(am, o, lane));
    const float sc = am > 0.f ? 224.f / am : 1.f;
    if (lane == 0) scl[row] = am > 0.f ? am * (1.f / 224.f) : 1.f;
    uint4 o;
    int t = 0;
    t = __builtin_amdgcn_cvt_pk_fp8_f32(v0.x * sc, v0.y * sc, t, false); t = __builtin_amdgcn_cvt_pk_fp8_f32(v0.z * sc, v0.w * sc, t, true); o.x = (unsigned)t;
    t = __builtin_amdgcn_cvt_pk_fp8_f32(v1.x * sc, v1.y * sc, t, false); t = __builtin_amdgcn_cvt_pk_fp8_f32(v1.z * sc, v1.w * sc, t, true); o.y = (unsigned)t;
    t = __builtin_amdgcn_cvt_pk_fp8_f32(v2.x * sc, v2.y * sc, t, false); t = __builtin_amdgcn_cvt_pk_fp8_f32(v2.z * sc, v2.w * sc, t, true); o.z = (unsigned)t;
    t = __builtin_amdgcn_cvt_pk_fp8_f32(v3.x * sc, v3.y * sc, t, false); t = __builtin_amdgcn_cvt_pk_fp8_f32(v3.z * sc, v3.w * sc, t, true); o.w = (unsigned)t;
    *(uint4*)(dst + (size_t)row * 1024 + lane * 16) = o;
  }
}
DI void mod_gemv(const int TIDX, const P& p, int layer_sel, int bid, int nb, char* smem) {
  float* sc = (float*)smem;
  float* red = sc + 9 * 1024;
  float* modo = (float*)(p.ws + OFF_MOD);
  for (int task = nb - 1 - bid; task < 96; task += nb) {
    const int l = layer_sel, j0 = task * 64;
    __syncthreads();
    for (int e = TIDX; e < 9 * 1024; e += NTHR) {
      int rr = e >> 10, k = e & 1023;
      float v = rr < 8 ? p.c[rr * 1024 + k] : p.c_ctx[k];
      sc[e] = v / (1.f + expf(-v));
    }
    __syncthreads();
    const int kg = TIDX >> 6, col = TIDX & 63;
    float acc[9];
#pragma unroll
    for (int q = 0; q < 9; q++) acc[q] = 0.f;
    const float* W = p.mod_w + (size_t)l * 1024 * 6144 + j0 + col;
#pragma unroll 16
    for (int k = kg * 128; k < kg * 128 + 128; ++k) {
      float w = W[(size_t)k * 6144];
#pragma unroll
      for (int q = 0; q < 9; q++) acc[q] += sc[q * 1024 + k] * w;
    }
#pragma unroll
    for (int q = 0; q < 9; q++) red[(kg * 9 + q) * 64 + col] = acc[q];
    __syncthreads();
    for (int e = TIDX; e < 9 * 64; e += NTHR) {
      int rr = e >> 6, cc = e & 63;
      float s = p.mod_b[l * 6144 + j0 + cc];
#pragma unroll
      for (int g = 0; g < 8; g++) s += red[(g * 9 + rr) * 64 + cc];
      modo[(size_t)(l * 9 + rr) * 6144 + j0 + cc] = s;
    }
  }
}

DI void norm_rows(const int TIDX, const P& p, int layer, int which, bool from_input, bool latent_only, int bid, int nb) {
  const int lane = TIDX & 63, wave = TIDX >> 6;
  const float* mod = (const float*)(p.ws + OFF_MOD);
  const float* X = (const float*)(p.ws + OFF_X);
  bf16_t* H = (bf16_t*)(p.ws + OFF_H);
  const float* g = (which ? p.n2g : p.n1g) + layer * 1024;
  const int ntok = latent_only ? NB * SEQ : NTOK;
  const int nw = nb * 8;
  for (int it = bid * 8 + wave; it < ntok; it += 4 * nw) {
    int nn[4];
    bool val[4];
    float4 v[4][4];
#pragma unroll
    for (int t = 0; t < 4; t++) {
      int ti = it + t * nw;
      val[t] = ti < ntok;
      if (!val[t]) ti = it;
      nn[t] = latent_only ? ((ti >> 11) * LT + LC + (ti & 2047)) : ti;
      const float* src = from_input ? xin_row(p, nn[t]) : X + (size_t)nn[t] * DM;
#pragma unroll
      for (int i = 0; i < 4; i++) v[t][i] = *(const float4*)(src + i * 256 + lane * 4);
    }
#pragma unroll
    for (int t = 0; t < 4; t++) {
      float ss = 0.f;
#pragma unroll
      for (int i = 0; i < 4; i++) ss += v[t][i].x * v[t][i].x + v[t][i].y * v[t][i].y + v[t][i].z * v[t][i].z + v[t][i].w * v[t][i].w;
      ss = wave_sum_dpp(ss, lane);
      const float rs = rsqrtf(ss * (1.f / 1024.f) + 1e-6f);
      const int n = nn[t];
      const int b = n / LT, pos = n - b * LT;
      const int rr = pos < LC ? 8 : b;
      const float* msc = mod + (size_t)(layer * 9 + rr) * 6144 + (which ? 4 : 1) * 1024;
      const float* msh = mod + (size_t)(layer * 9 + rr) * 6144 + (which ? 3 : 0) * 1024;
      if (val[t]) {
#pragma unroll
        for (int i = 0; i < 4; i++) {
          int idx = i * 256 + lane * 4;
          float4 gg = *(const float4*)(g + idx), sc = *(const float4*)(msc + idx), sh = *(const float4*)(msh + idx);
          float y0 = v[t][i].x * rs * gg.x * (1.f + sc.x) + sh.x;
          float y1 = v[t][i].y * rs * gg.y * (1.f + sc.y) + sh.y;
          float y2 = v[t][i].z * rs * gg.z * (1.f + sc.z) + sh.z;
          float y3 = v[t][i].w * rs * gg.w * (1.f + sc.w) + sh.w;
          uint2 o; o.x = pack2(y0, y1); o.y = pack2(y2, y3);
          *(uint2*)(H + (size_t)n * DM + idx) = o;
        }
      }
    }
  }
}

DI void rope8(float* v, int e, int t, int lane) {
  const int half = e >> 2, isx2 = (e >> 1) & 1, ibase = (e & 1) * 8;
  const float posf = half ? (float)(t & 63) : (float)(t >> 6);
#pragma unroll
  for (int j = 0; j < 8; j++) {
    float pv = SHX(v[j], 2);
    float inv = exp2f(-(float)(ibase + j) * 0.83048202f);
    float ang = posf * inv;
    float rev = ang * 0.15915494309f;
    rev -= floorf(rev);
    float sn = __builtin_amdgcn_sinf(rev), cs = __builtin_amdgcn_cosf(rev);
    v[j] = isx2 ? (v[j] * cs + pv * sn) : (v[j] * cs - pv * sn);
  }
}
DI void prep0(const int TIDX, const P& p, int bid, int nb) {
  char* big = p.ws + OFF_BIG;
  const bf16_t* Z = (const bf16_t*)(big + B_Z0);
  bf16_t* QN = (bf16_t*)(big + B_QN); bf16_t* KN = (bf16_t*)(big + B_KN); bf16_t* VT = (bf16_t*)(big + B_VT);
  bf16_t* R = (bf16_t*)(big + B_R); bf16_t* KB = (bf16_t*)(big + B_KB); bf16_t* KK = (bf16_t*)(big + B_KK);
  bf16_t* V = (bf16_t*)(big + B_V); bf16_t* AW = (bf16_t*)(big + B_AW); bf16_t* AA = (bf16_t*)(big + B_AA);
  bf16_t* AG = (bf16_t*)(big + B_AG);
  const int lane = TIDX & 63, wave = TIDX >> 6;
  for (int n = bid * 8 + wave; n < NTOK; n += nb * 8) {
    const int b = n / LT, pos = n - b * LT;
    const bool lat = pos >= LC;
    const int t = pos - LC;
    const bf16_t* zr = Z + (size_t)n * 2560;
    const bool hasp = (pos != 0 && pos != LC), hasn = (pos != LC - 1 && pos != LT - 1);
    const bf16_t* zc = zr + 768;
    const uint4 rawq = *(const uint4*)(zr + (lane >> 3) * 64 + (lane & 7) * 8);
    uint4 rawkv = make_uint4(0, 0, 0, 0);
    if (lane < 32) rawkv = *(const uint4*)(zr + 512 + ((lane >> 3) & 3) * 64 + (lane & 7) * 8);
    uint2 cuA[7], puA[7], nuA[7];
#pragma unroll
    for (int i = 0; i < 7; i++) {
      const int j = i * 256 + lane * 4;
      cuA[i] = *(const uint2*)(zc + j);
      puA[i] = make_uint2(0, 0); nuA[i] = make_uint2(0, 0);
      if (hasp) puA[i] = *(const uint2*)(zc - 2560 + j);
      if (hasn) nuA[i] = *(const uint2*)(zc + 2560 + j);
    }
    {
      const int head = lane >> 3, e = lane & 7;
      float v[8]; unpack8(rawq, v);
      float ss = 0.f;
#pragma unroll
      for (int j = 0; j < 8; j++) ss += v[j] * v[j];
      ss += SHX(ss, 1); ss += SHX(ss, 2); ss += SHX(ss, 4);
      const float rs = rsqrtf(ss * (1.f / 64.f) + 1e-6f);
#pragma unroll
      for (int j = 0; j < 8; j++) v[j] = v[j] * rs * p.qg[e * 8 + j];
      if (lat) rope8(v, e, t, lane);
#pragma unroll
      for (int j = 0; j < 8; j++) v[j] *= 0.18033688011f;
      *(uint4*)(QN + ((size_t)(b * 8 + head) * LT + pos) * 64 + e * 8) = pack8(v);
    }
    {
      const int hh = (lane >> 3) & 3, e = lane & 7;
      float v[8]; unpack8(rawkv, v);
      float kv[8];
      float ss = 0.f;
#pragma unroll
      for (int j = 0; j < 8; j++) ss += v[j] * v[j];
      ss += SHX(ss, 1); ss += SHX(ss, 2); ss += SHX(ss, 4);
      const float rs = rsqrtf(ss * (1.f / 64.f) + 1e-6f);
#pragma unroll
      for (int j = 0; j < 8; j++) kv[j] = v[j] * rs * p.kg[e * 8 + j];
      if (lat) rope8(kv, e, t, lane);
      if (lane < 16) {
        *(uint4*)(KN + ((size_t)(b * 2 + hh) * LT + pos) * 64 + e * 8) = pack8(kv);
      } else if (lane < 32) {
        const int kvh = hh - 2;
#pragma unroll
        for (int j = 0; j < 8; j++) VT[((size_t)(b * 2 + kvh) * 64 + e * 8 + j) * LT + pos] = f2bf(v[j]);
      }
    }
#pragma unroll
    for (int i = 0; i < 7; i++) {
      const int j = i * 256 + lane * 4;
      const uint2 cu = cuA[i], pu = puA[i], nu = nuA[i];
      float4 m4 = *(const float4*)(p.mu + j);
      float cv[4] = {lo2f(cu.x), hi2f(cu.x), lo2f(cu.y), hi2f(cu.y)};
      float pv[4] = {lo2f(pu.x), hi2f(pu.x), lo2f(pu.y), hi2f(pu.y)};
      float nv[4] = {lo2f(nu.x), hi2f(nu.x), lo2f(nu.y), hi2f(nu.y)};
      float mm[4] = {m4.x, m4.y, m4.z, m4.w};
      float zm[4];
#pragma unroll
      for (int q = 0; q < 4; q++) zm[q] = cv[q] + mm[q] * (0.5f * (pv[q] + nv[q]) - cv[q]);
      if (i < 6) {
        const int cc = (i & 1) * 256 + lane * 4;
        const int head = cc >> 6, within = cc & 63;
        const size_t oidx = ((size_t)(b * 8 + head) * LT + pos) * 64 + within;
        uint2 o; o.x = pack2(zm[0], zm[1]); o.y = pack2(zm[2], zm[3]);
        if (i < 2) {
          *(uint2*)(R + oidx) = o;
        } else if (i < 4) {
          *(uint2*)(KB + oidx) = o;
          float4 kk4 = *(const float4*)(p.k_k + cc);
          float k0 = zm[0] * kk4.x, k1 = zm[1] * kk4.y, k2 = zm[2] * kk4.z, k3 = zm[3] * kk4.w;
          float ss = k0 * k0 + k1 * k1 + k2 * k2 + k3 * k3;
          ss += SHX(ss, 1); ss += SHX(ss, 2); ss += SHX(ss, 4); ss += SHX(ss, 8);
          const float inv = 1.f / fmaxf(sqrtf(ss), 1e-12f);
          uint2 o2; o2.x = pack2(k0 * inv, k1 * inv); o2.y = pack2(k2 * inv, k3 * inv);
          *(uint2*)(KK + oidx) = o2;
        } else {
          *(uint2*)(V + oidx) = o;
        }
      } else {
        if (lane < 16) {
          uint2 o; o.x = pack2(tanhf(zm[0]), tanhf(zm[1])); o.y = pack2(tanhf(zm[2]), tanhf(zm[3]));
          *(uint2*)(AW + (size_t)n * 64 + lane * 4) = o;
        } else if (lane < 32) {
          uint2 o; o.x = pack2(zm[0], zm[1]); o.y = pack2(zm[2], zm[3]);
          *(uint2*)(AA + (size_t)n * 64 + (lane - 16) * 4) = o;
        } else {
          uint2 o; o.x = pack2(sigmoidf_(zm[0]), sigmoidf_(zm[1])); o.y = pack2(sigmoidf_(zm[2]), sigmoidf_(zm[3]));
          *(uint2*)(AG + (size_t)n * 128 + (lane - 32) * 4) = o;
        }
      }
    }
  }
}

DI void lds_barrier() {
  asm volatile("s_waitcnt lgkmcnt(0)" ::: "memory");
  __builtin_amdgcn_s_barrier();
  asm volatile("" ::: "memory");
}
DI float reduce16(float v) {
  v += dpp_f(v, 0);
  v += dpp_f(v, 1);
  v += dpp_f(v, 2);
  v += __builtin_bit_cast(float, __builtin_amdgcn_mov_dpp(__builtin_bit_cast(int, v), 0x140, 0xF, 0xF, true));
  return v;
}
DI void reduce16_2(float& a, float& b) {
  a += dpp_f(a, 0); b += dpp_f(b, 0);
  a += dpp_f(a, 1); b += dpp_f(b, 1);
  a += dpp_f(a, 2); b += dpp_f(b, 2);
  a += __builtin_bit_cast(float, __builtin_amdgcn_mov_dpp(__builtin_bit_cast(int, a), 0x140, 0xF, 0xF, true));
  b += __builtin_bit_cast(float, __builtin_amdgcn_mov_dpp(__builtin_bit_cast(int, b), 0x140, 0xF, 0xF, true));
}
DI void wkv2_task(const int TIDX, const P& p, int task, char* smem) {
  char* big = p.ws + OFF_BIG;
  const int rh = task & 1, d = (task >> 1) & 1, h = (task >> 2) & 7, b = task >> 5;
  const bf16_t* R = (const bf16_t*)(big + B_R); const bf16_t* KB = (const bf16_t*)(big + B_KB);
  const bf16_t* KK = (const bf16_t*)(big + B_KK); const bf16_t* V = (const bf16_t*)(big + B_V);
  const bf16_t* AL = (const bf16_t*)(big + B_AL) + (size_t)d * NB * 8 * LT * 64;
  const float* DEC = (const float*)(big + B_DEC) + (size_t)d * NB * 8 * LT * 64;
  bf16_t* OUT = (bf16_t*)(big + B_OUT) + (size_t)d * NB * 8 * LT * 64;
  float* BON = (float*)(p.ws + OFF_BON) + (size_t)d * NB * 8 * LT;
  float* bufs = (float*)smem;
  float* outb = bufs + 2 * 6 * 2048;
  const int tid = TIDX;
  const int row = tid >> 4, ks = tid & 15;
  const int ls = tid >> 4, li = (tid & 15) * 4;
  const size_t hb = (size_t)(b * 8 + h) * LT;
  const float4 ka = *(const float4*)(p.k_a + h * 64 + li);
  const float4 rk = *(const float4*)(p.r_k + h * 64 + li);
  f32x2 S01 = {0.f, 0.f}, S23 = {0.f, 0.f};
  float pr[24];
  auto gload = [&](int chunk) {
    const int pos = scanpos(d, chunk * 32 + ls);
    const size_t e0 = (hb + pos) * 64 + li;
    const uint2 r4 = *(const uint2*)(R + e0), k4 = *(const uint2*)(KB + e0), kk4 = *(const uint2*)(KK + e0);
    const uint2 v4 = *(const uint2*)(V + e0), a4 = *(const uint2*)(AL + e0);
    const float4 dc = *(const float4*)(DEC + e0);
    const float a0 = lo2f(a4.x), a1 = hi2f(a4.x), a2 = lo2f(a4.y), a3 = hi2f(a4.y);
    const float q0 = lo2f(kk4.x), q1 = hi2f(kk4.x), q2 = lo2f(kk4.y), q3 = hi2f(kk4.y);
    pr[0] = lo2f(r4.x); pr[1] = hi2f(r4.x); pr[2] = lo2f(r4.y); pr[3] = hi2f(r4.y);
    pr[4] = dc.x; pr[5] = dc.y; pr[6] = dc.z; pr[7] = dc.w;
    pr[8] = lo2f(k4.x) * (1.f + (a0 - 1.f) * ka.x); pr[9] = hi2f(k4.x) * (1.f + (a1 - 1.f) * ka.y);
    pr[10] = lo2f(k4.y) * (1.f + (a2 - 1.f) * ka.z); pr[11] = hi2f(k4.y) * (1.f + (a3 - 1.f) * ka.w);
    pr[12] = lo2f(v4.x); pr[13] = hi2f(v4.x); pr[14] = lo2f(v4.y); pr[15] = hi2f(v4.y);
    pr[16] = -q0; pr[17] = -q1; pr[18] = -q2; pr[19] = -q3;
    pr[20] = q0 * a0; pr[21] = q1 * a1; pr[22] = q2 * a2; pr[23] = q3 * a3;
    float bp = pr[0] * pr[8] * rk.x + pr[1] * pr[9] * rk.y + pr[2] * pr[10] * rk.z + pr[3] * pr[11] * rk.w;
    bp = reduce16(bp);
    if (rh == 0 && (tid & 15) == 0) BON[hb + pos] = bp;
  };
  auto lstore = [&](int bufi) {
    float* bb = bufs + bufi * 6 * 2048 + ls * 64 + li;
#pragma unroll
    for (int q = 0; q < 6; q++) *(float4*)(bb + q * 2048) = make_float4(pr[4 * q], pr[4 * q + 1], pr[4 * q + 2], pr[4 * q + 3]);
  };
  __syncthreads();
  gload(0);
  lstore(0);
  __syncthreads();
  const int nch = LT / 32;
  for (int ch = 0; ch < nch; ch++) {
    const int cur = ch & 1;
    if (ch + 1 < nch) gload(ch + 1);
    const float* bb = bufs + cur * 6 * 2048;
    float* ob = outb + cur * 1024;
    const float* qb = bb + ks * 4;
    const float* vb = bb + 3 * 2048 + rh * 32 + row;
    float4 n_kn = *(const float4*)(qb + 4 * 2048), n_dc = *(const float4*)(qb + 1 * 2048), n_bv = *(const float4*)(qb + 5 * 2048);
    float4 n_kd = *(const float4*)(qb + 2 * 2048), n_rr = *(const float4*)(qb);
    float n_vv = vb[0];
    float upend = 0.f;
#pragma unroll 4
    for (int s = 0; s < 32; s++) {
      const float4 kn = n_kn, dc = n_dc, bv = n_bv, kd = n_kd, rr = n_rr;
      const float vv = n_vv;
      if (s + 1 < 32) {
        const float* q1 = qb + (s + 1) * 64;
        n_kn = *(const float4*)(q1 + 4 * 2048); n_dc = *(const float4*)(q1 + 1 * 2048); n_bv = *(const float4*)(q1 + 5 * 2048);
        n_kd = *(const float4*)(q1 + 2 * 2048); n_rr = *(const float4*)(q1);
        n_vv = vb[(s + 1) * 64];
      }
      f32x2 t = S01 * (f32x2){kn.x, kn.y};
      t = S23 * (f32x2){kn.z, kn.w} + t;
      float sa = t.x + t.y;
      reduce16_2(sa, upend);
      if (s > 0) ob[(s - 1) * 32 + row] = upend;
      const f32x2 sa2 = {sa, sa}, vv2 = {vv, vv};
      S01 = S01 * (f32x2){dc.x, dc.y} + sa2 * (f32x2){bv.x, bv.y} + vv2 * (f32x2){kd.x, kd.y};
      S23 = S23 * (f32x2){dc.z, dc.w} + sa2 * (f32x2){bv.z, bv.w} + vv2 * (f32x2){kd.z, kd.w};
      f32x2 u = S01 * (f32x2){rr.x, rr.y};
      u = S23 * (f32x2){rr.z, rr.w} + u;
      upend = u.x + u.y;
    }
    upend = reduce16(upend);
    ob[31 * 32 + row] = upend;
    if (ch + 1 < nch) lstore(cur ^ 1);
    lds_barrier();
    {
      const int idx = tid * 2, s = idx >> 5, r2 = idx & 31;
      const int pos = scanpos(d, ch * 32 + s);
      *(unsigned*)(OUT + (hb + pos) * 64 + rh * 32 + r2) = pack2(ob[idx], ob[idx + 1]);
    }
  }
  __syncthreads();
}
DI void wkv_finalize(const int TIDX, const P& p, int bid, int nb) {
  char* big = p.ws + OFF_BIG;
  const bf16_t* OUT = (const bf16_t*)(big + B_OUT);
  const float* BON = (const float*)(p.ws + OFF_BON);
  const bf16_t* V = (const bf16_t*)(big + B_V);
  const bf16_t* G = (const bf16_t*)(big + B_G);
  bf16_t* YM = (bf16_t*)(big + B_YMIX);
  const int lane = TIDX & 63, wave = TIDX >> 6;
  for (int item = bid * 8 + wave; item < NTOK * 8; item += nb * 8) {
    const int n = item >> 3, h = item & 7;
    const int b = n / LT, pos = n - b * LT;
    const size_t hb = (size_t)(b * 8 + h) * LT + pos;
    const int c = h * 64 + lane;
    const float vval = bf2f(V[hb * 64 + lane]);
    const float gw = p.gn_w[c], gb = p.gn_b[c];
    float y = 0.f;
#pragma unroll
    for (int d = 0; d < 2; d++) {
      const float o = bf2f(OUT[((size_t)d * NB * 8 * LT + hb) * 64 + lane]);
      const float mean = wave_sum_dpp(o, lane) * (1.f / 64.f);
      const float dd = o - mean;
      const float var = wave_sum_dpp(dd * dd, lane) * (1.f / 64.f);
      const float rstd = rsqrtf(var + 64e-5f);
      const float bon = BON[(size_t)d * NB * 8 * LT + hb];
      y += dd * rstd * gw + gb + bon * vval;
    }
    y *= bf2f(G[(size_t)n * 512 + c]);
    YM[(size_t)n * 1024 + 512 + c] = f2bf(y);
  }
}

DI void attn_body(const int TIDX, const P& p, int b, int head, int qt, char* smem);
DI void attn_task(const int TIDX, const P& p, int task, char* smem) {
  int b, head, qt;
  if (task < 512) { qt = 1 + (task & 7); head = (task >> 3) & 7; b = task >> 6; }
  else { int t2 = task - 512; qt = 0; head = t2 & 7; b = t2 >> 3; }
  attn_body(TIDX, p, b, head, qt, smem);
}
DI void attn_xcd(const int TIDX, const P& p, int bid, int nb, char* smem) {
  const int xcd = bid & 7, lb = bid >> 3, st = nb >> 3;
  for (int j = lb; j < 72; j += st) {
    int pair, head4, qt;
    if (j < 64) { pair = 2 * xcd + (j >> 5); head4 = (j & 31) >> 3; qt = 1 + (j & 7); }
    else { pair = 2 * xcd + ((j - 64) >> 2); head4 = (j - 64) & 3; qt = 0; }
    attn_body(TIDX, p, pair >> 1, (pair & 1) * 4 + head4, qt, smem);
  }
}
DI void attn_body(const int TIDX, const P& p, int b, int head, int qt, char* smem) {
  char* big = p.ws + OFF_BIG;
  const int kvh = head >> 2;
  const int nkt = (qt == 0 ? 256 : LT) / 64;
  bf16_t* Ks = (bf16_t*)smem;
  bf16_t* Vs = Ks + 2 * 64 * 72;
  const bf16_t* Kg = (const bf16_t*)(big + B_KN) + (size_t)(b * 2 + kvh) * LT * 64;
  const bf16_t* Vg = (const bf16_t*)(big + B_VT) + (size_t)(b * 2 + kvh) * 64 * LT;
  const bf16_t* QN = (const bf16_t*)(big + B_QN);
  bf16_t* YM = (bf16_t*)(big + B_YMIX);
  const int tid = TIDX, lane = tid & 63, wave = tid >> 6;
  const int r = lane & 31, h8 = lane >> 5;
  const int q0 = qt * 256 + wave * 32;
  bf16x8 qf[4];
#pragma unroll
  for (int kk = 0; kk < 4; kk++)
    qf[kk] = *(const bf16x8*)(QN + ((size_t)(b * 8 + head) * LT + q0 + r) * 64 + kk * 16 + h8 * 8);
  f32x16 o0, o1;
#pragma unroll
  for (int q = 0; q < 16; q++) { o0[q] = 0.f; o1[q] = 0.f; }
  float m = -1e30f, l = 0.f;
  const int lr = tid >> 3, lc = tid & 7;
  uint4 kreg = *(const uint4*)(Kg + (size_t)lr * 64 + lc * 8);
  uint4 vreg = *(const uint4*)(Vg + (size_t)lr * LT + lc * 8);
  __syncthreads();
  *(uint4*)(Ks + lr * 72 + lc * 8) = kreg;
  *(uint4*)(Vs + lr * 72 + lc * 8) = vreg;
  __syncthreads();
  for (int kt = 0; kt < nkt; kt++) {
    const int cur = kt & 1;
    if (kt + 1 < nkt) {
      kreg = *(const uint4*)(Kg + (size_t)((kt + 1) * 64 + lr) * 64 + lc * 8);
      vreg = *(const uint4*)(Vg + (size_t)lr * LT + (kt + 1) * 64 + lc * 8);
    }
    const bf16_t* Kc = Ks + cur * 64 * 72;
    const bf16_t* Vc = Vs + cur * 64 * 72;
    f32x16 s0, s1;
#pragma unroll
    for (int q = 0; q < 16; q++) { s0[q] = 0.f; s1[q] = 0.f; }
#pragma unroll
    for (int kk = 0; kk < 4; kk++) {
      bf16x8 a0 = *(const bf16x8*)(Kc + r * 72 + kk * 16 + h8 * 8);
      bf16x8 a1 = *(const bf16x8*)(Kc + (32 + r) * 72 + kk * 16 + h8 * 8);
      s0 = __builtin_amdgcn_mfma_f32_32x32x16_bf16(a0, qf[kk], s0, 0, 0, 0);
      s1 = __builtin_amdgcn_mfma_f32_32x32x16_bf16(a1, qf[kk], s1, 0, 0, 0);
    }
    float mx = s0[0];
#pragma unroll
    for (int q = 1; q < 16; q++) mx = fmaxf(mx, s0[q]);
#pragma unroll
    for (int q = 0; q < 16; q++) mx = fmaxf(mx, s1[q]);
    mx = fmaxf(mx, SHX(mx, 32));
    const float mnew = fmaxf(m, mx);
    const float alpha = __builtin_amdgcn_exp2f(m - mnew);
    float sum = 0.f;
#pragma unroll
    for (int q = 0; q < 16; q++) { s0[q] = __builtin_amdgcn_exp2f(s0[q] - mnew); sum += s0[q]; }
#pragma unroll
    for (int q = 0; q < 16; q++) { s1[q] = __builtin_amdgcn_exp2f(s1[q] - mnew); sum += s1[q]; }
    l = l * alpha + sum;
    m = mnew;
#pragma unroll
    for (int q = 0; q < 16; q++) { o0[q] *= alpha; o1[q] *= alpha; }
#pragma unroll
    for (int t = 0; t < 2; t++) {
#pragma unroll
      for (int s = 0; s < 2; s++) {
        union { bf16x8 v; unsigned u[4]; } pf;
#pragma unroll
        for (int q = 0; q < 4; q++) {
          float x0 = t ? s1[8 * s + 2 * q] : s0[8 * s + 2 * q];
          float x1 = t ? s1[8 * s + 2 * q + 1] : s0[8 * s + 2 * q + 1];
          pf.u[q] = pack2(x0, x1);
        }
        const int kb = 32 * t + 16 * s + 4 * h8;
        union { bf16x8 v; uint2 u[2]; } v0, v1;
        v0.u[0] = *(const uint2*)(Vc + r * 72 + kb);
        v0.u[1] = *(const uint2*)(Vc + r * 72 + kb + 8);
        v1.u[0] = *(const uint2*)(Vc + (32 + r) * 72 + kb);
        v1.u[1] = *(const uint2*)(Vc + (32 + r) * 72 + kb + 8);
        o0 = __builtin_amdgcn_mfma_f32_32x32x16_bf16(v0.v, pf.v, o0, 0, 0, 0);
        o1 = __builtin_amdgcn_mfma_f32_32x32x16_bf16(v1.v, pf.v, o1, 0, 0, 0);
      }
    }
    if (kt + 1 < nkt) {
      *(uint4*)(Ks + (cur ^ 1) * 64 * 72 + lr * 72 + lc * 8) = kreg;
      *(uint4*)(Vs + (cur ^ 1) * 64 * 72 + lr * 72 + lc * 8) = vreg;
    }
    __syncthreads();
  }
  l += SHX(l, 32);
  const float inv = 1.f / l;
  bf16_t* orow = YM + (size_t)(b * LT + q0 + r) * 1024 + head * 64;
#pragma unroll
  for (int g4 = 0; g4 < 4; g4++) {
    uint2 w0, w1;
    w0.x = pack2(o0[4 * g4] * inv, o0[4 * g4 + 1] * inv); w0.y = pack2(o0[4 * g4 + 2] * inv, o0[4 * g4 + 3] * inv);
    w1.x = pack2(o1[4 * g4] * inv, o1[4 * g4 + 1] * inv); w1.y = pack2(o1[4 * g4 + 2] * inv, o1[4 * g4 + 3] * inv);
    *(uint2*)(orow + 8 * g4 + 4 * h8) = w0;
    *(uint2*)(orow + 32 + 8 * g4 + 4 * h8) = w1;
  }
}

DI void route_task(const int TIDX, const P& p, int n0, char* smem) {
  char* big = p.ws + OFF_BIG;
  const float* S = (const float*)(big + B_S);
  int* EI = (int*)(big + B_EI);
  float* EG = (float*)(big + B_EG);
  float* sc = (float*)smem;
  float* sv = sc + 256 * 129;
  unsigned char* si = (unsigned char*)(sv + 256 * 16);
  const int tid = TIDX;
  __syncthreads();
  for (int e = tid; e < 256 * 128; e += NTHR) {
    int row = e >> 7, j = e & 127;
    sc[row * 129 + j] = S[(size_t)n0 * 2048 + e];
  }
  __syncthreads();
  if (tid < 256) {
    const float* rowp = sc + tid * 129;
    float pv = __builtin_inff();
    int pi = -1;
    for (int k = 0; k < 16; k++) {
      float bv = -__builtin_inff();
      int bi = 0;
      for (int j = 0; j < 128; j++) {
        float x = rowp[j];
        bool elig = (x < pv) || (x == pv && j > pi);
        if (elig && x > bv) { bv = x; bi = j; }
      }
      sv[tid * 16 + k] = bv;
      si[tid * 16 + k] = (unsigned char)bi;
      pv = bv; pi = bi;
    }
  }
  __syncthreads();
  if (tid < 128) {
    const int tl = tid >> 3, head = tid & 7;
    const int r0 = tl * 16 + head * 2, r1 = r0 + 1;
    const float* a = sv + r0 * 16;
    const float* bq = sv + r1 * 16;
    float* eg = sc + tid * 17;
    const int n = n0 + tl;
    float pv = __builtin_inff();
    int pc = -1;
    float mx = 0.f, sum = 0.f;
    for (int k = 0; k < 16; k++) {
      float bv = -__builtin_inff();
      int bc = 0;
      for (int i = 0; i < 16; i++) {
        const int jn = 16 / (i + 1);
        const float ai = a[i];
        for (int j = 0; j < jn; j++) {
          float x = ai + bq[j];
          int c = i * 16 + j;
          bool elig = (x < pv) || (x == pv && c > pc);
          if (elig && x > bv) { bv = x; bc = c; }
        }
      }
      if (k == 0) mx = bv;
      float ev = __expf(bv - mx);
      sum += ev;
      eg[k] = ev;
      EI[(size_t)n * 128 + head * 16 + k] = (int)si[r0 * 16 + (bc >> 4)] * 128 + (int)si[r1 * 16 + (bc & 15)];
      pv = bv; pc = bc;
    }
    const float inv = 1.f / sum;
    for (int k = 0; k < 16; k++) EG[(size_t)n * 128 + head * 16 + k] = eg[k] * inv;
  }
}


DI int f2ord(float f) { int s = __float_as_int(f); return s ^ ((s >> 31) & 0x7fffffff); }
DI float ord2f(int s) { return __int_as_float(s ^ ((s >> 31) & 0x7fffffff)); }
DI void ce_desc(int& a, int& b) { int hi = max(a, b), lo = min(a, b); a = hi; b = lo; }
template <int N>
DI void bsort_desc(int* v) {
#pragma unroll
  for (int k = 2; k <= N; k <<= 1)
#pragma unroll
    for (int j = k >> 1; j > 0; j >>= 1)
#pragma unroll
      for (int i = 0; i < N; i++) {
        const int l = i ^ j;
        if (l > i) {
          if ((i & k) == 0) ce_desc(v[i], v[l]); else ce_desc(v[l], v[i]);
        }
      }
}
DI void merge16(int* a, const int* b) {
#pragma unroll
  for (int i = 0; i < 16; i++) a[i] = max(a[i], b[15 - i]);
#pragma unroll
  for (int j = 8; j > 0; j >>= 1)
#pragma unroll
    for (int i = 0; i < 16; i++) {
      const int l = i ^ j;
      if (l > i) ce_desc(a[i], a[l]);
    }
}
DI void top16_of_64(int* v) {
  bsort_desc<16>(v); bsort_desc<16>(v + 16); bsort_desc<16>(v + 32); bsort_desc<16>(v + 48);
  merge16(v, v + 16); merge16(v + 32, v + 48); merge16(v, v + 32);
}
DI void route2_task(const int TIDX, const P& p, int layer, int m0, int head, char* smem, const bool load_keys = true) {
  char* big = p.ws + OFF_BIG;
  const bf16_t* QP = (const bf16_t*)(big + B_QP);
  int* EI = (int*)(big + B_EI);
  float* EG = (float*)(big + B_EG);
  bf16_t* Ks = (bf16_t*)smem;
  unsigned char* sidx = (unsigned char*)(Ks + 256 * 136);
  const bf16_t* keys = (const bf16_t*)(p.ws + OFF_KEYS) + (size_t)(layer * 16 + head * 2) * 128 * 128;
  const int tid = TIDX, lane = tid & 63, wave = tid >> 6;
  const int r = lane & 31, h8 = lane >> 5;
  __syncthreads();
  if (load_keys) {
    const int row = tid >> 1, half = tid & 1;
#pragma unroll
    for (int q = 0; q < 8; q++)
      *(uint4*)(Ks + row * 136 + half * 64 + q * 8) = *(const uint4*)(keys + (size_t)row * 128 + half * 64 + q * 8);
  }
  __syncthreads();
  const int tok = m0 + wave * 32 + r;
  int la[16], lb[16];
#pragma unroll
  for (int pp = 0; pp < 2; pp++) {
    bf16x8 qf[8];
#pragma unroll
    for (int ks = 0; ks < 8; ks++)
      qf[ks] = *(const bf16x8*)(QP + (size_t)tok * 2048 + head * 256 + pp * 128 + ks * 16 + h8 * 8);
    int v[64];
#pragma unroll
    for (int kt = 0; kt < 4; kt++) {
      f32x16 acc;
#pragma unroll
      for (int q = 0; q < 16; q++) acc[q] = 0.f;
#pragma unroll
      for (int ks = 0; ks < 8; ks++) {
        bf16x8 a = *(const bf16x8*)(Ks + (pp * 128 + kt * 32 + r) * 136 + ks * 16 + h8 * 8);
        acc = __builtin_amdgcn_mfma_f32_32x32x16_bf16(a, qf[ks], acc, 0, 0, 0);
      }
#pragma unroll
      for (int q = 0; q < 16; q++) v[kt * 16 + q] = (f2ord(acc[q]) & ~127) | (kt * 32 + (q & 3) + 8 * (q >> 2) + 4 * h8);
    }
    top16_of_64(v);
    int pr[16];
#pragma unroll
    for (int i = 0; i < 16; i++) pr[i] = __builtin_amdgcn_ds_bpermute((lane ^ 32) << 2, v[i]);
    merge16(v, pr);
#pragma unroll
    for (int i = 0; i < 16; i++) { if (pp == 0) la[i] = v[i]; else lb[i] = v[i]; }
  }
  {
    unsigned* sw = (unsigned*)(sidx + tid * 32);
#pragma unroll
    for (int i = 0; i < 4; i++) {
      sw[i] = (la[4 * i] & 127) | ((la[4 * i + 1] & 127) << 8) | ((la[4 * i + 2] & 127) << 16) | ((la[4 * i + 3] & 127) << 24);
      sw[4 + i] = (lb[4 * i] & 127) | ((lb[4 * i + 1] & 127) << 8) | ((lb[4 * i + 2] & 127) << 16) | ((lb[4 * i + 3] & 127) << 24);
    }
  }
  float fa[16], fb[16];
#pragma unroll
  for (int i = 0; i < 16; i++) { fa[i] = ord2f(la[i]); fb[i] = ord2f(lb[i]); }
  int c[64];
  {
    int cnt = 0;
#pragma unroll
    for (int i = 0; i < 16; i++)
#pragma unroll
      for (int j = 0; j < 16; j++)
        if ((i + 1) * (j + 1) <= 16) { c[cnt] = (f2ord(fa[i] + fb[j]) & ~255) | (i * 16 + j); cnt++; }
#pragma unroll
    for (int q = 50; q < 64; q++) c[q] = (int)0x80000000;
  }
  top16_of_64(c);
  const float mx = ord2f(c[0]);
  float ev[16], sum = 0.f;
#pragma unroll
  for (int k = 0; k < 16; k++) { ev[k] = __expf(ord2f(c[k]) - mx); sum += ev[k]; }
  const float inv = 1.f / sum;
  const size_t ob = (size_t)tok * 128 + head * 16;
#pragma unroll
  for (int k = 0; k < 16; k++) {
    const int code = c[k] & 255;
    const int ia = sidx[tid * 32 + (code >> 4)], ib = sidx[tid * 32 + 16 + (code & 15)];
    if (h8 == 0) EI[ob + k] = ia * 128 + ib; else EG[ob + k] = ev[k] * inv;
  }
}

DI void peer_u2(const int TIDX, const P& p, bool last, int bid, int nb) {
  char* big = p.ws + OFF_BIG;
  const int* EI = (const int*)(big + B_EI);
  float* ACT = (float*)(big + B_S);
  const unsigned char* UB = (const unsigned char*)(p.ws + OFF_UB);
  const float* US = (const float*)(p.ws + OFF_UB + 16777216);
  const bf16_t* H = (const bf16_t*)(p.ws + OFF_H);
  const int lane = TIDX & 63, wave = TIDX >> 6;
  const bool dry = false;
  for (int n = bid * 8 + wave; n < NTOK; n += nb * 8) {
    const int b = n / LT, pos = n - b * LT;
    if (last && pos < LC) continue;
    float hv[16];
    {
      uint4 h0 = *(const uint4*)(H + (size_t)n * DM + lane * 16);
      uint4 h1 = *(const uint4*)(H + (size_t)n * DM + lane * 16 + 8);
      unpack8(h0, hv); unpack8(h1, hv + 8);
    }
    const int id_lo = EI[(size_t)n * 128 + lane], id_hi = EI[(size_t)n * 128 + 64 + lane];
    const float us_lo = US[id_lo], us_hi = US[id_hi];
    float act_lo = 0.f, act_hi = 0.f;
#pragma unroll 1
    for (int half = 0; half < 2; half++) {
      const int idv = half ? id_hi : id_lo;
      float actv = 0.f;
#pragma unroll 8
      for (int e = 0; e < 64; e++) {
        const int id = __builtin_amdgcn_readlane(idv, e);
        const uint4 w = *(const uint4*)(UB + (size_t)id * 1024 + lane * 16);
        float uv[16];
        cvt16_fp8(w, uv);
        float d0 = 0.f, d1 = 0.f;
#pragma unroll
        for (int j = 0; j < 8; j++) { d0 += hv[j] * uv[j]; d1 += hv[8 + j] * uv[8 + j]; }
        const float dsum = wave_sum_dpp(d0 + d1, lane);
        if (lane == e) actv = dsum;
      }
      if (half) act_hi = actv; else act_lo = actv;
    }
    ACT[(size_t)n * 128 + lane] = act_lo * us_lo;
    ACT[(size_t)n * 128 + 64 + lane] = act_hi * us_hi;
  }
}

DI void peer_gather(const int TIDX, const P& p, int layer, bool last, int bid, int nb, const bool dry) {
  char* big = p.ws + OFF_BIG;
  const int* EI = (const int*)(big + B_EI);
  const float* EG = (const float*)(big + B_EG);
  const unsigned char* UB = (const unsigned char*)(p.ws + OFF_UB);
  const unsigned char* VB = (const unsigned char*)(p.ws + OFF_VB);
  const float* ACT = (const float*)(big + B_S);
  const float* VS = (const float*)(p.ws + OFF_VB + 16777216);
  const bf16_t* H = (const bf16_t*)(p.ws + OFF_H);
  const float* X = (const float*)(p.ws + OFF_X);
  bf16_t* Hw = dry ? (bf16_t*)(big + B_QP) : (bf16_t*)(p.ws + OFF_H);
  float* Xw = dry ? (float*)(big + B_S + 16777216) : (float*)(p.ws + OFF_X);
  const float* mod = (const float*)(p.ws + OFF_MOD);
  const int lane = TIDX & 63, wave = TIDX >> 6;
  for (int n = bid * 8 + wave; n < NTOK; n += nb * 8) {
    const int b = n / LT, pos = n - b * LT;
    if (last && pos < LC) continue;
    const int id_lo = EI[(size_t)n * 128 + lane], id_hi = EI[(size_t)n * 128 + 64 + lane];
    const float g_lo = EG[(size_t)n * 128 + lane], g_hi = EG[(size_t)n * 128 + 64 + lane];
    const float vs_lo = VS[id_lo], vs_hi = VS[id_hi];
    const float act_lo = ACT[(size_t)n * 128 + lane], act_hi = ACT[(size_t)n * 128 + 64 + lane];
    const float cf_lo = g_lo * 0.5f * act_lo * (1.f + erff(act_lo * 0.70710678f)) * vs_lo;
    const float cf_hi = g_hi * 0.5f * act_hi * (1.f + erff(act_hi * 0.70710678f)) * vs_hi;
    float acc[16];
#pragma unroll
    for (int j = 0; j < 16; j++) acc[j] = 0.f;
#pragma unroll 1
    for (int half = 0; half < 2; half++) {
      const int idv = half ? id_hi : id_lo;
      const float cfv = half ? cf_hi : cf_lo;
#pragma unroll 8
      for (int e = 0; e < 64; e++) {
        const int id = __builtin_amdgcn_readlane(idv, e);
        const float cf = __builtin_bit_cast(float, __builtin_amdgcn_readlane(__builtin_bit_cast(int, cfv), e));
        const uint4 w = *(const uint4*)(VB + (size_t)id * 1024 + lane * 16);
        float uv[16];
        cvt16_fp8(w, uv);
#pragma unroll
        for (int j = 0; j < 16; j++) acc[j] += cf * uv[j];
      }
    }
    const int rr = pos < LC ? 8 : b;
    const float* gate = mod + (size_t)(layer * 9 + rr) * 6144 + 5 * 1024 + lane * 16;
    const float* xr = X + (size_t)n * DM + lane * 16;
    float xo[16];
#pragma unroll
    for (int q = 0; q < 4; q++) {
      float4 x0 = *(const float4*)(xr + q * 4), g0 = *(const float4*)(gate + q * 4);
      xo[q * 4 + 0] = x0.x + g0.x * acc[q * 4 + 0]; xo[q * 4 + 1] = x0.y + g0.y * acc[q * 4 + 1];
      xo[q * 4 + 2] = x0.z + g0.z * acc[q * 4 + 2]; xo[q * 4 + 3] = x0.w + g0.w * acc[q * 4 + 3];
    }
    if (last) {
      float* orow = p.out + ((size_t)(b * SEQ + pos - LC)) * DM + lane * 16;
#pragma unroll
      for (int q = 0; q < 4; q++) *(float4*)(orow + q * 4) = make_float4(xo[q * 4], xo[q * 4 + 1], xo[q * 4 + 2], xo[q * 4 + 3]);
    } else {
      float ss = 0.f;
#pragma unroll
      for (int j = 0; j < 16; j++) ss += xo[j] * xo[j];
      ss = wave_sum(ss);
      const float rs = rsqrtf(ss * (1.f / 1024.f) + 1e-6f);
      const float* g = p.n1g + (layer + 1) * 1024 + lane * 16;
      const float* msc = mod + (size_t)((layer + 1) * 9 + rr) * 6144 + 1 * 1024 + lane * 16;
      const float* msh = mod + (size_t)((layer + 1) * 9 + rr) * 6144 + lane * 16;
      float* xw = Xw + (size_t)n * DM + lane * 16;
#pragma unroll
      for (int q = 0; q < 4; q++) *(float4*)(xw + q * 4) = make_float4(xo[q * 4], xo[q * 4 + 1], xo[q * 4 + 2], xo[q * 4 + 3]);
      float y[16];
#pragma unroll
      for (int j = 0; j < 16; j++) y[j] = xo[j] * rs * g[j] * (1.f + msc[j]) + msh[j];
      *(uint4*)(Hw + (size_t)n * DM + lane * 16) = pack8(y);
      *(uint4*)(Hw + (size_t)n * DM + lane * 16 + 8) = pack8(y + 8);
    }
  }
}

DI void conv_phase(const int TIDX, const P& p, int bid, int nb) {
  char* big = p.ws + OFF_BIG;
  const bf16_t* ZX = (const bf16_t*)(big + B_ZX);
  bf16_t* XBC = (bf16_t*)(big + B_XBC);
  const int total = NTOK * 384;
  for (int it = bid * NTHR + TIDX; it < total; it += nb * NTHR) {
    const int n = it / 384, c8 = (it - n * 384) * 8;
    const int b = n / LT, pos = n - b * LT;
    const bool hasp = (pos != 0 && pos != LC), hasn = (pos != LC - 1 && pos != LT - 1);
    const bf16_t* zc = ZX + (size_t)n * 3072 + c8;
    uint4 cu = *(const uint4*)zc, pu = make_uint4(0, 0, 0, 0), nu = make_uint4(0, 0, 0, 0);
    if (hasp) pu = *(const uint4*)(zc - 3072);
    if (hasn) nu = *(const uint4*)(zc + 3072);
    float cv[8], pv[8], nv[8], y[8];
    unpack8(cu, cv); unpack8(pu, pv); unpack8(nu, nv);
#pragma unroll
    for (int j = 0; j < 8; j++) {
      float a = p.conv_b[c8 + j] + p.conv_w[c8 + j] * pv[j] + p.conv_w[3072 + c8 + j] * cv[j] + p.conv_w[6144 + c8 + j] * nv[j];
      y[j] = siluf_(a);
    }
    *(uint4*)(XBC + (size_t)n * 3072 + c8) = pack8(y);
  }
}

DI void ssd_task(const int TIDX, const P& p, int task, char* smem) {
  char* big = p.ws + OFF_BIG;
  const int b = task >> 5, h = task & 31, g = h >> 3;
  bf16_t* Cs = (bf16_t*)smem;
  bf16_t* Bs = Cs + 128 * 136;
  bf16_t* BT = Bs + 128 * 136;
  bf16_t* xT = BT + 128 * 136;
  bf16_t* sb = xT + 64 * 136;
  float* cumb = (float*)(sb + 64 * 136);
  float* dtvb = cumb + 256;
  const bf16_t* XBC = (const bf16_t*)(big + B_XBC);
  const float* DT = (const float*)(big + B_DT);
  bf16_t* Y = (bf16_t*)(big + B_Y);
  const int tid = TIDX, lane = tid & 63, wave = tid >> 6;
  const int r = lane & 31, h8 = lane >> 5;
  const float dskip = p.ssd_d[h];
  const int lj = tid >> 2, lpart = tid & 3;
  uint4 pc0, pc1, pc2, pc3, pb0, pb1, pb2, pb3, px0, px1;
  float pdt0 = 0.f, pdt1 = 0.f;
  auto prefetch = [&](int itn) {
    const int dn = itn >= 18 ? 1 : 0, cn = itn - dn * 18;
    const int pos = scanpos(dn, cn * 128 + lj);
    const bf16_t* rowp = XBC + (size_t)(b * LT + pos) * 3072;
    const bf16_t* cp = rowp + 2560 + g * 128 + lpart * 32;
    const bf16_t* bp = rowp + 2048 + g * 128 + lpart * 32;
    const bf16_t* xp = rowp + h * 64 + lpart * 16;
    pc0 = *(const uint4*)(cp); pc1 = *(const uint4*)(cp + 8); pc2 = *(const uint4*)(cp + 16); pc3 = *(const uint4*)(cp + 24);
    pb0 = *(const uint4*)(bp); pb1 = *(const uint4*)(bp + 8); pb2 = *(const uint4*)(bp + 16); pb3 = *(const uint4*)(bp + 24);
    px0 = *(const uint4*)(xp); px1 = *(const uint4*)(xp + 8);
    if (wave == 1) {
      const int p0 = scanpos(dn, cn * 128 + lane * 2), p1 = scanpos(dn, cn * 128 + lane * 2 + 1);
      pdt0 = DT[(size_t)(b * LT + p0) * 64 + dn * 32 + h];
      pdt1 = DT[(size_t)(b * LT + p1) * 64 + dn * 32 + h];
    }
  };
  const float aA[2] = {-expf(p.a_log[h]), -expf(p.a_log[32 + h])};
  const float biasA[2] = {p.dt_bias[h], p.dt_bias[32 + h]};
  auto cumcalc = [&](int itn) {
    const int dn = itn >= 18 ? 1 : 0;
    const float an = dn ? aA[1] : aA[0], bn = dn ? biasA[1] : biasA[0];
    float* cw = cumb + (itn & 1) * 128;
    float* dw = dtvb + (itn & 1) * 128;
    const int i0 = lane * 2, i1 = i0 + 1;
    const float dt0 = softplusf_(pdt0 + bn), dt1 = softplusf_(pdt1 + bn);
    const float a0 = an * dt0, a1 = a0 + an * dt1;
    float tot = a1;
#pragma unroll
    for (int off = 1; off < 64; off <<= 1) {
      float t = shup_(tot, off, lane);
      if (lane >= off) tot += t;
    }
    const float excl = tot - a1;
    cw[i0] = excl + a0; cw[i1] = excl + a1;
    dw[i0] = dt0; dw[i1] = dt1;
  };
  __syncthreads();
  prefetch(0);
  if (wave == 1) cumcalc(0);
  f32x16 sacc;
  for (int it = 0; it < 36; it++) {
    const int d = it >= 18 ? 1 : 0, c = it - d * 18;
    const float* cum = cumb + (it & 1) * 128;
    const float* dtv = dtvb + (it & 1) * 128;
    lds_barrier();
    if (c == 0) {
#pragma unroll
      for (int q = 0; q < 16; q++) sacc[q] = 0.f;
      for (int e = tid; e < 64 * 136; e += NTHR) sb[e] = 0;
    }
    const float cl = cum[127];
    {
      const int j = lj;
      const float wj = __expf(cl - cum[j]) * dtv[j];
      const int col0 = lpart * 32;
      *(uint4*)(Cs + j * 136 + col0) = pc0; *(uint4*)(Cs + j * 136 + col0 + 8) = pc1;
      *(uint4*)(Cs + j * 136 + col0 + 16) = pc2; *(uint4*)(Cs + j * 136 + col0 + 24) = pc3;
      *(uint4*)(Bs + j * 136 + col0) = pb0; *(uint4*)(Bs + j * 136 + col0 + 8) = pb1;
      *(uint4*)(Bs + j * 136 + col0 + 16) = pb2; *(uint4*)(Bs + j * 136 + col0 + 24) = pb3;
      float bf[8];
      unpack8(pb0, bf);
#pragma unroll
      for (int e = 0; e < 8; e++) BT[(col0 + e) * 136 + j] = f2bf(bf[e] * wj);
      unpack8(pb1, bf);
#pragma unroll
      for (int e = 0; e < 8; e++) BT[(col0 + 8 + e) * 136 + j] = f2bf(bf[e] * wj);
      unpack8(pb2, bf);
#pragma unroll
      for (int e = 0; e < 8; e++) BT[(col0 + 16 + e) * 136 + j] = f2bf(bf[e] * wj);
      unpack8(pb3, bf);
#pragma unroll
      for (int e = 0; e < 8; e++) BT[(col0 + 24 + e) * 136 + j] = f2bf(bf[e] * wj);
      const int xc0 = lpart * 16;
      {
        const unsigned w[8] = {px0.x, px0.y, px0.z, px0.w, px1.x, px1.y, px1.z, px1.w};
#pragma unroll
        for (int e = 0; e < 8; e++) {
          xT[(xc0 + 2 * e) * 136 + j] = (bf16_t)(w[e] & 0xffffu);
          xT[(xc0 + 2 * e + 1) * 136 + j] = (bf16_t)(w[e] >> 16);
        }
      }
    }
    if (it + 1 < 36) prefetch(it + 1);
    lds_barrier();
    if (wave == 1 && it + 1 < 36) cumcalc(it + 1);
    const int itl = wave >> 1;
    if (c >= 2) {
    f32x16 G0, G1;
#pragma unroll
    for (int q = 0; q < 16; q++) { G0[q] = 0.f; G1[q] = 0.f; }
    {
      const int jt0 = (wave & 1) * 2, jt1 = jt0 + 1;
      if (jt0 <= itl) {
#pragma unroll
        for (int ks = 0; ks < 8; ks++) {
          bf16x8 av = *(const bf16x8*)(Cs + (itl * 32 + r) * 136 + ks * 16 + h8 * 8);
          bf16x8 b0 = *(const bf16x8*)(Bs + (jt0 * 32 + r) * 136 + ks * 16 + h8 * 8);
          G0 = __builtin_amdgcn_mfma_f32_32x32x16_bf16(av, b0, G0, 0, 0, 0);
          if (jt1 <= itl) {
            bf16x8 b1 = *(const bf16x8*)(Bs + (jt1 * 32 + r) * 136 + ks * 16 + h8 * 8);
            G1 = __builtin_amdgcn_mfma_f32_32x32x16_bf16(av, b1, G1, 0, 0, 0);
          }
        }
      }
    }
    lds_barrier();
    {
      bf16_t* Ms = Bs;
      const int jt0 = (wave & 1) * 2;
      const int j0 = jt0 * 32 + r, j1 = j0 + 32;
      const float cj0 = cum[j0], cj1 = cum[j1], dj0 = dtv[j0], dj1 = dtv[j1];
#pragma unroll
      for (int q = 0; q < 16; q++) {
        const int i = itl * 32 + (q & 3) + 8 * (q >> 2) + 4 * h8;
        const float ci = cum[i];
        float m0 = (j0 <= i) ? G0[q] * __expf(ci - cj0) * dj0 : 0.f;
        float m1 = (j1 <= i) ? G1[q] * __expf(ci - cj1) * dj1 : 0.f;
        Ms[i * 136 + j0] = f2bf(m0);
        Ms[i * 136 + j1] = f2bf(m1);
      }
    }
    lds_barrier();
    {
      const bf16_t* Ms = Bs;
      const int pt = wave & 1;
      const int pp = pt * 32 + r;
      bf16_t yold[16];
      if (d == 1 && c >= 2) {
#pragma unroll
        for (int q = 0; q < 16; q++) {
          const int i = itl * 32 + (q & 3) + 8 * (q >> 2) + 4 * h8;
          const int pos = scanpos(1, c * 128 + i);
          yold[q] = Y[(size_t)(b * LT + pos) * 2048 + h * 64 + pp];
        }
      }
      f32x16 yd, yo;
#pragma unroll
      for (int q = 0; q < 16; q++) { yd[q] = 0.f; yo[q] = 0.f; }
#pragma unroll
      for (int ks = 0; ks < 8; ks++) {
        if (ks < (itl + 1) * 2) {
          bf16x8 av = *(const bf16x8*)(Ms + (itl * 32 + r) * 136 + ks * 16 + h8 * 8);
          bf16x8 bv = *(const bf16x8*)(xT + (pt * 32 + r) * 136 + ks * 16 + h8 * 8);
          yd = __builtin_amdgcn_mfma_f32_32x32x16_bf16(av, bv, yd, 0, 0, 0);
        }
        bf16x8 cv = *(const bf16x8*)(Cs + (itl * 32 + r) * 136 + ks * 16 + h8 * 8);
        bf16x8 sv = *(const bf16x8*)(sb + (pt * 32 + r) * 136 + ks * 16 + h8 * 8);
        yo = __builtin_amdgcn_mfma_f32_32x32x16_bf16(cv, sv, yo, 0, 0, 0);
      }
      if (c >= 2) {
#pragma unroll
        for (int q = 0; q < 16; q++) {
          const int i = itl * 32 + (q & 3) + 8 * (q >> 2) + 4 * h8;
          float y = yd[q] + __expf(cum[i]) * yo[q];
          const int pos = scanpos(d, c * 128 + i);
          const size_t idx = (size_t)(b * LT + pos) * 2048 + h * 64 + pp;
          if (d == 0) y += dskip * bf2f(xT[pp * 136 + i]);
          else y += bf2f(yold[q]);
          Y[idx] = f2bf(y);
        }
      }
    }
    lds_barrier();
    }
    {
      const int pt = wave & 1, nt = wave >> 1;
      const float ecl = __expf(cl);
#pragma unroll
      for (int q = 0; q < 16; q++) sacc[q] *= ecl;
#pragma unroll
      for (int ks = 0; ks < 8; ks++) {
        bf16x8 av = *(const bf16x8*)(xT + (pt * 32 + r) * 136 + ks * 16 + h8 * 8);
        bf16x8 bv = *(const bf16x8*)(BT + (nt * 32 + r) * 136 + ks * 16 + h8 * 8);
        sacc = __builtin_amdgcn_mfma_f32_32x32x16_bf16(av, bv, sacc, 0, 0, 0);
      }
#pragma unroll
      for (int q = 0; q < 16; q++) {
        const int pp = pt * 32 + (q & 3) + 8 * (q >> 2) + 4 * h8;
        sb[pp * 136 + nt * 32 + r] = f2bf(sacc[q]);
      }
    }
  }
  __syncthreads();
}

DI void gate_norm(const int TIDX, const P& p, int bid, int nb) {
  char* big = p.ws + OFF_BIG;
  const bf16_t* Y = (const bf16_t*)(big + B_Y);
  const bf16_t* ZG = (const bf16_t*)(big + B_ZG);
  bf16_t* YN = (bf16_t*)(big + B_YN);
  const int lane = TIDX & 63, wave = TIDX >> 6;
  const int ntok = NB * SEQ, nw = nb * 8;
  for (int it = bid * 8 + wave; it < ntok; it += 2 * nw) {
    uint4 yv[2][4], zv[2][4];
    int nn[2];
    bool val[2];
#pragma unroll
    for (int t = 0; t < 2; t++) {
      int ti = it + t * nw;
      val[t] = ti < ntok;
      if (!val[t]) ti = it;
      nn[t] = (ti >> 11) * LT + LC + (ti & 2047);
#pragma unroll
      for (int gq = 0; gq < 4; gq++) {
        yv[t][gq] = *(const uint4*)(Y + (size_t)nn[t] * 2048 + gq * 512 + lane * 8);
        zv[t][gq] = *(const uint4*)(ZG + (size_t)nn[t] * 2048 + gq * 512 + lane * 8);
      }
    }
#pragma unroll
    for (int t = 0; t < 2; t++) {
      if (!val[t]) continue;
#pragma unroll
      for (int gq = 0; gq < 4; gq++) {
        const int base = gq * 512 + lane * 8;
        float y[8], z[8];
        unpack8(yv[t][gq], y); unpack8(zv[t][gq], z);
        float ss = 0.f;
#pragma unroll
        for (int j = 0; j < 8; j++) { y[j] = y[j] * siluf_(z[j]); ss += y[j] * y[j]; }
        ss = wave_sum_dpp(ss, lane);
        const float rs = rsqrtf(ss * (1.f / 512.f) + 1e-6f);
#pragma unroll
        for (int j = 0; j < 8; j++) y[j] = y[j] * rs * p.ssd_nw[base + j];
        *(uint4*)(YN + (size_t)nn[t] * 2048 + base) = pack8(y);
      }
    }
  }
}

#define XB_TMO      128
#define XB_XCNT(j)  (256  + 64 * (j))
#define XB_XSUB(j)  (1280 + 64 * (j))
#define XB_XGEN(j)  (2304 + 64 * (j))
#define XB_TOP      3328
#define XB_TOPGEN   3392
#define XCD_BAR_WORDS 3456
#define XB_SPIN_CAP (1u << 18)
#define LAS __attribute__((address_space(3)))
DI unsigned xb_ld(unsigned* p) { return __hip_atomic_load(p, __ATOMIC_RELAXED, __HIP_MEMORY_SCOPE_AGENT); }
DI unsigned xb_add(unsigned* p, unsigned v) { return __hip_atomic_fetch_add(p, v, __ATOMIC_RELAXED, __HIP_MEMORY_SCOPE_AGENT); }
DI unsigned xb_xcc_id() { return (unsigned)__builtin_amdgcn_s_getreg((3 << 11) | 20) & 0xFu; }
#define XB_SPIN(cond, bar) do { unsigned _sp = 0; while (cond) { __builtin_amdgcn_s_sleep(1); \
    if ((++_sp & 255u) == 0u) { if (xb_ld(&(bar)[XB_TMO])) break; if (_sp > XB_SPIN_CAP) { atomicAdd(&(bar)[XB_TMO], 1u); break; } } } } while (0)
struct XcdBarrier { unsigned* bar; unsigned x; volatile LAS unsigned* st; };
DI XcdBarrier xcd_barrier_post(unsigned* bar, volatile LAS unsigned* st) {
  XcdBarrier b; b.bar = bar; b.x = xb_xcc_id(); b.st = st;
  if (threadIdx.x == 0) (void)xb_add(&bar[XB_XCNT(b.x)], 1u);
  return b;
}
DI void xcd_barrier_complete(unsigned* bar, unsigned x, unsigned& nloc, unsigned& nx) {
  const unsigned G = gridDim.x * gridDim.y * gridDim.z;
  unsigned sum, cnt, mine, sp = 0u;
  for (;;) {
    sum = 0u; cnt = 0u; mine = 0u;
#pragma unroll
    for (unsigned j = 0; j < 16; ++j) { const unsigned c = xb_ld(&bar[XB_XCNT(j)]); sum += c; cnt += (c > 0u) ? 1u : 0u; mine = (j == x) ? c : mine; }
    if (sum == G) break;
    __builtin_amdgcn_s_sleep(1);
    if ((++sp & 255u) == 0u) { if (xb_ld(&bar[XB_TMO])) break; if (sp > XB_SPIN_CAP) { atomicAdd(&bar[XB_TMO], 1u); break; } }
  }
  nloc = mine > 0u ? mine : 1u; nx = cnt > 0u ? cnt : 1u;
}
DI void xcd_barrier(const XcdBarrier& b) {
  asm volatile("s_waitcnt vmcnt(0)" ::: "memory");
  __syncthreads();
  if (threadIdx.x == 0) {
    unsigned* bar = b.bar;
    __builtin_amdgcn_s_waitcnt(0);
    unsigned nloc = b.st[0], nx = b.st[1];
    if (nloc == 0u) { xcd_barrier_complete(bar, b.x, nloc, nx); b.st[0] = nloc; b.st[1] = nx; }
    const unsigned old = xb_add(&bar[XB_XSUB(b.x)], 1u);
    const unsigned gen = old / nloc;
    if (old + 1u == (gen + 1u) * nloc) {
      __builtin_amdgcn_fence(__ATOMIC_RELEASE, "agent");
      asm volatile("s_waitcnt vmcnt(0)" ::: "memory");
      const unsigned og = xb_add(&bar[XB_TOP], 1u);
      const unsigned tg = og / nx;
      if (og + 1u == (tg + 1u) * nx) xb_add(&bar[XB_TOPGEN], 1u);
      else XB_SPIN(xb_ld(&bar[XB_TOPGEN]) == tg, bar);
      __builtin_amdgcn_fence(__ATOMIC_ACQUIRE, "agent");
      xb_add(&bar[XB_XGEN(b.x)], 1u);
      asm volatile("s_waitcnt vmcnt(0)" ::: "memory");
    } else {
      XB_SPIN(xb_ld(&bar[XB_XGEN(b.x)]) == gen, bar);
      __builtin_amdgcn_fence(__ATOMIC_ACQUIRE, "agent");
      asm volatile("s_waitcnt vmcnt(0)" ::: "memory");
    }
  }
  __syncthreads();
}
constexpr size_t OFF_BAR = OFF_VB + 16777216 + 1048576;

DI void run_phase(const int TIDX, const P& p, int ph, int bid, int nb, char* smem, const bool dry = false) {
  char* ws = p.ws;
  char* big = ws + OFF_BIG;
  float* X = (float*)(ws + OFF_X);
  const float* mod = (const float*)(ws + OFF_MOD);
  bf16_t* H = (bf16_t*)(ws + OFF_H);
  switch (ph) {
    case 0: {
      mod_gemv(TIDX, p, 0, bid, nb, smem);
      tconv(TIDX, p.ev_w_in, 2560, 1024, 2560, (bf16_t*)(ws + OFF_WIN0), 1024, 0, bid, nb, smem);
      tconv(TIDX, p.ev_w_out, 1024, 1024, 1024, (bf16_t*)(ws + OFF_WOUT0), 1024, 0, bid, nb, smem);
      tconv(TIDX, p.pwq, 2048, 1024, 2048, (bf16_t*)(ws + OFF_WQ), 1024, 0, bid, nb, smem);
      tconv(TIDX, p.w2, 512, 64, 512, (bf16_t*)(ws + OFF_W2C), 64, 0, bid, nb, smem);
      tconv(TIDX, p.w2 + 64 * 512, 512, 64, 512, (bf16_t*)(ws + OFF_W2C) + 512 * 64, 64, 0, bid, nb, smem);
      tconv(TIDX, p.a2, 512, 64, 512, (bf16_t*)(ws + OFF_A2C), 64, 0, bid, nb, smem);
      tconv(TIDX, p.a2 + 64 * 512, 512, 64, 512, (bf16_t*)(ws + OFF_A2C) + 512 * 64, 64, 0, bid, nb, smem);
      tconv(TIDX, p.g2, 512, 128, 512, (bf16_t*)(ws + OFF_G2T), 128, 0, bid, nb, smem);
      conv_flat(TIDX, p.pkeys, (bf16_t*)(ws + OFF_KEYS), (size_t)2 * 16 * 128 * 128, bid, nb);
    } break;
    case 1: norm_rows(TIDX, p, 0, 0, true, false, bid, nb); break;
    case 2: {
      bf16_t* Z = (bf16_t*)(big + B_Z0);
      auto epi = [=](int m, int n, const float* v) { *(uint4*)(Z + (size_t)m * 2560 + n) = pack8(v); };
      big_gemm(TIDX, H, (const bf16_t*)(ws + OFF_WIN0), 1024, 72, 10, 0, epi, bid, nb, smem);
    } break;
    case 3: prep0(TIDX, p, bid, nb); break;
    case 4: {
      float* DEC = (float*)(big + B_DEC);
      bf16_t* AL = (bf16_t*)(big + B_AL);
      bf16_t* G = (bf16_t*)(big + B_G);
      const float* w0 = p.w0; const float* a0 = p.a0;
      auto epi1 = [=](int m, int n, const float* v) {
        int d = n >> 9, c = n & 511, hh = c >> 6, i = c & 63;
        int b = m / LT, pos = m - b * LT;
        float o[8];
#pragma unroll
        for (int j = 0; j < 8; j++) {
          float x = w0[n + j] + v[j];
          float w = -softplusf_(-x) - 0.5f;
          o[j] = __expf(-__expf(w));
        }
        float* dp = DEC + (size_t)d * (NB * 8 * LT * 64) + ((size_t)(b * 8 + hh) * LT + pos) * 64 + i;
        *(float4*)dp = make_float4(o[0], o[1], o[2], o[3]);
        *(float4*)(dp + 4) = make_float4(o[4], o[5], o[6], o[7]);
      };
      auto epi2 = [=](int m, int n, const float* v) {
        int d = n >> 9, c = n & 511, hh = c >> 6, i = c & 63;
        int b = m / LT, pos = m - b * LT;
        float o[8];
#pragma unroll
        for (int j = 0; j < 8; j++) o[j] = sigmoidf_(a0[n + j] + v[j]);
        *(uint4*)(AL + (size_t)d * (NB * 8 * LT * 64) + ((size_t)(b * 8 + hh) * LT + pos) * 64 + i) = pack8(o);
      };
      auto epi3 = [=](int m, int n, const float* v) { *(uint4*)(G + (size_t)m * 512 + n) = pack8(v); };
      for (int t = bid; t < 1440; t += nb) {
        if (t < 576) {
          gemm_tile(TIDX, (const bf16_t*)(big + B_AW), 64, (const bf16_t*)(ws + OFF_W2C), 64, 64, (t >> 3) * 256, (t & 7) * 128, epi1, smem);
        } else if (t < 1152) {
          int t2 = t - 576;
          gemm_tile(TIDX, (const bf16_t*)(big + B_AA), 64, (const bf16_t*)(ws + OFF_A2C), 64, 64, (t2 >> 3) * 256, (t2 & 7) * 128, epi2, smem);
        } else {
          int t2 = t - 1152;
          gemm_tile(TIDX, (const bf16_t*)(big + B_AG), 128, (const bf16_t*)(ws + OFF_G2T), 128, 128, (t2 >> 2) * 256, (t2 & 3) * 128, epi3, smem);
        }
      }
    } break;
    case 5: {
      if ((nb & 7) == 0) {
        const int hh = bid & 7;
        for (int lb = bid >> 3; lb < 32; lb += nb >> 3) wkv2_task(TIDX, p, (lb >> 2) * 32 + hh * 4 + (lb & 3), smem);
      } else {
        for (int t = bid; t < 256; t += nb) wkv2_task(TIDX, p, t, smem);
      }
      if ((nb & 7) == 0) attn_xcd(TIDX, p, bid, nb, smem);
      else for (int t = bid; t < 576; t += nb) attn_task(TIDX, p, t, smem);
    } break;
    case 22: wkv_finalize(TIDX, p, bid, nb); break;
    case 23: for (int t = bid; t < 256; t += nb) wkv2_task(TIDX, p, t, smem); break;
    case 24: for (int t = bid; t < 576; t += nb) attn_task(TIDX, p, t, smem); break;
    case 6: {
      const float* gate = mod;
      const float* xc_ = p.ctx; const float* xl_ = p.x;
      auto epi = [=](int m, int n, const float* v) {
        int b = m / LT, pos = m - b * LT;
        int rr = pos < LC ? 8 : b;
        const float* xr = (pos < LC ? xc_ + ((size_t)(b * LC + pos)) * DM : xl_ + ((size_t)(b * SEQ + pos - LC)) * DM) + n;
        const float* gp = gate + (size_t)rr * 6144 + 2 * 1024 + n;
        const float4 x0 = *(const float4*)xr, x1 = *(const float4*)(xr + 4), g0 = *(const float4*)gp, g1 = *(const float4*)(gp + 4);
        float* xo = X + (size_t)m * DM + n;
        *(float4*)xo = make_float4(x0.x + g0.x * v[0], x0.y + g0.y * v[1], x0.z + g0.z * v[2], x0.w + g0.w * v[3]);
        *(float4*)(xo + 4) = make_float4(x1.x + g1.x * v[4], x1.y + g1.y * v[5], x1.z + g1.z * v[6], x1.w + g1.w * v[7]);
      };
      big_gemm(TIDX, (const bf16_t*)(big + B_YMIX), (const bf16_t*)(ws + OFF_WOUT0), 1024, 72, 4, 0, epi, bid, nb, smem);
      if (nb > 64 && bid >= 32) {
        mod_gemv(TIDX, p, 1, bid - 32, nb - 32, smem);
        tconv(TIDX, p.ssd_w_in, 5184, 1024, 5184, (bf16_t*)(ws + OFF_WIN1), 1024, 0, bid - 32, nb - 32, smem);
        tconv(TIDX, p.ssd_w_out, 1024, 2048, 1024, (bf16_t*)(ws + OFF_WOUT1), 2048, 0, bid - 32, nb - 32, smem);
        tconv(TIDX, p.pwq + 1024 * 2048, 2048, 1024, 2048, (bf16_t*)(ws + OFF_WQ) + 2048 * 1024, 1024, 0, bid - 32, nb - 32, smem);
      } else if (nb <= 64) {
        mod_gemv(TIDX, p, 1, bid, nb, smem);
        tconv(TIDX, p.ssd_w_in, 5184, 1024, 5184, (bf16_t*)(ws + OFF_WIN1), 1024, 0, bid, nb, smem);
        tconv(TIDX, p.ssd_w_out, 1024, 2048, 1024, (bf16_t*)(ws + OFF_WOUT1), 2048, 0, bid, nb, smem);
        tconv(TIDX, p.pwq + 1024 * 2048, 2048, 1024, 2048, (bf16_t*)(ws + OFF_WQ) + 2048 * 1024, 1024, 0, bid, nb, smem);
      }
    } break;
    case 7: norm_rows(TIDX, p, 0, 1, false, false, bid, nb); break;
    case 8: {
      bf16_t* QP = (bf16_t*)(big + B_QP);
      auto epi = [=](int m, int n, const float* v) { *(uint4*)(QP + (size_t)m * 2048 + n) = pack8(v); };
      big_gemm(TIDX, H, (const bf16_t*)(ws + OFF_WQ), 1024, 72, 8, 0, epi, bid, nb, smem);
      if (nb > 128 && bid >= 64) {
        conv_fp8(TIDX, p.pu, (unsigned char*)(ws + OFF_UB), (float*)(ws + OFF_UB + 16777216), bid - 64, nb - 64);
        conv_fp8(TIDX, p.pv, (unsigned char*)(ws + OFF_VB), (float*)(ws + OFF_VB + 16777216), bid - 64, nb - 64);
      } else if (nb <= 128) {
        conv_fp8(TIDX, p.pu, (unsigned char*)(ws + OFF_UB), (float*)(ws + OFF_UB + 16777216), bid, nb);
        conv_fp8(TIDX, p.pv, (unsigned char*)(ws + OFF_VB), (float*)(ws + OFF_VB + 16777216), bid, nb);
      }
    } break;
    case 9: break;
    case 10:
      if ((nb & 7) == 0) { for (int tile = bid >> 3; tile < 72; tile += nb >> 3) route2_task(TIDX, p, 0, tile * 256, bid & 7, smem, tile == (bid >> 3)); }
      else for (int t = bid; t < 72 * 8; t += nb) route2_task(TIDX, p, 0, (t >> 3) * 256, t & 7, smem);
      break;
    case 26: peer_u2(TIDX, p, false, bid, nb); break;
    case 27: peer_u2(TIDX, p, true, bid, nb); break;
    case 11: peer_gather(TIDX, p, 0, false, bid, nb, dry); break;
    case 12: {
      bf16_t* ZG = (bf16_t*)(big + B_ZG);
      bf16_t* ZX = (bf16_t*)(big + B_ZX);
      float* DT = (float*)(big + B_DT);
      auto epi = [=](int m, int n, const float* v) {
        if (n < 2048) *(uint4*)(ZG + (size_t)m * 2048 + n) = pack8(v);
        else if (n < 5120) *(uint4*)(ZX + (size_t)m * 3072 + n - 2048) = pack8(v);
        else if (n < 5184) {
          float* dp = DT + (size_t)m * 64 + n - 5120;
          *(float4*)dp = make_float4(v[0], v[1], v[2], v[3]);
          *(float4*)(dp + 4) = make_float4(v[4], v[5], v[6], v[7]);
        }
      };
      big_gemm(TIDX, H, (const bf16_t*)(ws + OFF_WIN1), 1024, 72, 21, 0, epi, bid, nb, smem);
    } break;
    case 13: {
      conv_phase(TIDX, p, bid, nb);
      conv_fp8(TIDX, p.pu + (size_t)16384 * 1024, (unsigned char*)(ws + OFF_UB), (float*)(ws + OFF_UB + 16777216), bid, nb);
      conv_fp8(TIDX, p.pv + (size_t)16384 * 1024, (unsigned char*)(ws + OFF_VB), (float*)(ws + OFF_VB + 16777216), bid, nb);
    } break;
    case 14:
      if ((nb & 7) == 0) {
        const int xcd = bid & 7, st = nb >> 3;
        for (int lb = bid >> 3; lb < 32; lb += st) {
          const int gi = xcd + 8 * (lb >> 3), hh = lb & 7;
          ssd_task(TIDX, p, (gi >> 2) * 32 + (gi & 3) * 8 + hh, smem);
        }
      } else {
        for (int t = bid; t < 256; t += nb) ssd_task(TIDX, p, t, smem);
      }
      break;
    case 15: gate_norm(TIDX, p, bid, nb); break;
    case 16: {
      const float* gate = mod + (size_t)9 * 6144;
      auto epi = [=](int m, int n, const float* v) {
        int b = m / LT;
        const float* gp = gate + (size_t)b * 6144 + 2 * 1024 + n;
        const float4 g0 = *(const float4*)gp, g1 = *(const float4*)(gp + 4);
        float* xo = X + (size_t)m * DM + n;
        const float4 x0 = *(const float4*)xo, x1 = *(const float4*)(xo + 4);
        *(float4*)xo = make_float4(x0.x + g0.x * v[0], x0.y + g0.y * v[1], x0.z + g0.z * v[2], x0.w + g0.w * v[3]);
        *(float4*)(xo + 4) = make_float4(x1.x + g1.x * v[4], x1.y + g1.y * v[5], x1.z + g1.z * v[6], x1.w + g1.w * v[7]);
      };
      big_gemm(TIDX, (const bf16_t*)(big + B_YN), (const bf16_t*)(ws + OFF_WOUT1), 2048, 64, 4, 1, epi, bid, nb, smem);
    } break;
    case 17: norm_rows(TIDX, p, 1, 1, false, true, bid, nb); break;
    case 18: {
      bf16_t* QP = (bf16_t*)(big + B_QP);
      auto epi = [=](int m, int n, const float* v) { *(uint4*)(QP + (size_t)m * 2048 + n) = pack8(v); };
      big_gemm(TIDX, H, (const bf16_t*)(ws + OFF_WQ) + 2048 * 1024, 1024, 64, 8, 1, epi, bid, nb, smem);
    } break;
    case 19: break;
    case 20:
      if ((nb & 7) == 0) {
        for (int mtl = bid >> 3; mtl < 64; mtl += nb >> 3) {
          int b = mtl >> 3, mt = b * 9 + 1 + (mtl & 7);
          route2_task(TIDX, p, 1, mt * 256, bid & 7, smem, mtl == (bid >> 3));
        }
      } else
      for (int t = bid; t < 64 * 8; t += nb) {
        int mtl = t >> 3, b = mtl >> 3, mt = b * 9 + 1 + (mtl & 7);
        route2_task(TIDX, p, 1, mt * 256, t & 7, smem);
      }
      break;
    case 21: peer_gather(TIDX, p, 1, true, bid, nb, false); break;
  }
}
constexpr int NPHASE = 22;
#ifndef EXTRA
#define EXTRA
#endif
#ifndef DUP_MASK
#define DUP_MASK 0u
#endif

__global__ void __launch_bounds__(NTHR) mega(P p) {
  __shared__ __attribute__((aligned(16))) char smem[SMEM_BYTES];
  cg::grid_group grid = cg::this_grid();
  __shared__ uint4 xb_words;
  if (threadIdx.x == 0) xb_words = make_uint4(0u, 0u, 0u, 0u);
  __syncthreads();
  XcdBarrier xb = xcd_barrier_post((unsigned*)(p.ws + OFF_BAR), (volatile LAS unsigned*)&xb_words);
  if (gridDim.x == 0x7fffffffu) grid.sync();
#define PHC(i, last)                                             \
  {                                                              \
    P q = p;                                                     \
    int bid = blockIdx.x, nb = gridDim.x;                        \
    char* sm = smem;                                             \
    int TIDX = __builtin_amdgcn_workitem_id_x();                 \
    asm volatile("" : "+s"(q.ws), "+s"(bid), "+s"(nb), "+v"(TIDX)); \
    if ((DUP_MASK >> i) & 1) { run_phase(TIDX, q, i, bid, nb, sm, true); xcd_barrier(xb); } \
    run_phase(TIDX, q, i, bid, nb, sm);                          \
    if (!last) xcd_barrier(xb);                                  \
  }
#define PHN(i)                                                   \
  {                                                              \
    P q = p;                                                     \
    int bid = blockIdx.x, nb = gridDim.x;                        \
    char* sm = smem;                                             \
    int TIDX = __builtin_amdgcn_workitem_id_x();                 \
    asm volatile("" : "+s"(q.ws), "+s"(bid), "+s"(nb), "+v"(TIDX)); \
    run_phase(TIDX, q, i, bid, nb, sm);                          \
  }
  PHC(0, 0) PHC(1, 0) PHC(2, 0) PHC(3, 0) PHC(4, 0) PHC(5, 0) EXTRA PHC(22, 0) PHC(6, 0) PHC(7, 0) PHC(8, 0) PHC(10, 0) PHN(26)
  PHC(11, 0) PHC(12, 0) PHC(13, 0) PHC(14, 0) PHC(15, 0) PHC(16, 0) PHC(17, 0) PHC(18, 0) PHC(20, 0) PHN(27) PHC(21, 1)
}

extern "C" void kernel_launch(void* const* d_in, const int* in_sizes, int n_in, void* d_out, int out_size, void* d_ws,
                              size_t ws_size, hipStream_t stream) {
  static int grid_blocks = 0;
  if (!grid_blocks) {
    int dev = 0, cus = 0, per_cu = 0;
    hipGetDevice(&dev);
    hipDeviceGetAttribute(&cus, hipDeviceAttributeMultiprocessorCount, dev);
    hipOccupancyMaxActiveBlocksPerMultiprocessor(&per_cu, mega, NTHR, 0);
    if (per_cu < 1) per_cu = 1;
    grid_blocks = cus * per_cu;
  }
  P p;
  memset(&p, 0, sizeof(p));
  const float** fp = (const float**)&p;
  for (int i = 0; i < 35; i++) fp[i] = (const float*)d_in[i];
  p.out = (float*)d_out;
  p.ws = (char*)d_ws;
  if (ws_size < WS_NEED) fprintf(stderr, "workspace too small: %zu < %zu\n", ws_size, (size_t)WS_NEED);
  hipMemsetAsync((char*)d_ws + OFF_BAR, 0, XCD_BAR_WORDS * sizeof(unsigned), stream);
  void* args[] = {&p};
  hipError_t e = hipLaunchCooperativeKernel((void*)mega, dim3(grid_blocks), dim3(NTHR), args, 0, stream);
  if (e != hipSuccess) fprintf(stderr, "cooperative launch failed: %s (grid %d)\n", hipGetErrorString(e), grid_blocks);
}
```
